# Optimizing an MI355X kernel written in HIP

```python
import math
import jax, jax.numpy as jnp
from jax import lax
import numpy as np

D_MODEL = 4096
BATCH = 4
SEQ = 2048
DEPTH = 2

N_META = 16
NORM_EPS = 1e-6
POOL_WIDTH = D_MODEL // 2
POOL_WINDOWS = (2, 4, 8, 16)
POOL_GROUP = POOL_WIDTH // len(POOL_WINDOWS)
RWKV_WIDTH = D_MODEL // 2
RWKV_HEAD = 64
RWKV_HEADS = RWKV_WIDTH // RWKV_HEAD
RWKV_W_RANK = 96
RWKV_A_RANK = 96
RWKV_G_RANK = 256
RWKV_GN_EPS = 64e-5
RWKV_SPLITS = (RWKV_WIDTH, 2 * RWKV_WIDTH, 3 * RWKV_WIDTH,
               3 * RWKV_WIDTH + RWKV_W_RANK, 3 * RWKV_WIDTH + RWKV_W_RANK + RWKV_A_RANK)
SHIFT_COLS = 3 * RWKV_WIDTH + RWKV_W_RANK + RWKV_A_RANK + RWKV_G_RANK
IN_EVEN_COLS = POOL_WIDTH + SHIFT_COLS
SSM_WIDTH = D_MODEL // 2
SSM_GROUP = 16
SSM_GROUPS = SSM_WIDTH // SSM_GROUP
SSM_STATE = 64
SSM_DT_MIN = 1e-3
SSM_DT_MAX = 1e-1
PEER_KEYS = 128
PEER_EXPERTS = PEER_KEYS * PEER_KEYS
PEER_HEADS = 8
PEER_TOPK = 16
PEER_QHALF = 128
PEER_QDIM = 2 * PEER_QHALF
TOKEN_BLOCK = 64

N_EVEN = (DEPTH + 1) // 2
N_ODD = DEPTH // 2

kernel_name = "hybrid_pool_rwkv7_s5_peer_meta"


def rms_norm(x, gain):
    xf = x.astype(jnp.float32)
    inv = lax.rsqrt(jnp.mean(xf * xf, axis=-1, keepdims=True) + NORM_EPS)
    return (xf * inv).astype(x.dtype) * gain


def shift_prev(z):
    return jnp.pad(z, ((0, 0), (1, 0), (0, 0)))[:, :-1]


def pool_mixer(z, pool_w, pool_scale):
    bsz, L, _ = z.shape
    zg = z.astype(jnp.float32).reshape(bsz, L, len(POOL_WINDOWS), POOL_GROUP)
    cs = jnp.cumsum(zg, axis=1)
    pos1 = jnp.arange(1, L + 1, dtype=jnp.float32)
    outs = []
    for i, w in enumerate(POOL_WINDOWS):
        c = cs[:, :, i]
        lag = jnp.pad(c, ((0, 0), (w, 0), (0, 0)))[:, :L]
        cnt = jnp.minimum(pos1, float(w))[None, :, None]
        outs.append((c - lag) / cnt - zg[:, :, i])
    m = jnp.stack(outs, axis=2)
    y = jnp.einsum('blgc,gcd->blgd', m, pool_w.astype(jnp.float32))
    return (y.reshape(bsz, L, POOL_WIDTH) * pool_scale).astype(z.dtype)


def rwkv7_mixer(z, shift_mu, w0, w2, a0, a2, g2, k_k, k_a, r_k, gn_gain, gn_bias):
    bsz, L, _ = z.shape
    f32 = jnp.float32
    z = z + (shift_prev(z) - z) * shift_mu
    r, k, v, w_lr, a_lr, g_lr = jnp.split(z, RWKV_SPLITS, axis=-1)
    w = -jax.nn.softplus(-(w0 + jnp.tanh(w_lr) @ w2).astype(f32)) - 0.5
    decay = jnp.exp(-jnp.exp(w))
    a = jax.nn.sigmoid(a0 + a_lr @ a2)
    g = jax.nn.sigmoid(g_lr) @ g2
    heads = lambda t: t.reshape(bsz, L, RWKV_HEADS, RWKV_HEAD).astype(f32)
    kk = heads(k * k_k)
    kk = kk / jnp.maximum(jnp.sqrt(jnp.sum(kk * kk, axis=-1, keepdims=True)), 1e-12)
    k = k * (1 + (a - 1) * k_a)
    r_h, k_h, v_h, a_h, w_h = heads(r), heads(k), heads(v), heads(a), heads(decay)

    def step(S, inp):
        r_t, w_t, k_t, v_t, kk_t, a_t = inp
        sa = jnp.einsum('bhij,bhj->bhi', S, -kk_t)
        S = (S * w_t[:, :, None, :] + sa[..., None] * (kk_t * a_t)[:, :, None, :]
             + v_t[..., None] * k_t[:, :, None, :])
        return S, jnp.einsum('bhij,bhj->bhi', S, r_t)

    S0 = jnp.zeros((bsz, RWKV_HEADS, RWKV_HEAD, RWKV_HEAD), f32)
    xs = tuple(jnp.moveaxis(t, 1, 0) for t in (r_h, w_h, k_h, v_h, kk, a_h))
    _, y = lax.scan(step, S0, xs)
    y = jnp.moveaxis(y, 0, 1)
    mean = jnp.mean(y, axis=-1, keepdims=True)
    var = jnp.mean(jnp.square(y - mean), axis=-1, keepdims=True)
    y = ((y - mean) * lax.rsqrt(var + RWKV_GN_EPS)).reshape(bsz, L, RWKV_WIDTH) * gn_gain + gn_bias
    bonus = jnp.sum(r_h * k_h * r_k, axis=-1, keepdims=True) * v_h
    y = (y + bonus.reshape(bsz, L, RWKV_WIDTH)) * g.astype(f32)
    return y.astype(z.dtype)


def _complex_affine_combine(e1, e2):
    a1r, a1i, b1r, b1i = e1
    a2r, a2i, b2r, b2i = e2
    return (a2r * a1r - a2i * a1i,
            a2r * a1i + a2i * a1r,
            a2r * b1r - a2i * b1i + b2r,
            a2r * b1i + a2i * b1r + b2i)


def s5_mixer(u, lam_re, lam_im, log_dt, b_re, b_im, c_re, c_im, d_skip):
    bsz, L, _ = u.shape
    f32 = jnp.float32
    uf = u.astype(f32).reshape(bsz, L, SSM_GROUPS, SSM_GROUP)
    lr, li = lam_re.astype(f32), lam_im.astype(f32)
    dt = jnp.exp(log_dt.astype(f32))[:, None]
    mag = jnp.exp(lr * dt)
    ar, ai = mag * jnp.cos(li * dt), mag * jnp.sin(li * dt)
    den = lr * lr + li * li
    fr = ((ar - 1.0) * lr + ai * li) / den
    fi = (ai * lr - (ar - 1.0) * li) / den
    br, bi = b_re.astype(f32), b_im.astype(f32)
    bbar_re = fr[..., None] * br - fi[..., None] * bi
    bbar_im = fr[..., None] * bi + fi[..., None] * br
    bu_re = jnp.einsum('blgc,gpc->blgp', uf, bbar_re)
    bu_im = jnp.einsum('blgc,gpc->blgp', uf, bbar_im)
    a_re = jnp.broadcast_to(ar, (1, L) + ar.shape)
    a_im = jnp.broadcast_to(ai, (1, L) + ai.shape)
    _, _, x_re, x_im = lax.associative_scan(_complex_affine_combine, (a_re, a_im, bu_re, bu_im), axis=1)
    y = (jnp.einsum('gcp,blgp->blgc', c_re.astype(f32), x_re)
         - jnp.einsum('gcp,blgp->blgc', c_im.astype(f32), x_im)
         + uf * d_skip.astype(f32).reshape(SSM_GROUPS, SSM_GROUP))
    return y.reshape(bsz, L, SSM_WIDTH).astype(u.dtype)


def peer_ffn(h, w_q, sub_keys, u_emb, v_emb):
    bsz, L, D = h.shape
    f32 = jnp.float32
    q = (h @ w_q).reshape(bsz, L, PEER_HEADS, 2, PEER_QHALF).astype(f32)
    s = jnp.einsum('blhpd,hpnd->blhpn', q, sub_keys.astype(f32))
    s1, i1 = lax.top_k(s[..., 0, :], PEER_TOPK)
    s2, i2 = lax.top_k(s[..., 1, :], PEER_TOPK)
    n_cand = PEER_TOPK * PEER_TOPK
    cand_s = (s1[..., :, None] + s2[..., None, :]).reshape(bsz, L, PEER_HEADS, n_cand)
    cand_id = (i1[..., :, None] * PEER_KEYS + i2[..., None, :]).reshape(bsz, L, PEER_HEADS, n_cand)
    top_s, pos = lax.top_k(cand_s, PEER_TOPK)
    eid = jnp.take_along_axis(cand_id, pos, axis=-1)
    gate = jax.nn.softmax(top_s, axis=-1).astype(h.dtype)

    n_tok = bsz * L
    pad = (-n_tok) % TOKEN_BLOCK
    n_blk = (n_tok + pad) // TOKEN_BLOCK

    def blockify(t):
        t = t.reshape((n_tok,) + t.shape[2:])
        t = jnp.pad(t, [(0, pad)] + [(0, 0)] * (t.ndim - 1))
        return t.reshape((n_blk, TOKEN_BLOCK) + t.shape[1:])

    def expert_block(args):
        hb, eb, gb = args
        act = jax.nn.gelu(jnp.einsum('cd,chkd->chk', hb, u_emb[eb]), approximate=False)
        return jnp.einsum('chk,chkd->cd', gb * act, v_emb[eb])

    out = lax.map(expert_block, (blockify(h), blockify(eid), blockify(gate)))
    return out.reshape(n_blk * TOKEN_BLOCK, D)[:n_tok].reshape(bsz, L, D)


def setup_inputs(seed: int = 0) -> dict:
    key = jax.random.key(seed)
    ks = iter(jax.random.split(key, 48))
    f32 = jnp.float32
    nrm = lambda shape, scale: scale * jax.random.normal(next(ks), shape, f32)
    gain = lambda shape: 1.0 + nrm(shape, 0.02)
    uni = lambda shape, lo, hi: jax.random.uniform(next(ks), shape, f32, minval=lo, maxval=hi)
    G, P = SSM_GROUPS, SSM_STATE
    return {
        "x": nrm((BATCH, SEQ, D_MODEL), 1.0),
        "meta_tokens": nrm((N_META, D_MODEL), 1.0),
        "mix_norm_gain": gain((DEPTH, D_MODEL)),
        "ffn_norm_gain": gain((DEPTH, D_MODEL)),
        "final_norm_gain": gain((D_MODEL,)),
        "w_in_even": nrm((N_EVEN, D_MODEL, IN_EVEN_COLS), D_MODEL ** -0.5),
        "pool_w": nrm((N_EVEN, len(POOL_WINDOWS), POOL_GROUP, POOL_GROUP), POOL_GROUP ** -0.5),
        "pool_scale": gain((N_EVEN, POOL_WIDTH)),
        "shift_mu": uni((N_EVEN, SHIFT_COLS), 0.0, 1.0),
        "rwkv_w0": uni((N_EVEN, RWKV_WIDTH), -4.0, 0.0),
        "rwkv_w2": nrm((N_EVEN, RWKV_W_RANK, RWKV_WIDTH), 0.5 * RWKV_W_RANK ** -0.5),
        "rwkv_a0": nrm((N_EVEN, RWKV_WIDTH), 0.1),
        "rwkv_a2": nrm((N_EVEN, RWKV_A_RANK, RWKV_WIDTH), 0.5 * RWKV_A_RANK ** -0.5),
        "rwkv_g2": nrm((N_EVEN, RWKV_G_RANK, RWKV_WIDTH), RWKV_G_RANK ** -0.5),
        "rwkv_k_k": 0.85 + nrm((N_EVEN, RWKV_WIDTH), 0.05),
        "rwkv_k_a": 1.0 + nrm((N_EVEN, RWKV_WIDTH), 0.05),
        "rwkv_r_k": nrm((N_EVEN, RWKV_HEADS, RWKV_HEAD), 0.1),
        "rwkv_gn_gain": gain((N_EVEN, RWKV_WIDTH)),
        "rwkv_gn_bias": nrm((N_EVEN, RWKV_WIDTH), 0.02),
        "w_out_even": nrm((N_EVEN, POOL_WIDTH + RWKV_WIDTH, D_MODEL), (POOL_WIDTH + RWKV_WIDTH) ** -0.5),
        "w_in_odd": nrm((N_ODD, D_MODEL, SSM_WIDTH), D_MODEL ** -0.5),
        "ssm_lam_re": -0.5 + nrm((N_ODD, G, P), 0.01),
        "ssm_lam_im": jnp.pi * jnp.arange(P, dtype=f32) + nrm((N_ODD, G, P), 0.01),
        "ssm_log_dt": uni((N_ODD, G), math.log(SSM_DT_MIN), math.log(SSM_DT_MAX)),
        "ssm_b_re": nrm((N_ODD, G, P, SSM_GROUP), (2 * SSM_GROUP) ** -0.5),
        "ssm_b_im": nrm((N_ODD, G, P, SSM_GROUP), (2 * SSM_GROUP) ** -0.5),
        "ssm_c_re": nrm((N_ODD, G, SSM_GROUP, P), P ** -0.5),
        "ssm_c_im": nrm((N_ODD, G, SSM_GROUP, P), P ** -0.5),
        "ssm_d": nrm((N_ODD, SSM_WIDTH), 1.0),
        "w_glu": nrm((N_ODD, SSM_WIDTH, 2 * D_MODEL), SSM_WIDTH ** -0.5),
        "peer_w_q": nrm((DEPTH, D_MODEL, PEER_HEADS * PEER_QDIM), D_MODEL ** -0.5),
        "peer_sub_keys": nrm((DEPTH, PEER_HEADS, 2, PEER_KEYS, PEER_QHALF), PEER_QHALF ** -0.5),
        "peer_u": nrm((DEPTH, PEER_EXPERTS, D_MODEL), D_MODEL ** -0.5),
        "peer_v": nrm((DEPTH, PEER_EXPERTS, D_MODEL), PEER_HEADS ** -0.5),
    }


def reference(x, meta_tokens, mix_norm_gain, ffn_norm_gain, final_norm_gain,
              w_in_even, pool_w, pool_scale, shift_mu, rwkv_w0, rwkv_w2, rwkv_a0, rwkv_a2,
              rwkv_g2, rwkv_k_k, rwkv_k_a, rwkv_r_k, rwkv_gn_gain, rwkv_gn_bias, w_out_even,
              w_in_odd, ssm_lam_re, ssm_lam_im, ssm_log_dt, ssm_b_re, ssm_b_im, ssm_c_re,
              ssm_c_im, ssm_d, w_glu, peer_w_q, peer_sub_keys, peer_u, peer_v):
    bsz = x.shape[0]
    meta = jnp.broadcast_to(meta_tokens[None].astype(x.dtype), (bsz, N_META, D_MODEL))
    h = jnp.concatenate([meta, x], axis=1)
    for layer in range(DEPTH):
        hn = rms_norm(h, mix_norm_gain[layer])
        if layer % 2 == 0:
            i = layer // 2
            z = hn @ w_in_even[i]
            y_pool = pool_mixer(z[..., :POOL_WIDTH], pool_w[i], pool_scale[i])
            y_rwkv = rwkv7_mixer(z[..., POOL_WIDTH:], shift_mu[i], rwkv_w0[i], rwkv_w2[i],
                                 rwkv_a0[i], rwkv_a2[i], rwkv_g2[i], rwkv_k_k[i], rwkv_k_a[i],
                                 rwkv_r_k[i], rwkv_gn_gain[i], rwkv_gn_bias[i])
            h = h + jnp.concatenate([y_pool, y_rwkv], axis=-1) @ w_out_even[i]
        else:
            j = layer // 2
            u = hn @ w_in_odd[j]
            y = jax.nn.gelu(s5_mixer(u, ssm_lam_re[j], ssm_lam_im[j], ssm_log_dt[j], ssm_b_re[j],
                                     ssm_b_im[j], ssm_c_re[j], ssm_c_im[j], ssm_d[j]),
                            approximate=False)
            ga, gb = jnp.split(y @ w_glu[j], 2, axis=-1)
            h = h + ga * jax.nn.sigmoid(gb)
        h = h + peer_ffn(rms_norm(h, ffn_norm_gain[layer]), peer_w_q[layer], peer_sub_keys[layer],
                         peer_u[layer], peer_v[layer])
    return rms_norm(h, final_norm_gain)[:, N_META:]
```

```cpp
#include <hip/hip_runtime.h>
#include <cstdio>
#include <cstdint>

#define LAS __attribute__((address_space(3)))
typedef unsigned short bf16_t;
typedef short bf16x8 __attribute__((ext_vector_type(8)));
typedef __bf16 bf16x2 __attribute__((ext_vector_type(2)));
typedef float f32x4 __attribute__((ext_vector_type(4)));
typedef float f32x2 __attribute__((ext_vector_type(2)));
typedef unsigned u32x4 __attribute__((ext_vector_type(4)));
typedef unsigned u32x2 __attribute__((ext_vector_type(2)));

__device__ __forceinline__ unsigned f2bf(float f) { unsigned u = __builtin_bit_cast(unsigned, f); return (u + 0x7fffu + ((u >> 16) & 1u)) >> 16; }
__device__ __forceinline__ unsigned pk2(float lo, float hi) { return f2bf(lo) | (f2bf(hi) << 16); }
__device__ __forceinline__ unsigned cvt_pk_bf16(float lo, float hi) { unsigned r; asm volatile("v_cvt_pk_bf16_f32 %0, %1, %2" : "=v"(r) : "v"(lo), "v"(hi)); return r; }
__device__ __forceinline__ float bflo(unsigned w) { return __builtin_bit_cast(float, w << 16); }
__device__ __forceinline__ float bfhi(unsigned w) { return __builtin_bit_cast(float, w & 0xffff0000u); }
__device__ __forceinline__ float bf2f(bf16_t b) { return __builtin_bit_cast(float, ((unsigned)b) << 16); }
__device__ __forceinline__ float dot2(unsigned a, unsigned b, float acc) { return __builtin_amdgcn_fdot2_f32_bf16(__builtin_bit_cast(bf16x2, a), __builtin_bit_cast(bf16x2, b), acc, false); }
template <int CTRL> __device__ __forceinline__ float dppf(float x) { return __builtin_bit_cast(float, __builtin_amdgcn_mov_dpp(__builtin_bit_cast(int, x), CTRL, 0xf, 0xf, true)); }
template <int CTRL> __device__ __forceinline__ unsigned dppu(unsigned x) { return (unsigned)__builtin_amdgcn_mov_dpp((int)x, CTRL, 0xf, 0xf, true); }
constexpr int DPP_XOR1 = 0xB1, DPP_XOR2 = 0x4E, DPP_HMIRROR = 0x141, DPP_MIRROR = 0x140;
__device__ __forceinline__ float sum8(float x) { x += dppf<DPP_XOR1>(x); x += dppf<DPP_XOR2>(x); x += dppf<DPP_HMIRROR>(x); return x; }
__device__ __forceinline__ float sum16(float x) { x = sum8(x); x += dppf<DPP_MIRROR>(x); return x; }
__device__ __forceinline__ float sum64(float x) {
    x = sum16(x);
    { const auto s = __builtin_amdgcn_permlane16_swap(__float_as_uint(x), __float_as_uint(x), false, false); const unsigned a = s[0], b = s[1]; x = __uint_as_float(a) + __uint_as_float(b); }
    { const auto t = __builtin_amdgcn_permlane32_swap(__float_as_uint(x), __float_as_uint(x), false, false); const unsigned a = t[0], b = t[1]; x = __uint_as_float(a) + __uint_as_float(b); }
    return x;
}
__device__ __forceinline__ unsigned umax_u(unsigned a, unsigned b) { return a > b ? a : b; }
__device__ __forceinline__ unsigned max64u(unsigned x) {
    x = umax_u(x, dppu<DPP_XOR1>(x)); x = umax_u(x, dppu<DPP_XOR2>(x)); x = umax_u(x, dppu<DPP_HMIRROR>(x)); x = umax_u(x, dppu<DPP_MIRROR>(x));
    auto s = __builtin_amdgcn_permlane16_swap(x, x, false, false); x = umax_u(s[0], s[1]);
    auto t = __builtin_amdgcn_permlane32_swap(x, x, false, false); return umax_u(t[0], t[1]);
}
__device__ __forceinline__ float gelu_erf(float v) { return 0.5f * v * (1.0f + erff(v * 0.70710678118654752f)); }
__device__ __forceinline__ float sigmoidf_(float v) { return 1.0f / (1.0f + __expf(-v)); }
#define DBG_SKIP 0
namespace pg8 {
#define PG8_LAS __attribute__((address_space(3)))
constexpr int BM = 256, BK = 64, HALF = 128, HTB = HALF * BK * 2  , STAGE_BYTES = 8 * HTB, NXCD = 8, WGM = 8;

__host__ __device__ __forceinline__ int lds_byte(int r, int c) { const int st = (r >> 4) * 2 + (c >> 5), rr = r & 15, cc = c & 31, ob = rr * 64 + cc * 2; return st * 1024 + (ob ^ (((ob >> 9) & 1) << 5)); }
__host__ __device__ __forceinline__ void stage_rc(int b, int& R, int& C) { const int st = b / 1024, sb = b % 1024, swz = sb ^ (((sb >> 9) & 1) << 5); R = (st >> 1) * 16 + swz / 64; C = (st & 1) * 32 + (swz % 64) / 2; }
__host__ __device__ __forceinline__ int perm32(int rho) { const int n = rho >> 4, i = rho & 15; return 8 * (i >> 2) + 4 * n + (i & 3); }

struct Unit { int pm, pn; };
struct Gemm { const bf16_t* A; const bf16_t* Bt; int lda, ldb, K; };

struct StaticOrder {
    int nM, nN, nwg, G, c, kdiv, kmul;
    __device__ void init(int nM_, int nN_, int G_, int c_, int kdiv_ = 1 << 30, int kmul_ = 0) { nM = nM_; nN = nN_; nwg = nM * nN; G = G_; c = c_; kdiv = kdiv_; kmul = kmul_; }
    __device__ bool next(int i, Unit& u) const {
        const long L = (long)i * G + c; if (L >= nwg) return false;
        int wgid = (int)L; { const int q = nwg / NXCD, r = nwg % NXCD, xcd = wgid % NXCD, off = wgid / NXCD; wgid = (xcd < r ? xcd * (q + 1) : r * (q + 1) + (xcd - r) * q) + off; }
        const int nig = WGM * nN, gid = wgid / nig, fm = gid * WGM, gsz = (nM - fm) < WGM ? (nM - fm) : WGM;
        u.pm = fm + ((wgid % nig) % gsz); u.pn = (wgid % nig) / gsz; return true;
    }
    __device__ __forceinline__ int koff(const Unit& u) const { return (u.pn / kdiv) * kmul; }
};

template <class Epi, class Sched, bool ALIGN_EPI>
__device__ __forceinline__ void gemm_phase(PG8_LAS unsigned char* lds, const Gemm g, const Sched& S, const Epi& E) {
    int tid = threadIdx.x; asm volatile("" : "+v"(tid));
    const int wid = __builtin_amdgcn_readfirstlane(tid >> 6), lane = tid & 63, wr = wid >> 2, wc = wid & 3, fr = lane & 15, fq = lane >> 4;
    const int K = g.K, nt = K / BK;
    unsigned voffA[2], voffB[2];
#pragma unroll
    for (int i = 0; i < 2; ++i) { int R, C; stage_rc(tid * 16 + i * 8192, R, C); const int Rb = Epi::PERM ? ((R & ~31) + perm32(R & 31)) : R;
        voffA[i] = (unsigned)(R * g.lda + C) * 2u; voffB[i] = (unsigned)(Rb * g.ldb + C) * 2u; }
    const size_t kstep = (size_t)(BK * 2);
    const size_t hstepA = (size_t)HALF * g.lda * 2, hstepB = (size_t)HALF * g.ldb * 2;
    const size_t tstepA = 2 * hstepA, tstepB = 2 * hstepB;
    const unsigned ldsw = (unsigned)wid * 1024u;
    const int aoff = lds_byte(wr * 64 + fr, fq * 8), boff = lds_byte(wc * 32 + fr, fq * 8);
#define PG8_SA(b, h) (((b) * 2 + (h)) * HTB)
#define PG8_SB(b, h) ((4 + (b) * 2 + (h)) * HTB)
#define PG8_STAGE(bufoff, gbase, voff) do { _Pragma("unroll") for (int _i = 0; _i < 2; ++_i) \
        __builtin_amdgcn_global_load_lds((const unsigned*)((const char*)(gbase) + (voff)[_i]), (PG8_LAS unsigned*)(lds + (bufoff) + ldsw + _i * 8192), 16, 0, 0); } while (0)
#define PG8_LDA(dst, b, h) do { _Pragma("unroll") for (int m = 0; m < 4; ++m) _Pragma("unroll") for (int k = 0; k < 2; ++k) dst[m][k] = *(const PG8_LAS bf16x8*)(lds + PG8_SA(b, h) + aoff + m * 2048 + k * 1024); } while (0)
#define PG8_LDB(dst, b, h) do { _Pragma("unroll") for (int n = 0; n < 2; ++n) _Pragma("unroll") for (int k = 0; k < 2; ++k) dst[n][k] = *(const PG8_LAS bf16x8*)(lds + PG8_SB(b, h) + boff + n * 2048 + k * 1024); } while (0)
#define PG8_MMA(ai, bj, At, Bt) do { __builtin_amdgcn_s_setprio(1); _Pragma("unroll") for (int m = 0; m < 4; ++m) _Pragma("unroll") for (int n = 0; n < 2; ++n) _Pragma("unroll") for (int k = 0; k < 2; ++k) \
        acc[ai][bj][m][n] = __builtin_amdgcn_mfma_f32_16x16x32_bf16(Bt[n][k], At[m][k], acc[ai][bj][m][n], 0, 0, 0); __builtin_amdgcn_s_setprio(0); } while (0)
#define PG8_WAIT_V(n) asm volatile("s_waitcnt vmcnt(" #n ")" ::: "memory")
#define PG8_WAIT_L(n) asm volatile("s_waitcnt lgkmcnt(" #n ")" ::: "memory")
#define PG8_BAR __builtin_amdgcn_s_barrier()
#define PG8_SCHED __builtin_amdgcn_sched_barrier(0)
    Unit cur, nxt; int ui = 0;
    if (!S.next(0, cur)) return;
    f32x4 acc[2][2][4][2];
#pragma unroll
    for (int a = 0; a < 2; ++a)
#pragma unroll
        for (int b = 0; b < 2; ++b)
#pragma unroll
            for (int m = 0; m < 4; ++m)
#pragma unroll
                for (int n = 0; n < 2; ++n) acc[a][b][m][n] = (f32x4){0.f, 0.f, 0.f, 0.f};
    bf16x8 At[4][2], B0[2][2], B1[2][2];
    const char* cA = (const char*)g.A + (size_t)cur.pm * tstepA + (size_t)S.koff(cur) * 2; const char* cB = (const char*)g.Bt + (size_t)cur.pn * tstepB;
    PG8_STAGE(PG8_SB(0, 0), cB, voffB); PG8_STAGE(PG8_SB(0, 1), cB + hstepB, voffB); PG8_STAGE(PG8_SA(0, 0), cA, voffA); PG8_STAGE(PG8_SA(0, 1), cA + hstepA, voffA);
    if (wr == 1) PG8_BAR;
    PG8_WAIT_V(2); PG8_BAR;
    PG8_STAGE(PG8_SB(1, 0), cB + kstep, voffB); PG8_STAGE(PG8_SA(1, 0), cA + kstep, voffA); PG8_STAGE(PG8_SB(1, 1), cB + hstepB + kstep, voffB);
    PG8_WAIT_V(6); PG8_BAR;
    for (;;) {
        const bool has_next = S.next(ui + 1, nxt);
        const char* nA = has_next ? (const char*)g.A + (size_t)nxt.pm * tstepA + (size_t)S.koff(nxt) * 2 : cA; const char* nB = has_next ? (const char*)g.Bt + (size_t)nxt.pn * tstepB : cB;
        for (int t = 0; t < nt; t += 2) {
            const bool last = (t == nt - 2);
            const char* a1 = cA + (size_t)(t + 1) * kstep;
            const char* a2 = last ? nA : cA + (size_t)(t + 2) * kstep; const char* b2 = last ? nB : cB + (size_t)(t + 2) * kstep;
            const char* a3 = a2 + kstep; const char* b3 = b2 + kstep;
            PG8_LDB(B0, 0, 0); PG8_LDB(B1, 0, 1); PG8_SCHED; PG8_LDA(At, 0, 0); PG8_STAGE(PG8_SA(1, 1), a1 + hstepA, voffA);
            PG8_WAIT_V(8); PG8_WAIT_L(0); PG8_BAR; PG8_MMA(0, 0, At, B0); PG8_MMA(0, 1, At, B1); PG8_BAR; PG8_SCHED;
            PG8_LDA(At, 0, 1); PG8_STAGE(PG8_SB(0, 0), b2, voffB); PG8_STAGE(PG8_SB(0, 1), b2 + hstepB, voffB); PG8_STAGE(PG8_SA(0, 0), a2, voffA);
            PG8_WAIT_V(8); PG8_WAIT_L(0); PG8_BAR; PG8_MMA(1, 0, At, B0); PG8_MMA(1, 1, At, B1); PG8_BAR; PG8_SCHED;
            PG8_LDB(B0, 1, 0); PG8_LDB(B1, 1, 1); PG8_SCHED; PG8_LDA(At, 1, 0); PG8_STAGE(PG8_SA(0, 1), a2 + hstepA, voffA);
            PG8_WAIT_V(8); PG8_WAIT_L(0); PG8_BAR; PG8_MMA(0, 0, At, B0); PG8_MMA(0, 1, At, B1); PG8_BAR; PG8_SCHED;
            PG8_LDA(At, 1, 1); PG8_STAGE(PG8_SB(1, 0), b3, voffB); PG8_STAGE(PG8_SB(1, 1), b3 + hstepB, voffB); PG8_STAGE(PG8_SA(1, 0), a3, voffA);
            PG8_WAIT_V(8); PG8_WAIT_L(0); PG8_BAR; PG8_MMA(1, 0, At, B0); PG8_MMA(1, 1, At, B1); PG8_BAR; PG8_SCHED;
        }
        if constexpr (ALIGN_EPI) { if (wr == 0) PG8_BAR; }
        E(acc, cur, wr, wc, fr, fq);
        if (!has_next) break;
#pragma unroll
        for (int a = 0; a < 2; ++a)
#pragma unroll
            for (int b = 0; b < 2; ++b)
#pragma unroll
                for (int m = 0; m < 4; ++m)
#pragma unroll
                    for (int n = 0; n < 2; ++n) acc[a][b][m][n] = (f32x4){0.f, 0.f, 0.f, 0.f};
        cur = nxt; cA = nA; cB = nB; ++ui;
        if constexpr (ALIGN_EPI) { if (wr == 1) PG8_BAR; }
    }
    PG8_WAIT_V(0);
    if constexpr (!ALIGN_EPI) { if (wr == 0) PG8_BAR; }
    PG8_BAR;
#undef PG8_SA
#undef PG8_SB
#undef PG8_STAGE
#undef PG8_LDA
#undef PG8_LDB
#undef PG8_MMA
}

template <class Epi, class Sched>
__device__ __forceinline__ void gemm_tail(const bf16_t* A16, const Gemm g, int nN, const Sched& S, const Epi& E) {
    int tid = threadIdx.x; asm volatile("" : "+v"(tid));
    const int wid = __builtin_amdgcn_readfirstlane(tid >> 6), lane = tid & 63, fr = lane & 15, fq = lane >> 4;
    for (int pn = S.G - 1 - S.c; pn < nN; pn += S.G) {
        Unit u; u.pm = 0; u.pn = pn;
        const bf16_t* a = A16 + (size_t)fr * g.lda + S.koff(u) + fq * 8;
        const bf16_t* b0 = g.Bt + (size_t)(pn * 256 + 16 * wid + fr) * g.ldb + fq * 8;
        const bf16_t* b1 = b0 + (size_t)128 * g.ldb;
        f32x4 acc0 = (f32x4){0.f, 0.f, 0.f, 0.f}, acc1 = acc0;
#pragma unroll 4
        for (int k0 = 0; k0 < g.K; k0 += 32) {
            const bf16x8 af = *(const bf16x8*)(a + k0), w0 = *(const bf16x8*)(b0 + k0), w1 = *(const bf16x8*)(b1 + k0);
            acc0 = __builtin_amdgcn_mfma_f32_16x16x32_bf16(w0, af, acc0, 0, 0, 0);
            acc1 = __builtin_amdgcn_mfma_f32_16x16x32_bf16(w1, af, acc1, 0, 0, 0);
        }
        E.tail(fr, pn, 16 * wid + 4 * fq, acc0, acc1);
    }
}
#undef PG8_WAIT_V
#undef PG8_WAIT_L
#undef PG8_BAR
#undef PG8_SCHED
}
#define XB_TMO      128
#define XB_XCNT(j)  (256  + 64 * (j))
#define XB_XSUB(j)  (1280 + 64 * (j))
#define XB_XGEN(j)  (2304 + 64 * (j))
#define XB_TOP      3328
#define XB_TOPGEN   3392
#define XCD_BAR_WORDS 3456
#define XB_SPIN_CAP (1u << 18)

__device__ __forceinline__ unsigned xb_ld(unsigned* p)              { return __hip_atomic_load(p, __ATOMIC_RELAXED, __HIP_MEMORY_SCOPE_AGENT); }
__device__ __forceinline__ unsigned xb_add(unsigned* p, unsigned v) { return __hip_atomic_fetch_add(p, v, __ATOMIC_RELAXED, __HIP_MEMORY_SCOPE_AGENT); }
__device__ __forceinline__ unsigned xb_xcc_id() { return (unsigned)__builtin_amdgcn_s_getreg((3 << 11) | 20) & 0xFu; }
#define XB_SPIN(cond, bar) do { unsigned _sp = 0; while (cond) { __builtin_amdgcn_s_sleep(1); \
    if ((++_sp & 255u) == 0u) { if (xb_ld(&(bar)[XB_TMO])) break; if (_sp > XB_SPIN_CAP) { atomicAdd(&(bar)[XB_TMO], 1u); break; } } } } while (0)

struct XcdBarrier {
    unsigned* bar; unsigned x;
    volatile LAS unsigned* st;
};

__device__ __forceinline__ XcdBarrier xcd_barrier_post(unsigned* bar, volatile LAS unsigned* st) {
    XcdBarrier b; b.bar = bar; b.x = xb_xcc_id(); b.st = st;
    if (threadIdx.x == 0) (void)xb_add(&bar[XB_XCNT(b.x)], 1u);
    return b;
}
__device__ __forceinline__ void xcd_barrier_complete(unsigned* bar, unsigned x, unsigned& nloc, unsigned& nx) {
    const unsigned G = gridDim.x * gridDim.y * gridDim.z;
    unsigned sum, cnt, mine, sp = 0u;
    for (;;) {
        sum = 0u; cnt = 0u; mine = 0u;
#pragma unroll
        for (unsigned j = 0; j < 16; ++j) { const unsigned c = xb_ld(&bar[XB_XCNT(j)]); sum += c; cnt += (c > 0u) ? 1u : 0u; mine = (j == x) ? c : mine; }
        if (sum == G) break;
        __builtin_amdgcn_s_sleep(1);
        if ((++sp & 255u) == 0u) { if (xb_ld(&bar[XB_TMO])) break; if (sp > XB_SPIN_CAP) { atomicAdd(&bar[XB_TMO], 1u); break; } }
    }
    nloc = mine > 0u ? mine : 1u; nx = cnt > 0u ? cnt : 1u;
}

__device__ __forceinline__ void xcd_barrier(const XcdBarrier& b) {
    asm volatile("s_waitcnt vmcnt(0)" ::: "memory");
    __syncthreads();
    if (threadIdx.x == 0) {
        unsigned* bar = b.bar;
        __builtin_amdgcn_s_waitcnt(0);
        unsigned nloc = b.st[0], nx = b.st[1];
        if (nloc == 0u) { xcd_barrier_complete(bar, b.x, nloc, nx); b.st[0] = nloc; b.st[1] = nx; }
        const unsigned old = xb_add(&bar[XB_XSUB(b.x)], 1u);
        const unsigned gen = old / nloc;
        if (old + 1u == (gen + 1u) * nloc) {
            __builtin_amdgcn_fence(__ATOMIC_RELEASE, "agent");
            asm volatile("s_waitcnt vmcnt(0)" ::: "memory");
            const unsigned og = xb_add(&bar[XB_TOP], 1u);
            const unsigned tg = og / nx;
            if (og + 1u == (tg + 1u) * nx) xb_add(&bar[XB_TOPGEN], 1u);
            else XB_SPIN(xb_ld(&bar[XB_TOPGEN]) == tg, bar);
            __builtin_amdgcn_fence(__ATOMIC_ACQUIRE, "agent");
            xb_add(&bar[XB_XGEN(b.x)], 1u);
            asm volatile("s_waitcnt vmcnt(0)" ::: "memory");
        } else {
            XB_SPIN(xb_ld(&bar[XB_XGEN(b.x)]) == gen, bar);
            __builtin_amdgcn_fence(__ATOMIC_ACQUIRE, "agent");
            asm volatile("s_waitcnt vmcnt(0)" ::: "memory");
        }
    }
    __syncthreads();
}
constexpr int D = 4096, NB = 4, SEQ = 2048, NMETA = 16, LSEQ = SEQ + NMETA;
constexpr int MX = NB * SEQ;
constexpr int MROWS = MX + NMETA;
constexpr float NORM_EPS = 1e-6f, GN_EPS = 64e-5f;
constexpr int ZC = 8640, ZLD = 8704;
constexpr int ZR = 2048, ZK = 4096, ZV = 6144, ZWL = 8192, ZAL = 8288, ZGL = 8384;
constexpr int NHEAD = 32, HDIM = 64;
constexpr int WAGLD = 6144;
constexpr int NEXP = 16384;
__device__ __forceinline__ int rowof(int b, int pos) { return pos < NMETA ? MX + pos : b * SEQ + pos - NMETA; }

constexpr size_t MiB = 1u << 20;
constexpr size_t wsal(size_t x) { return (x + 4095) & ~(size_t)4095; }
constexpr size_t WS_CTL = 0, CTL_ZERO_BYTES = 1 * MiB;
constexpr size_t WS_W1T = 1 * MiB;
constexpr size_t WS_WOT = WS_W1T + wsal((size_t)ZLD * D * 2);
constexpr size_t WS_WIO = WS_WOT + wsal((size_t)D * D * 2);
constexpr size_t WS_WGT = WS_WIO + wsal((size_t)2048 * D * 2);
constexpr size_t WS_WST = WS_WGT + wsal((size_t)8192 * 2048 * 2);
constexpr size_t WS_BTP = WS_WST + wsal((size_t)2 * 2048 * D * 2);
constexpr size_t WS_BTL = WS_BTP + wsal((size_t)2048 * 512 * 2);
constexpr size_t WS_PU  = WS_BTL + wsal((size_t)6144 * 256 * 2);
constexpr size_t WS_PV  = WS_PU + wsal((size_t)2 * NEXP * D * 2);
constexpr size_t WS_H   = WS_PV + wsal((size_t)2 * NEXP * D * 2);
constexpr size_t WS_HB  = WS_H + wsal((size_t)MROWS * D * 4);
constexpr size_t WS_Z   = WS_HB + wsal((size_t)MROWS * D * 2);
constexpr size_t WS_PM  = WS_Z + wsal((size_t)MROWS * ZLD * 2);
constexpr size_t WS_LA  = WS_PM + wsal((size_t)MROWS * 2048 * 2);
constexpr size_t WS_WAG = WS_LA + wsal((size_t)MROWS * 512 * 2);
constexpr size_t WS_Y   = WS_WAG + wsal((size_t)MROWS * WAGLD * 4);
constexpr size_t WS_SC  = WS_Y + wsal((size_t)MROWS * D * 2);
constexpr size_t WS_U   = WS_SC + wsal((size_t)MROWS * 2048 * 4);
constexpr size_t WS_YS  = WS_U + wsal((size_t)MROWS * 2048 * 2);
constexpr size_t WS_END = WS_YS + wsal((size_t)MROWS * 2048 * 2);
constexpr int CW_BAR = 4096;

constexpr int LDS_BYTES = 163840;
constexpr int SCR_BYTES = 131072;
constexpr int MISC_OFF = SCR_BYTES;
constexpr int RED_OFF = MISC_OFF + 256;
constexpr int BONUS_OFF = MISC_OFF + 512;

struct EpiBf16 {
    static constexpr bool PERM = true;
    bf16_t* O; int ldc; const float* colscale;
    __device__ __forceinline__ void operator()(const f32x4 (&acc)[2][2][4][2], const pg8::Unit& u, int wr, int wc, int fr, int fq) const {
        const int row0 = u.pm * 256 + wr * 64 + fr, col0 = u.pn * 256 + wc * 32 + 8 * fq;
        f32x4 sv[2][2];
#pragma unroll
        for (int bj = 0; bj < 2; ++bj)
#pragma unroll
            for (int n = 0; n < 2; ++n) sv[bj][n] = colscale ? *(const f32x4*)(colscale + col0 + bj * 128 + 4 * n) : (f32x4){1.f, 1.f, 1.f, 1.f};
#pragma unroll
        for (int ai = 0; ai < 2; ++ai)
#pragma unroll
            for (int m = 0; m < 4; ++m) { bf16_t* rowp = O + (size_t)(row0 + ai * 128 + m * 16) * ldc + col0;
#pragma unroll
                for (int bj = 0; bj < 2; ++bj) { const f32x4 v0 = acc[ai][bj][m][0] * sv[bj][0], v1 = acc[ai][bj][m][1] * sv[bj][1];
                    u32x4 w; w.x = cvt_pk_bf16(v0[0], v0[1]); w.y = cvt_pk_bf16(v0[2], v0[3]); w.z = cvt_pk_bf16(v1[0], v1[1]); w.w = cvt_pk_bf16(v1[2], v1[3]);
                    *(u32x4*)(rowp + bj * 128) = w; } }
    }
    __device__ __forceinline__ void tail(int r, int pn, int c4, f32x4 lo, f32x4 hi) const {
        const int col = pn * 256 + c4; bf16_t* rowp = O + (size_t)(MX + r) * ldc + col;
        if (colscale) { lo = lo * *(const f32x4*)(colscale + col); hi = hi * *(const f32x4*)(colscale + col + 128); }
        u32x2 a, b; a.x = cvt_pk_bf16(lo[0], lo[1]); a.y = cvt_pk_bf16(lo[2], lo[3]); b.x = cvt_pk_bf16(hi[0], hi[1]); b.y = cvt_pk_bf16(hi[2], hi[3]);
        *(u32x2*)rowp = a; *(u32x2*)(rowp + 128) = b;
    }
};
struct EpiF32 {
    static constexpr bool PERM = false;
    float* C; int ldc; int accum;
    __device__ __forceinline__ void operator()(const f32x4 (&acc)[2][2][4][2], const pg8::Unit& u, int wr, int wc, int fr, int fq) const {
        const int row0 = u.pm * 256 + wr * 64 + fr, col0 = u.pn * 256 + wc * 32 + 4 * fq;
#pragma unroll
        for (int ai = 0; ai < 2; ++ai)
#pragma unroll
            for (int m = 0; m < 4; ++m) { float* rowp = C + (size_t)(row0 + ai * 128 + m * 16) * ldc + col0;
#pragma unroll
                for (int bj = 0; bj < 2; ++bj)
#pragma unroll
                    for (int n = 0; n < 2; ++n) { f32x4* p = (f32x4*)(rowp + bj * 128 + n * 16); f32x4 v = acc[ai][bj][m][n]; if (accum) v = v + *p; *p = v; } }
    }
    __device__ __forceinline__ void tail(int r, int pn, int c4, f32x4 lo, f32x4 hi) const {
        float* rowp = C + (size_t)(MX + r) * ldc + pn * 256 + c4; f32x4* p0 = (f32x4*)rowp; f32x4* p1 = (f32x4*)(rowp + 128);
        if (accum) { lo = lo + *p0; hi = hi + *p1; }
        *p0 = lo; *p1 = hi;
    }
};
__device__ __forceinline__ float decay_of(float x) {
    const float y = -x, sp = fmaxf(y, 0.f) + log1pf(__expf(-fabsf(y)));
    return __expf(-__expf(-sp - 0.5f));
}
#ifndef DBG_SKIP
#define DBG_SKIP 0
#endif
struct EpiGlu {
    static constexpr bool PERM = false;
    float* H;
    __device__ __forceinline__ void operator()(const f32x4 (&acc)[2][2][4][2], const pg8::Unit& u, int wr, int wc, int fr, int fq) const {
        const int row0 = u.pm * 256 + wr * 64 + fr, col0 = u.pn * 128 + wc * 32 + 4 * fq;
#pragma unroll
        for (int ai = 0; ai < 2; ++ai)
#pragma unroll
            for (int m = 0; m < 4; ++m) { float* rowp = H + (size_t)(row0 + ai * 128 + m * 16) * D + col0;
#pragma unroll
                for (int n = 0; n < 2; ++n) { f32x4* p = (f32x4*)(rowp + n * 16); const f32x4 ga = acc[ai][0][m][n], gb = acc[ai][1][m][n]; f32x4 v = *p;
                    if (!(DBG_SKIP & 2)) { v[0] += ga[0] * sigmoidf_(gb[0]); v[1] += ga[1] * sigmoidf_(gb[1]); v[2] += ga[2] * sigmoidf_(gb[2]); v[3] += ga[3] * sigmoidf_(gb[3]); } *p = v; } }
    }
    __device__ __forceinline__ void tail(int r, int pn, int c4, f32x4 lo, f32x4 hi) const {
        f32x4* p = (f32x4*)(H + (size_t)(MX + r) * D + pn * 128 + c4); f32x4 v = *p;
        v[0] += lo[0] * sigmoidf_(hi[0]); v[1] += lo[1] * sigmoidf_(hi[1]); v[2] += lo[2] * sigmoidf_(hi[2]); v[3] += lo[3] * sigmoidf_(hi[3]); *p = v;
    }
};
#define LDS_WAIT() asm volatile("s_waitcnt lgkmcnt(0)" ::: "memory")
constexpr int NWAVES = 8, NTHREADS = 512;

__device__ __forceinline__ void transpose_item(const float* W, int ldw, int k0, int n0, const float* scale, bf16_t* dst, int dld, int drow0, LAS float* scr, int lane) {
#pragma unroll 8
    for (int i = 0; i < 32; ++i) { const int kk = 2 * i + (lane >> 5); float v = W[(size_t)(k0 + kk) * ldw + n0 + (lane & 31)]; if (scale) v *= scale[k0 + kk]; scr[kk * 33 + (lane & 31)] = v; }
    LDS_WAIT();
    const int c = lane & 7;
#pragma unroll
    for (int j = 0; j < 4; ++j) { const int n = (lane >> 3) + 8 * j; const LAS float* s = scr + (8 * c) * 33 + n;
        u32x4 o; o.x = pk2(s[0 * 33], s[1 * 33]); o.y = pk2(s[2 * 33], s[3 * 33]); o.z = pk2(s[4 * 33], s[5 * 33]); o.w = pk2(s[6 * 33], s[7 * 33]);
        *(u32x4*)(dst + (size_t)(drow0 + n) * dld + k0 + 8 * c) = o; }
    LDS_WAIT();
}
__device__ __forceinline__ void norm_row(const float* src, float* cpy, bf16_t* dstb, int lane) {
    f32x4 v[16]; float s = 0.f;
#pragma unroll
    for (int j = 0; j < 16; ++j) { v[j] = ((const f32x4*)src)[lane + 64 * j]; s += (v[j][0] * v[j][0] + v[j][1] * v[j][1]) + (v[j][2] * v[j][2] + v[j][3] * v[j][3]); }
    s = sum64(s);
    const float inv = rsqrtf(s * (1.0f / D) + NORM_EPS);
#pragma unroll
    for (int j = 0; j < 16; ++j) { if (cpy) ((f32x4*)cpy)[lane + 64 * j] = v[j];
        u32x2 o; o.x = cvt_pk_bf16(v[j][0] * inv, v[j][1] * inv); o.y = cvt_pk_bf16(v[j][2] * inv, v[j][3] * inv); ((u32x2*)dstb)[lane + 64 * j] = o; }
}
__device__ __forceinline__ bf16x8 cvt8(const float* p) {
    const f32x4 a = *(const f32x4*)p, b = *(const f32x4*)(p + 4);
    u32x4 o; o.x = pk2(a[0], a[1]); o.y = pk2(a[2], a[3]); o.z = pk2(b[0], b[1]); o.w = pk2(b[2], b[3]);
    return __builtin_bit_cast(bf16x8, o);
}

struct P0Args { const float* const* in; };

__device__ __forceinline__ void phase_prologue(const float* const (&in)[34], unsigned char* ws, LAS unsigned char* lds, int G) {
    int tid = threadIdx.x; asm volatile("" : "+v"(tid)); const int lane = tid & 63, wid = __builtin_amdgcn_readfirstlane(tid >> 6);
    const int gw = blockIdx.x * NWAVES + wid, NGW = G * NWAVES;
    const size_t gt = (size_t)blockIdx.x * NTHREADS + tid, NT = (size_t)G * NTHREADS;
    LAS float* scr = (LAS float*)(lds + wid * 16384);
    bf16_t* W1T = (bf16_t*)(ws + WS_W1T); bf16_t* WOT = (bf16_t*)(ws + WS_WOT); bf16_t* WIO = (bf16_t*)(ws + WS_WIO); bf16_t* WGT = (bf16_t*)(ws + WS_WGT);
    bf16_t* WST = (bf16_t*)(ws + WS_WST); bf16_t* BTP = (bf16_t*)(ws + WS_BTP); bf16_t* BTL = (bf16_t*)(ws + WS_BTL);
    constexpr int I1 = (D / 64) * (ZC / 32), I2 = (D / 64) * (D / 32), I3 = (D / 64) * (2048 / 32), I4 = (2048 / 64) * (8192 / 32), I5 = 4 * (512 / 64) * (512 / 32);
    for (int it = gw; it < I1 + I2 + I3 + I4 + I5; it += NGW) {
        int r = it;
        if (r < I1) { const int nb = ZC / 32, kb = r / nb, n0 = (r % nb) * 32; transpose_item(in[5], ZC, kb * 64, n0, in[2], W1T, D, n0, scr, lane); continue; } r -= I1;
        if (r < I2) { const int nb = D / 32, kb = r / nb, n0 = (r % nb) * 32; transpose_item(in[19], D, kb * 64, n0, nullptr, WOT, D, n0, scr, lane); continue; } r -= I2;
        if (r < I3) { const int nb = 2048 / 32, kb = r / nb, n0 = (r % nb) * 32; transpose_item(in[20], 2048, kb * 64, n0, in[2] + D, WIO, D, n0, scr, lane); continue; } r -= I3;
        if (r < I4) { const int nb = 8192 / 32, kb = r / nb, n0 = (r % nb) * 32;
            const int half = n0 >= 4096, c = n0 - half * 4096, drow = (c >> 7) * 256 + half * 128 + (c & 127);
            transpose_item(in[29], 8192, kb * 64, n0, nullptr, WGT, 2048, drow, scr, lane); continue; } r -= I4;
        { const int grp = r / 128, rr = r % 128, kb = rr / 16, n0 = (rr % 16) * 32; transpose_item(in[6] + (size_t)grp * 512 * 512, 512, kb * 64, n0, nullptr, BTP, 512, grp * 512 + n0, scr, lane); }
    }
    for (size_t i = gt; i < (size_t)(ZLD - ZC) * D / 8; i += NT) ((u32x4*)(W1T + (size_t)ZC * D))[i] = (u32x4){0u, 0u, 0u, 0u};
    for (size_t i = gt; i < (size_t)6144 * 256; i += NT) { const int n = (int)(i >> 8), k = (int)(i & 255), reg = n >> 11, c = n & 2047; float v = 0.f;
        if (reg == 0) { if (k < 96) v = in[10][(size_t)k * 2048 + c]; }
        else if (reg == 1) { if (k >= 128 && k < 224) v = in[12][(size_t)(k - 128) * 2048 + c]; }
        else v = in[13][(size_t)k * 2048 + c];
        BTL[i] = (bf16_t)f2bf(v); }
    { const int fr = lane & 15, fq = lane >> 4;
      for (int it = gw; it < 2 * 16 * 256; it += NGW) {
        const int layer = it >> 12, hp = (it >> 8) & 15, d0 = (it & 255) * 16;
        const float* wq = in[30] + (size_t)layer * D * 2048 + (size_t)(d0 + fr) * 2048 + hp * 128 + fq * 8;
        const float* sk = in[31] + ((size_t)(layer * 16 + hp) * 128 + fr) * 128 + fq * 8;
        f32x4 acc[8];
#pragma unroll
        for (int kt = 0; kt < 8; ++kt) acc[kt] = (f32x4){0.f, 0.f, 0.f, 0.f};
#pragma unroll
        for (int ks = 0; ks < 4; ++ks) { const bf16x8 a = cvt8(wq + ks * 32);
#pragma unroll
            for (int kt = 0; kt < 8; ++kt) { const bf16x8 b = cvt8(sk + (size_t)kt * 16 * 128 + ks * 32); acc[kt] = __builtin_amdgcn_mfma_f32_16x16x32_bf16(a, b, acc[kt], 0, 0, 0); } }
        const f32x4 gn = *(const f32x4*)(in[3] + layer * D + d0 + 4 * fq);
#pragma unroll
        for (int kt = 0; kt < 8; ++kt) { const f32x4 v = acc[kt] * gn; u32x2 o; o.x = cvt_pk_bf16(v[0], v[1]); o.y = cvt_pk_bf16(v[2], v[3]);
            *(u32x2*)(WST + ((size_t)layer * 2048 + hp * 128 + kt * 16 + fr) * D + d0 + 4 * fq) = o; }
      } }
    { bf16_t* PU = (bf16_t*)(ws + WS_PU); bf16_t* PV = (bf16_t*)(ws + WS_PV);
      const size_t per = (size_t)NEXP * D / 8;
      for (size_t i = gt; i < 2 * per; i += NT) { const int layer = i >= per; const int d = (int)((i * 8) & (D - 1));
          const f32x4 a = *(const f32x4*)(in[32] + i * 8), b = *(const f32x4*)(in[32] + i * 8 + 4);
          const f32x4 g0 = *(const f32x4*)(in[3] + layer * D + d), g1 = *(const f32x4*)(in[3] + layer * D + d + 4);
          u32x4 o; o.x = cvt_pk_bf16(a[0] * g0[0], a[1] * g0[1]); o.y = cvt_pk_bf16(a[2] * g0[2], a[3] * g0[3]); o.z = cvt_pk_bf16(b[0] * g1[0], b[1] * g1[1]); o.w = cvt_pk_bf16(b[2] * g1[2], b[3] * g1[3]);
          ((u32x4*)PU)[i] = o; }
      for (size_t i = gt; i < 2 * per; i += NT) {
          const f32x4 a = *(const f32x4*)(in[33] + i * 8), b = *(const f32x4*)(in[33] + i * 8 + 4);
          u32x4 o; o.x = cvt_pk_bf16(a[0], a[1]); o.y = cvt_pk_bf16(a[2], a[3]); o.z = cvt_pk_bf16(b[0], b[1]); o.w = cvt_pk_bf16(b[2], b[3]);
          ((u32x4*)PV)[i] = o; } }
    { float* H = (float*)(ws + WS_H); bf16_t* HB = (bf16_t*)(ws + WS_HB);
      for (int r = gw; r < MROWS; r += NGW) { const float* src = r < MX ? in[0] + (size_t)r * D : in[1] + (size_t)(r - MX) * D; norm_row(src, H + (size_t)r * D, HB + (size_t)r * D, lane); } }
}

__device__ __forceinline__ void phase_norm(unsigned char* ws, int G) {
    int tid = threadIdx.x; asm volatile("" : "+v"(tid)); const int lane = tid & 63, wid = __builtin_amdgcn_readfirstlane(tid >> 6);
    const float* H = (const float*)(ws + WS_H); bf16_t* HB = (bf16_t*)(ws + WS_HB);
    for (int r = blockIdx.x * NWAVES + wid; r < MROWS; r += G * NWAVES) norm_row(H + (size_t)r * D, nullptr, HB + (size_t)r * D, lane);
}

__device__ __forceinline__ void phase_prep(const float* mu, unsigned char* ws, int G) {
    int tid = threadIdx.x; asm volatile("" : "+v"(tid));
    const bf16_t* Z = (const bf16_t*)(ws + WS_Z); bf16_t* PM = (bf16_t*)(ws + WS_PM); bf16_t* LA = (bf16_t*)(ws + WS_LA);
    const int c4 = tid * 4, grp = c4 >> 9, w = 2 << grp;
    float msk[16];
#pragma unroll
    for (int i = 0; i < 16; ++i) msk[i] = i < w ? 1.f : 0.f;
    for (int it = blockIdx.x; it < NB * 129; it += G) {
        const int b = it / 129, blk = it % 129; if (b > 0 && blk == 0) continue;
        const int p0 = blk * 16;
        float zz[31][4];
#pragma unroll
        for (int i = 0; i < 31; ++i) { const int pos = p0 - 15 + i;
            if (pos >= 0) { const u32x2 q = *(const u32x2*)(Z + (size_t)rowof(b, pos) * ZLD + c4); zz[i][0] = bflo(q.x); zz[i][1] = bfhi(q.x); zz[i][2] = bflo(q.y); zz[i][3] = bfhi(q.y); }
            else { zz[i][0] = 0.f; zz[i][1] = 0.f; zz[i][2] = 0.f; zz[i][3] = 0.f; } }
#pragma unroll
        for (int t = 0; t < 16; ++t) { const int pos = p0 + t; float s[4] = {0.f, 0.f, 0.f, 0.f};
#pragma unroll
            for (int i = 0; i < 16; ++i) {
#pragma unroll
                for (int e = 0; e < 4; ++e) s[e] = fmaf(zz[15 + t - i][e], msk[i], s[e]); }
            const float ic = 1.0f / (float)(pos + 1 < w ? pos + 1 : w);
            u32x2 o; o.x = cvt_pk_bf16(s[0] * ic - zz[15 + t][0], s[1] * ic - zz[15 + t][1]); o.y = cvt_pk_bf16(s[2] * ic - zz[15 + t][2], s[3] * ic - zz[15 + t][3]);
            *(u32x2*)(PM + (size_t)rowof(b, pos) * 2048 + c4) = o; }
    }
    for (size_t i = (size_t)blockIdx.x * NTHREADS + tid; i < (size_t)MROWS * 512; i += (size_t)G * NTHREADS) {
        const int row = (int)(i >> 9), k = (int)(i & 511);
        int prow; if (row >= MX) prow = row > MX ? row - 1 : -1; else prow = (row & (SEQ - 1)) ? row - 1 : MX + NMETA - 1;
        int zc = -1, kind = 0;
        if (k < 96) { zc = ZWL + k; kind = 1; } else if (k >= 128 && k < 224) { zc = ZAL + k - 128; kind = 2; } else if (k >= 256) { zc = ZGL + k - 256; kind = 3; }
        float v = 0.f;
        if (zc >= 0) { const float z = bf2f(Z[(size_t)row * ZLD + zc]), zp = prow >= 0 ? bf2f(Z[(size_t)prow * ZLD + zc]) : 0.f; const float sh = z + (zp - z) * mu[zc - 2048];
            v = kind == 1 ? tanhf(sh) : (kind == 2 ? sh : sigmoidf_(sh)); }
        LA[i] = (bf16_t)f2bf(v);
    }
}

struct RwkvRegs { u32x2 zr, zk, zv, pr, pk, pv; f32x4 dec, a, g; };
__device__ __forceinline__ void rwkv_load(RwkvRegs& R, const bf16_t* Z, const float* WAG, int b, int h, int pos, int j4, f32x4 w0v, f32x4 a0v) {
    const u32x2 z0 = {0u, 0u};
    if (pos < LSEQ) { const int row = rowof(b, pos); const bf16_t* zp = Z + (size_t)row * ZLD + h * 64 + j4;
        R.zr = *(const u32x2*)(zp + ZR); R.zk = *(const u32x2*)(zp + ZK); R.zv = *(const u32x2*)(zp + ZV);
        if (pos > 0) { const bf16_t* pp = Z + (size_t)rowof(b, pos - 1) * ZLD + h * 64 + j4; R.pr = *(const u32x2*)(pp + ZR); R.pk = *(const u32x2*)(pp + ZK); R.pv = *(const u32x2*)(pp + ZV); }
        else { R.pr = z0; R.pk = z0; R.pv = z0; }
        const float* wp = WAG + (size_t)row * WAGLD + h * 64 + j4; R.dec = *(const f32x4*)wp; R.a = *(const f32x4*)(wp + 2048); R.g = *(const f32x4*)(wp + 4096);
        R.dec = R.dec + w0v; R.a = R.a + a0v;
#pragma unroll
        for (int e = 0; e < 4; ++e) { R.dec[e] = decay_of(R.dec[e]); R.a[e] = sigmoidf_(R.a[e]); }
    } else { R.zr = z0; R.zk = z0; R.zv = z0; R.pr = z0; R.pk = z0; R.pv = z0; R.dec = (f32x4){1.f, 1.f, 1.f, 1.f}; R.a = (f32x4){0.f, 0.f, 0.f, 0.f}; R.g = R.a; }
}
__device__ __forceinline__ f32x4 unpack4(u32x2 q) { return (f32x4){bflo(q.x), bfhi(q.x), bflo(q.y), bfhi(q.y)}; }
__device__ __forceinline__ void phase_rwkv(const float* const (&in)[34], unsigned char* ws, LAS unsigned char* lds, int G) {
    int tid = threadIdx.x; asm volatile("" : "+v"(tid)); const int lane = tid & 63, wid = __builtin_amdgcn_readfirstlane(tid >> 6);
    const bf16_t* Z = (const bf16_t*)(ws + WS_Z); const float* WAG = (const float*)(ws + WS_WAG); bf16_t* Y = (bf16_t*)(ws + WS_Y);
    const int tt = tid >> 4, q = tid & 15, j4 = q * 4;
    const int ri = lane >> 3, cg = lane & 7, myrow = wid * 8 + ri;
    LAS float* bonus = (LAS float*)(lds + BONUS_OFF);
    for (int chain = blockIdx.x; chain < NB * NHEAD; chain += G) {
        const int b = chain >> 5, h = chain & 31;
        const float* mu = in[8];
        const f32x4 mur = *(const f32x4*)(mu + h * 64 + j4), muk = *(const f32x4*)(mu + 2048 + h * 64 + j4), muv = *(const f32x4*)(mu + 4096 + h * 64 + j4);
        const f32x4 kk_ = *(const f32x4*)(in[14] + h * 64 + j4), ka_ = *(const f32x4*)(in[15] + h * 64 + j4), rk_ = *(const f32x4*)(in[16] + h * 64 + j4);
        const f32x4 gng = *(const f32x4*)(in[17] + h * 64 + j4), gnb = *(const f32x4*)(in[18] + h * 64 + j4);
        float S[8];
#pragma unroll
        for (int j = 0; j < 8; ++j) S[j] = 0.f;
        const f32x4 w0v = *(const f32x4*)(in[9] + h * 64 + j4), a0v = *(const f32x4*)(in[11] + h * 64 + j4);
        RwkvRegs R; rwkv_load(R, Z, WAG, b, h, tt, j4, w0v, a0v);
        const int nchunk = (LSEQ + 31) / 32;
        for (int c = 0; c < nchunk; ++c) {
            LAS float* buf = (LAS float*)(lds + (c & 1) * 65536);
            LAS float* bon = bonus + (c & 1) * 32;
            {
                const f32x4 zr = unpack4(R.zr), zk = unpack4(R.zk), zv = unpack4(R.zv), pr = unpack4(R.pr), pk = unpack4(R.pk), pv = unpack4(R.pv);
                const f32x4 r = zr + (pr - zr) * mur, k = zk + (pk - zk) * muk, v = zv + (pv - zv) * muv;
                const f32x4 kr = k * kk_;
                const float ss = sum16((kr[0] * kr[0] + kr[1] * kr[1]) + (kr[2] * kr[2] + kr[3] * kr[3]));
                const float inrm = 1.0f / fmaxf(sqrtf(ss), 1e-12f);
                const f32x4 kk = kr * inrm;
                const f32x4 km = k * (1.0f + (R.a - 1.0f) * ka_);
                const f32x4 kka = kk * R.a;
                const f32x4 rb = r * km * rk_;
                const float bs = sum16((rb[0] + rb[1]) + (rb[2] + rb[3]));
                const int o = tt * 64 + j4;
                *(LAS f32x4*)(buf + 0 * 2048 + o) = r; *(LAS f32x4*)(buf + 1 * 2048 + o) = R.dec; *(LAS f32x4*)(buf + 2 * 2048 + o) = km; *(LAS f32x4*)(buf + 3 * 2048 + o) = v;
                *(LAS f32x4*)(buf + 4 * 2048 + o) = kk; *(LAS f32x4*)(buf + 5 * 2048 + o) = kka; *(LAS f32x4*)(buf + 6 * 2048 + o) = R.g;
                if (q == 0) bon[tt] = bs;
            }
            __syncthreads();
            if (c + 1 < nchunk) rwkv_load(R, Z, WAG, b, h, (c + 1) * 32 + tt, j4, w0v, a0v);
            const int nst = (LSEQ - c * 32) < 32 ? (LSEQ - c * 32) : 32;
            for (int t = 0; t < nst; ++t) {
                const LAS float* p = buf + t * 64 + cg * 8;
                const f32x4 r0 = *(const LAS f32x4*)(p), r1 = *(const LAS f32x4*)(p + 4);
                const f32x4 d0 = *(const LAS f32x4*)(p + 2048), d1 = *(const LAS f32x4*)(p + 2048 + 4);
                const f32x4 m0 = *(const LAS f32x4*)(p + 4096), m1 = *(const LAS f32x4*)(p + 4096 + 4);
                const float vv = buf[3 * 2048 + t * 64 + myrow];
                const f32x4 k0 = *(const LAS f32x4*)(p + 8192), k1 = *(const LAS f32x4*)(p + 8192 + 4);
                const f32x4 a0 = *(const LAS f32x4*)(p + 10240), a1 = *(const LAS f32x4*)(p + 10240 + 4);
                float sa = (S[0] * k0[0] + S[1] * k0[1]) + (S[2] * k0[2] + S[3] * k0[3]) + (S[4] * k1[0] + S[5] * k1[1]) + (S[6] * k1[2] + S[7] * k1[3]);
                sa = -sum8(sa);
                S[0] = S[0] * d0[0] + sa * a0[0] + vv * m0[0]; S[1] = S[1] * d0[1] + sa * a0[1] + vv * m0[1]; S[2] = S[2] * d0[2] + sa * a0[2] + vv * m0[2]; S[3] = S[3] * d0[3] + sa * a0[3] + vv * m0[3];
                S[4] = S[4] * d1[0] + sa * a1[0] + vv * m1[0]; S[5] = S[5] * d1[1] + sa * a1[1] + vv * m1[1]; S[6] = S[6] * d1[2] + sa * a1[2] + vv * m1[2]; S[7] = S[7] * d1[3] + sa * a1[3] + vv * m1[3];
                float y = (S[0] * r0[0] + S[1] * r0[1]) + (S[2] * r0[2] + S[3] * r0[3]) + (S[4] * r1[0] + S[5] * r1[1]) + (S[6] * r1[2] + S[7] * r1[3]);
                y = sum8(y);
                if (cg == 0) buf[7 * 2048 + t * 64 + myrow] = y;
            }
            __syncthreads();
            {
                const int pos = c * 32 + tt;
                const int o = tt * 64 + j4;
                const f32x4 y = *(const LAS f32x4*)(buf + 7 * 2048 + o), v = *(const LAS f32x4*)(buf + 3 * 2048 + o), g = *(const LAS f32x4*)(buf + 6 * 2048 + o);
                const float mean = sum16((y[0] + y[1]) + (y[2] + y[3])) * (1.0f / 64.0f);
                const f32x4 dy = y - mean;
                const float var = sum16((dy[0] * dy[0] + dy[1] * dy[1]) + (dy[2] * dy[2] + dy[3] * dy[3])) * (1.0f / 64.0f);
                const float rs = rsqrtf(var + GN_EPS), bs = bon[tt];
#if (DBG_SKIP & 4)
                const f32x4 out = (f32x4){0.f, 0.f, 0.f, 0.f};
#else
                const f32x4 out = (dy * rs * gng + gnb + v * bs) * g;
#endif
                if (pos < LSEQ && (b == 0 || pos >= NMETA)) { u32x2 w; w.x = cvt_pk_bf16(out[0], out[1]); w.y = cvt_pk_bf16(out[2], out[3]);
                    *(u32x2*)(Y + (size_t)rowof(b, pos) * D + 2048 + h * 64 + j4) = w; }
            }
        }
        __syncthreads();
    }
}

__device__ __forceinline__ void phase_s5(const float* const (&in)[34], unsigned char* ws, LAS unsigned char* lds, int G) {
    int tid = threadIdx.x; asm volatile("" : "+v"(tid)); const int lane = tid & 63, wid = __builtin_amdgcn_readfirstlane(tid >> 6), fr = lane & 15, fq = lane >> 4;
    if (wid >= 2) return;
    const bf16_t* U = (const bf16_t*)(ws + WS_U); bf16_t* YS = (bf16_t*)(ws + WS_YS);
    LAS unsigned char* wl = lds + wid * 32768;
    LAS bf16_t* BB = (LAS bf16_t*)wl;
    LAS float* BU = (LAS float*)(wl + 4096);
    LAS unsigned char* XB = wl + 4096 + 16 * 132 * 4;
    for (int chain = blockIdx.x * 2 + wid; chain < NB * 128; chain += G * 2) {
        const int b = chain >> 7, g = chain & 127, p = lane;
        const float lr = in[21][g * 64 + p], li = in[22][g * 64 + p], dt = expf(in[23][g]);
        const float mag = expf(lr * dt); float sn, cs; sincosf(li * dt, &sn, &cs);
        const float ar = mag * cs, ai = mag * sn, den = lr * lr + li * li;
        const float f_r = ((ar - 1.0f) * lr + ai * li) / den, f_i = (ai * lr - (ar - 1.0f) * li) / den;
        {   const float* br = in[24] + (size_t)(g * 64 + p) * 16; const float* bi = in[25] + (size_t)(g * 64 + p) * 16;
            unsigned wre[8], wim[8];
#pragma unroll
            for (int c = 0; c < 16; c += 2) { const float r0 = br[c], i0 = bi[c], r1 = br[c + 1], i1 = bi[c + 1];
                wre[c >> 1] = pk2(f_r * r0 - f_i * i0, f_r * r1 - f_i * i1); wim[c >> 1] = pk2(f_r * i0 + f_i * r0, f_r * i1 + f_i * r1); }
            *(LAS u32x4*)(BB + p * 16) = (u32x4){wre[0], wre[1], wre[2], wre[3]}; *(LAS u32x4*)(BB + p * 16 + 8) = (u32x4){wre[4], wre[5], wre[6], wre[7]};
            *(LAS u32x4*)(BB + (64 + p) * 16) = (u32x4){wim[0], wim[1], wim[2], wim[3]}; *(LAS u32x4*)(BB + (64 + p) * 16 + 8) = (u32x4){wim[4], wim[5], wim[6], wim[7]};
        }
        LDS_WAIT();
        bf16x8 bop[8];
#pragma unroll
        for (int nt = 0; nt < 8; ++nt) { u32x4 z = {0u, 0u, 0u, 0u}; if (fq < 2) z = *(const LAS u32x4*)(BB + (nt * 16 + fr) * 16 + fq * 8); bop[nt] = __builtin_bit_cast(bf16x8, z); }
        bf16x8 cop[4];
#pragma unroll
        for (int ks = 0; ks < 4; ++ks) { const float* src = (ks < 2 ? in[26] : in[27]) + (size_t)(g * 16 + fr) * 64 + (ks & 1) * 32 + fq * 8;
            const f32x4 a = *(const f32x4*)src, c2 = *(const f32x4*)(src + 4); const float sg = ks < 2 ? 1.f : -1.f;
            u32x4 o; o.x = pk2(sg * a[0], sg * a[1]); o.y = pk2(sg * a[2], sg * a[3]); o.z = pk2(sg * c2[0], sg * c2[1]); o.w = pk2(sg * c2[2], sg * c2[3]); cop[ks] = __builtin_bit_cast(bf16x8, o); }
        const f32x4 dsk = *(const f32x4*)(in[28] + g * 16 + 4 * fq);
        float xr = 0.f, xi = 0.f;
        for (int ck = 0; ck < LSEQ / 16; ++ck) {
            const int pos0 = ck * 16;
            const bf16_t* urow = U + (size_t)rowof(b, pos0 + fr) * 2048 + g * 16;
            u32x4 uz = {0u, 0u, 0u, 0u}; if (fq < 2) uz = *(const u32x4*)(urow + fq * 8);
            const u32x2 usk = *(const u32x2*)(urow + 4 * fq);
            const bf16x8 uop = __builtin_bit_cast(bf16x8, uz);
#pragma unroll
            for (int nt = 0; nt < 8; ++nt) { f32x4 acc = __builtin_amdgcn_mfma_f32_16x16x32_bf16(uop, bop[nt], (f32x4){0.f, 0.f, 0.f, 0.f}, 0, 0, 0);
#pragma unroll
                for (int i = 0; i < 4; ++i) BU[(4 * fq + i) * 132 + nt * 16 + fr] = acc[i]; }
            LDS_WAIT();
#pragma unroll
            for (int t = 0; t < 16; ++t) { const float bur = BU[t * 132 + p], bui = BU[t * 132 + 64 + p];
                const float nr = ar * xr - ai * xi + bur, ni = ar * xi + ai * xr + bui; xr = nr; xi = ni;
                *(LAS bf16_t*)(XB + t * 272 + p * 2) = (bf16_t)f2bf(nr); *(LAS bf16_t*)(XB + t * 272 + 128 + p * 2) = (bf16_t)f2bf(ni); }
            LDS_WAIT();
            f32x4 yacc = {0.f, 0.f, 0.f, 0.f};
#pragma unroll
            for (int ks = 0; ks < 4; ++ks) { const bf16x8 xop = *(const LAS bf16x8*)(XB + fr * 272 + ks * 64 + fq * 16); yacc = __builtin_amdgcn_mfma_f32_16x16x32_bf16(cop[ks], xop, yacc, 0, 0, 0); }
            LDS_WAIT();
            const int pos = pos0 + fr;
            const f32x4 uu = unpack4(usk);
            f32x4 yv = yacc + uu * dsk;
            yv[0] = gelu_erf(yv[0]); yv[1] = gelu_erf(yv[1]); yv[2] = gelu_erf(yv[2]); yv[3] = gelu_erf(yv[3]);
            if (b == 0 || pos >= NMETA) { u32x2 o; o.x = cvt_pk_bf16(yv[0], yv[1]); o.y = cvt_pk_bf16(yv[2], yv[3]); *(u32x2*)(YS + (size_t)rowof(b, pos) * 2048 + g * 16 + 4 * fq) = o; }
        }
    }
}

__device__ __forceinline__ unsigned ordkey(float v) { const unsigned u = __builtin_bit_cast(unsigned, v); return (u & 0x80000000u) ? ~u : (u | 0x80000000u); }
__device__ __forceinline__ float unord(unsigned k) { const unsigned u = (k & 0x80000000u) ? (k & 0x7fffffffu) : ~k; return __builtin_bit_cast(float, u); }
#ifndef EXP_VG
#define EXP_VG 2
#endif
constexpr int VG = EXP_VG;
template <bool FINAL>
__device__ __forceinline__ void phase_expert(const float* fgain, float* out, unsigned char* ws, LAS unsigned char* lds, int layer, int G) {
    int tid = threadIdx.x; asm volatile("" : "+v"(tid)); const int lane = tid & 63, wid = __builtin_amdgcn_readfirstlane(tid >> 6);
    const float* SC = (const float*)(ws + WS_SC); float* H = (float*)(ws + WS_H); bf16_t* HB = (bf16_t*)(ws + WS_HB);
    const bf16_t* PU = (const bf16_t*)(ws + WS_PU) + (size_t)layer * NEXP * D; const bf16_t* PV = (const bf16_t*)(ws + WS_PV) + (size_t)layer * NEXP * D;
    LAS float* part = (LAS float*)lds;
    LAS float* red = (LAS float*)(lds + RED_OFF);
    for (int tok = blockIdx.x; tok < MROWS; tok += G) {
        const float* sc = SC + (size_t)tok * 2048 + wid * 256;
        float s12[2]; int i12[2];
#pragma unroll
        for (int hf = 0; hf < 2; ++hf) {
            const float v0 = sc[hf * 128 + lane], v1 = sc[hf * 128 + 64 + lane];
            unsigned k0 = (ordkey(v0) & ~127u) | (unsigned)(127 - lane), k1 = (ordkey(v1) & ~127u) | (unsigned)(63 - lane);
            float sv = 0.f; int si = 0;
#pragma unroll 1
            for (int k = 0; k < 16; ++k) { const unsigned w = max64u(umax_u(k0, k1)); if (lane == k) { sv = unord(w & ~127u); si = 127 - (int)(w & 127u); } if (k0 == w) k0 = 0u; if (k1 == w) k1 = 0u; }
            s12[hf] = sv; i12[hf] = si;
        }
        const float c1 = __shfl(s12[0], lane >> 2);
        unsigned ck[4];
#pragma unroll
        for (int jj = 0; jj < 4; ++jj) { const int j = (lane & 3) * 4 + jj; const float c2 = __shfl(s12[1], j); ck[jj] = (ordkey(c1 + c2) & ~255u) | (unsigned)(255 - ((lane >> 2) * 16 + j)); }
        float ts = 0.f; int tp = 0;
#pragma unroll 1
        for (int k = 0; k < 16; ++k) { const unsigned w = max64u(umax_u(umax_u(ck[0], ck[1]), umax_u(ck[2], ck[3]))); if (lane == k) { ts = unord(w & ~255u); tp = 255 - (int)(w & 255u); }
#pragma unroll
            for (int jj = 0; jj < 4; ++jj) if (ck[jj] == w) ck[jj] = 0u; }
        const int e1 = __shfl(i12[0], tp >> 4), e2 = __shfl(i12[1], tp & 15);
        const int eid = e1 * 128 + e2;
        float mx = ts; mx = fmaxf(mx, dppf<DPP_XOR1>(mx)); mx = fmaxf(mx, dppf<DPP_XOR2>(mx)); mx = fmaxf(mx, dppf<DPP_HMIRROR>(mx)); mx = fmaxf(mx, dppf<DPP_MIRROR>(mx));
        const float ex = __expf(ts - mx), gate = ex / sum16(ex);
        const u32x4* hbp = (const u32x4*)(HB + (size_t)tok * D) + lane;
        u32x4 hb[8];
#pragma unroll
        for (int j = 0; j < 8; ++j) hb[j] = hbp[64 * j];
        float wgt = 0.f;
        {   u32x4 rb[4][8];
#pragma unroll
            for (int kk = 0; kk < 4; ++kk) { const int e = __builtin_amdgcn_readlane(eid, kk); const u32x4* up = (const u32x4*)(PU + (size_t)e * D) + lane;
#pragma unroll
                for (int j = 0; j < 8; ++j) rb[kk][j] = up[64 * j]; }
#pragma unroll 1
            for (int k4 = 0; k4 < 16; k4 += 4) {
#pragma unroll
                for (int kk = 0; kk < 4; ++kk) { float d0 = 0.f, d1 = 0.f;
#pragma unroll
                    for (int j = 0; j < 8; ++j) { d0 = dot2(rb[kk][j].x, hb[j].x, d0); d1 = dot2(rb[kk][j].y, hb[j].y, d1); d0 = dot2(rb[kk][j].z, hb[j].z, d0); d1 = dot2(rb[kk][j].w, hb[j].w, d1); }
                    __builtin_amdgcn_sched_barrier(0);
                    if (k4 + 4 < 16) { const int e = __builtin_amdgcn_readlane(eid, k4 + 4 + kk); const u32x4* up = (const u32x4*)(PU + (size_t)e * D) + lane;
#pragma unroll
                        for (int j = 0; j < 8; ++j) rb[kk][j] = up[64 * j]; }
                    const float dt = sum64(d0 + d1);
                    if (lane == k4 + kk) wgt = gate * gelu_erf(dt);
                    __builtin_amdgcn_sched_barrier(0); }
            }
        }
        float acc[8][8];
#pragma unroll
        for (int j = 0; j < 8; ++j)
#pragma unroll
            for (int e = 0; e < 8; ++e) acc[j][e] = 0.f;
        {   u32x4 rb[VG][8];
#pragma unroll
            for (int kk = 0; kk < VG; ++kk) { const int e = __builtin_amdgcn_readlane(eid, kk); const u32x4* vp = (const u32x4*)(PV + (size_t)e * D) + lane;
#pragma unroll
                for (int j = 0; j < 8; ++j) rb[kk][j] = vp[64 * j]; }
#pragma unroll 1
            for (int k4 = 0; k4 < 16; k4 += VG) {
#pragma unroll
                for (int kk = 0; kk < VG; ++kk) { const float w = __builtin_bit_cast(float, __builtin_amdgcn_readlane(__builtin_bit_cast(int, wgt), k4 + kk));
#pragma unroll
                    for (int j = 0; j < 8; ++j) { const u32x4 q = rb[kk][j];
                        acc[j][0] = fmaf(w, bflo(q.x), acc[j][0]); acc[j][1] = fmaf(w, bfhi(q.x), acc[j][1]); acc[j][2] = fmaf(w, bflo(q.y), acc[j][2]); acc[j][3] = fmaf(w, bfhi(q.y), acc[j][3]);
                        acc[j][4] = fmaf(w, bflo(q.z), acc[j][4]); acc[j][5] = fmaf(w, bfhi(q.z), acc[j][5]); acc[j][6] = fmaf(w, bflo(q.w), acc[j][6]); acc[j][7] = fmaf(w, bfhi(q.w), acc[j][7]); }
                    __builtin_amdgcn_sched_barrier(0);
                    if (k4 + VG < 16) { const int e = __builtin_amdgcn_readlane(eid, k4 + VG + kk); const u32x4* vp = (const u32x4*)(PV + (size_t)e * D) + lane;
#pragma unroll
                        for (int j = 0; j < 8; ++j) rb[kk][j] = vp[64 * j]; }
                    __builtin_amdgcn_sched_barrier(0); }
            }
        }
#pragma unroll
        for (int j = 0; j < 8; ++j) { *(LAS f32x4*)(part + ((wid * 16 + j * 2 + 0) * 64 + lane) * 4) = (f32x4){acc[j][0], acc[j][1], acc[j][2], acc[j][3]};
                                      *(LAS f32x4*)(part + ((wid * 16 + j * 2 + 1) * 64 + lane) * 4) = (f32x4){acc[j][4], acc[j][5], acc[j][6], acc[j][7]}; }
        __syncthreads();
        {   f32x4 a = (f32x4){0.f, 0.f, 0.f, 0.f}, c = a;
#pragma unroll
            for (int w = 0; w < 8; ++w) { a = a + *(const LAS f32x4*)(part + ((w * 16 + wid * 2 + 0) * 64 + lane) * 4); c = c + *(const LAS f32x4*)(part + ((w * 16 + wid * 2 + 1) * 64 + lane) * 4); }
            f32x4* hp = (f32x4*)(H + (size_t)tok * D + 8 * tid);
#if (DBG_SKIP & 1)
            a = hp[0]; c = hp[1];
#elif (DBG_SKIP & 8)
            a = a * 0.5f + hp[0]; c = c * 0.5f + hp[1];
#else
            a = a + hp[0]; c = c + hp[1];
#endif
            if (!FINAL) { hp[0] = a; hp[1] = c; }
            float ss = (a[0] * a[0] + a[1] * a[1]) + (a[2] * a[2] + a[3] * a[3]) + (c[0] * c[0] + c[1] * c[1]) + (c[2] * c[2] + c[3] * c[3]);
            ss = sum64(ss);
            if (lane == 0) red[wid] = ss;
            __syncthreads();
            float tot = 0.f;
#pragma unroll
            for (int w = 0; w < 8; ++w) tot += red[w];
            const float inv = rsqrtf(tot * (1.0f / D) + NORM_EPS);
            if (!FINAL) { u32x4 o; o.x = cvt_pk_bf16(a[0] * inv, a[1] * inv); o.y = cvt_pk_bf16(a[2] * inv, a[3] * inv); o.z = cvt_pk_bf16(c[0] * inv, c[1] * inv); o.w = cvt_pk_bf16(c[2] * inv, c[3] * inv);
                *(u32x4*)(HB + (size_t)tok * D + 8 * tid) = o; }
            else if (tok < MX) { const f32x4 g0 = *(const f32x4*)(fgain + 8 * tid), g1 = *(const f32x4*)(fgain + 8 * tid + 4);
                f32x4* op = (f32x4*)(out + (size_t)tok * D + 8 * tid); op[0] = a * inv * g0; op[1] = c * inv * g1; }
        }
        __syncthreads();
    }
}
#define MK_PER_PHASE 0
#ifndef MK_PER_PHASE
#define MK_PER_PHASE 0
#endif
constexpr int NPHASE = 15;
struct Args { const float* in[34]; float* out; unsigned char* ws; int ph_lo, ph_hi; };

__global__ void __launch_bounds__(NTHREADS, 2) fwd(Args args) {
    extern __shared__ __attribute__((aligned(16))) unsigned char lds_raw[];
    LAS unsigned char* lds = (LAS unsigned char*)lds_raw;
    const int tid = threadIdx.x, G = gridDim.x, cblk = blockIdx.x;
    unsigned char* ws = args.ws;
    volatile LAS unsigned* MISC = (volatile LAS unsigned*)(lds + MISC_OFF);
    if (tid < 64) MISC[tid] = 0u;
    __syncthreads();
    const int lo = args.ph_lo, hi = args.ph_hi;
    unsigned* barw = (unsigned*)(ws + WS_CTL) + CW_BAR;
    XcdBarrier bar; bar.bar = barw; bar.x = 0; bar.st = nullptr;
    if (hi - lo > 1) bar = xcd_barrier_post(barw, MISC + 8);
#ifndef PH_MASK
#define PH_MASK 0x7fff
#endif
#define IN(k) (((PH_MASK >> (k)) & 1) && lo <= (k) && (k) < hi)
#define SEAM(k) do { if ((k) + 1 < hi) xcd_barrier(bar); } while (0)
    bf16_t* HB = (bf16_t*)(ws + WS_HB); float* H = (float*)(ws + WS_H);

    if (IN(0)) { phase_prologue(args.in, ws, lds, G); SEAM(0); }
    if (IN(1)) { pg8::Gemm g{HB, (const bf16_t*)(ws + WS_W1T), D, D, D}; pg8::StaticOrder S; S.init(MX / 256, ZLD / 256, G, cblk);
        EpiBf16 E{(bf16_t*)(ws + WS_Z), ZLD, nullptr};
        pg8::gemm_phase<EpiBf16, pg8::StaticOrder, true>(lds, g, S, E);
        pg8::gemm_tail(HB + (size_t)MX * D, g, ZLD / 256, S, E); SEAM(1); }
    if (IN(2)) { phase_prep(args.in[8], ws, G); SEAM(2); }
    if (IN(3)) {
        { pg8::Gemm g{(const bf16_t*)(ws + WS_LA), (const bf16_t*)(ws + WS_BTL), 512, 256, 256}; pg8::StaticOrder S; S.init(MX / 256, 24, G, cblk, 16, 256);
          EpiF32 E{(float*)(ws + WS_WAG), WAGLD, 0};
          pg8::gemm_phase<EpiF32, pg8::StaticOrder, true>(lds, g, S, E);
          pg8::gemm_tail((const bf16_t*)(ws + WS_LA) + (size_t)MX * 512, g, 24, S, E); }
        { pg8::Gemm g{(const bf16_t*)(ws + WS_PM), (const bf16_t*)(ws + WS_BTP), 2048, 512, 512}; pg8::StaticOrder S; S.init(MX / 256, 8, G, cblk, 2, 512);
          EpiBf16 E{(bf16_t*)(ws + WS_Y), D, args.in[7]};
          pg8::gemm_phase<EpiBf16, pg8::StaticOrder, true>(lds, g, S, E);
          pg8::gemm_tail((const bf16_t*)(ws + WS_PM) + (size_t)MX * 2048, g, 8, S, E); }
        SEAM(3); }
    if (IN(4)) { phase_rwkv(args.in, ws, lds, G); SEAM(4); }
    if (IN(5)) { pg8::Gemm g{(const bf16_t*)(ws + WS_Y), (const bf16_t*)(ws + WS_WOT), D, D, D}; pg8::StaticOrder S; S.init(MX / 256, D / 256, G, cblk);
        EpiF32 E{H, D, 1};
        pg8::gemm_phase<EpiF32, pg8::StaticOrder, true>(lds, g, S, E);
        pg8::gemm_tail((const bf16_t*)(ws + WS_Y) + (size_t)MX * D, g, D / 256, S, E); SEAM(5); }
    if (IN(6)) { phase_norm(ws, G); SEAM(6); }
    if (IN(7)) { pg8::Gemm g{HB, (const bf16_t*)(ws + WS_WST), D, D, D}; pg8::StaticOrder S; S.init(MX / 256, 8, G, cblk);
        EpiF32 E{(float*)(ws + WS_SC), 2048, 0};
        pg8::gemm_phase<EpiF32, pg8::StaticOrder, true>(lds, g, S, E);
        pg8::gemm_tail(HB + (size_t)MX * D, g, 8, S, E); SEAM(7); }
    if (IN(8)) { phase_expert<false>(nullptr, nullptr, ws, lds, 0, G); SEAM(8); }
    if (IN(9)) { pg8::Gemm g{HB, (const bf16_t*)(ws + WS_WIO), D, D, D}; pg8::StaticOrder S; S.init(MX / 256, 8, G, cblk);
        EpiBf16 E{(bf16_t*)(ws + WS_U), 2048, nullptr};
        pg8::gemm_phase<EpiBf16, pg8::StaticOrder, true>(lds, g, S, E);
        pg8::gemm_tail(HB + (size_t)MX * D, g, 8, S, E); SEAM(9); }
    if (IN(10)) { phase_s5(args.in, ws, lds, G); SEAM(10); }
    if (IN(11)) { pg8::Gemm g{(const bf16_t*)(ws + WS_YS), (const bf16_t*)(ws + WS_WGT), 2048, 2048, 2048}; pg8::StaticOrder S; S.init(MX / 256, 32, G, cblk);
        EpiGlu E{H};
        pg8::gemm_phase<EpiGlu, pg8::StaticOrder, true>(lds, g, S, E);
        pg8::gemm_tail((const bf16_t*)(ws + WS_YS) + (size_t)MX * 2048, g, 32, S, E); SEAM(11); }
    if (IN(12)) { phase_norm(ws, G); SEAM(12); }
    if (IN(13)) { pg8::Gemm g{HB, (const bf16_t*)(ws + WS_WST) + (size_t)2048 * D, D, D, D}; pg8::StaticOrder S; S.init(MX / 256, 8, G, cblk);
        EpiF32 E{(float*)(ws + WS_SC), 2048, 0};
        pg8::gemm_phase<EpiF32, pg8::StaticOrder, true>(lds, g, S, E);
        pg8::gemm_tail(HB + (size_t)MX * D, g, 8, S, E); SEAM(13); }
    if (IN(14)) { phase_expert<true>(args.in[4], args.out, ws, lds, 1, G); }
#undef IN
#undef SEAM
}

extern "C" void kernel_launch(void* const* d_in, const int* in_sizes, int n_in, void* d_out, int out_size, void* d_ws, size_t ws_size, hipStream_t stream) {
    static int grid = 0;
    if (grid == 0) {
        if (n_in != 34 || out_size != MX * D || ws_size < WS_END) { fprintf(stderr, "kernel_launch: unexpected shapes (n_in %d, out %d, ws %zu < %zu); nothing launched\n", n_in, out_size, ws_size, (size_t)WS_END); grid = -1; return; }
        int dev = 0, cus = 0, per_cu = 0;
        if (hipGetDevice(&dev) != hipSuccess || hipDeviceGetAttribute(&cus, hipDeviceAttributeMultiprocessorCount, dev) != hipSuccess) { grid = -1; return; }
        if (hipFuncSetAttribute((const void*)fwd, hipFuncAttributeMaxDynamicSharedMemorySize, LDS_BYTES) != hipSuccess) { fprintf(stderr, "kernel_launch: hipFuncSetAttribute failed\n"); grid = -1; return; }
        if (hipOccupancyMaxActiveBlocksPerMultiprocessor(&per_cu, (const void*)fwd, NTHREADS, LDS_BYTES) != hipSuccess || per_cu < 1) { fprintf(stderr, "kernel_launch: occupancy query reports %d workgroups per CU\n", per_cu); }
        (void)hipGetLastError();
        grid = cus;
    }
    if (grid < 0) return;
    (void)hipMemsetAsync((char*)d_ws + WS_CTL, 0, CTL_ZERO_BYTES, stream);
    Args a{};
    for (int i = 0; i < 34; ++i) a.in[i] = (const float*)d_in[i];
    a.out = (float*)d_out; a.ws = (unsigned char*)d_ws;
#if MK_PER_PHASE
    for (int p = 0; p < NPHASE; ++p) { a.ph_lo = p; a.ph_hi = p + 1; hipLaunchKernelGGL(fwd, dim3(grid), dim3(NTHREADS), LDS_BYTES, stream, a); }
#else
    a.ph_lo = 0; a.ph_hi = NPHASE; hipLaunchKernelGGL(fwd, dim3(grid), dim3(NTHREADS), LDS_BYTES, stream, a);
#endif
}
```

```cpp
#include <hip/hip_runtime.h>
#include <cstdio>
#include <cstdint>

#define LAS __attribute__((address_space(3)))
typedef unsigned short bf16_t;
typedef short bf16x8 __attribute__((ext_vector_type(8)));
typedef __bf16 bf16x2 __attribute__((ext_vector_type(2)));
typedef float f32x4 __attribute__((ext_vector_type(4)));
typedef float f32x2 __attribute__((ext_vector_type(2)));
typedef unsigned u32x4 __attribute__((ext_vector_type(4)));
typedef unsigned u32x2 __attribute__((ext_vector_type(2)));

__device__ __forceinline__ unsigned f2bf(float f) { unsigned u = __builtin_bit_cast(unsigned, f); return (u + 0x7fffu + ((u >> 16) & 1u)) >> 16; }
__device__ __forceinline__ unsigned pk2(float lo, float hi) { return f2bf(lo) | (f2bf(hi) << 16); }
__device__ __forceinline__ unsigned cvt_pk_bf16(float lo, float hi) { unsigned r; asm volatile("v_cvt_pk_bf16_f32 %0, %1, %2" : "=v"(r) : "v"(lo), "v"(hi)); return r; }
__device__ __forceinline__ float bflo(unsigned w) { return __builtin_bit_cast(float, w << 16); }
__device__ __forceinline__ float bfhi(unsigned w) { return __builtin_bit_cast(float, w & 0xffff0000u); }
__device__ __forceinline__ float bf2f(bf16_t b) { return __builtin_bit_cast(float, ((unsigned)b) << 16); }
__device__ __forceinline__ float dot2(unsigned a, unsigned b, float acc) { return __builtin_amdgcn_fdot2_f32_bf16(__builtin_bit_cast(bf16x2, a), __builtin_bit_cast(bf16x2, b), acc, false); }
template <int CTRL> __device__ __forceinline__ float dppf(float x) { return __builtin_bit_cast(float, __builtin_amdgcn_mov_dpp(__builtin_bit_cast(int, x), CTRL, 0xf, 0xf, true)); }
template <int CTRL> __device__ __forceinline__ unsigned dppu(unsigned x) { return (unsigned)__builtin_amdgcn_mov_dpp((int)x, CTRL, 0xf, 0xf, true); }
constexpr int DPP_XOR1 = 0xB1, DPP_XOR2 = 0x4E, DPP_HMIRROR = 0x141, DPP_MIRROR = 0x140;
__device__ __forceinline__ float sum8(float x) { x += dppf<DPP_XOR1>(x); x += dppf<DPP_XOR2>(x); x += dppf<DPP_HMIRROR>(x); return x; }
__device__ __forceinline__ float sum16(float x) { x = sum8(x); x += dppf<DPP_MIRROR>(x); return x; }
__device__ __forceinline__ float sum64(float x) {
    x = sum16(x);
    { const auto s = __builtin_amdgcn_permlane16_swap(__float_as_uint(x), __float_as_uint(x), false, false); const unsigned a = s[0], b = s[1]; x = __uint_as_float(a) + __uint_as_float(b); }
    { const auto t = __builtin_amdgcn_permlane32_swap(__float_as_uint(x), __float_as_uint(x), false, false); const unsigned a = t[0], b = t[1]; x = __uint_as_float(a) + __uint_as_float(b); }
    return x;
}
__device__ __forceinline__ unsigned umax_u(unsigned a, unsigned b) { return a > b ? a : b; }
__device__ __forceinline__ unsigned max64u(unsigned x) {
    x = umax_u(x, dppu<DPP_XOR1>(x)); x = umax_u(x, dppu<DPP_XOR2>(x)); x = umax_u(x, dppu<DPP_HMIRROR>(x)); x = umax_u(x, dppu<DPP_MIRROR>(x));
    auto s = __builtin_amdgcn_permlane16_swap(x, x, false, false); x = umax_u(s[0], s[1]);
    auto t = __builtin_amdgcn_permlane32_swap(x, x, false, false); return umax_u(t[0], t[1]);
}
__device__ __forceinline__ float gelu_erf(float v) { return 0.5f * v * (1.0f + erff(v * 0.70710678118654752f)); }
__device__ __forceinline__ float sigmoidf_(float v) { return 1.0f / (1.0f + __expf(-v)); }
#define DBG_SKIP 0
#define PROBE_DUP 0
namespace pg8 {
#define PG8_LAS __attribute__((address_space(3)))
constexpr int BM = 256, BK = 64, HALF = 128, HTB = HALF * BK * 2  , STAGE_BYTES = 8 * HTB, NXCD = 8, WGM = 8;

__host__ __device__ __forceinline__ int lds_byte(int r, int c) { const int st = (r >> 4) * 2 + (c >> 5), rr = r & 15, cc = c & 31, ob = rr * 64 + cc * 2; return st * 1024 + (ob ^ (((ob >> 9) & 1) << 5)); }
__host__ __device__ __forceinline__ void stage_rc(int b, int& R, int& C) { const int st = b / 1024, sb = b % 1024, swz = sb ^ (((sb >> 9) & 1) << 5); R = (st >> 1) * 16 + swz / 64; C = (st & 1) * 32 + (swz % 64) / 2; }
__host__ __device__ __forceinline__ int perm32(int rho) { const int n = rho >> 4, i = rho & 15; return 8 * (i >> 2) + 4 * n + (i & 3); }

struct Unit { int pm, pn; };
struct Gemm { const bf16_t* A; const bf16_t* Bt; int lda, ldb, K; };

struct StaticOrder {
    int nM, nN, nwg, G, c, kdiv, kmul;
    __device__ void init(int nM_, int nN_, int G_, int c_, int kdiv_ = 1 << 30, int kmul_ = 0) { nM = nM_; nN = nN_; nwg = nM * nN; G = G_; c = c_; kdiv = kdiv_; kmul = kmul_; }
    __device__ bool next(int i, Unit& u) const {
        const long L = (long)i * G + c; if (L >= nwg) return false;
        int wgid = (int)L; { const int q = nwg / NXCD, r = nwg % NXCD, xcd = wgid % NXCD, off = wgid / NXCD; wgid = (xcd < r ? xcd * (q + 1) : r * (q + 1) + (xcd - r) * q) + off; }
        const int nig = WGM * nN, gid = wgid / nig, fm = gid * WGM, gsz = (nM - fm) < WGM ? (nM - fm) : WGM;
        u.pm = fm + ((wgid % nig) % gsz); u.pn = (wgid % nig) / gsz; return true;
    }
    __device__ __forceinline__ int koff(const Unit& u) const { return (u.pn / kdiv) * kmul; }
};

template <class Epi, class Sched, bool ALIGN_EPI>
__device__ __forceinline__ void gemm_phase(PG8_LAS unsigned char* lds, const Gemm g, const Sched& S, const Epi& E) {
    int tid = threadIdx.x; asm volatile("" : "+v"(tid));
    const int wid = __builtin_amdgcn_readfirstlane(tid >> 6), lane = tid & 63, wr = wid >> 2, wc = wid & 3, fr = lane & 15, fq = lane >> 4;
    const int K = g.K, nt = K / BK;
    unsigned voffA[2], voffB[2];
#pragma unroll
    for (int i = 0; i < 2; ++i) { int R, C; stage_rc(tid * 16 + i * 8192, R, C); const int Rb = Epi::PERM ? ((R & ~31) + perm32(R & 31)) : R;
        voffA[i] = (unsigned)(R * g.lda + C) * 2u; voffB[i] = (unsigned)(Rb * g.ldb + C) * 2u; }
    const size_t kstep = (size_t)(BK * 2);
    const size_t hstepA = (size_t)HALF * g.lda * 2, hstepB = (size_t)HALF * g.ldb * 2;
    const size_t tstepA = 2 * hstepA, tstepB = 2 * hstepB;
    const unsigned ldsw = (unsigned)wid * 1024u;
    const int aoff = lds_byte(wr * 64 + fr, fq * 8), boff = lds_byte(wc * 32 + fr, fq * 8);
#define PG8_SA(b, h) (((b) * 2 + (h)) * HTB)
#define PG8_SB(b, h) ((4 + (b) * 2 + (h)) * HTB)
#define PG8_STAGE(bufoff, gbase, voff) do { _Pragma("unroll") for (int _i = 0; _i < 2; ++_i) \
        __builtin_amdgcn_global_load_lds((const unsigned*)((const char*)(gbase) + (voff)[_i]), (PG8_LAS unsigned*)(lds + (bufoff) + ldsw + _i * 8192), 16, 0, 0); } while (0)
#define PG8_LDA(dst, b, h) do { _Pragma("unroll") for (int m = 0; m < 4; ++m) _Pragma("unroll") for (int k = 0; k < 2; ++k) dst[m][k] = *(const PG8_LAS bf16x8*)(lds + PG8_SA(b, h) + aoff + m * 2048 + k * 1024); } while (0)
#define PG8_LDB(dst, b, h) do { _Pragma("unroll") for (int n = 0; n < 2; ++n) _Pragma("unroll") for (int k = 0; k < 2; ++k) dst[n][k] = *(const PG8_LAS bf16x8*)(lds + PG8_SB(b, h) + boff + n * 2048 + k * 1024); } while (0)
#define PG8_MMA(ai, bj, At, Bt) do { __builtin_amdgcn_s_setprio(1); _Pragma("unroll") for (int m = 0; m < 4; ++m) _Pragma("unroll") for (int n = 0; n < 2; ++n) _Pragma("unroll") for (int k = 0; k < 2; ++k) \
        acc[ai][bj][m][n] = __builtin_amdgcn_mfma_f32_16x16x32_bf16(Bt[n][k], At[m][k], acc[ai][bj][m][n], 0, 0, 0); __builtin_amdgcn_s_setprio(0); } while (0)
#define PG8_WAIT_V(n) asm volatile("s_waitcnt vmcnt(" #n ")" ::: "memory")
#define PG8_WAIT_L(n) asm volatile("s_waitcnt lgkmcnt(" #n ")" ::: "memory")
#define PG8_BAR __builtin_amdgcn_s_barrier()
#define PG8_SCHED __builtin_amdgcn_sched_barrier(0)
    Unit cur, nxt; int ui = 0;
    if (!S.next(0, cur)) return;
    f32x4 acc[2][2][4][2];
#pragma unroll
    for (int a = 0; a < 2; ++a)
#pragma unroll
        for (int b = 0; b < 2; ++b)
#pragma unroll
            for (int m = 0; m < 4; ++m)
#pragma unroll
                for (int n = 0; n < 2; ++n) acc[a][b][m][n] = (f32x4){0.f, 0.f, 0.f, 0.f};
    bf16x8 At[4][2], B0[2][2], B1[2][2];
    const char* cA = (const char*)g.A + (size_t)cur.pm * tstepA + (size_t)S.koff(cur) * 2; const char* cB = (const char*)g.Bt + (size_t)cur.pn * tstepB;
    PG8_STAGE(PG8_SB(0, 0), cB, voffB); PG8_STAGE(PG8_SB(0, 1), cB + hstepB, voffB); PG8_STAGE(PG8_SA(0, 0), cA, voffA); PG8_STAGE(PG8_SA(0, 1), cA + hstepA, voffA);
    if (wr == 1) PG8_BAR;
    PG8_WAIT_V(2); PG8_BAR;
    PG8_STAGE(PG8_SB(1, 0), cB + kstep, voffB); PG8_STAGE(PG8_SA(1, 0), cA + kstep, voffA); PG8_STAGE(PG8_SB(1, 1), cB + hstepB + kstep, voffB);
    PG8_WAIT_V(6); PG8_BAR;
    for (;;) {
        const bool has_next = S.next(ui + 1, nxt);
        const char* nA = has_next ? (const char*)g.A + (size_t)nxt.pm * tstepA + (size_t)S.koff(nxt) * 2 : cA; const char* nB = has_next ? (const char*)g.Bt + (size_t)nxt.pn * tstepB : cB;
        for (int t = 0; t < nt; t += 2) {
            const bool last = (t == nt - 2);
            const char* a1 = cA + (size_t)(t + 1) * kstep;
            const char* a2 = last ? nA : cA + (size_t)(t + 2) * kstep; const char* b2 = last ? nB : cB + (size_t)(t + 2) * kstep;
            const char* a3 = a2 + kstep; const char* b3 = b2 + kstep;
            PG8_LDB(B0, 0, 0); PG8_LDB(B1, 0, 1); PG8_SCHED; PG8_LDA(At, 0, 0); PG8_STAGE(PG8_SA(1, 1), a1 + hstepA, voffA);
            PG8_WAIT_V(8); PG8_WAIT_L(0); PG8_BAR; PG8_MMA(0, 0, At, B0); PG8_MMA(0, 1, At, B1); PG8_BAR; PG8_SCHED;
            PG8_LDA(At, 0, 1); PG8_STAGE(PG8_SB(0, 0), b2, voffB); PG8_STAGE(PG8_SB(0, 1), b2 + hstepB, voffB); PG8_STAGE(PG8_SA(0, 0), a2, voffA);
            PG8_WAIT_V(8); PG8_WAIT_L(0); PG8_BAR; PG8_MMA(1, 0, At, B0); PG8_MMA(1, 1, At, B1); PG8_BAR; PG8_SCHED;
            PG8_LDB(B0, 1, 0); PG8_LDB(B1, 1, 1); PG8_SCHED; PG8_LDA(At, 1, 0); PG8_STAGE(PG8_SA(0, 1), a2 + hstepA, voffA);
            PG8_WAIT_V(8); PG8_WAIT_L(0); PG8_BAR; PG8_MMA(0, 0, At, B0); PG8_MMA(0, 1, At, B1); PG8_BAR; PG8_SCHED;
            PG8_LDA(At, 1, 1); PG8_STAGE(PG8_SB(1, 0), b3, voffB); PG8_STAGE(PG8_SB(1, 1), b3 + hstepB, voffB); PG8_STAGE(PG8_SA(1, 0), a3, voffA);
            PG8_WAIT_V(8); PG8_WAIT_L(0); PG8_BAR; PG8_MMA(1, 0, At, B0); PG8_MMA(1, 1, At, B1); PG8_BAR; PG8_SCHED;
        }
        if constexpr (ALIGN_EPI) { if (wr == 0) PG8_BAR; }
        E(acc, cur, wr, wc, fr, fq);
        if (!has_next) break;
#pragma unroll
        for (int a = 0; a < 2; ++a)
#pragma unroll
            for (int b = 0; b < 2; ++b)
#pragma unroll
                for (int m = 0; m < 4; ++m)
#pragma unroll
                    for (int n = 0; n < 2; ++n) acc[a][b][m][n] = (f32x4){0.f, 0.f, 0.f, 0.f};
        cur = nxt; cA = nA; cB = nB; ++ui;
        if constexpr (ALIGN_EPI) { if (wr == 1) PG8_BAR; }
    }
    PG8_WAIT_V(0);
    if constexpr (!ALIGN_EPI) { if (wr == 0) PG8_BAR; }
    PG8_BAR;
#undef PG8_SA
#undef PG8_SB
#undef PG8_STAGE
#undef PG8_LDA
#undef PG8_LDB
#undef PG8_MMA
}

template <class Epi, class Sched>
__device__ __forceinline__ void gemm_tail(const bf16_t* A16, const Gemm g, int nN, const Sched& S, const Epi& E) {
    int tid = threadIdx.x; asm volatile("" : "+v"(tid));
    const int wid = __builtin_amdgcn_readfirstlane(tid >> 6), lane = tid & 63, fr = lane & 15, fq = lane >> 4;
    for (int pn = S.G - 1 - S.c; pn < nN; pn += S.G) {
        Unit u; u.pm = 0; u.pn = pn;
        const bf16_t* a = A16 + (size_t)fr * g.lda + S.koff(u) + fq * 8;
        const bf16_t* b0 = g.Bt + (size_t)(pn * 256 + 16 * wid + fr) * g.ldb + fq * 8;
        const bf16_t* b1 = b0 + (size_t)128 * g.ldb;
        f32x4 acc0 = (f32x4){0.f, 0.f, 0.f, 0.f}, acc1 = acc0;
#pragma unroll 4
        for (int k0 = 0; k0 < g.K; k0 += 32) {
            const bf16x8 af = *(const bf16x8*)(a + k0), w0 = *(const bf16x8*)(b0 + k0), w1 = *(const bf16x8*)(b1 + k0);
            acc0 = __builtin_amdgcn_mfma_f32_16x16x32_bf16(w0, af, acc0, 0, 0, 0);
            acc1 = __builtin_amdgcn_mfma_f32_16x16x32_bf16(w1, af, acc1, 0, 0, 0);
        }
        E.tail(fr, pn, 16 * wid + 4 * fq, acc0, acc1);
    }
}
#undef PG8_WAIT_V
#undef PG8_WAIT_L
#undef PG8_BAR
#undef PG8_SCHED
}
#define XB_TMO      128
#define XB_XCNT(j)  (256  + 64 * (j))
#define XB_XSUB(j)  (1280 + 64 * (j))
#define XB_XGEN(j)  (2304 + 64 * (j))
#define XB_TOP      3328
#define XB_TOPGEN   3392
#define XCD_BAR_WORDS 3456
#define XB_SPIN_CAP (1u << 18)

__device__ __forceinline__ unsigned xb_ld(unsigned* p)              { return __hip_atomic_load(p, __ATOMIC_RELAXED, __HIP_MEMORY_SCOPE_AGENT); }
__device__ __forceinline__ unsigned xb_add(unsigned* p, unsigned v) { return __hip_atomic_fetch_add(p, v, __ATOMIC_RELAXED, __HIP_MEMORY_SCOPE_AGENT); }
__device__ __forceinline__ unsigned xb_xcc_id() { return (unsigned)__builtin_amdgcn_s_getreg((3 << 11) | 20) & 0xFu; }
#define XB_SPIN(cond, bar) do { unsigned _sp = 0; while (cond) { __builtin_amdgcn_s_sleep(1); \
    if ((++_sp & 255u) == 0u) { if (xb_ld(&(bar)[XB_TMO])) break; if (_sp > XB_SPIN_CAP) { atomicAdd(&(bar)[XB_TMO], 1u); break; } } } } while (0)

struct XcdBarrier {
    unsigned* bar; unsigned x;
    volatile LAS unsigned* st;
};

__device__ __forceinline__ XcdBarrier xcd_barrier_post(unsigned* bar, volatile LAS unsigned* st) {
    XcdBarrier b; b.bar = bar; b.x = xb_xcc_id(); b.st = st;
    if (threadIdx.x == 0) (void)xb_add(&bar[XB_XCNT(b.x)], 1u);
    return b;
}
__device__ __forceinline__ void xcd_barrier_complete(unsigned* bar, unsigned x, unsigned& nloc, unsigned& nx) {
    const unsigned G = gridDim.x * gridDim.y * gridDim.z;
    unsigned sum, cnt, mine, sp = 0u;
    for (;;) {
        sum = 0u; cnt = 0u; mine = 0u;
#pragma unroll
        for (unsigned j = 0; j < 16; ++j) { const unsigned c = xb_ld(&bar[XB_XCNT(j)]); sum += c; cnt += (c > 0u) ? 1u : 0u; mine = (j == x) ? c : mine; }
        if (sum == G) break;
        __builtin_amdgcn_s_sleep(1);
        if ((++sp & 255u) == 0u) { if (xb_ld(&bar[XB_TMO])) break; if (sp > XB_SPIN_CAP) { atomicAdd(&bar[XB_TMO], 1u); break; } }
    }
    nloc = mine > 0u ? mine : 1u; nx = cnt > 0u ? cnt : 1u;
}

__device__ __forceinline__ void xcd_barrier(const XcdBarrier& b) {
    asm volatile("s_waitcnt vmcnt(0)" ::: "memory");
    __syncthreads();
    if (threadIdx.x == 0) {
        unsigned* bar = b.bar;
        __builtin_amdgcn_s_waitcnt(0);
        unsigned nloc = b.st[0], nx = b.st[1];
        if (nloc == 0u) { xcd_barrier_complete(bar, b.x, nloc, nx); b.st[0] = nloc; b.st[1] = nx; }
        const unsigned old = xb_add(&bar[XB_XSUB(b.x)], 1u);
        const unsigned gen = old / nloc;
        if (old + 1u == (gen + 1u) * nloc) {
            __builtin_amdgcn_fence(__ATOMIC_RELEASE, "agent");
            asm volatile("s_waitcnt vmcnt(0)" ::: "memory");
            const unsigned og = xb_add(&bar[XB_TOP], 1u);
            const unsigned tg = og / nx;
            if (og + 1u == (tg + 1u) * nx) xb_add(&bar[XB_TOPGEN], 1u);
            else XB_SPIN(xb_ld(&bar[XB_TOPGEN]) == tg, bar);
            __builtin_amdgcn_fence(__ATOMIC_ACQUIRE, "agent");
            xb_add(&bar[XB_XGEN(b.x)], 1u);
            asm volatile("s_waitcnt vmcnt(0)" ::: "memory");
        } else {
            XB_SPIN(xb_ld(&bar[XB_XGEN(b.x)]) == gen, bar);
            __builtin_amdgcn_fence(__ATOMIC_ACQUIRE, "agent");
            asm volatile("s_waitcnt vmcnt(0)" ::: "memory");
        }
    }
    __syncthreads();
}
constexpr int D = 4096, NB = 4, SEQ = 2048, NMETA = 16, LSEQ = SEQ + NMETA;
constexpr int MX = NB * SEQ;
constexpr int MROWS = MX + NMETA;
constexpr float NORM_EPS = 1e-6f, GN_EPS = 64e-5f;
constexpr int ZC = 8640, ZLD = 8704;
constexpr int ZR = 2048, ZK = 4096, ZV = 6144, ZWL = 8192, ZAL = 8288, ZGL = 8384;
constexpr int NHEAD = 32, HDIM = 64;
constexpr int WAGLD = 6144;
constexpr int NEXP = 16384;
__device__ __forceinline__ int rowof(int b, int pos) { return pos < NMETA ? MX + pos : b * SEQ + pos - NMETA; }

constexpr size_t MiB = 1u << 20;
constexpr size_t wsal(size_t x) { return (x + 4095) & ~(size_t)4095; }
constexpr size_t WS_CTL = 0, CTL_ZERO_BYTES = 1 * MiB;
constexpr size_t WS_W1T = 1 * MiB;
constexpr size_t WS_WOT = WS_W1T + wsal((size_t)ZLD * D * 2);
constexpr size_t WS_WIO = WS_WOT + wsal((size_t)D * D * 2);
constexpr size_t WS_WGT = WS_WIO + wsal((size_t)2048 * D * 2);
constexpr size_t WS_WST = WS_WGT + wsal((size_t)8192 * 2048 * 2);
constexpr size_t WS_BTP = WS_WST + wsal((size_t)2 * 2048 * D * 2);
constexpr size_t WS_BTL = WS_BTP + wsal((size_t)2048 * 512 * 2);
constexpr size_t WS_PU  = WS_BTL + wsal((size_t)6144 * 256 * 2);
constexpr size_t WS_PV  = WS_PU + wsal((size_t)2 * NEXP * D);
constexpr size_t WS_SU  = WS_PV + wsal((size_t)2 * NEXP * D);
constexpr size_t WS_SV  = WS_SU + wsal((size_t)2 * NEXP * 4);
constexpr size_t WS_H   = WS_SV + wsal((size_t)2 * NEXP * 4);
constexpr size_t WS_HB  = WS_H + wsal((size_t)MROWS * D * 4);
constexpr size_t WS_Z   = WS_HB + wsal((size_t)MROWS * D * 2);
constexpr size_t WS_PM  = WS_Z + wsal((size_t)MROWS * ZLD * 2);
constexpr size_t WS_LA  = WS_PM + wsal((size_t)MROWS * 2048 * 2);
constexpr size_t WS_WAG = WS_LA + wsal((size_t)MROWS * 512 * 2);
constexpr size_t WS_Y   = WS_WAG + wsal((size_t)MROWS * WAGLD * 4);
constexpr size_t WS_SC  = WS_Y + wsal((size_t)MROWS * D * 2);
constexpr size_t WS_U   = WS_SC + wsal((size_t)MROWS * 2048 * 4);
constexpr size_t WS_YS  = WS_U + wsal((size_t)MROWS * 2048 * 2);
constexpr size_t WS_END = WS_YS + wsal((size_t)MROWS * 2048 * 2);
constexpr int CW_BAR = 4096;

constexpr int LDS_BYTES = 163840;
constexpr int SCR_BYTES = 131072;
constexpr int MISC_OFF = SCR_BYTES;
constexpr int RED_OFF = MISC_OFF + 256;
constexpr int BONUS_OFF = MISC_OFF + 512;

struct EpiBf16 {
    static constexpr bool PERM = true;
    bf16_t* O; int ldc; const float* colscale;
    __device__ __forceinline__ void operator()(const f32x4 (&acc)[2][2][4][2], const pg8::Unit& u, int wr, int wc, int fr, int fq) const {
        const int row0 = u.pm * 256 + wr * 64 + fr, col0 = u.pn * 256 + wc * 32 + 8 * fq;
        f32x4 sv[2][2];
#pragma unroll
        for (int bj = 0; bj < 2; ++bj)
#pragma unroll
            for (int n = 0; n < 2; ++n) sv[bj][n] = colscale ? *(const f32x4*)(colscale + col0 + bj * 128 + 4 * n) : (f32x4){1.f, 1.f, 1.f, 1.f};
#pragma unroll
        for (int ai = 0; ai < 2; ++ai)
#pragma unroll
            for (int m = 0; m < 4; ++m) { bf16_t* rowp = O + (size_t)(row0 + ai * 128 + m * 16) * ldc + col0;
#pragma unroll
                for (int bj = 0; bj < 2; ++bj) { const f32x4 v0 = acc[ai][bj][m][0] * sv[bj][0], v1 = acc[ai][bj][m][1] * sv[bj][1];
                    u32x4 w; w.x = cvt_pk_bf16(v0[0], v0[1]); w.y = cvt_pk_bf16(v0[2], v0[3]); w.z = cvt_pk_bf16(v1[0], v1[1]); w.w = cvt_pk_bf16(v1[2], v1[3]);
                    *(u32x4*)(rowp + bj * 128) = w; } }
    }
    __device__ __forceinline__ void tail(int r, int pn, int c4, f32x4 lo, f32x4 hi) const {
        const int col = pn * 256 + c4; bf16_t* rowp = O + (size_t)(MX + r) * ldc + col;
        if (colscale) { lo = lo * *(const f32x4*)(colscale + col); hi = hi * *(const f32x4*)(colscale + col + 128); }
        u32x2 a, b; a.x = cvt_pk_bf16(lo[0], lo[1]); a.y = cvt_pk_bf16(lo[2], lo[3]); b.x = cvt_pk_bf16(hi[0], hi[1]); b.y = cvt_pk_bf16(hi[2], hi[3]);
        *(u32x2*)rowp = a; *(u32x2*)(rowp + 128) = b;
    }
};
struct EpiF32 {
    static constexpr bool PERM = false;
    float* C; int ldc; int accum;
    __device__ __forceinline__ void operator()(const f32x4 (&acc)[2][2][4][2], const pg8::Unit& u, int wr, int wc, int fr, int fq) const {
        const int row0 = u.pm * 256 + wr * 64 + fr, col0 = u.pn * 256 + wc * 32 + 4 * fq;
#pragma unroll
        for (int ai = 0; ai < 2; ++ai)
#pragma unroll
            for (int m = 0; m < 4; ++m) { float* rowp = C + (size_t)(row0 + ai * 128 + m * 16) * ldc + col0;
#pragma unroll
                for (int bj = 0; bj < 2; ++bj)
#pragma unroll
                    for (int n = 0; n < 2; ++n) { f32x4* p = (f32x4*)(rowp + bj * 128 + n * 16); f32x4 v = acc[ai][bj][m][n]; if (accum) v = v + *p; *p = v; } }
    }
    __device__ __forceinline__ void tail(int r, int pn, int c4, f32x4 lo, f32x4 hi) const {
        float* rowp = C + (size_t)(MX + r) * ldc + pn * 256 + c4; f32x4* p0 = (f32x4*)rowp; f32x4* p1 = (f32x4*)(rowp + 128);
        if (accum) { lo = lo + *p0; hi = hi + *p1; }
        *p0 = lo; *p1 = hi;
    }
};
__device__ __forceinline__ float decay_of(float x) {
    const float y = -x, sp = fmaxf(y, 0.f) + log1pf(__expf(-fabsf(y)));
    return __expf(-__expf(-sp - 0.5f));
}
#ifndef DBG_SKIP
#define DBG_SKIP 0
#endif
struct EpiGlu {
    static constexpr bool PERM = false;
    float* H;
    __device__ __forceinline__ void operator()(const f32x4 (&acc)[2][2][4][2], const pg8::Unit& u, int wr, int wc, int fr, int fq) const {
        const int row0 = u.pm * 256 + wr * 64 + fr, col0 = u.pn * 128 + wc * 32 + 4 * fq;
#pragma unroll
        for (int ai = 0; ai < 2; ++ai)
#pragma unroll
            for (int m = 0; m < 4; ++m) { float* rowp = H + (size_t)(row0 + ai * 128 + m * 16) * D + col0;
#pragma unroll
                for (int n = 0; n < 2; ++n) { f32x4* p = (f32x4*)(rowp + n * 16); const f32x4 ga = acc[ai][0][m][n], gb = acc[ai][1][m][n]; f32x4 v = *p;
                    if (!(DBG_SKIP & 2)) { v[0] += ga[0] * sigmoidf_(gb[0]); v[1] += ga[1] * sigmoidf_(gb[1]); v[2] += ga[2] * sigmoidf_(gb[2]); v[3] += ga[3] * sigmoidf_(gb[3]); } *p = v; } }
    }
    __device__ __forceinline__ void tail(int r, int pn, int c4, f32x4 lo, f32x4 hi) const {
        f32x4* p = (f32x4*)(H + (size_t)(MX + r) * D + pn * 128 + c4); f32x4 v = *p;
        v[0] += lo[0] * sigmoidf_(hi[0]); v[1] += lo[1] * sigmoidf_(hi[1]); v[2] += lo[2] * sigmoidf_(hi[2]); v[3] += lo[3] * sigmoidf_(hi[3]); *p = v;
    }
};
#define LDS_WAIT() asm volatile("s_waitcnt lgkmcnt(0)" ::: "memory")
constexpr int NWAVES = 8, NTHREADS = 512;

__device__ __forceinline__ void transpose_item(const float* W, int ldw, int k0, int n0, const float* scale, bf16_t* dst, int dld, int drow0, LAS float* scr, int lane) {
#pragma unroll 8
    for (int i = 0; i < 32; ++i) { const int kk = 2 * i + (lane >> 5); float v = W[(size_t)(k0 + kk) * ldw + n0 + (lane & 31)]; if (scale) v *= scale[k0 + kk]; scr[kk * 33 + (lane & 31)] = v; }
    LDS_WAIT();
    const int c = lane & 7;
#pragma unroll
    for (int j = 0; j < 4; ++j) { const int n = (lane >> 3) + 8 * j; const LAS float* s = scr + (8 * c) * 33 + n;
        u32x4 o; o.x = pk2(s[0 * 33], s[1 * 33]); o.y = pk2(s[2 * 33], s[3 * 33]); o.z = pk2(s[4 * 33], s[5 * 33]); o.w = pk2(s[6 * 33], s[7 * 33]);
        *(u32x4*)(dst + (size_t)(drow0 + n) * dld + k0 + 8 * c) = o; }
    LDS_WAIT();
}
__device__ __forceinline__ void norm_row(const float* src, float* cpy, bf16_t* dstb, int lane) {
    f32x4 v[16]; float s = 0.f;
#pragma unroll
    for (int j = 0; j < 16; ++j) { v[j] = ((const f32x4*)src)[lane + 64 * j]; s += (v[j][0] * v[j][0] + v[j][1] * v[j][1]) + (v[j][2] * v[j][2] + v[j][3] * v[j][3]); }
    s = sum64(s);
    const float inv = rsqrtf(s * (1.0f / D) + NORM_EPS);
#pragma unroll
    for (int j = 0; j < 16; ++j) { if (cpy) ((f32x4*)cpy)[lane + 64 * j] = v[j];
        u32x2 o; o.x = cvt_pk_bf16(v[j][0] * inv, v[j][1] * inv); o.y = cvt_pk_bf16(v[j][2] * inv, v[j][3] * inv); ((u32x2*)dstb)[lane + 64 * j] = o; }
}
__device__ __forceinline__ bf16x8 cvt8(const float* p) {
    const f32x4 a = *(const f32x4*)p, b = *(const f32x4*)(p + 4);
    u32x4 o; o.x = pk2(a[0], a[1]); o.y = pk2(a[2], a[3]); o.z = pk2(b[0], b[1]); o.w = pk2(b[2], b[3]);
    return __builtin_bit_cast(bf16x8, o);
}

struct P0Args { const float* const* in; };

__device__ __forceinline__ void phase_prologue(const float* const (&in)[34], unsigned char* ws, LAS unsigned char* lds, int G) {
    int tid = threadIdx.x; asm volatile("" : "+v"(tid)); const int lane = tid & 63, wid = __builtin_amdgcn_readfirstlane(tid >> 6);
    const int gw = blockIdx.x * NWAVES + wid, NGW = G * NWAVES;
    const size_t gt = (size_t)blockIdx.x * NTHREADS + tid, NT = (size_t)G * NTHREADS;
    LAS float* scr = (LAS float*)(lds + wid * 16384);
    bf16_t* W1T = (bf16_t*)(ws + WS_W1T); bf16_t* WOT = (bf16_t*)(ws + WS_WOT); bf16_t* WIO = (bf16_t*)(ws + WS_WIO); bf16_t* WGT = (bf16_t*)(ws + WS_WGT);
    bf16_t* WST = (bf16_t*)(ws + WS_WST); bf16_t* BTP = (bf16_t*)(ws + WS_BTP); bf16_t* BTL = (bf16_t*)(ws + WS_BTL);
    constexpr int I1 = (D / 64) * (ZC / 32), I2 = (D / 64) * (D / 32), I3 = (D / 64) * (2048 / 32), I4 = (2048 / 64) * (8192 / 32), I5 = 4 * (512 / 64) * (512 / 32);
    for (int it = gw; it < I1 + I2 + I3 + I4 + I5; it += NGW) {
        int r = it;
        if (r < I1) { const int nb = ZC / 32, kb = r / nb, n0 = (r % nb) * 32; transpose_item(in[5], ZC, kb * 64, n0, in[2], W1T, D, n0, scr, lane); continue; } r -= I1;
        if (r < I2) { const int nb = D / 32, kb = r / nb, n0 = (r % nb) * 32; transpose_item(in[19], D, kb * 64, n0, nullptr, WOT, D, n0, scr, lane); continue; } r -= I2;
        if (r < I3) { const int nb = 2048 / 32, kb = r / nb, n0 = (r % nb) * 32; transpose_item(in[20], 2048, kb * 64, n0, in[2] + D, WIO, D, n0, scr, lane); continue; } r -= I3;
        if (r < I4) { const int nb = 8192 / 32, kb = r / nb, n0 = (r % nb) * 32;
            const int half = n0 >= 4096, c = n0 - half * 4096, drow = (c >> 7) * 256 + half * 128 + (c & 127);
            transpose_item(in[29], 8192, kb * 64, n0, nullptr, WGT, 2048, drow, scr, lane); continue; } r -= I4;
        { const int grp = r / 128, rr = r % 128, kb = rr / 16, n0 = (rr % 16) * 32; transpose_item(in[6] + (size_t)grp * 512 * 512, 512, kb * 64, n0, nullptr, BTP, 512, grp * 512 + n0, scr, lane); }
    }
    for (size_t i = gt; i < (size_t)(ZLD - ZC) * D / 8; i += NT) ((u32x4*)(W1T + (size_t)ZC * D))[i] = (u32x4){0u, 0u, 0u, 0u};
    for (size_t i = gt; i < (size_t)6144 * 256; i += NT) { const int n = (int)(i >> 8), k = (int)(i & 255), reg = n >> 11, c = n & 2047; float v = 0.f;
        if (reg == 0) { if (k < 96) v = in[10][(size_t)k * 2048 + c]; }
        else if (reg == 1) { if (k >= 128 && k < 224) v = in[12][(size_t)(k - 128) * 2048 + c]; }
        else v = in[13][(size_t)k * 2048 + c];
        BTL[i] = (bf16_t)f2bf(v); }
    { const int fr = lane & 15, fq = lane >> 4;
      for (int it = gw; it < 2 * 16 * 256; it += NGW) {
        const int layer = it >> 12, hp = (it >> 8) & 15, d0 = (it & 255) * 16;
        const float* wq = in[30] + (size_t)layer * D * 2048 + (size_t)(d0 + fr) * 2048 + hp * 128 + fq * 8;
        const float* sk = in[31] + ((size_t)(layer * 16 + hp) * 128 + fr) * 128 + fq * 8;
        f32x4 acc[8];
#pragma unroll
        for (int kt = 0; kt < 8; ++kt) acc[kt] = (f32x4){0.f, 0.f, 0.f, 0.f};
#pragma unroll
        for (int ks = 0; ks < 4; ++ks) { const bf16x8 a = cvt8(wq + ks * 32);
#pragma unroll
            for (int kt = 0; kt < 8; ++kt) { const bf16x8 b = cvt8(sk + (size_t)kt * 16 * 128 + ks * 32); acc[kt] = __builtin_amdgcn_mfma_f32_16x16x32_bf16(a, b, acc[kt], 0, 0, 0); } }
        const f32x4 gn = *(const f32x4*)(in[3] + layer * D + d0 + 4 * fq);
#pragma unroll
        for (int kt = 0; kt < 8; ++kt) { const f32x4 v = acc[kt] * gn; u32x2 o; o.x = cvt_pk_bf16(v[0], v[1]); o.y = cvt_pk_bf16(v[2], v[3]);
            *(u32x2*)(WST + ((size_t)layer * 2048 + hp * 128 + kt * 16 + fr) * D + d0 + 4 * fq) = o; }
      } }
    { unsigned char* PU8 = ws + WS_PU; unsigned char* PV8 = ws + WS_PV; float* SU = (float*)(ws + WS_SU); float* SV = (float*)(ws + WS_SV);
      for (int it = gw; it < 4 * NEXP; it += NGW) {
          const int tbl = it >= 2 * NEXP, r = it - tbl * 2 * NEXP, layer = r >= NEXP;
          const f32x4* src = (const f32x4*)((tbl ? in[33] : in[32]) + (size_t)r * D) + lane;
          const f32x4* gp = (const f32x4*)(in[3] + layer * D) + lane;
          f32x4 v[16]; float am = 0.f;
#pragma unroll
          for (int j = 0; j < 16; ++j) { v[j] = src[64 * j]; if (!tbl) v[j] = v[j] * gp[64 * j];
              am = fmaxf(fmaxf(am, fmaxf(fabsf(v[j][0]), fabsf(v[j][1]))), fmaxf(fabsf(v[j][2]), fabsf(v[j][3]))); }
          am = __uint_as_float(max64u(__float_as_uint(am)));
          const float q = am > 0.f ? 256.0f / am : 0.f;
          unsigned* dst = (unsigned*)((tbl ? PV8 : PU8) + (size_t)r * D) + lane;
#pragma unroll
          for (int j = 0; j < 16; ++j) { int w = __builtin_amdgcn_cvt_pk_fp8_f32(v[j][0] * q, v[j][1] * q, 0, false); w = __builtin_amdgcn_cvt_pk_fp8_f32(v[j][2] * q, v[j][3] * q, w, true); dst[64 * j] = (unsigned)w; }
          if (lane == 0) (tbl ? SV : SU)[r] = am * (1.0f / 256.0f);
      } }
    { float* H = (float*)(ws + WS_H); bf16_t* HB = (bf16_t*)(ws + WS_HB);
      for (int r = gw; r < MROWS; r += NGW) { const float* src = r < MX ? in[0] + (size_t)r * D : in[1] + (size_t)(r - MX) * D; norm_row(src, H + (size_t)r * D, HB + (size_t)r * D, lane); } }
}

__device__ __forceinline__ void phase_norm(unsigned char* ws, int G) {
    int tid = threadIdx.x; asm volatile("" : "+v"(tid)); const int lane = tid & 63, wid = __builtin_amdgcn_readfirstlane(tid >> 6);
    const float* H = (const float*)(ws + WS_H); bf16_t* HB = (bf16_t*)(ws + WS_HB);
    for (int r = blockIdx.x * NWAVES + wid; r < MROWS; r += G * NWAVES) norm_row(H + (size_t)r * D, nullptr, HB + (size_t)r * D, lane);
}

__device__ __forceinline__ void phase_prep(const float* mu, unsigned char* ws, int G) {
    int tid = threadIdx.x; asm volatile("" : "+v"(tid));
    const bf16_t* Z = (const bf16_t*)(ws + WS_Z); bf16_t* PM = (bf16_t*)(ws + WS_PM); bf16_t* LA = (bf16_t*)(ws + WS_LA);
    const int c4 = tid * 4, grp = c4 >> 9, w = 2 << grp;
    float msk[16];
#pragma unroll
    for (int i = 0; i < 16; ++i) msk[i] = i < w ? 1.f : 0.f;
    for (int it = blockIdx.x; it < NB * 129; it += G) {
        const int b = it / 129, blk = it % 129; if (b > 0 && blk == 0) continue;
        const int p0 = blk * 16;
        float zz[31][4];
#pragma unroll
        for (int i = 0; i < 31; ++i) { const int pos = p0 - 15 + i;
            if (pos >= 0) { const u32x2 q = *(const u32x2*)(Z + (size_t)rowof(b, pos) * ZLD + c4); zz[i][0] = bflo(q.x); zz[i][1] = bfhi(q.x); zz[i][2] = bflo(q.y); zz[i][3] = bfhi(q.y); }
            else { zz[i][0] = 0.f; zz[i][1] = 0.f; zz[i][2] = 0.f; zz[i][3] = 0.f; } }
#pragma unroll
        for (int t = 0; t < 16; ++t) { const int pos = p0 + t; float s[4] = {0.f, 0.f, 0.f, 0.f};
#pragma unroll
            for (int i = 0; i < 16; ++i) {
#pragma unroll
                for (int e = 0; e < 4; ++e) s[e] = fmaf(zz[15 + t - i][e], msk[i], s[e]); }
            const float ic = 1.0f / (float)(pos + 1 < w ? pos + 1 : w);
            u32x2 o; o.x = cvt_pk_bf16(s[0] * ic - zz[15 + t][0], s[1] * ic - zz[15 + t][1]); o.y = cvt_pk_bf16(s[2] * ic - zz[15 + t][2], s[3] * ic - zz[15 + t][3]);
            *(u32x2*)(PM + (size_t)rowof(b, pos) * 2048 + c4) = o; }
    }
    for (size_t i = (size_t)blockIdx.x * NTHREADS + tid; i < (size_t)MROWS * 512; i += (size_t)G * NTHREADS) {
        const int row = (int)(i >> 9), k = (int)(i & 511);
        int prow; if (row >= MX) prow = row > MX ? row - 1 : -1; else prow = (row & (SEQ - 1)) ? row - 1 : MX + NMETA - 1;
        int zc = -1, kind = 0;
        if (k < 96) { zc = ZWL + k; kind = 1; } else if (k >= 128 && k < 224) { zc = ZAL + k - 128; kind = 2; } else if (k >= 256) { zc = ZGL + k - 256; kind = 3; }
        float v = 0.f;
        if (zc >= 0) { const float z = bf2f(Z[(size_t)row * ZLD + zc]), zp = prow >= 0 ? bf2f(Z[(size_t)prow * ZLD + zc]) : 0.f; const float sh = z + (zp - z) * mu[zc - 2048];
            v = kind == 1 ? tanhf(sh) : (kind == 2 ? sh : sigmoidf_(sh)); }
        LA[i] = (bf16_t)f2bf(v);
    }
}

struct RwkvRegs { u32x2 zr, zk, zv, pr, pk, pv; f32x4 dec, a, g; };
__device__ __forceinline__ void rwkv_load(RwkvRegs& R, const bf16_t* Z, const float* WAG, int b, int h, int pos, int j4, f32x4 w0v, f32x4 a0v) {
    const u32x2 z0 = {0u, 0u};
    if (pos < LSEQ) { const int row = rowof(b, pos); const bf16_t* zp = Z + (size_t)row * ZLD + h * 64 + j4;
        R.zr = *(const u32x2*)(zp + ZR); R.zk = *(const u32x2*)(zp + ZK); R.zv = *(const u32x2*)(zp + ZV);
        if (pos > 0) { const bf16_t* pp = Z + (size_t)rowof(b, pos - 1) * ZLD + h * 64 + j4; R.pr = *(const u32x2*)(pp + ZR); R.pk = *(const u32x2*)(pp + ZK); R.pv = *(const u32x2*)(pp + ZV); }
        else { R.pr = z0; R.pk = z0; R.pv = z0; }
        const float* wp = WAG + (size_t)row * WAGLD + h * 64 + j4; R.dec = *(const f32x4*)wp; R.a = *(const f32x4*)(wp + 2048); R.g = *(const f32x4*)(wp + 4096);
        R.dec = R.dec + w0v; R.a = R.a + a0v;
#pragma unroll
        for (int e = 0; e < 4; ++e) { R.dec[e] = decay_of(R.dec[e]); R.a[e] = sigmoidf_(R.a[e]); }
    } else { R.zr = z0; R.zk = z0; R.zv = z0; R.pr = z0; R.pk = z0; R.pv = z0; R.dec = (f32x4){1.f, 1.f, 1.f, 1.f}; R.a = (f32x4){0.f, 0.f, 0.f, 0.f}; R.g = R.a; }
}
__device__ __forceinline__ f32x4 unpack4(u32x2 q) { return (f32x4){bflo(q.x), bfhi(q.x), bflo(q.y), bfhi(q.y)}; }
__device__ __forceinline__ void phase_rwkv(const float* const (&in)[34], unsigned char* ws, LAS unsigned char* lds, int G) {
    int tid = threadIdx.x; asm volatile("" : "+v"(tid)); const int lane = tid & 63, wid = __builtin_amdgcn_readfirstlane(tid >> 6);
    const bf16_t* Z = (const bf16_t*)(ws + WS_Z); const float* WAG = (const float*)(ws + WS_WAG); bf16_t* Y = (bf16_t*)(ws + WS_Y);
    const int tt = tid >> 4, q = tid & 15, j4 = q * 4;
    const int ri = lane >> 3, cg = lane & 7, myrow = wid * 8 + ri;
    LAS float* bonus = (LAS float*)(lds + BONUS_OFF);
    for (int chain = blockIdx.x; chain < NB * NHEAD; chain += G) {
        const int b = chain >> 5, h = chain & 31;
        const float* mu = in[8];
        const f32x4 mur = *(const f32x4*)(mu + h * 64 + j4), muk = *(const f32x4*)(mu + 2048 + h * 64 + j4), muv = *(const f32x4*)(mu + 4096 + h * 64 + j4);
        const f32x4 kk_ = *(const f32x4*)(in[14] + h * 64 + j4), ka_ = *(const f32x4*)(in[15] + h * 64 + j4), rk_ = *(const f32x4*)(in[16] + h * 64 + j4);
        const f32x4 gng = *(const f32x4*)(in[17] + h * 64 + j4), gnb = *(const f32x4*)(in[18] + h * 64 + j4);
        float S[8];
#pragma unroll
        for (int j = 0; j < 8; ++j) S[j] = 0.f;
        const f32x4 w0v = *(const f32x4*)(in[9] + h * 64 + j4), a0v = *(const f32x4*)(in[11] + h * 64 + j4);
        RwkvRegs R; rwkv_load(R, Z, WAG, b, h, tt, j4, w0v, a0v);
        const int nchunk = (LSEQ + 31) / 32;
        for (int c = 0; c < nchunk; ++c) {
            LAS float* buf = (LAS float*)(lds + (c & 1) * 65536);
            LAS float* bon = bonus + (c & 1) * 32;
            {
                const f32x4 zr = unpack4(R.zr), zk = unpack4(R.zk), zv = unpack4(R.zv), pr = unpack4(R.pr), pk = unpack4(R.pk), pv = unpack4(R.pv);
                const f32x4 r = zr + (pr - zr) * mur, k = zk + (pk - zk) * muk, v = zv + (pv - zv) * muv;
                const f32x4 kr = k * kk_;
                const float ss = sum16((kr[0] * kr[0] + kr[1] * kr[1]) + (kr[2] * kr[2] + kr[3] * kr[3]));
                const float inrm = 1.0f / fmaxf(sqrtf(ss), 1e-12f);
                const f32x4 kk = kr * inrm;
                const f32x4 km = k * (1.0f + (R.a - 1.0f) * ka_);
                const f32x4 kka = kk * R.a;
                const f32x4 rb = r * km * rk_;
                const float bs = sum16((rb[0] + rb[1]) + (rb[2] + rb[3]));
                const int o = tt * 64 + j4;
                *(LAS f32x4*)(buf + 0 * 2048 + o) = r; *(LAS f32x4*)(buf + 1 * 2048 + o) = R.dec; *(LAS f32x4*)(buf + 2 * 2048 + o) = km; *(LAS f32x4*)(buf + 3 * 2048 + o) = v;
                *(LAS f32x4*)(buf + 4 * 2048 + o) = kk; *(LAS f32x4*)(buf + 5 * 2048 + o) = kka; *(LAS f32x4*)(buf + 6 * 2048 + o) = R.g;
                if (q == 0) bon[tt] = bs;
            }
            __syncthreads();
            if (c + 1 < nchunk) rwkv_load(R, Z, WAG, b, h, (c + 1) * 32 + tt, j4, w0v, a0v);
            const int nst = (LSEQ - c * 32) < 32 ? (LSEQ - c * 32) : 32;
            for (int t = 0; t < nst; ++t) {
                const LAS float* p = buf + t * 64 + cg * 8;
                const f32x4 r0 = *(const LAS f32x4*)(p), r1 = *(const LAS f32x4*)(p + 4);
                const f32x4 d0 = *(const LAS f32x4*)(p + 2048), d1 = *(const LAS f32x4*)(p + 2048 + 4);
                const f32x4 m0 = *(const LAS f32x4*)(p + 4096), m1 = *(const LAS f32x4*)(p + 4096 + 4);
                const float vv = buf[3 * 2048 + t * 64 + myrow];
                const f32x4 k0 = *(const LAS f32x4*)(p + 8192), k1 = *(const LAS f32x4*)(p + 8192 + 4);
                const f32x4 a0 = *(const LAS f32x4*)(p + 10240), a1 = *(const LAS f32x4*)(p + 10240 + 4);
                float sa = (S[0] * k0[0] + S[1] * k0[1]) + (S[2] * k0[2] + S[3] * k0[3]) + (S[4] * k1[0] + S[5] * k1[1]) + (S[6] * k1[2] + S[7] * k1[3]);
                sa = -sum8(sa);
                S[0] = S[0] * d0[0] + sa * a0[0] + vv * m0[0]; S[1] = S[1] * d0[1] + sa * a0[1] + vv * m0[1]; S[2] = S[2] * d0[2] + sa * a0[2] + vv * m0[2]; S[3] = S[3] * d0[3] + sa * a0[3] + vv * m0[3];
                S[4] = S[4] * d1[0] + sa * a1[0] + vv * m1[0]; S[5] = S[5] * d1[1] + sa * a1[1] + vv * m1[1]; S[6] = S[6] * d1[2] + sa * a1[2] + vv * m1[2]; S[7] = S[7] * d1[3] + sa * a1[3] + vv * m1[3];
                float y = (S[0] * r0[0] + S[1] * r0[1]) + (S[2] * r0[2] + S[3] * r0[3]) + (S[4] * r1[0] + S[5] * r1[1]) + (S[6] * r1[2] + S[7] * r1[3]);
                y = sum8(y);
                if (cg == 0) buf[7 * 2048 + t * 64 + myrow] = y;
            }
            __syncthreads();
            {
                const int pos = c * 32 + tt;
                const int o = tt * 64 + j4;
                const f32x4 y = *(const LAS f32x4*)(buf + 7 * 2048 + o), v = *(const LAS f32x4*)(buf + 3 * 2048 + o), g = *(const LAS f32x4*)(buf + 6 * 2048 + o);
                const float mean = sum16((y[0] + y[1]) + (y[2] + y[3])) * (1.0f / 64.0f);
                const f32x4 dy = y - mean;
                const float var = sum16((dy[0] * dy[0] + dy[1] * dy[1]) + (dy[2] * dy[2] + dy[3] * dy[3])) * (1.0f / 64.0f);
                const float rs = rsqrtf(var + GN_EPS), bs = bon[tt];
#if (DBG_SKIP & 4)
                const f32x4 out = (f32x4){0.f, 0.f, 0.f, 0.f};
#else
                const f32x4 out = (dy * rs * gng + gnb + v * bs) * g;
#endif
                if (pos < LSEQ && (b == 0 || pos >= NMETA)) { u32x2 w; w.x = cvt_pk_bf16(out[0], out[1]); w.y = cvt_pk_bf16(out[2], out[3]);
                    *(u32x2*)(Y + (size_t)rowof(b, pos) * D + 2048 + h * 64 + j4) = w; }
            }
        }
        __syncthreads();
    }
}

__device__ __forceinline__ void phase_s5(const float* const (&in)[34], unsigned char* ws, LAS unsigned char* lds, int G) {
    int tid = threadIdx.x; asm volatile("" : "+v"(tid)); const int lane = tid & 63, wid = __builtin_amdgcn_readfirstlane(tid >> 6), fr = lane & 15, fq = lane >> 4;
    if (wid >= 2) return;
    const bf16_t* U = (const bf16_t*)(ws + WS_U); bf16_t* YS = (bf16_t*)(ws + WS_YS);
    LAS unsigned char* wl = lds + wid * 32768;
    LAS bf16_t* BB = (LAS bf16_t*)wl;
    LAS float* BU = (LAS float*)(wl + 4096);
    LAS unsigned char* XB = wl + 4096 + 16 * 132 * 4;
    for (int chain = blockIdx.x * 2 + wid; chain < NB * 128; chain += G * 2) {
        const int b = chain >> 7, g = chain & 127, p = lane;
        const float lr = in[21][g * 64 + p], li = in[22][g * 64 + p], dt = expf(in[23][g]);
        const float mag = expf(lr * dt); float sn, cs; sincosf(li * dt, &sn, &cs);
        const float ar = mag * cs, ai = mag * sn, den = lr * lr + li * li;
        const float f_r = ((ar - 1.0f) * lr + ai * li) / den, f_i = (ai * lr - (ar - 1.0f) * li) / den;
        {   const float* br = in[24] + (size_t)(g * 64 + p) * 16; const float* bi = in[25] + (size_t)(g * 64 + p) * 16;
            unsigned wre[8], wim[8];
#pragma unroll
            for (int c = 0; c < 16; c += 2) { const float r0 = br[c], i0 = bi[c], r1 = br[c + 1], i1 = bi[c + 1];
                wre[c >> 1] = pk2(f_r * r0 - f_i * i0, f_r * r1 - f_i * i1); wim[c >> 1] = pk2(f_r * i0 + f_i * r0, f_r * i1 + f_i * r1); }
            *(LAS u32x4*)(BB + p * 16) = (u32x4){wre[0], wre[1], wre[2], wre[3]}; *(LAS u32x4*)(BB + p * 16 + 8) = (u32x4){wre[4], wre[5], wre[6], wre[7]};
            *(LAS u32x4*)(BB + (64 + p) * 16) = (u32x4){wim[0], wim[1], wim[2], wim[3]}; *(LAS u32x4*)(BB + (64 + p) * 16 + 8) = (u32x4){wim[4], wim[5], wim[6], wim[7]};
        }
        LDS_WAIT();
        bf16x8 bop[8];
#pragma unroll
        for (int nt = 0; nt < 8; ++nt) { u32x4 z = {0u, 0u, 0u, 0u}; if (fq < 2) z = *(const LAS u32x4*)(BB + (nt * 16 + fr) * 16 + fq * 8); bop[nt] = __builtin_bit_cast(bf16x8, z); }
        bf16x8 cop[4];
#pragma unroll
        for (int ks = 0; ks < 4; ++ks) { const float* src = (ks < 2 ? in[26] : in[27]) + (size_t)(g * 16 + fr) * 64 + (ks & 1) * 32 + fq * 8;
            const f32x4 a = *(const f32x4*)src, c2 = *(const f32x4*)(src + 4); const float sg = ks < 2 ? 1.f : -1.f;
            u32x4 o; o.x = pk2(sg * a[0], sg * a[1]); o.y = pk2(sg * a[2], sg * a[3]); o.z = pk2(sg * c2[0], sg * c2[1]); o.w = pk2(sg * c2[2], sg * c2[3]); cop[ks] = __builtin_bit_cast(bf16x8, o); }
        const f32x4 dsk = *(const f32x4*)(in[28] + g * 16 + 4 * fq);
        float xr = 0.f, xi = 0.f;
        for (int ck = 0; ck < LSEQ / 16; ++ck) {
            const int pos0 = ck * 16;
            const bf16_t* urow = U + (size_t)rowof(b, pos0 + fr) * 2048 + g * 16;
            u32x4 uz = {0u, 0u, 0u, 0u}; if (fq < 2) uz = *(const u32x4*)(urow + fq * 8);
            const u32x2 usk = *(const u32x2*)(urow + 4 * fq);
            const bf16x8 uop = __builtin_bit_cast(bf16x8, uz);
#pragma unroll
            for (int nt = 0; nt < 8; ++nt) { f32x4 acc = __builtin_amdgcn_mfma_f32_16x16x32_bf16(uop, bop[nt], (f32x4){0.f, 0.f, 0.f, 0.f}, 0, 0, 0);
#pragma unroll
                for (int i = 0; i < 4; ++i) BU[(4 * fq + i) * 132 + nt * 16 + fr] = acc[i]; }
            LDS_WAIT();
#pragma unroll
            for (int t = 0; t < 16; ++t) { const float bur = BU[t * 132 + p], bui = BU[t * 132 + 64 + p];
                const float nr = ar * xr - ai * xi + bur, ni = ar * xi + ai * xr + bui; xr = nr; xi = ni;
                *(LAS bf16_t*)(XB + t * 272 + p * 2) = (bf16_t)f2bf(nr); *(LAS bf16_t*)(XB + t * 272 + 128 + p * 2) = (bf16_t)f2bf(ni); }
            LDS_WAIT();
            f32x4 yacc = {0.f, 0.f, 0.f, 0.f};
#pragma unroll
            for (int ks = 0; ks < 4; ++ks) { const bf16x8 xop = *(const LAS bf16x8*)(XB + fr * 272 + ks * 64 + fq * 16); yacc = __builtin_amdgcn_mfma_f32_16x16x32_bf16(cop[ks], xop, yacc, 0, 0, 0); }
            LDS_WAIT();
            const int pos = pos0 + fr;
            const f32x4 uu = unpack4(usk);
            f32x4 yv = yacc + uu * dsk;
            yv[0] = gelu_erf(yv[0]); yv[1] = gelu_erf(yv[1]); yv[2] = gelu_erf(yv[2]); yv[3] = gelu_erf(yv[3]);
            if (b == 0 || pos >= NMETA) { u32x2 o; o.x = cvt_pk_bf16(yv[0], yv[1]); o.y = cvt_pk_bf16(yv[2], yv[3]); *(u32x2*)(YS + (size_t)rowof(b, pos) * 2048 + g * 16 + 4 * fq) = o; }
        }
    }
}

__device__ __forceinline__ unsigned ordkey(float v) { const unsigned u = __builtin_bit_cast(unsigned, v); return (u & 0x80000000u) ? ~u : (u | 0x80000000u); }
__device__ __forceinline__ float unord(unsigned k) { const unsigned u = (k & 0x80000000u) ? (k & 0x7fffffffu) : ~k; return __builtin_bit_cast(float, u); }
#ifndef EXP_UR
#define EXP_UR 4
#endif
#ifndef EXP_VR
#define EXP_VR 4
#endif
constexpr int UR = EXP_UR, VR = EXP_VR;
template <bool FINAL, bool DRY = false>
__device__ __forceinline__ void phase_expert(const float* fgain, float* out, unsigned char* ws, LAS unsigned char* lds, int layer, int G) {
    int tid = threadIdx.x; asm volatile("" : "+v"(tid)); const int lane = tid & 63, wid = __builtin_amdgcn_readfirstlane(tid >> 6);
    const float* SC = (const float*)(ws + WS_SC); float* H = (float*)(ws + WS_H); bf16_t* HB = (bf16_t*)(ws + WS_HB);
    const unsigned char* PU = ws + WS_PU + (size_t)layer * NEXP * D; const unsigned char* PV = ws + WS_PV + (size_t)layer * NEXP * D;
    const float* SU = (const float*)(ws + WS_SU) + layer * NEXP; const float* SV = (const float*)(ws + WS_SV) + layer * NEXP;
    LAS float* part = (LAS float*)lds;
    LAS float* red = (LAS float*)(lds + RED_OFF);
    for (int tok = blockIdx.x; tok < MROWS; tok += G) {
        const float* sc = SC + (size_t)tok * 2048 + wid * 256;
        float s12[2]; int i12[2];
#pragma unroll
        for (int hf = 0; hf < 2; ++hf) {
            const float v0 = sc[hf * 128 + lane], v1 = sc[hf * 128 + 64 + lane];
            unsigned k0 = (ordkey(v0) & ~127u) | (unsigned)(127 - lane), k1 = (ordkey(v1) & ~127u) | (unsigned)(63 - lane);
            float sv = 0.f; int si = 0;
#pragma unroll 1
            for (int k = 0; k < 16; ++k) { const unsigned w = max64u(umax_u(k0, k1)); if (lane == k) { sv = unord(w & ~127u); si = 127 - (int)(w & 127u); } if (k0 == w) k0 = 0u; if (k1 == w) k1 = 0u; }
            s12[hf] = sv; i12[hf] = si;
        }
        const float c1 = __shfl(s12[0], lane >> 2);
        unsigned ck[4];
#pragma unroll
        for (int jj = 0; jj < 4; ++jj) { const int j = (lane & 3) * 4 + jj; const float c2 = __shfl(s12[1], j); ck[jj] = (ordkey(c1 + c2) & ~255u) | (unsigned)(255 - ((lane >> 2) * 16 + j)); }
        float ts = 0.f; int tp = 0;
#pragma unroll 1
        for (int k = 0; k < 16; ++k) { const unsigned w = max64u(umax_u(umax_u(ck[0], ck[1]), umax_u(ck[2], ck[3]))); if (lane == k) { ts = unord(w & ~255u); tp = 255 - (int)(w & 255u); }
#pragma unroll
            for (int jj = 0; jj < 4; ++jj) if (ck[jj] == w) ck[jj] = 0u; }
        const int e1 = __shfl(i12[0], tp >> 4), e2 = __shfl(i12[1], tp & 15);
        const int eid = e1 * 128 + e2;
        float mx = ts; mx = fmaxf(mx, dppf<DPP_XOR1>(mx)); mx = fmaxf(mx, dppf<DPP_XOR2>(mx)); mx = fmaxf(mx, dppf<DPP_HMIRROR>(mx)); mx = fmaxf(mx, dppf<DPP_MIRROR>(mx));
        const float ex = __expf(ts - mx), gate = ex / sum16(ex);
        float su = 0.f, sv = 0.f; if (lane < 16) { su = SU[eid]; sv = SV[eid]; }
        float hbf[4][16];
#pragma unroll
        for (int j = 0; j < 4; ++j) { const u32x4* hp8 = (const u32x4*)(HB + (size_t)tok * D + j * 1024 + 16 * lane); const u32x4 h0 = hp8[0], h1 = hp8[1];
            hbf[j][0] = bflo(h0.x); hbf[j][1] = bfhi(h0.x); hbf[j][2] = bflo(h0.y); hbf[j][3] = bfhi(h0.y); hbf[j][4] = bflo(h0.z); hbf[j][5] = bfhi(h0.z); hbf[j][6] = bflo(h0.w); hbf[j][7] = bfhi(h0.w);
            hbf[j][8] = bflo(h1.x); hbf[j][9] = bfhi(h1.x); hbf[j][10] = bflo(h1.y); hbf[j][11] = bfhi(h1.y); hbf[j][12] = bflo(h1.z); hbf[j][13] = bfhi(h1.z); hbf[j][14] = bflo(h1.w); hbf[j][15] = bfhi(h1.w); }
        float wgt = 0.f;
        {   u32x4 rb[UR][4];
#pragma unroll
            for (int kk = 0; kk < UR; ++kk) { const int e = __builtin_amdgcn_readlane(eid, kk); const u32x4* up = (const u32x4*)(PU + (size_t)e * D) + lane;
#pragma unroll
                for (int j = 0; j < 4; ++j) rb[kk][j] = up[64 * j]; }
#pragma unroll 1
            for (int k4 = 0; k4 < 16; k4 += UR) {
#pragma unroll
                for (int kk = 0; kk < UR; ++kk) { float d0 = 0.f, d1 = 0.f;
#pragma unroll
                    for (int j = 0; j < 4; ++j) { const unsigned wv[4] = {rb[kk][j].x, rb[kk][j].y, rb[kk][j].z, rb[kk][j].w};
#pragma unroll
                        for (int q = 0; q < 4; ++q) { const f32x2 lo = __builtin_amdgcn_cvt_pk_f32_fp8((int)wv[q], false), hi = __builtin_amdgcn_cvt_pk_f32_fp8((int)wv[q], true);
                            d0 = fmaf(lo.x, hbf[j][4 * q + 0], d0); d1 = fmaf(lo.y, hbf[j][4 * q + 1], d1); d0 = fmaf(hi.x, hbf[j][4 * q + 2], d0); d1 = fmaf(hi.y, hbf[j][4 * q + 3], d1); } }
                    __builtin_amdgcn_sched_barrier(0);
                    if (k4 + UR < 16) { const int e = __builtin_amdgcn_readlane(eid, k4 + UR + kk); const u32x4* up = (const u32x4*)(PU + (size_t)e * D) + lane;
#pragma unroll
                        for (int j = 0; j < 4; ++j) rb[kk][j] = up[64 * j]; }
                    const float dt = sum64(d0 + d1);
                    if (lane == k4 + kk) wgt = gate * gelu_erf(dt * su) * sv;
                    __builtin_amdgcn_sched_barrier(0); }
            }
        }
        float acc[4][16];
#pragma unroll
        for (int j = 0; j < 4; ++j)
#pragma unroll
            for (int e = 0; e < 16; ++e) acc[j][e] = 0.f;
        {   u32x4 rb[VR][4];
#pragma unroll
            for (int kk = 0; kk < VR; ++kk) { const int e = __builtin_amdgcn_readlane(eid, kk); const u32x4* vp = (const u32x4*)(PV + (size_t)e * D) + lane;
#pragma unroll
                for (int j = 0; j < 4; ++j) rb[kk][j] = vp[64 * j]; }
#pragma unroll 1
            for (int k4 = 0; k4 < 16; k4 += VR) {
#pragma unroll
                for (int kk = 0; kk < VR; ++kk) { const float w = __builtin_bit_cast(float, __builtin_amdgcn_readlane(__builtin_bit_cast(int, wgt), k4 + kk));
#pragma unroll
                    for (int j = 0; j < 4; ++j) { const unsigned wv[4] = {rb[kk][j].x, rb[kk][j].y, rb[kk][j].z, rb[kk][j].w};
#pragma unroll
                        for (int q = 0; q < 4; ++q) { const f32x2 lo = __builtin_amdgcn_cvt_pk_f32_fp8((int)wv[q], false), hi = __builtin_amdgcn_cvt_pk_f32_fp8((int)wv[q], true);
                            acc[j][4 * q + 0] = fmaf(w, lo.x, acc[j][4 * q + 0]); acc[j][4 * q + 1] = fmaf(w, lo.y, acc[j][4 * q + 1]); acc[j][4 * q + 2] = fmaf(w, hi.x, acc[j][4 * q + 2]); acc[j][4 * q + 3] = fmaf(w, hi.y, acc[j][4 * q + 3]); } }
                    __builtin_amdgcn_sched_barrier(0);
                    if (k4 + VR < 16) { const int e = __builtin_amdgcn_readlane(eid, k4 + VR + kk); const u32x4* vp = (const u32x4*)(PV + (size_t)e * D) + lane;
#pragma unroll
                        for (int j = 0; j < 4; ++j) rb[kk][j] = vp[64 * j]; }
                    __builtin_amdgcn_sched_barrier(0); }
            }
        }
#pragma unroll
        for (int j = 0; j < 4; ++j)
#pragma unroll
            for (int q = 0; q < 4; ++q) *(LAS f32x4*)(part + ((wid * 16 + j * 4 + q) * 64 + lane) * 4) = (f32x4){acc[j][4 * q + 0], acc[j][4 * q + 1], acc[j][4 * q + 2], acc[j][4 * q + 3]};
        __syncthreads();
        {   f32x4 a = (f32x4){0.f, 0.f, 0.f, 0.f}, c = a;
            const int pj = tid >> 7, pl = (tid >> 1) & 63, pq = (tid & 1) * 2;
#pragma unroll
            for (int w = 0; w < 8; ++w) { a = a + *(const LAS f32x4*)(part + ((w * 16 + pj * 4 + pq) * 64 + pl) * 4); c = c + *(const LAS f32x4*)(part + ((w * 16 + pj * 4 + pq + 1) * 64 + pl) * 4); }
            f32x4* hp = (f32x4*)(H + (size_t)tok * D + 8 * tid);
#if (DBG_SKIP & 1)
            a = hp[0]; c = hp[1];
#elif (DBG_SKIP & 8)
            a = a * 0.5f + hp[0]; c = c * 0.5f + hp[1];
#else
            a = a + hp[0]; c = c + hp[1];
#endif
            if (!FINAL && !DRY) { hp[0] = a; hp[1] = c; }
            float ss = (a[0] * a[0] + a[1] * a[1]) + (a[2] * a[2] + a[3] * a[3]) + (c[0] * c[0] + c[1] * c[1]) + (c[2] * c[2] + c[3] * c[3]);
            ss = sum64(ss);
            if (lane == 0) red[wid] = ss;
            __syncthreads();
            float tot = 0.f;
#pragma unroll
            for (int w = 0; w < 8; ++w) tot += red[w];
            const float inv = rsqrtf(tot * (1.0f / D) + NORM_EPS);
            if (DRY) { if (inv == 123.456f) red[9] = inv; }
            else if (!FINAL) { u32x4 o; o.x = cvt_pk_bf16(a[0] * inv, a[1] * inv); o.y = cvt_pk_bf16(a[2] * inv, a[3] * inv); o.z = cvt_pk_bf16(c[0] * inv, c[1] * inv); o.w = cvt_pk_bf16(c[2] * inv, c[3] * inv);
                *(u32x4*)(HB + (size_t)tok * D + 8 * tid) = o; }
            else if (tok < MX) { const f32x4 g0 = *(const f32x4*)(fgain + 8 * tid), g1 = *(const f32x4*)(fgain + 8 * tid + 4);
                f32x4* op = (f32x4*)(out + (size_t)tok * D + 8 * tid); op[0] = a * inv * g0; op[1] = c * inv * g1; }
        }
        __syncthreads();
    }
}
#define MK_PER_PHASE 0
#ifndef PROBE_DUP
#define PROBE_DUP 0
#endif
#ifndef MK_PER_PHASE
#define MK_PER_PHASE 0
#endif
constexpr int NPHASE = 15;
struct Args { const float* in[34]; float* out; unsigned char* ws; int ph_lo, ph_hi; };

__global__ void __launch_bounds__(NTHREADS, 2) fwd(Args args) {
    extern __shared__ __attribute__((aligned(16))) unsigned char lds_raw[];
    LAS unsigned char* lds = (LAS unsigned char*)lds_raw;
    const int tid = threadIdx.x, G = gridDim.x, cblk = blockIdx.x;
    unsigned char* ws = args.ws;
    volatile LAS unsigned* MISC = (volatile LAS unsigned*)(lds + MISC_OFF);
    if (tid < 64) MISC[tid] = 0u;
    __syncthreads();
    const int lo = args.ph_lo, hi = args.ph_hi;
    unsigned* barw = (unsigned*)(ws + WS_CTL) + CW_BAR;
    XcdBarrier bar; bar.bar = barw; bar.x = 0; bar.st = nullptr;
    if (hi - lo > 1) bar = xcd_barrier_post(barw, MISC + 8);
#ifndef PH_MASK
#define PH_MASK 0x7fff
#endif
#define IN(k) (((PH_MASK >> (k)) & 1) && lo <= (k) && (k) < hi)
#define SEAM(k) do { if ((k) + 1 < hi) xcd_barrier(bar); } while (0)
    bf16_t* HB = (bf16_t*)(ws + WS_HB); float* H = (float*)(ws + WS_H);

    if (IN(0)) { phase_prologue(args.in, ws, lds, G); SEAM(0); }
    if (IN(1)) { pg8::Gemm g{HB, (const bf16_t*)(ws + WS_W1T), D, D, D}; pg8::StaticOrder S; S.init(MX / 256, ZLD / 256, G, cblk);
        EpiBf16 E{(bf16_t*)(ws + WS_Z), ZLD, nullptr};
        pg8::gemm_phase<EpiBf16, pg8::StaticOrder, true>(lds, g, S, E);
        pg8::gemm_tail(HB + (size_t)MX * D, g, ZLD / 256, S, E); SEAM(1); }
    if (IN(2)) { phase_prep(args.in[8], ws, G); SEAM(2); }
    if (IN(3)) {
        { pg8::Gemm g{(const bf16_t*)(ws + WS_LA), (const bf16_t*)(ws + WS_BTL), 512, 256, 256}; pg8::StaticOrder S; S.init(MX / 256, 24, G, cblk, 16, 256);
          EpiF32 E{(float*)(ws + WS_WAG), WAGLD, 0};
          pg8::gemm_phase<EpiF32, pg8::StaticOrder, true>(lds, g, S, E);
          pg8::gemm_tail((const bf16_t*)(ws + WS_LA) + (size_t)MX * 512, g, 24, S, E); }
        { pg8::Gemm g{(const bf16_t*)(ws + WS_PM), (const bf16_t*)(ws + WS_BTP), 2048, 512, 512}; pg8::StaticOrder S; S.init(MX / 256, 8, G, cblk, 2, 512);
          EpiBf16 E{(bf16_t*)(ws + WS_Y), D, args.in[7]};
          pg8::gemm_phase<EpiBf16, pg8::StaticOrder, true>(lds, g, S, E);
          pg8::gemm_tail((const bf16_t*)(ws + WS_PM) + (size_t)MX * 2048, g, 8, S, E); }
        SEAM(3); }
    if (IN(4)) {
#if (PROBE_DUP & 16)
        phase_rwkv(args.in, ws, lds, G);
#endif
        phase_rwkv(args.in, ws, lds, G); SEAM(4); }
    if (IN(5)) { pg8::Gemm g{(const bf16_t*)(ws + WS_Y), (const bf16_t*)(ws + WS_WOT), D, D, D}; pg8::StaticOrder S; S.init(MX / 256, D / 256, G, cblk);
        EpiF32 E{H, D, 1};
        pg8::gemm_phase<EpiF32, pg8::StaticOrder, true>(lds, g, S, E);
        pg8::gemm_tail((const bf16_t*)(ws + WS_Y) + (size_t)MX * D, g, D / 256, S, E); SEAM(5); }
    if (IN(6)) { phase_norm(ws, G); SEAM(6); }
    if (IN(7)) { pg8::Gemm g{HB, (const bf16_t*)(ws + WS_WST), D, D, D}; pg8::StaticOrder S; S.init(MX / 256, 8, G, cblk);
        EpiF32 E{(float*)(ws + WS_SC), 2048, 0};
        pg8::gemm_phase<EpiF32, pg8::StaticOrder, true>(lds, g, S, E);
        pg8::gemm_tail(HB + (size_t)MX * D, g, 8, S, E); SEAM(7); }
    if (IN(8)) {
#if (PROBE_DUP & 256)
        phase_expert<false, true>(nullptr, nullptr, ws, lds, 0, G);
#endif
        phase_expert<false>(nullptr, nullptr, ws, lds, 0, G); SEAM(8); }
    if (IN(9)) { pg8::Gemm g{HB, (const bf16_t*)(ws + WS_WIO), D, D, D}; pg8::StaticOrder S; S.init(MX / 256, 8, G, cblk);
        EpiBf16 E{(bf16_t*)(ws + WS_U), 2048, nullptr};
        pg8::gemm_phase<EpiBf16, pg8::StaticOrder, true>(lds, g, S, E);
        pg8::gemm_tail(HB + (size_t)MX * D, g, 8, S, E); SEAM(9); }
    if (IN(10)) { phase_s5(args.in, ws, lds, G); SEAM(10); }
    if (IN(11)) { pg8::Gemm g{(const bf16_t*)(ws + WS_YS), (const bf16_t*)(ws + WS_WGT), 2048, 2048, 2048}; pg8::StaticOrder S; S.init(MX / 256, 32, G, cblk);
        EpiGlu E{H};
        pg8::gemm_phase<EpiGlu, pg8::StaticOrder, true>(lds, g, S, E);
        pg8::gemm_tail((const bf16_t*)(ws + WS_YS) + (size_t)MX * 2048, g, 32, S, E); SEAM(11); }
    if (IN(12)) { phase_norm(ws, G); SEAM(12); }
    if (IN(13)) { pg8::Gemm g{HB, (const bf16_t*)(ws + WS_WST) + (size_t)2048 * D, D, D, D}; pg8::StaticOrder S; S.init(MX / 256, 8, G, cblk);
        EpiF32 E{(float*)(ws + WS_SC), 2048, 0};
        pg8::gemm_phase<EpiF32, pg8::StaticOrder, true>(lds, g, S, E);
        pg8::gemm_tail(HB + (size_t)MX * D, g, 8, S, E); SEAM(13); }
    if (IN(14)) { phase_expert<true>(args.in[4], args.out, ws, lds, 1, G); }
#undef IN
#undef SEAM
}

extern "C" void kernel_launch(void* const* d_in, const int* in_sizes, int n_in, void* d_out, int out_size, void* d_ws, size_t ws_size, hipStream_t stream) {
    static int grid = 0;
    if (grid == 0) {
        if (n_in != 34 || out_size != MX * D || ws_size < WS_END) { fprintf(stderr, "kernel_launch: unexpected shapes (n_in %d, out %d, ws %zu < %zu); nothing launched\n", n_in, out_size, ws_size, (size_t)WS_END); grid = -1; return; }
        int dev = 0, cus = 0, per_cu = 0;
        if (hipGetDevice(&dev) != hipSuccess || hipDeviceGetAttribute(&cus, hipDeviceAttributeMultiprocessorCount, dev) != hipSuccess) { grid = -1; return; }
        if (hipFuncSetAttribute((const void*)fwd, hipFuncAttributeMaxDynamicSharedMemorySize, LDS_BYTES) != hipSuccess) { fprintf(stderr, "kernel_launch: hipFuncSetAttribute failed\n"); grid = -1; return; }
        if (hipOccupancyMaxActiveBlocksPerMultiprocessor(&per_cu, (const void*)fwd, NTHREADS, LDS_BYTES) != hipSuccess || per_cu < 1) { fprintf(stderr, "kernel_launch: occupancy query reports %d workgroups per CU\n", per_cu); }
        (void)hipGetLastError();
        grid = cus;
    }
    if (grid < 0) return;
    (void)hipMemsetAsync((char*)d_ws + WS_CTL, 0, CTL_ZERO_BYTES, stream);
    Args a{};
    for (int i = 0; i < 34; ++i) a.in[i] = (const float*)d_in[i];
    a.out = (float*)d_out; a.ws = (unsigned char*)d_ws;
#if MK_PER_PHASE
    for (int p = 0; p < NPHASE; ++p) { a.ph_lo = p; a.ph_hi = p + 1; hipLaunchKernelGGL(fwd, dim3(grid), dim3(NTHREADS), LDS_BYTES, stream, a); }
#else
    a.ph_lo = 0; a.ph_hi = NPHASE; hipLaunchKernelGGL(fwd, dim3(grid), dim3(NTHREADS), LDS_BYTES, stream, a);
#endif
}
```

```cpp
#include <hip/hip_runtime.h>
#include <cstdio>
#include <cstdint>

#define LAS __attribute__((address_space(3)))
typedef unsigned short bf16_t;
typedef short bf16x8 __attribute__((ext_vector_type(8)));
typedef __bf16 bf16x2 __attribute__((ext_vector_type(2)));
typedef float f32x4 __attribute__((ext_vector_type(4)));
typedef float f32x2 __attribute__((ext_vector_type(2)));
typedef unsigned u32x4 __attribute__((ext_vector_type(4)));
typedef unsigned u32x2 __attribute__((ext_vector_type(2)));

__device__ __forceinline__ unsigned f2bf(float f) { unsigned u = __builtin_bit_cast(unsigned, f); return (u + 0x7fffu + ((u >> 16) & 1u)) >> 16; }
__device__ __forceinline__ unsigned pk2(float lo, float hi) { return f2bf(lo) | (f2bf(hi) << 16); }
__device__ __forceinline__ unsigned cvt_pk_bf16(float lo, float hi) { unsigned r; asm volatile("v_cvt_pk_bf16_f32 %0, %1, %2" : "=v"(r) : "v"(lo), "v"(hi)); return r; }
__device__ __forceinline__ float bflo(unsigned w) { return __builtin_bit_cast(float, w << 16); }
__device__ __forceinline__ float bfhi(unsigned w) { return __builtin_bit_cast(float, w & 0xffff0000u); }
__device__ __forceinline__ float bf2f(bf16_t b) { return __builtin_bit_cast(float, ((unsigned)b) << 16); }
__device__ __forceinline__ float dot2(unsigned a, unsigned b, float acc) { return __builtin_amdgcn_fdot2_f32_bf16(__builtin_bit_cast(bf16x2, a), __builtin_bit_cast(bf16x2, b), acc, false); }
template <int CTRL> __device__ __forceinline__ float dppf(float x) { return __builtin_bit_cast(float, __builtin_amdgcn_mov_dpp(__builtin_bit_cast(int, x), CTRL, 0xf, 0xf, true)); }
template <int CTRL> __device__ __forceinline__ unsigned dppu(unsigned x) { return (unsigned)__builtin_amdgcn_mov_dpp((int)x, CTRL, 0xf, 0xf, true); }
constexpr int DPP_XOR1 = 0xB1, DPP_XOR2 = 0x4E, DPP_HMIRROR = 0x141, DPP_MIRROR = 0x140;
__device__ __forceinline__ float sum8(float x) { x += dppf<DPP_XOR1>(x); x += dppf<DPP_XOR2>(x); x += dppf<DPP_HMIRROR>(x); return x; }
__device__ __forceinline__ float sum16(float x) { x = sum8(x); x += dppf<DPP_MIRROR>(x); return x; }
__device__ __forceinline__ float sum64(float x) {
    x = sum16(x);
    { const auto s = __builtin_amdgcn_permlane16_swap(__float_as_uint(x), __float_as_uint(x), false, false); const unsigned a = s[0], b = s[1]; x = __uint_as_float(a) + __uint_as_float(b); }
    { const auto t = __builtin_amdgcn_permlane32_swap(__float_as_uint(x), __float_as_uint(x), false, false); const unsigned a = t[0], b = t[1]; x = __uint_as_float(a) + __uint_as_float(b); }
    return x;
}
__device__ __forceinline__ unsigned umax_u(unsigned a, unsigned b) { return a > b ? a : b; }
__device__ __forceinline__ unsigned max64u(unsigned x) {
    x = umax_u(x, dppu<DPP_XOR1>(x)); x = umax_u(x, dppu<DPP_XOR2>(x)); x = umax_u(x, dppu<DPP_HMIRROR>(x)); x = umax_u(x, dppu<DPP_MIRROR>(x));
    auto s = __builtin_amdgcn_permlane16_swap(x, x, false, false); x = umax_u(s[0], s[1]);
    auto t = __builtin_amdgcn_permlane32_swap(x, x, false, false); return umax_u(t[0], t[1]);
}
__device__ __forceinline__ float gelu_erf(float v) { return 0.5f * v * (1.0f + erff(v * 0.70710678118654752f)); }
__device__ __forceinline__ float erf_as(float x) {
    const float ax = fabsf(x), t = __builtin_amdgcn_rcpf(fmaf(0.3275911f, ax, 1.0f));
    float pl = fmaf(1.061405429f, t, -1.453152027f); pl = fmaf(pl, t, 1.421413741f); pl = fmaf(pl, t, -0.284496736f); pl = fmaf(pl, t, 0.254829592f); pl *= t;
    const float e = __builtin_amdgcn_exp2f(-1.4426950408889634f * ax * ax);
    return copysignf(fmaf(-pl, e, 1.0f), x);
}
__device__ __forceinline__ float gelu_erf_fast(float v) { return 0.5f * v * (1.0f + erf_as(v * 0.70710678118654752f)); }
__device__ __forceinline__ float sigmoidf_(float v) { return __builtin_amdgcn_rcpf(1.0f + __expf(-v)); }
#define DBG_SKIP 0
#define PROBE_DUP 0
#define GPROBE_MODE 0
namespace pg8 {
#define PG8_LAS __attribute__((address_space(3)))
constexpr int BM = 256, BK = 64, HALF = 128, HTB = HALF * BK * 2  , STAGE_BYTES = 8 * HTB, NXCD = 8, WGM = 8;

__host__ __device__ __forceinline__ int lds_byte(int r, int c) { const int st = (r >> 4) * 2 + (c >> 5), rr = r & 15, cc = c & 31, ob = rr * 64 + cc * 2; return st * 1024 + (ob ^ (((ob >> 9) & 1) << 5)); }
__host__ __device__ __forceinline__ void stage_rc(int b, int& R, int& C) { const int st = b / 1024, sb = b % 1024, swz = sb ^ (((sb >> 9) & 1) << 5); R = (st >> 1) * 16 + swz / 64; C = (st & 1) * 32 + (swz % 64) / 2; }
__host__ __device__ __forceinline__ int perm32(int rho) { const int n = rho >> 4, i = rho & 15; return 8 * (i >> 2) + 4 * n + (i & 3); }

struct Unit { int pm, pn; };
struct Gemm { const bf16_t* A; const bf16_t* Bt; int lda, ldb, K; };

struct StaticOrder {
    int nM, nN, nwg, G, c, kdiv, kmul, bmod;
    __device__ void init(int nM_, int nN_, int G_, int c_, int kdiv_ = 1 << 30, int kmul_ = 0, int bmod_ = 0) { nM = nM_; nN = nN_; nwg = nM * nN; G = G_; c = c_; kdiv = kdiv_; kmul = kmul_; bmod = bmod_; }
    __device__ bool next(int i, Unit& u) const {
        const long L = (long)i * G + c; if (L >= nwg) return false;
        int wgid = (int)L; { const int q = nwg / NXCD, r = nwg % NXCD, xcd = wgid % NXCD, off = wgid / NXCD; wgid = (xcd < r ? xcd * (q + 1) : r * (q + 1) + (xcd - r) * q) + off; }
        const int nig = WGM * nN, gid = wgid / nig, fm = gid * WGM, gsz = (nM - fm) < WGM ? (nM - fm) : WGM;
        u.pm = fm + ((wgid % nig) % gsz); u.pn = (wgid % nig) / gsz; return true;
    }
    __device__ __forceinline__ int koff(const Unit& u) const { return (u.pn / kdiv) * kmul; }
    __device__ __forceinline__ size_t boff(const Unit& u, size_t tstepB) const { return bmod ? (size_t)(u.pn % bmod) * tstepB + (size_t)koff(u) * 2 : (size_t)u.pn * tstepB; }
};

template <class Epi, class Sched, bool ALIGN_EPI>
__device__ __forceinline__ void gemm_phase(PG8_LAS unsigned char* lds, const Gemm g, const Sched& S, const Epi& E) {
    int tid = threadIdx.x; asm volatile("" : "+v"(tid));
    const int wid = __builtin_amdgcn_readfirstlane(tid >> 6), lane = tid & 63, wr = wid >> 2, wc = wid & 3, fr = lane & 15, fq = lane >> 4;
    const int K = g.K, nt = K / BK;
    unsigned voffA[2], voffB[2];
#pragma unroll
    for (int i = 0; i < 2; ++i) { int R, C; stage_rc(tid * 16 + i * 8192, R, C); const int Rb = Epi::PERM ? ((R & ~31) + perm32(R & 31)) : R;
        voffA[i] = (unsigned)(R * g.lda + C) * 2u; voffB[i] = (unsigned)(Rb * g.ldb + C) * 2u; }
    const size_t kstep = (size_t)(BK * 2);
    const size_t hstepA = (size_t)HALF * g.lda * 2, hstepB = (size_t)HALF * g.ldb * 2;
    const size_t tstepA = 2 * hstepA, tstepB = 2 * hstepB;
    const unsigned ldsw = (unsigned)wid * 1024u;
    const int aoff = lds_byte(wr * 64 + fr, fq * 8), boff = lds_byte(wc * 32 + fr, fq * 8);
#define PG8_SA(b, h) (((b) * 2 + (h)) * HTB)
#define PG8_SB(b, h) ((4 + (b) * 2 + (h)) * HTB)
#define PG8_STAGE(bufoff, gbase, voff) do { _Pragma("unroll") for (int _i = 0; _i < 2; ++_i) \
        __builtin_amdgcn_global_load_lds((const unsigned*)((const char*)(gbase) + (voff)[_i]), (PG8_LAS unsigned*)(lds + (bufoff) + ldsw + _i * 8192), 16, 0, 0); } while (0)
#define PG8_LDA(dst, b, h) do { _Pragma("unroll") for (int m = 0; m < 4; ++m) _Pragma("unroll") for (int k = 0; k < 2; ++k) dst[m][k] = *(const PG8_LAS bf16x8*)(lds + PG8_SA(b, h) + aoff + m * 2048 + k * 1024); } while (0)
#define PG8_LDB(dst, b, h) do { _Pragma("unroll") for (int n = 0; n < 2; ++n) _Pragma("unroll") for (int k = 0; k < 2; ++k) dst[n][k] = *(const PG8_LAS bf16x8*)(lds + PG8_SB(b, h) + boff + n * 2048 + k * 1024); } while (0)
#define PG8_MMA(ai, bj, At, Bt) do { __builtin_amdgcn_s_setprio(1); _Pragma("unroll") for (int m = 0; m < 4; ++m) _Pragma("unroll") for (int n = 0; n < 2; ++n) _Pragma("unroll") for (int k = 0; k < 2; ++k) \
        acc[ai][bj][m][n] = __builtin_amdgcn_mfma_f32_16x16x32_bf16(Bt[n][k], At[m][k], acc[ai][bj][m][n], 0, 0, 0); __builtin_amdgcn_s_setprio(0); } while (0)
#define PG8_WAIT_V(n) asm volatile("s_waitcnt vmcnt(" #n ")" ::: "memory")
#define PG8_WAIT_L(n) asm volatile("s_waitcnt lgkmcnt(" #n ")" ::: "memory")
#define PG8_BAR __builtin_amdgcn_s_barrier()
#define PG8_SCHED __builtin_amdgcn_sched_barrier(0)
    Unit cur, nxt; int ui = 0;
    if (!S.next(0, cur)) return;
    f32x4 acc[2][2][4][2];
#pragma unroll
    for (int a = 0; a < 2; ++a)
#pragma unroll
        for (int b = 0; b < 2; ++b)
#pragma unroll
            for (int m = 0; m < 4; ++m)
#pragma unroll
                for (int n = 0; n < 2; ++n) acc[a][b][m][n] = (f32x4){0.f, 0.f, 0.f, 0.f};
    bf16x8 At[4][2], B0[2][2], B1[2][2];
    const char* cA = (const char*)g.A + (size_t)cur.pm * tstepA + (size_t)S.koff(cur) * 2; const char* cB = (const char*)g.Bt + (size_t)cur.pn * tstepB;
    PG8_STAGE(PG8_SB(0, 0), cB, voffB); PG8_STAGE(PG8_SB(0, 1), cB + hstepB, voffB); PG8_STAGE(PG8_SA(0, 0), cA, voffA); PG8_STAGE(PG8_SA(0, 1), cA + hstepA, voffA);
    if (wr == 1) PG8_BAR;
    PG8_WAIT_V(2); PG8_BAR;
    PG8_STAGE(PG8_SB(1, 0), cB + kstep, voffB); PG8_STAGE(PG8_SA(1, 0), cA + kstep, voffA); PG8_STAGE(PG8_SB(1, 1), cB + hstepB + kstep, voffB);
    PG8_WAIT_V(6); PG8_BAR;
    for (;;) {
        const bool has_next = S.next(ui + 1, nxt);
        const char* nA = has_next ? (const char*)g.A + (size_t)nxt.pm * tstepA + (size_t)S.koff(nxt) * 2 : cA; const char* nB = has_next ? (const char*)g.Bt + (size_t)nxt.pn * tstepB : cB;
        for (int t = 0; t < nt; t += 2) {
            const bool last = (t == nt - 2);
            const char* a1 = cA + (size_t)(t + 1) * kstep;
            const char* a2 = last ? nA : cA + (size_t)(t + 2) * kstep; const char* b2 = last ? nB : cB + (size_t)(t + 2) * kstep;
            const char* a3 = a2 + kstep; const char* b3 = b2 + kstep;
            PG8_LDB(B0, 0, 0); PG8_LDB(B1, 0, 1); PG8_SCHED; PG8_LDA(At, 0, 0); PG8_STAGE(PG8_SA(1, 1), a1 + hstepA, voffA);
            PG8_WAIT_V(8); PG8_WAIT_L(0); PG8_BAR; PG8_MMA(0, 0, At, B0); PG8_MMA(0, 1, At, B1); PG8_BAR; PG8_SCHED;
            PG8_LDA(At, 0, 1); PG8_STAGE(PG8_SB(0, 0), b2, voffB); PG8_STAGE(PG8_SB(0, 1), b2 + hstepB, voffB); PG8_STAGE(PG8_SA(0, 0), a2, voffA);
            PG8_WAIT_V(8); PG8_WAIT_L(0); PG8_BAR; PG8_MMA(1, 0, At, B0); PG8_MMA(1, 1, At, B1); PG8_BAR; PG8_SCHED;
            PG8_LDB(B0, 1, 0); PG8_LDB(B1, 1, 1); PG8_SCHED; PG8_LDA(At, 1, 0); PG8_STAGE(PG8_SA(0, 1), a2 + hstepA, voffA);
            PG8_WAIT_V(8); PG8_WAIT_L(0); PG8_BAR; PG8_MMA(0, 0, At, B0); PG8_MMA(0, 1, At, B1); PG8_BAR; PG8_SCHED;
            PG8_LDA(At, 1, 1); PG8_STAGE(PG8_SB(1, 0), b3, voffB); PG8_STAGE(PG8_SB(1, 1), b3 + hstepB, voffB); PG8_STAGE(PG8_SA(1, 0), a3, voffA);
            PG8_WAIT_V(8); PG8_WAIT_L(0); PG8_BAR; PG8_MMA(1, 0, At, B0); PG8_MMA(1, 1, At, B1); PG8_BAR; PG8_SCHED;
        }
        if constexpr (ALIGN_EPI) { if (wr == 0) PG8_BAR; }
        E(acc, cur, wr, wc, fr, fq);
        if (!has_next) break;
#pragma unroll
        for (int a = 0; a < 2; ++a)
#pragma unroll
            for (int b = 0; b < 2; ++b)
#pragma unroll
                for (int m = 0; m < 4; ++m)
#pragma unroll
                    for (int n = 0; n < 2; ++n) acc[a][b][m][n] = (f32x4){0.f, 0.f, 0.f, 0.f};
        cur = nxt; cA = nA; cB = nB; ++ui;
        if constexpr (ALIGN_EPI) { if (wr == 1) PG8_BAR; }
    }
    PG8_WAIT_V(0);
    if constexpr (!ALIGN_EPI) { if (wr == 0) PG8_BAR; }
    PG8_BAR;
#undef PG8_SA
#undef PG8_SB
#undef PG8_STAGE
#undef PG8_LDA
#undef PG8_LDB
#undef PG8_MMA
}

template <class Epi, class Sched>
__device__ __forceinline__ void gemm_tail(const bf16_t* A16, const Gemm g, int nN, const Sched& S, const Epi& E, LAS unsigned char* lds) {
    int tid = threadIdx.x; asm volatile("" : "+v"(tid));
    const int wid = __builtin_amdgcn_readfirstlane(tid >> 6), lane = tid & 63, fr = lane & 15, fq = lane >> 4;
    LAS f32x4* red = (LAS f32x4*)lds;
    const int kw = g.K >> 3, kb = wid * kw;
    for (int item = S.G - 1 - S.c; item < nN * 8; item += S.G) {
        const int pn = item >> 3, strip = item & 7;
        Unit u; u.pm = 0; u.pn = pn;
        const bf16_t* a = A16 + (size_t)fr * g.lda + S.koff(u) + fq * 8 + kb;
        const bf16_t* b0 = g.Bt + (size_t)(pn * 256 + 16 * strip + fr) * g.ldb + fq * 8 + kb;
        const bf16_t* b1 = b0 + (size_t)128 * g.ldb;
        f32x4 acc0 = (f32x4){0.f, 0.f, 0.f, 0.f}, acc1 = acc0;
#pragma unroll 8
        for (int k0 = 0; k0 < kw; k0 += 32) {
            const bf16x8 af = *(const bf16x8*)(a + k0), w0 = *(const bf16x8*)(b0 + k0), w1 = *(const bf16x8*)(b1 + k0);
            acc0 = __builtin_amdgcn_mfma_f32_16x16x32_bf16(w0, af, acc0, 0, 0, 0);
            acc1 = __builtin_amdgcn_mfma_f32_16x16x32_bf16(w1, af, acc1, 0, 0, 0);
        }
        red[(wid * 2 + 0) * 64 + lane] = acc0; red[(wid * 2 + 1) * 64 + lane] = acc1;
        __syncthreads();
        if (wid == 0) {
#pragma unroll
            for (int w = 1; w < 8; ++w) { acc0 = acc0 + red[(w * 2 + 0) * 64 + lane]; acc1 = acc1 + red[(w * 2 + 1) * 64 + lane]; }
            E.tail(fr, pn, 16 * strip + 4 * fq, acc0, acc1);
        }
        __syncthreads();
    }
}
#undef PG8_WAIT_V
#undef PG8_WAIT_L
#undef PG8_BAR
#undef PG8_SCHED
}
#define XB_TMO      128
#define XB_XCNT(j)  (256  + 64 * (j))
#define XB_XSUB(j)  (1280 + 64 * (j))
#define XB_XGEN(j)  (2304 + 64 * (j))
#define XB_TOP      3328
#define XB_TOPGEN   3392
#define XCD_BAR_WORDS 3456
#define XB_SPIN_CAP (1u << 18)

__device__ __forceinline__ unsigned xb_ld(unsigned* p)              { return __hip_atomic_load(p, __ATOMIC_RELAXED, __HIP_MEMORY_SCOPE_AGENT); }
__device__ __forceinline__ unsigned xb_add(unsigned* p, unsigned v) { return __hip_atomic_fetch_add(p, v, __ATOMIC_RELAXED, __HIP_MEMORY_SCOPE_AGENT); }
__device__ __forceinline__ unsigned xb_xcc_id() { return (unsigned)__builtin_amdgcn_s_getreg((3 << 11) | 20) & 0xFu; }
#define XB_SPIN(cond, bar) do { unsigned _sp = 0; while (cond) { __builtin_amdgcn_s_sleep(1); \
    if ((++_sp & 255u) == 0u) { if (xb_ld(&(bar)[XB_TMO])) break; if (_sp > XB_SPIN_CAP) { atomicAdd(&(bar)[XB_TMO], 1u); break; } } } } while (0)

struct XcdBarrier {
    unsigned* bar; unsigned x;
    volatile LAS unsigned* st;
};

__device__ __forceinline__ XcdBarrier xcd_barrier_post(unsigned* bar, volatile LAS unsigned* st) {
    XcdBarrier b; b.bar = bar; b.x = xb_xcc_id(); b.st = st;
    if (threadIdx.x == 0) (void)xb_add(&bar[XB_XCNT(b.x)], 1u);
    return b;
}
__device__ __forceinline__ void xcd_barrier_complete(unsigned* bar, unsigned x, unsigned& nloc, unsigned& nx) {
    const unsigned G = gridDim.x * gridDim.y * gridDim.z;
    unsigned sum, cnt, mine, sp = 0u;
    for (;;) {
        sum = 0u; cnt = 0u; mine = 0u;
#pragma unroll
        for (unsigned j = 0; j < 16; ++j) { const unsigned c = xb_ld(&bar[XB_XCNT(j)]); sum += c; cnt += (c > 0u) ? 1u : 0u; mine = (j == x) ? c : mine; }
        if (sum == G) break;
        __builtin_amdgcn_s_sleep(1);
        if ((++sp & 255u) == 0u) { if (xb_ld(&bar[XB_TMO])) break; if (sp > XB_SPIN_CAP) { atomicAdd(&bar[XB_TMO], 1u); break; } }
    }
    nloc = mine > 0u ? mine : 1u; nx = cnt > 0u ? cnt : 1u;
}

__device__ __forceinline__ void xcd_barrier(const XcdBarrier& b) {
    asm volatile("s_waitcnt vmcnt(0)" ::: "memory");
    __syncthreads();
    if (threadIdx.x == 0) {
        unsigned* bar = b.bar;
        __builtin_amdgcn_s_waitcnt(0);
        unsigned nloc = b.st[0], nx = b.st[1];
        if (nloc == 0u) { xcd_barrier_complete(bar, b.x, nloc, nx); b.st[0] = nloc; b.st[1] = nx; }
        const unsigned old = xb_add(&bar[XB_XSUB(b.x)], 1u);
        const unsigned gen = old / nloc;
        if (old + 1u == (gen + 1u) * nloc) {
            __builtin_amdgcn_fence(__ATOMIC_RELEASE, "agent");
            asm volatile("s_waitcnt vmcnt(0)" ::: "memory");
            const unsigned og = xb_add(&bar[XB_TOP], 1u);
            const unsigned tg = og / nx;
            if (og + 1u == (tg + 1u) * nx) xb_add(&bar[XB_TOPGEN], 1u);
            else XB_SPIN(xb_ld(&bar[XB_TOPGEN]) == tg, bar);
            __builtin_amdgcn_fence(__ATOMIC_ACQUIRE, "agent");
            xb_add(&bar[XB_XGEN(b.x)], 1u);
            asm volatile("s_waitcnt vmcnt(0)" ::: "memory");
        } else {
            XB_SPIN(xb_ld(&bar[XB_XGEN(b.x)]) == gen, bar);
            __builtin_amdgcn_fence(__ATOMIC_ACQUIRE, "agent");
            asm volatile("s_waitcnt vmcnt(0)" ::: "memory");
        }
    }
    __syncthreads();
}
constexpr int D = 4096, NB = 4, SEQ = 2048, NMETA = 16, LSEQ = SEQ + NMETA;
constexpr int MX = NB * SEQ;
constexpr int MROWS = MX + NMETA;
constexpr float NORM_EPS = 1e-6f, GN_EPS = 64e-5f;
constexpr int ZC = 8640, ZLD = 8704;
constexpr int ZR = 2048, ZK = 4096, ZV = 6144, ZWL = 8192, ZAL = 8288, ZGL = 8384;
constexpr int NHEAD = 32, HDIM = 64;
constexpr int WAGLD = 6144;
constexpr int NEXP = 16384;
__device__ __forceinline__ int rowof(int b, int pos) { return pos < NMETA ? MX + pos : b * SEQ + pos - NMETA; }

constexpr size_t MiB = 1u << 20;
constexpr size_t wsal(size_t x) { return (x + 4095) & ~(size_t)4095; }
constexpr size_t WS_CTL = 0, CTL_ZERO_BYTES = 1 * MiB;
constexpr size_t WS_W1T = 1 * MiB;
constexpr size_t WS_WOT = WS_W1T + wsal((size_t)ZLD * D * 2);
constexpr size_t WS_WIO = WS_WOT + wsal((size_t)D * D * 2);
constexpr size_t WS_WGT = WS_WIO + wsal((size_t)2048 * D * 2);
constexpr size_t WS_WST = WS_WGT + wsal((size_t)8192 * 2048 * 2);
constexpr size_t WS_BTP = WS_WST + wsal((size_t)2 * 2048 * D * 2);
constexpr size_t WS_BTL = WS_BTP + wsal((size_t)2048 * 512 * 2);
constexpr size_t WS_PU  = WS_BTL + wsal((size_t)6144 * 256 * 2);
constexpr size_t WS_PV  = WS_PU + wsal((size_t)2 * NEXP * D);
constexpr size_t WS_SU  = WS_PV + wsal((size_t)2 * NEXP * D);
constexpr size_t WS_SV  = WS_SU + wsal((size_t)2 * NEXP * 4);
constexpr size_t WS_H   = WS_SV + wsal((size_t)2 * NEXP * 4);
constexpr size_t WS_HB  = WS_H + wsal((size_t)MROWS * D * 4);
constexpr size_t WS_Z   = WS_HB + wsal((size_t)MROWS * D * 2);
constexpr size_t WS_PM  = WS_Z + wsal((size_t)MROWS * ZLD * 2);
constexpr size_t WS_LA  = WS_PM + wsal((size_t)MROWS * 2048 * 2);
constexpr size_t WS_WAG = WS_LA + wsal((size_t)MROWS * 512 * 2);
constexpr size_t WS_Y   = WS_WAG + wsal((size_t)MROWS * WAGLD * 4);
constexpr size_t WS_SC  = WS_Y + wsal((size_t)MROWS * D * 2);
constexpr size_t WS_U   = WS_SC + wsal((size_t)MROWS * 2048 * 4);
constexpr size_t WS_YS  = WS_U + wsal((size_t)MROWS * 2048 * 2);
constexpr size_t WS_EIDL = WS_YS + wsal((size_t)MROWS * 2048 * 2);
constexpr size_t WS_GATEL = WS_EIDL + wsal((size_t)MROWS * 128 * 4);
constexpr size_t WS_DOTP = WS_GATEL + wsal((size_t)MROWS * 128 * 4);
constexpr size_t WS_WL = WS_DOTP + wsal((size_t)MROWS * 4096 * 4);
constexpr size_t WS_HB8 = WS_WL + wsal((size_t)MROWS * 128 * 4);
constexpr size_t WS_HS = WS_HB8 + wsal((size_t)MROWS * D);
constexpr size_t WS_END = WS_HS + wsal((size_t)MROWS * 4);
constexpr int CW_BAR = 4096;

constexpr int LDS_BYTES = 163840;
constexpr int SCR_BYTES = 131072;
constexpr int MISC_OFF = SCR_BYTES;
constexpr int RED_OFF = MISC_OFF + 256;
constexpr int BONUS_OFF = MISC_OFF + 512;

struct EpiBf16 {
    static constexpr bool PERM = true;
    bf16_t* O; int ldc; const float* colscale;
    __device__ __forceinline__ void operator()(const f32x4 (&acc)[2][2][4][2], const pg8::Unit& u, int wr, int wc, int fr, int fq) const {
        const int row0 = u.pm * 256 + wr * 64 + fr, col0 = u.pn * 256 + wc * 32 + 8 * fq;
        f32x4 sv[2][2];
#pragma unroll
        for (int bj = 0; bj < 2; ++bj)
#pragma unroll
            for (int n = 0; n < 2; ++n) sv[bj][n] = colscale ? *(const f32x4*)(colscale + col0 + bj * 128 + 4 * n) : (f32x4){1.f, 1.f, 1.f, 1.f};
#pragma unroll
        for (int ai = 0; ai < 2; ++ai)
#pragma unroll
            for (int m = 0; m < 4; ++m) { bf16_t* rowp = O + (size_t)(row0 + ai * 128 + m * 16) * ldc + col0;
#pragma unroll
                for (int bj = 0; bj < 2; ++bj) { const f32x4 v0 = acc[ai][bj][m][0] * sv[bj][0], v1 = acc[ai][bj][m][1] * sv[bj][1];
                    u32x4 w; w.x = cvt_pk_bf16(v0[0], v0[1]); w.y = cvt_pk_bf16(v0[2], v0[3]); w.z = cvt_pk_bf16(v1[0], v1[1]); w.w = cvt_pk_bf16(v1[2], v1[3]);
                    *(u32x4*)(rowp + bj * 128) = w; } }
    }
    __device__ __forceinline__ void tail(int r, int pn, int c4, f32x4 lo, f32x4 hi) const {
        const int col = pn * 256 + c4; bf16_t* rowp = O + (size_t)(MX + r) * ldc + col;
        if (colscale) { lo = lo * *(const f32x4*)(colscale + col); hi = hi * *(const f32x4*)(colscale + col + 128); }
        u32x2 a, b; a.x = cvt_pk_bf16(lo[0], lo[1]); a.y = cvt_pk_bf16(lo[2], lo[3]); b.x = cvt_pk_bf16(hi[0], hi[1]); b.y = cvt_pk_bf16(hi[2], hi[3]);
        *(u32x2*)rowp = a; *(u32x2*)(rowp + 128) = b;
    }
};
struct EpiF32 {
    static constexpr bool PERM = false;
    float* C; int ldc; int accum; const float* base; const float* base_tail;
    __device__ __forceinline__ void operator()(const f32x4 (&acc)[2][2][4][2], const pg8::Unit& u, int wr, int wc, int fr, int fq) const {
        const int row0 = u.pm * 256 + wr * 64 + fr, col0 = u.pn * 256 + wc * 32 + 4 * fq;
        const float* bs = base ? base : C;
        if (accum) {
#pragma unroll
            for (int ai = 0; ai < 2; ++ai)
#pragma unroll
                for (int mh = 0; mh < 2; ++mh) { f32x4 t[2][2][2];
#pragma unroll
                    for (int ml = 0; ml < 2; ++ml) { const size_t ro = (size_t)(row0 + ai * 128 + (2 * mh + ml) * 16) * ldc + col0;
#pragma unroll
                        for (int bj = 0; bj < 2; ++bj)
#pragma unroll
                            for (int n = 0; n < 2; ++n) t[ml][bj][n] = *(const f32x4*)(bs + ro + bj * 128 + n * 16); }
#pragma unroll
                    for (int ml = 0; ml < 2; ++ml) { const size_t ro = (size_t)(row0 + ai * 128 + (2 * mh + ml) * 16) * ldc + col0;
#pragma unroll
                        for (int bj = 0; bj < 2; ++bj)
#pragma unroll
                            for (int n = 0; n < 2; ++n) *(f32x4*)(C + ro + bj * 128 + n * 16) = acc[ai][bj][2 * mh + ml][n] + t[ml][bj][n]; } }
        } else {
#pragma unroll
            for (int ai = 0; ai < 2; ++ai)
#pragma unroll
                for (int m = 0; m < 4; ++m) { const size_t ro = (size_t)(row0 + ai * 128 + m * 16) * ldc + col0;
#pragma unroll
                    for (int bj = 0; bj < 2; ++bj)
#pragma unroll
                        for (int n = 0; n < 2; ++n) *(f32x4*)(C + ro + bj * 128 + n * 16) = acc[ai][bj][m][n]; }
        }
    }
    __device__ __forceinline__ void tail(int r, int pn, int c4, f32x4 lo, f32x4 hi) const {
        const size_t co = (size_t)pn * 256 + c4; float* rowp = C + (size_t)(MX + r) * ldc + co; const float* bp = base_tail ? base_tail + (size_t)r * ldc + co : rowp;
        if (accum) { lo = lo + *(const f32x4*)bp; hi = hi + *(const f32x4*)(bp + 128); }
        *(f32x4*)rowp = lo; *(f32x4*)(rowp + 128) = hi;
    }
};
__device__ __forceinline__ float decay_of(float x) {
    const float sg = __builtin_amdgcn_rcpf(1.0f + __builtin_amdgcn_exp2f(-1.4426950408889634f * x));
    return __builtin_amdgcn_exp2f(-0.8750387749f * sg);
}
struct EpiLora {
    static constexpr bool PERM = false;
    float* C; int ldc; const float* w0; const float* a0;
    __device__ __forceinline__ f32x4 fn(int region, f32x4 v, const float* bias) const {
        if (region == 2) return v;
        const f32x4 bv = *(const f32x4*)bias; v = v + bv;
        if (region == 0) { v[0] = decay_of(v[0]); v[1] = decay_of(v[1]); v[2] = decay_of(v[2]); v[3] = decay_of(v[3]); }
        else { v[0] = sigmoidf_(v[0]); v[1] = sigmoidf_(v[1]); v[2] = sigmoidf_(v[2]); v[3] = sigmoidf_(v[3]); }
        return v;
    }
    __device__ __forceinline__ void operator()(const f32x4 (&acc)[2][2][4][2], const pg8::Unit& u, int wr, int wc, int fr, int fq) const {
        const int row0 = u.pm * 256 + wr * 64 + fr, col0 = u.pn * 256 + wc * 32 + 4 * fq, region = u.pn >> 3, cb = (u.pn & 7) * 256 + wc * 32 + 4 * fq;
        const float* bias = region == 0 ? w0 : a0;
#pragma unroll
        for (int bj = 0; bj < 2; ++bj)
#pragma unroll
            for (int n = 0; n < 2; ++n) {
#pragma unroll
                for (int ai = 0; ai < 2; ++ai)
#pragma unroll
                    for (int m = 0; m < 4; ++m) { *(f32x4*)(C + (size_t)(row0 + ai * 128 + m * 16) * ldc + col0 + bj * 128 + n * 16) = fn(region, acc[ai][bj][m][n], bias + cb + bj * 128 + n * 16);
                        __builtin_amdgcn_sched_barrier(0); } }
    }
    __device__ __forceinline__ void tail(int r, int pn, int c4, f32x4 lo, f32x4 hi) const {
        const int region = pn >> 3, cb = (pn & 7) * 256 + c4; const float* bias = region == 0 ? w0 : a0;
        float* rowp = C + (size_t)(MX + r) * ldc + (size_t)pn * 256 + c4;
        *(f32x4*)rowp = fn(region, lo, bias + cb); *(f32x4*)(rowp + 128) = fn(region, hi, bias + cb + 128);
    }
};
#ifndef DBG_SKIP
#define DBG_SKIP 0
#endif
struct EpiGlu {
    static constexpr bool PERM = false;
    float* H;
    __device__ __forceinline__ void operator()(const f32x4 (&acc)[2][2][4][2], const pg8::Unit& u, int wr, int wc, int fr, int fq) const {
        const int row0 = u.pm * 256 + wr * 64 + fr, col0 = u.pn * 128 + wc * 32 + 4 * fq;
#pragma unroll
        for (int ai = 0; ai < 2; ++ai) { f32x4 t[4][2];
#pragma unroll
            for (int m = 0; m < 4; ++m)
#pragma unroll
                for (int n = 0; n < 2; ++n) t[m][n] = *(const f32x4*)(H + (size_t)(row0 + ai * 128 + m * 16) * D + col0 + n * 16);
#pragma unroll
            for (int m = 0; m < 4; ++m)
#pragma unroll
                for (int n = 0; n < 2; ++n) { const f32x4 ga = acc[ai][0][m][n], gb = acc[ai][1][m][n]; f32x4 v = t[m][n];
                    if (!(DBG_SKIP & 2)) { v[0] += ga[0] * sigmoidf_(gb[0]); v[1] += ga[1] * sigmoidf_(gb[1]); v[2] += ga[2] * sigmoidf_(gb[2]); v[3] += ga[3] * sigmoidf_(gb[3]); }
                    *(f32x4*)(H + (size_t)(row0 + ai * 128 + m * 16) * D + col0 + n * 16) = v; } }
    }
    __device__ __forceinline__ void tail(int r, int pn, int c4, f32x4 lo, f32x4 hi) const {
        f32x4* p = (f32x4*)(H + (size_t)(MX + r) * D + pn * 128 + c4); f32x4 v = *p;
        v[0] += lo[0] * sigmoidf_(hi[0]); v[1] += lo[1] * sigmoidf_(hi[1]); v[2] += lo[2] * sigmoidf_(hi[2]); v[3] += lo[3] * sigmoidf_(hi[3]); *p = v;
    }
};
#define LDS_WAIT() asm volatile("s_waitcnt lgkmcnt(0)" ::: "memory")
constexpr int NWAVES = 8, NTHREADS = 512;

template <bool SCALE>
__device__ __forceinline__ void transpose_item(const float* W, int ldw, int k0, int n0, const float* scale, bf16_t* dst, int dld, int drow0, LAS float* scr, int lane) {
    float v[32];
#pragma unroll
    for (int i = 0; i < 32; ++i) { const int kk = 2 * i + (lane >> 5); v[i] = W[(size_t)(k0 + kk) * ldw + n0 + (lane & 31)]; }
    const int c = lane & 7;
    f32x4 s0 = {1.f, 1.f, 1.f, 1.f}, s1 = s0;
    if (SCALE) { s0 = *(const f32x4*)(scale + k0 + 8 * c); s1 = *(const f32x4*)(scale + k0 + 8 * c + 4); }
#pragma unroll
    for (int i = 0; i < 32; ++i) { const int kk = 2 * i + (lane >> 5); scr[kk * 33 + (lane & 31)] = v[i]; }
    LDS_WAIT();
#pragma unroll
    for (int j = 0; j < 4; ++j) { const int n = (lane >> 3) + 8 * j; const LAS float* s = scr + (8 * c) * 33 + n;
        u32x4 o; o.x = pk2(s[0 * 33] * s0[0], s[1 * 33] * s0[1]); o.y = pk2(s[2 * 33] * s0[2], s[3 * 33] * s0[3]); o.z = pk2(s[4 * 33] * s1[0], s[5 * 33] * s1[1]); o.w = pk2(s[6 * 33] * s1[2], s[7 * 33] * s1[3]);
        *(u32x4*)(dst + (size_t)(drow0 + n) * dld + k0 + 8 * c) = o; }
    LDS_WAIT();
}
__device__ __forceinline__ void norm_row(const float* src, float* cpy, bf16_t* dstb, int lane) {
    f32x4 v[16]; float s = 0.f;
#pragma unroll
    for (int j = 0; j < 16; ++j) { v[j] = ((const f32x4*)src)[lane + 64 * j]; s += (v[j][0] * v[j][0] + v[j][1] * v[j][1]) + (v[j][2] * v[j][2] + v[j][3] * v[j][3]); }
    s = sum64(s);
    const float inv = rsqrtf(s * (1.0f / D) + NORM_EPS);
#pragma unroll
    for (int j = 0; j < 16; ++j) { if (cpy) ((f32x4*)cpy)[lane + 64 * j] = v[j];
        u32x2 o; o.x = cvt_pk_bf16(v[j][0] * inv, v[j][1] * inv); o.y = cvt_pk_bf16(v[j][2] * inv, v[j][3] * inv); ((u32x2*)dstb)[lane + 64 * j] = o; }
}
__device__ __forceinline__ bf16x8 cvt8(const float* p) {
    const f32x4 a = *(const f32x4*)p, b = *(const f32x4*)(p + 4);
    u32x4 o; o.x = pk2(a[0], a[1]); o.y = pk2(a[2], a[3]); o.z = pk2(b[0], b[1]); o.w = pk2(b[2], b[3]);
    return __builtin_bit_cast(bf16x8, o);
}

__device__ __forceinline__ void peer_row_load(f32x4 (&v)[16], const float* const (&in)[34], int it, int layer, int lane) {
    const int tbl = it >= NEXP, r = it - tbl * NEXP + layer * NEXP;
    const f32x4* src = (const f32x4*)((tbl ? in[33] : in[32]) + (size_t)r * D) + lane;
#pragma unroll
    for (int j = 0; j < 16; ++j) v[j] = src[64 * j];
}
__device__ __forceinline__ void peer_row_store(const f32x4 (&v)[16], unsigned char* ws, int it, int layer, int lane) {
    const int tbl = it >= NEXP, r = it - tbl * NEXP + layer * NEXP;
    float am = 0.f;
#pragma unroll
    for (int j = 0; j < 16; ++j) am = fmaxf(fmaxf(am, fmaxf(fabsf(v[j][0]), fabsf(v[j][1]))), fmaxf(fabsf(v[j][2]), fabsf(v[j][3])));
    am = __uint_as_float(max64u(__float_as_uint(am)));
    const float q = am > 0.f ? 256.0f / am : 0.f;
    unsigned* dst = (unsigned*)(ws + (tbl ? WS_PV : WS_PU) + (size_t)r * D) + lane;
    if (tbl) {
        const int rl = it - NEXP;
        unsigned char* pvl = ws + WS_PV + (size_t)layer * NEXP * D + (size_t)rl * 8 + (lane & 1) * 4;
        unsigned char* pvg = ws + WS_PV + (size_t)layer * NEXP * D + (size_t)NEXP * 2048 + (size_t)rl * 2048 + 4 * lane;
#pragma unroll
        for (int j = 0; j < 16; ++j) { int w = __builtin_amdgcn_cvt_pk_bf8_f32(v[j][0] * q, v[j][1] * q, 0, false); w = __builtin_amdgcn_cvt_pk_bf8_f32(v[j][2] * q, v[j][3] * q, w, true);
            if (j < 8) *(unsigned*)(pvl + (size_t)((lane >> 1) + 32 * j) * (NEXP * 8)) = (unsigned)w;
            else *(unsigned*)(pvg + 256 * (j - 8)) = (unsigned)w; }
    } else {
#pragma unroll
        for (int j = 0; j < 16; ++j) { int w = __builtin_amdgcn_cvt_pk_fp8_f32(v[j][0] * q, v[j][1] * q, 0, false); w = __builtin_amdgcn_cvt_pk_fp8_f32(v[j][2] * q, v[j][3] * q, w, true); dst[64 * j] = (unsigned)w; }
    }
    if (lane == 0) ((float*)(ws + (tbl ? WS_SV : WS_SU)))[r] = am * (1.0f / 256.0f);
}
template <int R>
__device__ __forceinline__ void peer_vrow(const f32x4 (&v)[16], unsigned char* ws, LAS unsigned char* tile, int rl, int rr, int layer, int lane) {
    float am = 0.f;
#pragma unroll
    for (int j = 0; j < 16; ++j) am = fmaxf(fmaxf(am, fmaxf(fabsf(v[j][0]), fabsf(v[j][1]))), fmaxf(fabsf(v[j][2]), fabsf(v[j][3])));
    am = __uint_as_float(max64u(__float_as_uint(am)));
    const float q = am > 0.f ? 256.0f / am : 0.f;
    unsigned char* pvg = ws + WS_PV + (size_t)layer * NEXP * D + (size_t)NEXP * 2048 + (size_t)rl * 2048 + 4 * lane;
#pragma unroll
    for (int j = 0; j < 16; ++j) { int w = __builtin_amdgcn_cvt_pk_bf8_f32(v[j][0] * q, v[j][1] * q, 0, false); w = __builtin_amdgcn_cvt_pk_bf8_f32(v[j][2] * q, v[j][3] * q, w, true);
        if (j < 8) *(LAS unsigned*)(tile + rr * 2048 + 4 * (lane + 64 * j)) = (unsigned)w;
        else *(unsigned*)(pvg + 256 * (j - 8)) = (unsigned)w; }
    if (lane == 0) ((float*)(ws + WS_SV))[layer * NEXP + rl] = am * (1.0f / 256.0f);
}
template <int R>
__device__ __forceinline__ void peer_convert_v(const float* const (&in)[34], unsigned char* ws, LAS unsigned char* tile, int gw, int NGW, int lane, int layer) {
    f32x4 va[16], vb[16];
#pragma unroll 1
    for (int blk = gw; blk < NEXP / R; blk += NGW) {
        const int row0 = blk * R;
        peer_row_load(va, in, NEXP + row0, layer, lane);
#pragma unroll
        for (int rr = 0; rr < R; rr += 2) {
            peer_row_load(vb, in, NEXP + row0 + rr + 1, layer, lane);
            __builtin_amdgcn_sched_barrier(0);
            peer_vrow<R>(va, ws, tile, row0 + rr, rr, layer, lane);
            __builtin_amdgcn_sched_barrier(0);
            if (rr + 2 < R) peer_row_load(va, in, NEXP + row0 + rr + 2, layer, lane);
            __builtin_amdgcn_sched_barrier(0);
            peer_vrow<R>(vb, ws, tile, row0 + rr + 1, rr + 1, layer, lane);
            __builtin_amdgcn_sched_barrier(0);
        }
        LDS_WAIT();
        unsigned char* pvl = ws + WS_PV + (size_t)layer * NEXP * D + (size_t)row0 * 8;
#pragma unroll
        for (int m = 0; m < 4; ++m) { const int grp = lane + 64 * m; u32x2 t_[R];
#pragma unroll
            for (int rr = 0; rr < R; ++rr) t_[rr] = *(const LAS u32x2*)(tile + rr * 2048 + 8 * grp);
#pragma unroll
            for (int rr = 0; rr < R; rr += 2) *(u32x4*)(pvl + (size_t)grp * (NEXP * 8) + rr * 8) = (u32x4){t_[rr].x, t_[rr].y, t_[rr + 1].x, t_[rr + 1].y}; }
        LDS_WAIT();
    }
}
__device__ __forceinline__ void peer_convert(const float* const (&in)[34], unsigned char* ws, int gw, int NGW, int lane, int only_layer, int it_lo = 0, int it_hi = 2 * NEXP) {
    f32x4 va[16], vb[16];
    if (it_lo + gw >= it_hi) return;
    peer_row_load(va, in, it_lo + gw, only_layer, lane);
#pragma unroll 1
    for (int it = it_lo + gw; it < it_hi; it += 2 * NGW) {
        const int it1 = it + NGW, it2 = it + 2 * NGW;
        peer_row_load(vb, in, it1 < it_hi ? it1 : it, only_layer, lane);
        __builtin_amdgcn_sched_barrier(0);
        peer_row_store(va, ws, it, only_layer, lane);
        __builtin_amdgcn_sched_barrier(0);
        peer_row_load(va, in, it2 < it_hi ? it2 : it, only_layer, lane);
        __builtin_amdgcn_sched_barrier(0);
        if (it1 < it_hi) peer_row_store(vb, ws, it1, only_layer, lane);
        __builtin_amdgcn_sched_barrier(0);
    }
}


template <int PARTS = 3>
__device__ __forceinline__ void phase_prologue(const float* const (&in)[34], unsigned char* ws, LAS unsigned char* lds, int G) {
    int tid = threadIdx.x; asm volatile("" : "+v"(tid)); const int lane = tid & 63, wid = __builtin_amdgcn_readfirstlane(tid >> 6);
    const int gw = blockIdx.x * NWAVES + wid, NGW = G * NWAVES;
    const size_t gt = (size_t)blockIdx.x * NTHREADS + tid, NT = (size_t)G * NTHREADS;
    LAS float* scr = (LAS float*)(lds + wid * 16384);
    bf16_t* W1T = (bf16_t*)(ws + WS_W1T);
    constexpr int I1 = (D / 64) * (ZC / 32);
    if (PARTS & 1) for (int r = gw; r < I1; r += NGW) { const int kb = r % (D / 64), n0 = (r / (D / 64)) * 32;     transpose_item<true>(in[5], ZC, kb * 64, n0, in[2], W1T, D, n0, scr, lane); }
    for (size_t i = gt; i < (size_t)(ZLD - ZC) * D / 8; i += NT) ((u32x4*)(W1T + (size_t)ZC * D))[i] = (u32x4){0u, 0u, 0u, 0u};
    if (PARTS & 2) { bf16_t* HB = (bf16_t*)(ws + WS_HB);
      for (int r = gw; r < MROWS; r += NGW) { const float* src = r < MX ? in[0] + (size_t)r * D : in[1] + (size_t)(r - MX) * D; norm_row(src, nullptr, HB + (size_t)r * D, lane); } }
}
__device__ __forceinline__ void early_weights(const float* const (&in)[34], unsigned char* ws, LAS float* scr, int gw, int NGW, size_t gt, size_t NT, int lane) {
    bf16_t* WOT = (bf16_t*)(ws + WS_WOT); bf16_t* BTP = (bf16_t*)(ws + WS_BTP); bf16_t* BTL = (bf16_t*)(ws + WS_BTL);
    constexpr int I2 = (D / 64) * (D / 32), I5 = 4 * (512 / 64) * (512 / 32);
    for (int it = gw; it < I2 + I5; it += NGW) {
        int r = it;
        if (r < I2) { const int kb = r % (D / 64), n0 = (r / (D / 64)) * 32; transpose_item<false>(in[19], D, kb * 64, n0, nullptr, WOT, D, n0, scr, lane); continue; } r -= I2;
        { const int grp = r / 128, rr = r % 128, kb = rr % 8, n0 = (rr / 8) * 32; transpose_item<false>(in[6] + (size_t)grp * 512 * 512, 512, kb * 64, n0, nullptr, BTP, 512, grp * 512 + n0, scr, lane); }
    }
    for (size_t i = gt; i < (size_t)6144 * 256; i += NT) { const int k = (int)(i / 6144), n = (int)(i % 6144), reg = n >> 11, c = n & 2047; float v = 0.f;
        if (reg == 0) { if (k < 96) v = in[10][(size_t)k * 2048 + c]; }
        else if (reg == 1) { if (k >= 128 && k < 224) v = in[12][(size_t)(k - 128) * 2048 + c]; }
        else v = in[13][(size_t)k * 2048 + c];
        BTL[(size_t)n * 256 + k] = (bf16_t)f2bf(v); }
}
template <int PART>
__device__ __forceinline__ void late_weights(const float* const (&in)[34], unsigned char* ws, LAS float* scr, int gw, int NGW, int lane) {
    bf16_t* WIO = (bf16_t*)(ws + WS_WIO); bf16_t* WGT = (bf16_t*)(ws + WS_WGT); bf16_t* WST = (bf16_t*)(ws + WS_WST);
    constexpr int I3 = (D / 64) * (2048 / 32), I4 = (2048 / 64) * (8192 / 32);
    if (PART == 0) {
        for (int r = gw; r < I3; r += NGW) { const int kb = r % (D / 64), n0 = (r / (D / 64)) * 32; transpose_item<true>(in[20], 2048, kb * 64, n0, in[2] + D, WIO, D, n0, scr, lane); }
    } else if (PART == 2) {
        for (int r = gw; r < I4; r += NGW) { const int kb = r % (2048 / 64), n0 = (r / (2048 / 64)) * 32;
            const int half = n0 >= 4096, c = n0 - half * 4096, drow = (c >> 7) * 256 + half * 128 + (c & 127);
            transpose_item<false>(in[29], 8192, kb * 64, n0, nullptr, WGT, 2048, drow, scr, lane); }
    }
    if (PART < 2) { const int fr = lane & 15, fq = lane >> 4, layer = PART;
      for (int it = gw; it < 16 * 256; it += NGW) {
        const int hp = (it >> 8) & 15, d0 = (it & 255) * 16;
        const float* wq = in[30] + (size_t)layer * D * 2048 + (size_t)(d0 + fr) * 2048 + hp * 128 + fq * 8;
        const float* sk = in[31] + ((size_t)(layer * 16 + hp) * 128 + fr) * 128 + fq * 8;
        f32x4 acc[8]; f32x4 ra[2], rb[8][2];
#pragma unroll
        for (int kt = 0; kt < 8; ++kt) acc[kt] = (f32x4){0.f, 0.f, 0.f, 0.f};
#pragma unroll
        for (int ks = 0; ks < 4; ++ks) {
            if (ks == 0) { ra[0] = *(const f32x4*)(wq); ra[1] = *(const f32x4*)(wq + 4);
#pragma unroll
                for (int kt = 0; kt < 8; ++kt) { rb[kt][0] = *(const f32x4*)(sk + (size_t)kt * 16 * 128); rb[kt][1] = *(const f32x4*)(sk + (size_t)kt * 16 * 128 + 4); } }
            u32x4 ao; ao.x = pk2(ra[0][0], ra[0][1]); ao.y = pk2(ra[0][2], ra[0][3]); ao.z = pk2(ra[1][0], ra[1][1]); ao.w = pk2(ra[1][2], ra[1][3]);
            u32x4 bo[8];
#pragma unroll
            for (int kt = 0; kt < 8; ++kt) { bo[kt].x = pk2(rb[kt][0][0], rb[kt][0][1]); bo[kt].y = pk2(rb[kt][0][2], rb[kt][0][3]); bo[kt].z = pk2(rb[kt][1][0], rb[kt][1][1]); bo[kt].w = pk2(rb[kt][1][2], rb[kt][1][3]); }
            __builtin_amdgcn_sched_barrier(0);
            if (ks < 3) { ra[0] = *(const f32x4*)(wq + (ks + 1) * 32); ra[1] = *(const f32x4*)(wq + (ks + 1) * 32 + 4);
#pragma unroll
                for (int kt = 0; kt < 8; ++kt) { rb[kt][0] = *(const f32x4*)(sk + (size_t)kt * 16 * 128 + (ks + 1) * 32); rb[kt][1] = *(const f32x4*)(sk + (size_t)kt * 16 * 128 + (ks + 1) * 32 + 4); } }
            __builtin_amdgcn_sched_barrier(0);
#pragma unroll
            for (int kt = 0; kt < 8; ++kt) acc[kt] = __builtin_amdgcn_mfma_f32_16x16x32_bf16(__builtin_bit_cast(bf16x8, ao), __builtin_bit_cast(bf16x8, bo[kt]), acc[kt], 0, 0, 0);
            __builtin_amdgcn_sched_barrier(0);
        }
#pragma unroll
        for (int kt = 0; kt < 8; ++kt) { const f32x4 v = acc[kt]; u32x2 o; o.x = cvt_pk_bf16(v[0], v[1]); o.y = cvt_pk_bf16(v[2], v[3]);
            *(u32x2*)(WST + ((size_t)layer * 2048 + hp * 128 + kt * 16 + fr) * D + d0 + 4 * fq) = o; }
      } }
}

template <bool FP8, bool GAIN = false>
__device__ __forceinline__ void phase_norm(unsigned char* ws, int G, const float* gain = nullptr) {
    int tid = threadIdx.x; asm volatile("" : "+v"(tid)); const int lane = tid & 63, wid = __builtin_amdgcn_readfirstlane(tid >> 6);
    const float* H = (const float*)(ws + WS_H); bf16_t* HB = (bf16_t*)(ws + WS_HB);
    f32x4 gv[16];
    if (GAIN) {
#pragma unroll
        for (int j = 0; j < 16; ++j) gv[j] = ((const f32x4*)gain)[lane + 64 * j]; }
    const int r0 = blockIdx.x * NWAVES + wid, RS = G * NWAVES;
    if (r0 >= MROWS) return;
#define PN_LOAD(v, R) do { const f32x4* src_ = (const f32x4*)(H + (size_t)(R) * D) + lane; _Pragma("unroll") for (int j = 0; j < 16; ++j) v[j] = src_[64 * j]; } while (0)
#define PN_ROW(v, R) do { float s_ = 0.f; _Pragma("unroll") for (int j = 0; j < 16; ++j) s_ += (v[j][0] * v[j][0] + v[j][1] * v[j][1]) + (v[j][2] * v[j][2] + v[j][3] * v[j][3]); \
        s_ = sum64(s_); const float inv_ = rsqrtf(s_ * (1.0f / D) + NORM_EPS); u32x2* dstb_ = (u32x2*)(HB + (size_t)(R) * D) + lane; \
        _Pragma("unroll") for (int j = 0; j < 16; ++j) { f32x4 w_ = v[j] * inv_; if (GAIN) w_ = w_ * gv[j]; u32x2 o_; o_.x = cvt_pk_bf16(w_[0], w_[1]); o_.y = cvt_pk_bf16(w_[2], w_[3]); dstb_[64 * j] = o_; } } while (0)
    f32x4 va[16], vb[16];
    PN_LOAD(va, r0);
#pragma unroll 1
    for (int r = r0; r < MROWS; r += 2 * RS) {
        const int r1 = r + RS, r2 = r + 2 * RS;
        PN_LOAD(vb, r1 < MROWS ? r1 : r);
        __builtin_amdgcn_sched_barrier(0);
        PN_ROW(va, r);
        __builtin_amdgcn_sched_barrier(0);
        PN_LOAD(va, r2 < MROWS ? r2 : r);
        __builtin_amdgcn_sched_barrier(0);
        if (r1 < MROWS) PN_ROW(vb, r1);
        __builtin_amdgcn_sched_barrier(0);
    }
#undef PN_LOAD
#undef PN_ROW
}

__device__ __forceinline__ float zl_get(const float* ZL, int r, int c) { const float* p = ZL + (size_t)r * 2048 + c; return r < MX ? (p[0] + p[512]) + (p[1024] + p[1536]) : p[0]; }
__device__ __forceinline__ void phase_prep(const float* mu, unsigned char* ws, int G) {
    int tid = threadIdx.x; asm volatile("" : "+v"(tid));
    const bf16_t* Z = (const bf16_t*)(ws + WS_Z); bf16_t* PM = (bf16_t*)(ws + WS_PM); bf16_t* LA = (bf16_t*)(ws + WS_LA); const float* ZL = (const float*)(ws + WS_WAG);
    const int c4 = tid * 4, grp = c4 >> 9, w = 2 << grp;
    float msk[16];
#pragma unroll
    for (int i = 0; i < 16; ++i) msk[i] = i < w ? 1.f : 0.f;
    for (int it = blockIdx.x; it < NB * 129; it += G) {
        const int b = it / 129, blk = it % 129; if (b > 0 && blk == 0) continue;
        const int p0 = blk * 16;
        float zz[31][4];
        u32x2 zq[31];
#pragma unroll
        for (int i = 0; i < 31; ++i) { const int pos = p0 - 15 + i; zq[i] = *(const u32x2*)(Z + (size_t)rowof(b, pos < 0 ? 0 : pos) * ZLD + c4); }
#pragma unroll
        for (int i = 0; i < 31; ++i) { const int pos = p0 - 15 + i; const u32x2 q = pos >= 0 ? zq[i] : (u32x2){0u, 0u}; zz[i][0] = bflo(q.x); zz[i][1] = bfhi(q.x); zz[i][2] = bflo(q.y); zz[i][3] = bfhi(q.y); }
#pragma unroll
        for (int t = 0; t < 16; ++t) { const int pos = p0 + t; float s[4] = {0.f, 0.f, 0.f, 0.f};
#pragma unroll
            for (int i = 0; i < 16; ++i) {
#pragma unroll
                for (int e = 0; e < 4; ++e) s[e] = fmaf(zz[15 + t - i][e], msk[i], s[e]); }
            const float ic = 1.0f / (float)(pos + 1 < w ? pos + 1 : w);
            u32x2 o; o.x = cvt_pk_bf16(s[0] * ic - zz[15 + t][0], s[1] * ic - zz[15 + t][1]); o.y = cvt_pk_bf16(s[2] * ic - zz[15 + t][2], s[3] * ic - zz[15 + t][3]);
            *(u32x2*)(PM + (size_t)rowof(b, pos) * 2048 + c4) = o; }
    }
    {   const int k = tid;
        int zc = -1, kind = 0;
        if (k < 96) { zc = ZWL + k; kind = 1; } else if (k >= 128 && k < 224) { zc = ZAL + k - 128; kind = 2; } else if (k >= 256) { zc = ZGL + k - 256; kind = 3; }
        const int zcc = zc >= 0 ? zc : 0; const float muv = zc >= 0 ? mu[zc - 2048] : 0.f;
        for (int row0 = blockIdx.x * 4; row0 < MROWS; row0 += G * 4) {
            float z[4], zp[4];
#pragma unroll
            for (int u = 0; u < 4; ++u) { const int row = row0 + u;
                int prow; if (row >= MX) prow = row > MX ? row - 1 : -1; else prow = (row & (SEQ - 1)) ? row - 1 : MX + NMETA - 1;
                z[u] = bf2f(Z[(size_t)row * ZLD + zcc]); zp[u] = bf2f(Z[(size_t)(prow >= 0 ? prow : row) * ZLD + zcc]); if (prow < 0) zp[u] = 0.f; }
#pragma unroll
            for (int u = 0; u < 4; ++u) { const float sh = z[u] + (zp[u] - z[u]) * muv;
                float v = kind == 1 ? tanhf(sh) : (kind == 2 ? sh : sigmoidf_(sh)); if (zc < 0) v = 0.f;
                LA[(size_t)(row0 + u) * 512 + k] = (bf16_t)f2bf(v); }
        }
    }
}

__device__ __forceinline__ float vmul(float a, float b) { float d; asm("v_mul_f32 %0, %1, %2" : "=v"(d) : "v"(a), "v"(b)); return d; }
__device__ __forceinline__ float vfma(float a, float b, float c) { float d; asm("v_fma_f32 %0, %1, %2, %3" : "=v"(d) : "v"(a), "v"(b), "v"(c)); return d; }
__device__ __forceinline__ float vfnma(float a, float b, float c) { float d; asm("v_fma_f32 %0, -%1, %2, %3" : "=v"(d) : "v"(a), "v"(b), "v"(c)); return d; }
struct RwkvRegs { u32x2 zr, zk, zv, pr, pk, pv; f32x4 dec, a, g; };
__device__ __forceinline__ void rwkv_load(RwkvRegs& R, const bf16_t* Z, const float* WAG, int b, int h, int pos, int j4, f32x4 w0v, f32x4 a0v) {
    const u32x2 z0 = {0u, 0u};
    if (pos < LSEQ) { const int row = rowof(b, pos); const bf16_t* zp = Z + (size_t)row * ZLD + h * 64 + j4;
        R.zr = *(const u32x2*)(zp + ZR); R.zk = *(const u32x2*)(zp + ZK); R.zv = *(const u32x2*)(zp + ZV);
        if (pos > 0) { const bf16_t* pp = Z + (size_t)rowof(b, pos - 1) * ZLD + h * 64 + j4; R.pr = *(const u32x2*)(pp + ZR); R.pk = *(const u32x2*)(pp + ZK); R.pv = *(const u32x2*)(pp + ZV); }
        else { R.pr = z0; R.pk = z0; R.pv = z0; }
        const float* wp = WAG + (size_t)row * WAGLD + h * 64 + j4; R.dec = *(const f32x4*)wp; R.a = *(const f32x4*)(wp + 2048); R.g = *(const f32x4*)(wp + 4096);

    } else { R.zr = z0; R.zk = z0; R.zv = z0; R.pr = z0; R.pk = z0; R.pv = z0; R.dec = (f32x4){0.f, 0.f, 0.f, 0.f}; R.a = R.dec; R.g = R.dec; }
}
__device__ __forceinline__ f32x4 unpack4(u32x2 q) { return (f32x4){bflo(q.x), bfhi(q.x), bflo(q.y), bfhi(q.y)}; }
template <int MODE = 0>
__device__ __forceinline__ void phase_rwkv(const float* const (&in)[34], unsigned char* ws, LAS unsigned char* lds, int G) {
    int tid = threadIdx.x; asm volatile("" : "+v"(tid)); const int lane = tid & 63, wid = __builtin_amdgcn_readfirstlane(tid >> 6);
    const bf16_t* Z = (const bf16_t*)(ws + WS_Z); const float* WAG = (const float*)(ws + WS_WAG); bf16_t* Y = (bf16_t*)(ws + (MODE ? WS_SC : WS_Y));
    const int tt = tid >> 4, q = tid & 15, j4 = q * 4;
    const int cgi = lane & 15, rg = lane >> 4, myrow = wid * 8 + 2 * rg;
    LAS float* bonus = (LAS float*)(lds + BONUS_OFF);
    for (int chain = blockIdx.x; chain < NB * NHEAD; chain += G) {
        const int b = chain >> 5, h = chain & 31;
        const float* mu = in[8];
        const f32x4 mur = *(const f32x4*)(mu + h * 64 + j4), muk = *(const f32x4*)(mu + 2048 + h * 64 + j4), muv = *(const f32x4*)(mu + 4096 + h * 64 + j4);
        const f32x4 kk_ = *(const f32x4*)(in[14] + h * 64 + j4), ka_ = *(const f32x4*)(in[15] + h * 64 + j4), rk_ = *(const f32x4*)(in[16] + h * 64 + j4);
        const f32x4 gng = *(const f32x4*)(in[17] + h * 64 + j4), gnb = *(const f32x4*)(in[18] + h * 64 + j4);
        float S0[4], S1[4];
#pragma unroll
        for (int j = 0; j < 4; ++j) { S0[j] = 0.f; S1[j] = 0.f; }
        const f32x4 w0v = *(const f32x4*)(in[9] + h * 64 + j4), a0v = *(const f32x4*)(in[11] + h * 64 + j4);
        RwkvRegs R; rwkv_load(R, Z, WAG, b, h, tt, j4, w0v, a0v);
        const int nchunk = (LSEQ + 31) / 32;
        for (int c = 0; c < nchunk; ++c) {
            LAS float* buf = (LAS float*)(lds + (c & 1) * 65536);
            LAS float* bon = bonus + (c & 1) * 96;
            {
                const f32x4 zr = unpack4(R.zr), zk = unpack4(R.zk), zv = unpack4(R.zv), pr = unpack4(R.pr), pk = unpack4(R.pk), pv = unpack4(R.pv);
                f32x4 dec = R.dec + w0v, av = R.a + a0v;
#pragma unroll
                for (int e = 0; e < 4; ++e) { dec[e] = decay_of(dec[e]); av[e] = sigmoidf_(av[e]); }
                const f32x4 r = zr + (pr - zr) * mur, k = zk + (pk - zk) * muk, v = zv + (pv - zv) * muv;
                const f32x4 kr = k * kk_;
                const float ss = sum16((kr[0] * kr[0] + kr[1] * kr[1]) + (kr[2] * kr[2] + kr[3] * kr[3]));
                const float inrm = rsqrtf(fmaxf(ss, 1e-24f));
                const f32x4 kk = kr * inrm;
                const f32x4 km = k * (1.0f + (av - 1.0f) * ka_);
                const f32x4 kka = kk * av;
                const f32x4 rb = r * km * rk_;
                const float bs = sum16((rb[0] + rb[1]) + (rb[2] + rb[3]));
                const f32x4 rka = r * kka, rkm = r * km;
                const float c1 = sum16((rka[0] + rka[1]) + (rka[2] + rka[3])), c2 = sum16((rkm[0] + rkm[1]) + (rkm[2] + rkm[3]));
                const int o = tt * 64 + j4;
                *(LAS f32x4*)(buf + 0 * 2048 + o) = r * dec; *(LAS f32x4*)(buf + 1 * 2048 + o) = dec; *(LAS f32x4*)(buf + 2 * 2048 + o) = km; *(LAS f32x4*)(buf + 3 * 2048 + o) = v;
                *(LAS f32x4*)(buf + 4 * 2048 + o) = kk; *(LAS f32x4*)(buf + 5 * 2048 + o) = kka; *(LAS f32x4*)(buf + 6 * 2048 + o) = R.g;
                if (q == 0) { bon[tt] = bs; bon[32 + tt] = c1; bon[64 + tt] = c2; }
            }
            __syncthreads();
            if (c + 1 < nchunk) rwkv_load(R, Z, WAG, b, h, (c + 1) * 32 + tt, j4, w0v, a0v);
            const int nst = (LSEQ - c * 32) < 32 ? (LSEQ - c * 32) : 32;
            {   const LAS float* p = buf + cgi * 4;
                const LAS float* pv = buf + 3 * 2048 + myrow;
                LAS float* py = buf + 7 * 2048 + myrow;
#define RW_LOAD(r4, d4, m4, k4, a4, v2, cc, T) do { const LAS float* q_ = p + (T) * 64; r4 = *(const LAS f32x4*)(q_); d4 = *(const LAS f32x4*)(q_ + 2048); m4 = *(const LAS f32x4*)(q_ + 4096); \
        k4 = *(const LAS f32x4*)(q_ + 8192); a4 = *(const LAS f32x4*)(q_ + 10240); v2 = *(const LAS f32x2*)(pv + (T) * 64); cc = (f32x2){bon[32 + (T)], bon[64 + (T)]}; } while (0)
#define RW_DPP4(ctrl) "v_add_f32_dpp %0, %0, %0 " ctrl " row_mask:0xf bank_mask:0xf bound_ctrl:1\n\tv_add_f32_dpp %1, %1, %1 " ctrl " row_mask:0xf bank_mask:0xf bound_ctrl:1\n\t" \
                      "v_add_f32_dpp %2, %2, %2 " ctrl " row_mask:0xf bank_mask:0xf bound_ctrl:1\n\tv_add_f32_dpp %3, %3, %3 " ctrl " row_mask:0xf bank_mask:0xf bound_ctrl:1\n\t"
#define RW_STEP(r4, d4, m4, k4, a4, v2, cc, T) do { \
        float e0 = vmul(S0[0], k4[0]), e1 = vmul(S1[0], k4[0]), e2 = vmul(S0[0], r4[0]), e3 = vmul(S1[0], r4[0]);     \
        float w00 = vmul(S0[0], d4[0]), w10 = vmul(S1[0], d4[0]); \
        e0 = vfma(S0[1], k4[1], e0); e1 = vfma(S1[1], k4[1], e1); e2 = vfma(S0[1], r4[1], e2); e3 = vfma(S1[1], r4[1], e3); \
        float w01 = vmul(S0[1], d4[1]), w11 = vmul(S1[1], d4[1]); \
        e0 = vfma(S0[2], k4[2], e0); e1 = vfma(S1[2], k4[2], e1); e2 = vfma(S0[2], r4[2], e2); e3 = vfma(S1[2], r4[2], e3); \
        float w02 = vmul(S0[2], d4[2]), w12 = vmul(S1[2], d4[2]); \
        e0 = vfma(S0[3], k4[3], e0); e1 = vfma(S1[3], k4[3], e1); e2 = vfma(S0[3], r4[3], e2); e3 = vfma(S1[3], r4[3], e3); \
        float w03 = vmul(S0[3], d4[3]), w13 = vmul(S1[3], d4[3]); \
        w00 = vfma(v2[0], m4[0], w00); w10 = vfma(v2[1], m4[0], w10); w01 = vfma(v2[0], m4[1], w01); w11 = vfma(v2[1], m4[1], w11); \
        w02 = vfma(v2[0], m4[2], w02); w12 = vfma(v2[1], m4[2], w12); w03 = vfma(v2[0], m4[3], w03); w13 = vfma(v2[1], m4[3], w13); \
        asm volatile("s_nop 1\n\t" RW_DPP4("quad_perm:[1,0,3,2]") RW_DPP4("quad_perm:[2,3,0,1]") RW_DPP4("row_half_mirror") RW_DPP4("row_mirror") : "+v"(e0), "+v"(e1), "+v"(e2), "+v"(e3)); \
        S0[0] = vfnma(e0, a4[0], w00); S1[0] = vfnma(e1, a4[0], w10); S0[1] = vfnma(e0, a4[1], w01); S1[1] = vfnma(e1, a4[1], w11); \
        S0[2] = vfnma(e0, a4[2], w02); S1[2] = vfnma(e1, a4[2], w12); S0[3] = vfnma(e0, a4[3], w03); S1[3] = vfnma(e1, a4[3], w13); \
        if (cgi == 0) { const float y0 = vfnma(e0, cc[0], vfma(v2[0], cc[1], e2)), y1 = vfnma(e1, cc[0], vfma(v2[1], cc[1], e3)); *(LAS f32x2*)(py + (T) * 64) = (f32x2){y0, y1}; } } while (0)
                f32x4 Ar, Ad, Am, Ak, Aa, Br, Bd, Bm, Bk, Ba; f32x2 Av, Bv, Ac, Bc;
                RW_LOAD(Ar, Ad, Am, Ak, Aa, Av, Ac, 0);
                for (int t = 0; t < (MODE == 1 ? 0 : nst); t += 2) {
                    RW_LOAD(Br, Bd, Bm, Bk, Ba, Bv, Bc, t + 1);
                    __builtin_amdgcn_sched_barrier(0);
                    RW_STEP(Ar, Ad, Am, Ak, Aa, Av, Ac, t);
                    __builtin_amdgcn_sched_barrier(0);
                    RW_LOAD(Ar, Ad, Am, Ak, Aa, Av, Ac, (t + 2) & 31);
                    __builtin_amdgcn_sched_barrier(0);
                    RW_STEP(Br, Bd, Bm, Bk, Ba, Bv, Bc, t + 1);
                    __builtin_amdgcn_sched_barrier(0);
                }
#undef RW_LOAD
#undef RW_STEP
#undef RW_DPP4
            }
            __syncthreads();
            {
                const int pos = c * 32 + tt;
                const int o = tt * 64 + j4;
                const f32x4 y = *(const LAS f32x4*)(buf + 7 * 2048 + o), v = *(const LAS f32x4*)(buf + 3 * 2048 + o), g = *(const LAS f32x4*)(buf + 6 * 2048 + o);
                const float mean = sum16((y[0] + y[1]) + (y[2] + y[3])) * (1.0f / 64.0f);
                const f32x4 dy = y - mean;
                const float var = sum16((dy[0] * dy[0] + dy[1] * dy[1]) + (dy[2] * dy[2] + dy[3] * dy[3])) * (1.0f / 64.0f);
                const float rs = rsqrtf(var + GN_EPS), bs = bon[tt];
#if (DBG_SKIP & 4)
                const f32x4 out = (f32x4){0.f, 0.f, 0.f, 0.f};
#else
                const f32x4 out = (dy * rs * gng + gnb + v * bs) * g;
#endif
                if (pos < LSEQ && (b == 0 || pos >= NMETA)) { u32x2 w; w.x = cvt_pk_bf16(out[0], out[1]); w.y = cvt_pk_bf16(out[2], out[3]);
                    *(u32x2*)(Y + (size_t)rowof(b, pos) * D + 2048 + h * 64 + j4) = w; }
            }
        }
        __syncthreads();
    }
}

__device__ __forceinline__ void phase_s5(const float* const (&in)[34], unsigned char* ws, LAS unsigned char* lds, int G) {
    int tid = threadIdx.x; asm volatile("" : "+v"(tid)); const int lane = tid & 63, wid = __builtin_amdgcn_readfirstlane(tid >> 6), fr = lane & 15, fq = lane >> 4;
    if (wid >= 2) return;
    const bf16_t* U = (const bf16_t*)(ws + WS_U); bf16_t* YS = (bf16_t*)(ws + WS_YS);
    LAS unsigned char* wl = lds + wid * 32768;
    LAS bf16_t* BB = (LAS bf16_t*)wl;
    LAS float* BU0 = (LAS float*)(wl + 4096);
    LAS unsigned char* XB = wl + 4096 + 2 * 16 * 132 * 4;
    constexpr int NCK = LSEQ / 16;
    for (int chain = blockIdx.x * 2 + wid; chain < NB * 128; chain += G * 2) {
        const int b = chain >> 7, g = chain & 127, p = lane;
        const float lr = in[21][g * 64 + p], li = in[22][g * 64 + p], dt = expf(in[23][g]);
        const float mag = expf(lr * dt); float sn, cs; sincosf(li * dt, &sn, &cs);
        const float ar = mag * cs, ai = mag * sn, den = lr * lr + li * li;
        const float f_r = ((ar - 1.0f) * lr + ai * li) / den, f_i = (ai * lr - (ar - 1.0f) * li) / den;
        {   const float* br = in[24] + (size_t)(g * 64 + p) * 16; const float* bi = in[25] + (size_t)(g * 64 + p) * 16;
            unsigned wre[8], wim[8];
#pragma unroll
            for (int c = 0; c < 16; c += 2) { const float r0 = br[c], i0 = bi[c], r1 = br[c + 1], i1 = bi[c + 1];
                wre[c >> 1] = pk2(f_r * r0 - f_i * i0, f_r * r1 - f_i * i1); wim[c >> 1] = pk2(f_r * i0 + f_i * r0, f_r * i1 + f_i * r1); }
            *(LAS u32x4*)(BB + (2 * p) * 16) = (u32x4){wre[0], wre[1], wre[2], wre[3]}; *(LAS u32x4*)(BB + (2 * p) * 16 + 8) = (u32x4){wre[4], wre[5], wre[6], wre[7]};
            *(LAS u32x4*)(BB + (2 * p + 1) * 16) = (u32x4){wim[0], wim[1], wim[2], wim[3]}; *(LAS u32x4*)(BB + (2 * p + 1) * 16 + 8) = (u32x4){wim[4], wim[5], wim[6], wim[7]};
        }
        LDS_WAIT();
        bf16x8 bop[8];
#pragma unroll
        for (int nt = 0; nt < 8; ++nt) { u32x4 z = {0u, 0u, 0u, 0u}; if (fq < 2) z = *(const LAS u32x4*)(BB + (nt * 16 + fr) * 16 + fq * 8); bop[nt] = __builtin_bit_cast(bf16x8, z); }
        bf16x8 cop[4];
#pragma unroll
        for (int ks = 0; ks < 4; ++ks) { const size_t o = (size_t)(g * 16 + fr) * 64 + ks * 16 + fq * 4;
            const f32x4 cr = *(const f32x4*)(in[26] + o), ci = *(const f32x4*)(in[27] + o);
            u32x4 w; w.x = pk2(cr[0], -ci[0]); w.y = pk2(cr[1], -ci[1]); w.z = pk2(cr[2], -ci[2]); w.w = pk2(cr[3], -ci[3]); cop[ks] = __builtin_bit_cast(bf16x8, w); }
        const f32x4 dsk = *(const f32x4*)(in[28] + g * 16 + 4 * fq);
        float xr = 0.f, xi = 0.f;
        u32x4 uz1 = {0u, 0u, 0u, 0u}, uz2 = {0u, 0u, 0u, 0u}; u32x2 usk0, usk1, usk2, uskp = {0u, 0u}; f32x4 ya = {0.f, 0.f, 0.f, 0.f}, yb = {0.f, 0.f, 0.f, 0.f};
        {
            const bf16_t* ur0 = U + (size_t)rowof(b, fr) * 2048 + g * 16; u32x4 uz0 = {0u, 0u, 0u, 0u}; if (fq < 2) uz0 = *(const u32x4*)(ur0 + fq * 8); usk0 = *(const u32x2*)(ur0 + 4 * fq);
            const bf16_t* ur1 = U + (size_t)rowof(b, 16 + fr) * 2048 + g * 16; if (fq < 2) uz1 = *(const u32x4*)(ur1 + fq * 8); usk1 = *(const u32x2*)(ur1 + 4 * fq);
            const bf16x8 uop = __builtin_bit_cast(bf16x8, uz0);
#pragma unroll
            for (int nt = 0; nt < 8; ++nt) { const f32x4 acc = __builtin_amdgcn_mfma_f32_16x16x32_bf16(uop, bop[nt], (f32x4){0.f, 0.f, 0.f, 0.f}, 0, 0, 0);
#pragma unroll
                for (int i = 0; i < 4; ++i) BU0[(4 * fq + i) * 132 + nt * 16 + fr] = acc[i]; }
            LDS_WAIT();
        }
#pragma unroll 1
        for (int ck = 0; ck < NCK; ++ck) {
            LAS float* BUc = BU0 + (ck & 1) * (16 * 132); LAS float* BUn = BU0 + ((ck + 1) & 1) * (16 * 132);
            usk2 = usk1;
            if (ck + 2 < NCK) { const bf16_t* ur = U + (size_t)rowof(b, (ck + 2) * 16 + fr) * 2048 + g * 16; if (fq < 2) uz2 = *(const u32x4*)(ur + fq * 8); usk2 = *(const u32x2*)(ur + 4 * fq); }
            f32x2 bu[16];
#pragma unroll
            for (int t = 0; t < 16; ++t) bu[t] = *(const LAS f32x2*)(BUc + t * 132 + 2 * p);
            if (ck > 0) {
                const int pos = (ck - 1) * 16 + fr;
                f32x4 yv = (ya + yb) + unpack4(uskp) * dsk;
                yv[0] = gelu_erf_fast(yv[0]); yv[1] = gelu_erf_fast(yv[1]); yv[2] = gelu_erf_fast(yv[2]); yv[3] = gelu_erf_fast(yv[3]);
                if (b == 0 || pos >= NMETA) { u32x2 o; o.x = cvt_pk_bf16(yv[0], yv[1]); o.y = cvt_pk_bf16(yv[2], yv[3]); *(u32x2*)(YS + (size_t)rowof(b, pos) * 2048 + g * 16 + 4 * fq) = o; }
            }
            f32x4 accn[8];
            const bf16x8 uop = __builtin_bit_cast(bf16x8, uz1);
            __builtin_amdgcn_sched_barrier(0);
#pragma unroll
            for (int t = 0; t < 16; ++t) { const float nr = vfma(ar, xr, vfnma(ai, xi, bu[t][0])), ni = vfma(ar, xi, vfma(ai, xr, bu[t][1])); xr = nr; xi = ni;
                *(LAS unsigned*)(XB + t * 272 + p * 4) = cvt_pk_bf16(nr, ni);
                if (t & 1) accn[t >> 1] = __builtin_amdgcn_mfma_f32_16x16x32_bf16(uop, bop[t >> 1], (f32x4){0.f, 0.f, 0.f, 0.f}, 0, 0, 0);
                __builtin_amdgcn_sched_barrier(0); }
            if (ck + 1 < NCK) {
#pragma unroll
                for (int nt = 0; nt < 8; ++nt) {
#pragma unroll
                    for (int i = 0; i < 4; ++i) BUn[(4 * fq + i) * 132 + nt * 16 + fr] = accn[nt][i]; } }
            LDS_WAIT();
            { const bf16x8 x0 = *(const LAS bf16x8*)(XB + fr * 272 + 0 * 64 + fq * 16), x1 = *(const LAS bf16x8*)(XB + fr * 272 + 1 * 64 + fq * 16);
              const bf16x8 x2 = *(const LAS bf16x8*)(XB + fr * 272 + 2 * 64 + fq * 16), x3 = *(const LAS bf16x8*)(XB + fr * 272 + 3 * 64 + fq * 16);
              ya = __builtin_amdgcn_mfma_f32_16x16x32_bf16(cop[0], x0, (f32x4){0.f, 0.f, 0.f, 0.f}, 0, 0, 0); yb = __builtin_amdgcn_mfma_f32_16x16x32_bf16(cop[1], x1, (f32x4){0.f, 0.f, 0.f, 0.f}, 0, 0, 0);
              ya = __builtin_amdgcn_mfma_f32_16x16x32_bf16(cop[2], x2, ya, 0, 0, 0); yb = __builtin_amdgcn_mfma_f32_16x16x32_bf16(cop[3], x3, yb, 0, 0, 0); }
            LDS_WAIT();
            uskp = usk0; usk0 = usk1; usk1 = usk2; uz1 = uz2;
        }
        {
            const int pos = (NCK - 1) * 16 + fr;
            f32x4 yv = (ya + yb) + unpack4(uskp) * dsk;
            yv[0] = gelu_erf_fast(yv[0]); yv[1] = gelu_erf_fast(yv[1]); yv[2] = gelu_erf_fast(yv[2]); yv[3] = gelu_erf_fast(yv[3]);
            if (b == 0 || pos >= NMETA) { u32x2 o; o.x = cvt_pk_bf16(yv[0], yv[1]); o.y = cvt_pk_bf16(yv[2], yv[3]); *(u32x2*)(YS + (size_t)rowof(b, pos) * 2048 + g * 16 + 4 * fq) = o; }
        }
    }
}

#define S5_SPIN(ptr, need) do { while ((int)(*(volatile LAS unsigned*)(ptr)) < (int)(need)) __builtin_amdgcn_s_sleep(1); } while (0)
__device__ __forceinline__ void phase_s5p(const float* const (&in)[34], unsigned char* ws, LAS unsigned char* lds, int G) {
    int tid = threadIdx.x; asm volatile("" : "+v"(tid)); const int lane = tid & 63, wid = __builtin_amdgcn_readfirstlane(tid >> 6), fr = lane & 15, fq = lane >> 4;
    if (tid < 4) *(volatile LAS unsigned*)(lds + (tid >> 1) * 32768 + 29696 + (tid & 1) * 4) = 0u;
    __syncthreads();
    if (wid >= 4) return;
    const int slot = wid & 1; const bool producer = wid < 2;
    const bf16_t* U = (const bf16_t*)(ws + WS_U); bf16_t* YS = (bf16_t*)(ws + WS_YS);
    LAS unsigned char* wl = lds + slot * 32768;
    LAS bf16_t* BB = (LAS bf16_t*)wl;
    LAS float* BU0 = (LAS float*)(wl + 4096);
    LAS unsigned char* XB0 = wl + 4096 + 2 * 16 * 132 * 4;
    LAS unsigned char* fprod = wl + 29696; LAS unsigned char* fcons = wl + 29700;
    constexpr int NCK = LSEQ / 16;
    int base = 0;
    for (int chain = blockIdx.x * 2 + slot; chain < NB * 128; chain += G * 2, base += NCK) {
        const int b = chain >> 7, g = chain & 127, p = lane;
        if (producer) {
            const float lr = in[21][g * 64 + p], li = in[22][g * 64 + p], dt = expf(in[23][g]);
            const float mag = expf(lr * dt); float sn, cs; sincosf(li * dt, &sn, &cs);
            const float ar = mag * cs, ai = mag * sn, den = lr * lr + li * li;
            const float f_r = ((ar - 1.0f) * lr + ai * li) / den, f_i = (ai * lr - (ar - 1.0f) * li) / den;
            {   const float* br = in[24] + (size_t)(g * 64 + p) * 16; const float* bi = in[25] + (size_t)(g * 64 + p) * 16;
                unsigned wre[8], wim[8];
#pragma unroll
                for (int c = 0; c < 16; c += 2) { const float r0 = br[c], i0 = bi[c], r1 = br[c + 1], i1 = bi[c + 1];
                    wre[c >> 1] = pk2(f_r * r0 - f_i * i0, f_r * r1 - f_i * i1); wim[c >> 1] = pk2(f_r * i0 + f_i * r0, f_r * i1 + f_i * r1); }
                *(LAS u32x4*)(BB + (2 * p) * 16) = (u32x4){wre[0], wre[1], wre[2], wre[3]}; *(LAS u32x4*)(BB + (2 * p) * 16 + 8) = (u32x4){wre[4], wre[5], wre[6], wre[7]};
                *(LAS u32x4*)(BB + (2 * p + 1) * 16) = (u32x4){wim[0], wim[1], wim[2], wim[3]}; *(LAS u32x4*)(BB + (2 * p + 1) * 16 + 8) = (u32x4){wim[4], wim[5], wim[6], wim[7]};
            }
            LDS_WAIT();
            bf16x8 bop[8];
#pragma unroll
            for (int nt = 0; nt < 8; ++nt) { u32x4 z = {0u, 0u, 0u, 0u}; if (fq < 2) z = *(const LAS u32x4*)(BB + (nt * 16 + fr) * 16 + fq * 8); bop[nt] = __builtin_bit_cast(bf16x8, z); }
            float xr = 0.f, xi = 0.f;
            u32x4 uz1 = {0u, 0u, 0u, 0u}, uz2 = {0u, 0u, 0u, 0u};
            {   const bf16_t* ur0 = U + (size_t)rowof(b, fr) * 2048 + g * 16; u32x4 uz0 = {0u, 0u, 0u, 0u}; if (fq < 2) uz0 = *(const u32x4*)(ur0 + fq * 8);
                const bf16_t* ur1 = U + (size_t)rowof(b, 16 + fr) * 2048 + g * 16; if (fq < 2) uz1 = *(const u32x4*)(ur1 + fq * 8);
                const bf16x8 uop = __builtin_bit_cast(bf16x8, uz0);
#pragma unroll
                for (int nt = 0; nt < 8; ++nt) { const f32x4 acc = __builtin_amdgcn_mfma_f32_16x16x32_bf16(uop, bop[nt], (f32x4){0.f, 0.f, 0.f, 0.f}, 0, 0, 0);
#pragma unroll
                    for (int i = 0; i < 4; ++i) BU0[(4 * fq + i) * 132 + nt * 16 + fr] = acc[i]; }
                LDS_WAIT();
            }
#pragma unroll 1
            for (int ck = 0; ck < NCK; ++ck) {
                LAS float* BUc = BU0 + (ck & 1) * (16 * 132); LAS float* BUn = BU0 + ((ck + 1) & 1) * (16 * 132); LAS unsigned char* XB = XB0 + (ck & 1) * 4352;
                { const int pc = ck + 2 < NCK ? ck + 2 : ck; const bf16_t* ur = U + (size_t)rowof(b, pc * 16 + fr) * 2048 + g * 16; if (fq < 2) uz2 = *(const u32x4*)(ur + fq * 8); }
                f32x2 bu[16];
#pragma unroll
                for (int t = 0; t < 16; ++t) bu[t] = *(const LAS f32x2*)(BUc + t * 132 + 2 * p);
                if (ck >= 2) S5_SPIN(fcons, base + ck - 1);
                f32x4 accn[8];
                const bf16x8 uop = __builtin_bit_cast(bf16x8, uz1);
                __builtin_amdgcn_sched_barrier(0);
#pragma unroll
                for (int t = 0; t < 16; ++t) { const float nr = vfma(ar, xr, vfnma(ai, xi, bu[t][0])), ni = vfma(ar, xi, vfma(ai, xr, bu[t][1])); xr = nr; xi = ni;
                    *(LAS unsigned*)(XB + t * 272 + p * 4) = cvt_pk_bf16(nr, ni);
                    if (t & 1) accn[t >> 1] = __builtin_amdgcn_mfma_f32_16x16x32_bf16(uop, bop[t >> 1], (f32x4){0.f, 0.f, 0.f, 0.f}, 0, 0, 0);
                    __builtin_amdgcn_sched_barrier(0); }
                if (ck + 1 < NCK) {
#pragma unroll
                    for (int nt = 0; nt < 8; ++nt) {
#pragma unroll
                        for (int i = 0; i < 4; ++i) BUn[(4 * fq + i) * 132 + nt * 16 + fr] = accn[nt][i]; } }
                LDS_WAIT();
                *(volatile LAS unsigned*)fprod = (unsigned)(base + ck + 1);
                uz1 = uz2;
            }
        } else {
            bf16x8 cop[4];
#pragma unroll
            for (int ks = 0; ks < 4; ++ks) { const size_t o = (size_t)(g * 16 + fr) * 64 + ks * 16 + fq * 4;
                const f32x4 cr = *(const f32x4*)(in[26] + o), ci = *(const f32x4*)(in[27] + o);
                u32x4 w; w.x = pk2(cr[0], -ci[0]); w.y = pk2(cr[1], -ci[1]); w.z = pk2(cr[2], -ci[2]); w.w = pk2(cr[3], -ci[3]); cop[ks] = __builtin_bit_cast(bf16x8, w); }
            const f32x4 dsk = *(const f32x4*)(in[28] + g * 16 + 4 * fq);
            u32x2 uskn = *(const u32x2*)(U + (size_t)rowof(b, fr) * 2048 + g * 16 + 4 * fq);
#pragma unroll 1
            for (int ck = 0; ck < NCK; ++ck) {
                const u32x2 usk = uskn;
                { const int pc = ck + 1 < NCK ? ck + 1 : ck; uskn = *(const u32x2*)(U + (size_t)rowof(b, pc * 16 + fr) * 2048 + g * 16 + 4 * fq); }
                S5_SPIN(fprod, base + ck + 1);
                LAS unsigned char* XB = XB0 + (ck & 1) * 4352;
                const bf16x8 x0 = *(const LAS bf16x8*)(XB + fr * 272 + 0 * 64 + fq * 16), x1 = *(const LAS bf16x8*)(XB + fr * 272 + 1 * 64 + fq * 16);
                const bf16x8 x2 = *(const LAS bf16x8*)(XB + fr * 272 + 2 * 64 + fq * 16), x3 = *(const LAS bf16x8*)(XB + fr * 272 + 3 * 64 + fq * 16);
                LDS_WAIT();
                *(volatile LAS unsigned*)fcons = (unsigned)(base + ck + 1);
                f32x4 ya = __builtin_amdgcn_mfma_f32_16x16x32_bf16(cop[0], x0, (f32x4){0.f, 0.f, 0.f, 0.f}, 0, 0, 0), yb = __builtin_amdgcn_mfma_f32_16x16x32_bf16(cop[1], x1, (f32x4){0.f, 0.f, 0.f, 0.f}, 0, 0, 0);
                ya = __builtin_amdgcn_mfma_f32_16x16x32_bf16(cop[2], x2, ya, 0, 0, 0); yb = __builtin_amdgcn_mfma_f32_16x16x32_bf16(cop[3], x3, yb, 0, 0, 0);
                const int pos = ck * 16 + fr;
                f32x4 yv = (ya + yb) + unpack4(usk) * dsk;
                yv[0] = gelu_erf_fast(yv[0]); yv[1] = gelu_erf_fast(yv[1]); yv[2] = gelu_erf_fast(yv[2]); yv[3] = gelu_erf_fast(yv[3]);
                if (b == 0 || pos >= NMETA) { u32x2 o; o.x = cvt_pk_bf16(yv[0], yv[1]); o.y = cvt_pk_bf16(yv[2], yv[3]); *(u32x2*)(YS + (size_t)rowof(b, pos) * 2048 + g * 16 + 4 * fq) = o; }
            }
        }
    }
}

__device__ __forceinline__ unsigned ordkey(float v) { const unsigned u = __builtin_bit_cast(unsigned, v); return (u & 0x80000000u) ? ~u : (u | 0x80000000u); }
__device__ __forceinline__ float unord(unsigned k) { const unsigned u = (k & 0x80000000u) ? (k & 0x7fffffffu) : ~k; return __builtin_bit_cast(float, u); }
#ifndef EXP_UR
#define EXP_UR 4
#endif
#ifndef EXP_VR
#define EXP_VR 4
#endif
constexpr int UR = EXP_UR, VR = EXP_VR;
template <bool FINAL, bool DRY = false>
__device__ __forceinline__ void phase_expert(const float* fgain, float* out, unsigned char* ws, LAS unsigned char* lds, int layer, int G) {
    int tid = threadIdx.x; asm volatile("" : "+v"(tid)); const int lane = tid & 63, wid = __builtin_amdgcn_readfirstlane(tid >> 6);
    const float* SC = (const float*)(ws + WS_SC); float* H = (float*)(ws + WS_H); bf16_t* HB = (bf16_t*)(ws + WS_HB);
    const unsigned char* PU = ws + WS_PU + (size_t)layer * NEXP * D; const unsigned char* PV = ws + WS_PV + (size_t)layer * NEXP * D;
    const float* SU = (const float*)(ws + WS_SU) + layer * NEXP; const float* SV = (const float*)(ws + WS_SV) + layer * NEXP;
    LAS float* part = (LAS float*)lds;
    LAS float* red = (LAS float*)(lds + RED_OFF);
    for (int tok = blockIdx.x; tok < MROWS; tok += G) {
        const float* sc = SC + (size_t)tok * 2048 + wid * 256;
        float s12[2]; int i12[2];
#pragma unroll
        for (int hf = 0; hf < 2; ++hf) {
            const float v0 = sc[hf * 128 + lane], v1 = sc[hf * 128 + 64 + lane];
            unsigned k0 = (ordkey(v0) & ~127u) | (unsigned)(127 - lane), k1 = (ordkey(v1) & ~127u) | (unsigned)(63 - lane);
            float sv = 0.f; int si = 0;
#pragma unroll 1
            for (int k = 0; k < 16; ++k) { const unsigned w = max64u(umax_u(k0, k1)); if (lane == k) { sv = unord(w & ~127u); si = 127 - (int)(w & 127u); } if (k0 == w) k0 = 0u; if (k1 == w) k1 = 0u; }
            s12[hf] = sv; i12[hf] = si;
        }
        const float c1 = __shfl(s12[0], lane >> 2);
        unsigned ck[4];
#pragma unroll
        for (int jj = 0; jj < 4; ++jj) { const int j = (lane & 3) * 4 + jj; const float c2 = __shfl(s12[1], j); ck[jj] = (ordkey(c1 + c2) & ~255u) | (unsigned)(255 - ((lane >> 2) * 16 + j)); }
        float ts = 0.f; int tp = 0;
#pragma unroll 1
        for (int k = 0; k < 16; ++k) { const unsigned w = max64u(umax_u(umax_u(ck[0], ck[1]), umax_u(ck[2], ck[3]))); if (lane == k) { ts = unord(w & ~255u); tp = 255 - (int)(w & 255u); }
#pragma unroll
            for (int jj = 0; jj < 4; ++jj) if (ck[jj] == w) ck[jj] = 0u; }
        const int e1 = __shfl(i12[0], tp >> 4), e2 = __shfl(i12[1], tp & 15);
        const int eid = e1 * 128 + e2;
        float mx = ts; mx = fmaxf(mx, dppf<DPP_XOR1>(mx)); mx = fmaxf(mx, dppf<DPP_XOR2>(mx)); mx = fmaxf(mx, dppf<DPP_HMIRROR>(mx)); mx = fmaxf(mx, dppf<DPP_MIRROR>(mx));
        const float ex = __expf(ts - mx), gate = ex / sum16(ex);
        float su = 0.f, sv = 0.f; if (lane < 16) { su = SU[eid]; sv = SV[eid]; }
        float hbf[4][16];
#pragma unroll
        for (int j = 0; j < 4; ++j) { const u32x4* hp8 = (const u32x4*)(HB + (size_t)tok * D + j * 1024 + 16 * lane); const u32x4 h0 = hp8[0], h1 = hp8[1];
            hbf[j][0] = bflo(h0.x); hbf[j][1] = bfhi(h0.x); hbf[j][2] = bflo(h0.y); hbf[j][3] = bfhi(h0.y); hbf[j][4] = bflo(h0.z); hbf[j][5] = bfhi(h0.z); hbf[j][6] = bflo(h0.w); hbf[j][7] = bfhi(h0.w);
            hbf[j][8] = bflo(h1.x); hbf[j][9] = bfhi(h1.x); hbf[j][10] = bflo(h1.y); hbf[j][11] = bfhi(h1.y); hbf[j][12] = bflo(h1.z); hbf[j][13] = bfhi(h1.z); hbf[j][14] = bflo(h1.w); hbf[j][15] = bfhi(h1.w); }
        float wgt = 0.f;
        {   u32x4 rb[UR][4];
#pragma unroll
            for (int kk = 0; kk < UR; ++kk) { const int e = __builtin_amdgcn_readlane(eid, kk); const u32x4* up = (const u32x4*)(PU + (size_t)e * D) + lane;
#pragma unroll
                for (int j = 0; j < 4; ++j) rb[kk][j] = up[64 * j]; }
#pragma unroll 1
            for (int k4 = 0; k4 < 16; k4 += UR) {
#pragma unroll
                for (int kk = 0; kk < UR; ++kk) { float d0 = 0.f, d1 = 0.f;
#pragma unroll
                    for (int j = 0; j < 4; ++j) { const unsigned wv[4] = {rb[kk][j].x, rb[kk][j].y, rb[kk][j].z, rb[kk][j].w};
#pragma unroll
                        for (int q = 0; q < 4; ++q) { const f32x2 lo = __builtin_amdgcn_cvt_pk_f32_fp8((int)wv[q], false), hi = __builtin_amdgcn_cvt_pk_f32_fp8((int)wv[q], true);
                            d0 = fmaf(lo.x, hbf[j][4 * q + 0], d0); d1 = fmaf(lo.y, hbf[j][4 * q + 1], d1); d0 = fmaf(hi.x, hbf[j][4 * q + 2], d0); d1 = fmaf(hi.y, hbf[j][4 * q + 3], d1); } }
                    __builtin_amdgcn_sched_barrier(0);
                    if (k4 + UR < 16) { const int e = __builtin_amdgcn_readlane(eid, k4 + UR + kk); const u32x4* up = (const u32x4*)(PU + (size_t)e * D) + lane;
#pragma unroll
                        for (int j = 0; j < 4; ++j) rb[kk][j] = up[64 * j]; }
                    const float dt = sum64(d0 + d1);
                    if (lane == k4 + kk) wgt = gate * gelu_erf(dt * su) * sv;
                    __builtin_amdgcn_sched_barrier(0); }
            }
        }
        float acc[4][16];
#pragma unroll
        for (int j = 0; j < 4; ++j)
#pragma unroll
            for (int e = 0; e < 16; ++e) acc[j][e] = 0.f;
        {   u32x4 rb[VR][4];
#pragma unroll
            for (int kk = 0; kk < VR; ++kk) { const int e = __builtin_amdgcn_readlane(eid, kk); const u32x4* vp = (const u32x4*)(PV + (size_t)e * D) + lane;
#pragma unroll
                for (int j = 0; j < 4; ++j) rb[kk][j] = vp[64 * j]; }
#pragma unroll 1
            for (int k4 = 0; k4 < 16; k4 += VR) {
#pragma unroll
                for (int kk = 0; kk < VR; ++kk) { const float w = __builtin_bit_cast(float, __builtin_amdgcn_readlane(__builtin_bit_cast(int, wgt), k4 + kk));
#pragma unroll
                    for (int j = 0; j < 4; ++j) { const unsigned wv[4] = {rb[kk][j].x, rb[kk][j].y, rb[kk][j].z, rb[kk][j].w};
#pragma unroll
                        for (int q = 0; q < 4; ++q) { const f32x2 lo = __builtin_amdgcn_cvt_pk_f32_fp8((int)wv[q], false), hi = __builtin_amdgcn_cvt_pk_f32_fp8((int)wv[q], true);
                            acc[j][4 * q + 0] = fmaf(w, lo.x, acc[j][4 * q + 0]); acc[j][4 * q + 1] = fmaf(w, lo.y, acc[j][4 * q + 1]); acc[j][4 * q + 2] = fmaf(w, hi.x, acc[j][4 * q + 2]); acc[j][4 * q + 3] = fmaf(w, hi.y, acc[j][4 * q + 3]); } }
                    __builtin_amdgcn_sched_barrier(0);
                    if (k4 + VR < 16) { const int e = __builtin_amdgcn_readlane(eid, k4 + VR + kk); const u32x4* vp = (const u32x4*)(PV + (size_t)e * D) + lane;
#pragma unroll
                        for (int j = 0; j < 4; ++j) rb[kk][j] = vp[64 * j]; }
                    __builtin_amdgcn_sched_barrier(0); }
            }
        }
#pragma unroll
        for (int j = 0; j < 4; ++j)
#pragma unroll
            for (int q = 0; q < 4; ++q) *(LAS f32x4*)(part + ((wid * 16 + j * 4 + q) * 64 + lane) * 4) = (f32x4){acc[j][4 * q + 0], acc[j][4 * q + 1], acc[j][4 * q + 2], acc[j][4 * q + 3]};
        __syncthreads();
        {   f32x4 a = (f32x4){0.f, 0.f, 0.f, 0.f}, c = a;
            const int pj = tid >> 7, pl = (tid >> 1) & 63, pq = (tid & 1) * 2;
#pragma unroll
            for (int w = 0; w < 8; ++w) { a = a + *(const LAS f32x4*)(part + ((w * 16 + pj * 4 + pq) * 64 + pl) * 4); c = c + *(const LAS f32x4*)(part + ((w * 16 + pj * 4 + pq + 1) * 64 + pl) * 4); }
            f32x4* hp = (f32x4*)(H + (size_t)tok * D + 8 * tid);
#if (DBG_SKIP & 1)
            a = hp[0]; c = hp[1];
#elif (DBG_SKIP & 8)
            a = a * 0.5f + hp[0]; c = c * 0.5f + hp[1];
#else
            a = a + hp[0]; c = c + hp[1];
#endif
            if (!FINAL && !DRY) { hp[0] = a; hp[1] = c; }
            float ss = (a[0] * a[0] + a[1] * a[1]) + (a[2] * a[2] + a[3] * a[3]) + (c[0] * c[0] + c[1] * c[1]) + (c[2] * c[2] + c[3] * c[3]);
            ss = sum64(ss);
            if (lane == 0) red[wid] = ss;
            __syncthreads();
            float tot = 0.f;
#pragma unroll
            for (int w = 0; w < 8; ++w) tot += red[w];
            const float inv = rsqrtf(tot * (1.0f / D) + NORM_EPS);
            if (DRY) { if (inv == 123.456f) red[9] = inv; }
            else if (!FINAL) { u32x4 o; o.x = cvt_pk_bf16(a[0] * inv, a[1] * inv); o.y = cvt_pk_bf16(a[2] * inv, a[3] * inv); o.z = cvt_pk_bf16(c[0] * inv, c[1] * inv); o.w = cvt_pk_bf16(c[2] * inv, c[3] * inv);
                *(u32x4*)(HB + (size_t)tok * D + 8 * tid) = o; }
            else if (tok < MX) { const f32x4 g0 = *(const f32x4*)(fgain + 8 * tid), g1 = *(const f32x4*)(fgain + 8 * tid + 4);
                f32x4* op = (f32x4*)(out + (size_t)tok * D + 8 * tid); op[0] = a * inv * g0; op[1] = c * inv * g1; }
        }
        __syncthreads();
    }
}
#define PEER_DPP8(ctrl) "v_add_f32_dpp %0, %0, %0 " ctrl "\n\tv_add_f32_dpp %1, %1, %1 " ctrl "\n\tv_add_f32_dpp %2, %2, %2 " ctrl "\n\tv_add_f32_dpp %3, %3, %3 " ctrl "\n\t" \
                        "v_add_f32_dpp %4, %4, %4 " ctrl "\n\tv_add_f32_dpp %5, %5, %5 " ctrl "\n\tv_add_f32_dpp %6, %6, %6 " ctrl "\n\tv_add_f32_dpp %7, %7, %7 " ctrl "\n\t"

template <int CTRL> __device__ __forceinline__ unsigned rowmax_step(unsigned x) { const unsigned y = dppu<CTRL>(x); return x > y ? x : y; }
__device__ __forceinline__ unsigned rowmax16(unsigned x) { x = rowmax_step<DPP_XOR1>(x); x = rowmax_step<DPP_XOR2>(x); x = rowmax_step<DPP_HMIRROR>(x); x = rowmax_step<DPP_MIRROR>(x); return x; }
__device__ __forceinline__ void phase_topk(unsigned char* ws, int G) {
    int tid = threadIdx.x; asm volatile("" : "+v"(tid)); const int lane = tid & 63, wid = __builtin_amdgcn_readfirstlane(tid >> 6);
    const float* SC = (const float*)(ws + WS_SC); int* EIDL = (int*)(ws + WS_EIDL); float* GATEL = (float*)(ws + WS_GATEL);
    const int l16 = lane & 15, row = lane >> 4;
    float ca[8], cb[8];
    { const int it0 = blockIdx.x * NWAVES + wid;
      if (it0 < MROWS * 2) { const float* sc = SC + (size_t)(it0 >> 1) * 2048 + ((it0 & 1) * 4 + row) * 256 + l16;
#pragma unroll
          for (int j = 0; j < 8; ++j) { ca[j] = sc[16 * j]; cb[j] = sc[128 + 16 * j]; } } }
    for (int it = blockIdx.x * NWAVES + wid; it < MROWS * 2; it += G * NWAVES) {
        const int tok = it >> 1, h = (it & 1) * 4 + row;
        unsigned ka[8], kb[8];
#pragma unroll
        for (int j = 0; j < 8; ++j) { ka[j] = (ordkey(ca[j]) & ~127u) | (unsigned)(127 - (16 * j + l16)); kb[j] = (ordkey(cb[j]) & ~127u) | (unsigned)(127 - (16 * j + l16)); }
        { const int nit = it + G * NWAVES;
          if (nit < MROWS * 2) { const float* sc = SC + (size_t)(nit >> 1) * 2048 + ((nit & 1) * 4 + row) * 256 + l16;
#pragma unroll
              for (int j = 0; j < 8; ++j) { ca[j] = sc[16 * j]; cb[j] = sc[128 + 16 * j]; } } }
        __builtin_amdgcn_sched_barrier(0);
        float s1 = 0.f, s2 = 0.f; int i1 = 0, i2 = 0;
#pragma unroll 1
        for (int k = 0; k < 16; ++k) {
            unsigned ma = umax_u(umax_u(umax_u(ka[0], ka[1]), umax_u(ka[2], ka[3])), umax_u(umax_u(ka[4], ka[5]), umax_u(ka[6], ka[7])));
            unsigned mb = umax_u(umax_u(umax_u(kb[0], kb[1]), umax_u(kb[2], kb[3])), umax_u(umax_u(kb[4], kb[5]), umax_u(kb[6], kb[7])));
            ma = rowmax16(ma); mb = rowmax16(mb);
            if (l16 == k) { s1 = unord(ma & ~127u); i1 = 127 - (int)(ma & 127u); s2 = unord(mb & ~127u); i2 = 127 - (int)(mb & 127u); }
#pragma unroll
            for (int j = 0; j < 8; ++j) { ka[j] = ka[j] == ma ? 0u : ka[j]; kb[j] = kb[j] == mb ? 0u : kb[j]; }
        }
        unsigned ck[16];
        { const int s2i = __float_as_int(s2);
#define TK_CAND(n) { const int j = (l16 - (n)) & 15; const float c2 = (n) == 0 ? s2 : __shfl(s2, (lane & 48) + j); \
            ck[n] = (ordkey(s1 + c2) & ~255u) | (unsigned)(255 - (l16 * 16 + j)); }
          TK_CAND(0) TK_CAND(1) TK_CAND(2) TK_CAND(3) TK_CAND(4) TK_CAND(5) TK_CAND(6) TK_CAND(7) TK_CAND(8) TK_CAND(9) TK_CAND(10) TK_CAND(11) TK_CAND(12) TK_CAND(13) TK_CAND(14) TK_CAND(15)
#undef TK_CAND
        }
        float ts = 0.f; int tp = 0;
#pragma unroll 1
        for (int k = 0; k < 16; ++k) {
            unsigned m = umax_u(umax_u(umax_u(umax_u(ck[0], ck[1]), umax_u(ck[2], ck[3])), umax_u(umax_u(ck[4], ck[5]), umax_u(ck[6], ck[7]))),
                                umax_u(umax_u(umax_u(ck[8], ck[9]), umax_u(ck[10], ck[11])), umax_u(umax_u(ck[12], ck[13]), umax_u(ck[14], ck[15]))));
            m = rowmax16(m);
            if (l16 == k) { ts = unord(m & ~255u); tp = 255 - (int)(m & 255u); }
#pragma unroll
            for (int j = 0; j < 16; ++j) ck[j] = ck[j] == m ? 0u : ck[j];
        }
        const int e1 = __shfl(i1, (lane & 48) + (tp >> 4)), e2 = __shfl(i2, (lane & 48) + (tp & 15));
        float mx = ts; mx = fmaxf(mx, dppf<DPP_XOR1>(mx)); mx = fmaxf(mx, dppf<DPP_XOR2>(mx)); mx = fmaxf(mx, dppf<DPP_HMIRROR>(mx)); mx = fmaxf(mx, dppf<DPP_MIRROR>(mx));
        const float ex = __expf(ts - mx), gate = ex / sum16(ex);
        EIDL[(size_t)tok * 128 + h * 16 + l16] = (e1 * 128 + e2) * D;   GATEL[(size_t)tok * 128 + h * 16 + l16] = gate;
    }
}

__device__ __forceinline__ float dot16_fp8(const u32x4 r, const float (&h)[16]) {
    const unsigned wv[4] = {r.x, r.y, r.z, r.w}; float d0 = 0.f, d1 = 0.f;
#pragma unroll
    for (int q = 0; q < 4; ++q) { const f32x2 lo = __builtin_amdgcn_cvt_pk_f32_fp8((int)wv[q], false), hi = __builtin_amdgcn_cvt_pk_f32_fp8((int)wv[q], true);
        d0 = fmaf(lo.x, h[4 * q + 0], d0); d1 = fmaf(lo.y, h[4 * q + 1], d1); d0 = fmaf(hi.x, h[4 * q + 2], d0); d1 = fmaf(hi.y, h[4 * q + 3], d1); }
    return d0 + d1;
}
typedef __bf16 pbf2 __attribute__((ext_vector_type(2)));
__device__ __forceinline__ float dot16_fp8_bf16(const u32x4 r, const unsigned (&h)[8]) {
    const unsigned wv[4] = {r.x, r.y, r.z, r.w}; float d0 = 0.f, d1 = 0.f;
#pragma unroll
    for (int q = 0; q < 4; ++q) { const pbf2 lo = __builtin_amdgcn_cvt_scalef32_pk_bf16_fp8(wv[q], 1.0f, false), hi = __builtin_amdgcn_cvt_scalef32_pk_bf16_fp8(wv[q], 1.0f, true);
        d0 = __builtin_amdgcn_fdot2_f32_bf16(lo, __builtin_bit_cast(pbf2, h[2 * q]), d0, false); d1 = __builtin_amdgcn_fdot2_f32_bf16(hi, __builtin_bit_cast(pbf2, h[2 * q + 1]), d1, false); }
    return d0 + d1;
}
__device__ __forceinline__ int pair_get(int va, int vb, int p, int half4) { int addr = ((p & 63) << 2) + half4; asm volatile("" : "+v"(addr));
    return __builtin_amdgcn_ds_bpermute(addr, p < 64 ? va : vb); }
typedef _Float16 h16x2u __attribute__((ext_vector_type(2)));
__device__ __forceinline__ float dot16_bf8_f16(const u32x4 r, const h16x2u (&h)[8]) {
    const unsigned wv[4] = {r.x, r.y, r.z, r.w}; float d0 = 0.f, d1 = 0.f;
#pragma unroll
    for (int q = 0; q < 4; ++q) { const h16x2u lo = __builtin_bit_cast(h16x2u, __builtin_amdgcn_perm(0u, wv[q], 0x010c000cu)), hi = __builtin_bit_cast(h16x2u, __builtin_amdgcn_perm(0u, wv[q], 0x030c020cu));
        d0 = __builtin_amdgcn_fdot2(lo, h[2 * q], d0, false); d1 = __builtin_amdgcn_fdot2(hi, h[2 * q + 1], d1, false); }
    return d0 + d1;
}
__device__ __forceinline__ void phase_udot(unsigned char* ws, int layer, int G) {
    int tid = threadIdx.x; asm volatile("" : "+v"(tid)); const int lane = tid & 63, wid = __builtin_amdgcn_readfirstlane(tid >> 6);
    const int x = blockIdx.x & 7, g = (blockIdx.x >> 3) * NWAVES + wid, NG = (G >> 3) * NWAVES, half = lane >> 5, l32 = lane & 31, half4 = half * 4;
    const int* EIDL = (const int*)(ws + WS_EIDL); const bf16_t* HB = (const bf16_t*)(ws + WS_HB); float* DOTP = (float*)(ws + WS_DOTP);
    const unsigned char* ubase = ws + WS_PU + (size_t)layer * NEXP * D + 512 * x + 16 * l32;
    const int MAIN = (MROWS / NG) * NG;
    if (g >= MAIN) return;
    int ean = EIDL[(size_t)g * 128 + lane], ebn = EIDL[(size_t)g * 128 + 64 + lane];
    u32x4 h0n, h1n; { const u32x4* hp8 = (const u32x4*)(HB + (size_t)g * D + 512 * x + 16 * l32); h0n = hp8[0]; h1n = hp8[1]; }
#pragma unroll 1
    for (int tok = g; tok < MAIN; tok += NG) {
        const int ea = ean, eb = ebn;
        const unsigned hh[8] = {h0n.x, h0n.y, h0n.z, h0n.w, h1n.x, h1n.y, h1n.z, h1n.w};
        { const int tn = tok + NG < MAIN ? tok + NG : tok;
          ean = EIDL[(size_t)tn * 128 + lane]; ebn = EIDL[(size_t)tn * 128 + 64 + lane];
          const u32x4* hp8 = (const u32x4*)(HB + (size_t)tn * D + 512 * x + 16 * l32); h0n = hp8[0]; h1n = hp8[1]; }
        float* dp = DOTP + ((size_t)tok * 8 + x) * 128;
#define UD_LOAD(rb, B) do { unsigned eo_[8]; _Pragma("unroll") for (int i = 0; i < 8; ++i) eo_[i] = (unsigned)pair_get(ea, eb, 16 * (B) + 2 * i, half4); __builtin_amdgcn_sched_barrier(0); \
        _Pragma("unroll") for (int i = 0; i < 8; ++i) rb[i] = *(const u32x4*)(ubase + eo_[i]); } while (0)
#define UD_COMP(rb, B) do { float d0 = dot16_fp8_bf16(rb[0], hh), d1 = dot16_fp8_bf16(rb[1], hh), d2 = dot16_fp8_bf16(rb[2], hh), d3 = dot16_fp8_bf16(rb[3], hh), d4 = dot16_fp8_bf16(rb[4], hh), d5 = dot16_fp8_bf16(rb[5], hh), d6 = dot16_fp8_bf16(rb[6], hh), d7 = dot16_fp8_bf16(rb[7], hh); \
        asm volatile("s_nop 1\n\t" PEER_DPP8("quad_perm:[1,0,3,2] row_mask:0xf bank_mask:0xf bound_ctrl:1") PEER_DPP8("quad_perm:[2,3,0,1] row_mask:0xf bank_mask:0xf bound_ctrl:1") \
                     PEER_DPP8("row_half_mirror row_mask:0xf bank_mask:0xf bound_ctrl:1") PEER_DPP8("row_mirror row_mask:0xf bank_mask:0xf bound_ctrl:1") PEER_DPP8("row_bcast:15 row_mask:0xa bank_mask:0xf") \
                     : "+v"(d0), "+v"(d1), "+v"(d2), "+v"(d3), "+v"(d4), "+v"(d5), "+v"(d6), "+v"(d7)); \
        const int li = lane & 15; float v = d0; v = li == 1 ? d1 : v; v = li == 2 ? d2 : v; v = li == 3 ? d3 : v; v = li == 4 ? d4 : v; v = li == 5 ? d5 : v; v = li == 6 ? d6 : v; v = li == 7 ? d7 : v; \
        if ((lane & 16) && li < 8) dp[16 * (B) + 2 * li + half] = v; } while (0)
        u32x4 ra[8], rc[8];
        UD_LOAD(ra, 0);
#pragma unroll
        for (int b = 0; b < 8; b += 2) {
            UD_LOAD(rc, b + 1);
            __builtin_amdgcn_sched_barrier(0);
            UD_COMP(ra, b);
            __builtin_amdgcn_sched_barrier(0);
            if (b + 2 < 8) UD_LOAD(ra, b + 2);
            __builtin_amdgcn_sched_barrier(0);
            UD_COMP(rc, b + 1);
            __builtin_amdgcn_sched_barrier(0);
        }
    }
    for (int u = g; u < (MROWS - MAIN) * 8; u += NG) {
        const int tok = MAIN + (u >> 3), bt = u & 7;
        const int ea = EIDL[(size_t)tok * 128 + lane], eb = EIDL[(size_t)tok * 128 + 64 + lane];
        const u32x4* hp8 = (const u32x4*)(HB + (size_t)tok * D + 512 * x + 16 * l32); const u32x4 h0 = hp8[0], h1 = hp8[1];
        const unsigned hh[8] = {h0.x, h0.y, h0.z, h0.w, h1.x, h1.y, h1.z, h1.w};
        float* dp = DOTP + ((size_t)tok * 8 + x) * 128;
        u32x4 rt[8];
        { unsigned eo_[8];
#pragma unroll
          for (int i = 0; i < 8; ++i) eo_[i] = (unsigned)__builtin_amdgcn_ds_bpermute(((((16 * bt + 2 * i) & 63) << 2) + half4), bt < 4 ? ea : eb);
#pragma unroll
          for (int i = 0; i < 8; ++i) rt[i] = *(const u32x4*)(ubase + eo_[i]); }
        { float d0 = dot16_fp8_bf16(rt[0], hh), d1 = dot16_fp8_bf16(rt[1], hh), d2 = dot16_fp8_bf16(rt[2], hh), d3 = dot16_fp8_bf16(rt[3], hh), d4 = dot16_fp8_bf16(rt[4], hh), d5 = dot16_fp8_bf16(rt[5], hh), d6 = dot16_fp8_bf16(rt[6], hh), d7 = dot16_fp8_bf16(rt[7], hh);
          asm volatile("s_nop 1\n\t" PEER_DPP8("quad_perm:[1,0,3,2] row_mask:0xf bank_mask:0xf bound_ctrl:1") PEER_DPP8("quad_perm:[2,3,0,1] row_mask:0xf bank_mask:0xf bound_ctrl:1")
                       PEER_DPP8("row_half_mirror row_mask:0xf bank_mask:0xf bound_ctrl:1") PEER_DPP8("row_mirror row_mask:0xf bank_mask:0xf bound_ctrl:1") PEER_DPP8("row_bcast:15 row_mask:0xa bank_mask:0xf")
                       : "+v"(d0), "+v"(d1), "+v"(d2), "+v"(d3), "+v"(d4), "+v"(d5), "+v"(d6), "+v"(d7));
          const int li = lane & 15; float v = d0; v = li == 1 ? d1 : v; v = li == 2 ? d2 : v; v = li == 3 ? d3 : v; v = li == 4 ? d4 : v; v = li == 5 ? d5 : v; v = li == 6 ? d6 : v; v = li == 7 ? d7 : v;
          if ((lane & 16) && li < 8) dp[16 * bt + 2 * li + half] = v; }
    }
#undef UD_LOAD
#undef UD_COMP
}

__device__ __forceinline__ void phase_vacc(unsigned char* ws, int layer, int G) {
    int tid = threadIdx.x; asm volatile("" : "+v"(tid)); const int lane = tid & 63, wid = __builtin_amdgcn_readfirstlane(tid >> 6);
    const int x = blockIdx.x & 7, g = (blockIdx.x >> 3) * NWAVES + wid, NG = (G >> 3) * NWAVES, half = lane >> 5, l32 = lane & 31, half4 = half * 4;
    const int* EIDL = (const int*)(ws + WS_EIDL); const float* GATEL = (const float*)(ws + WS_GATEL); const float* DOTP = (const float*)(ws + WS_DOTP); float* H = (float*)(ws + WS_H);
    const float* SU = (const float*)(ws + WS_SU) + layer * NEXP; const float* SV = (const float*)(ws + WS_SV) + layer * NEXP; const float* HS = (const float*)(ws + WS_HS);
    const unsigned char* vbase = ws + WS_PV + (size_t)layer * NEXP * D + 512 * x + 16 * l32;
    for (int tok = g; tok < MROWS; tok += NG) {
        const int ea = EIDL[(size_t)tok * 128 + lane], eb = EIDL[(size_t)tok * 128 + 64 + lane];
        float wa, wb;
        {   const float* dq = DOTP + (size_t)tok * 1024 + lane; float da = 0.f, db = 0.f;
#pragma unroll
            for (int s = 0; s < 8; ++s) { da += dq[s * 128]; db += dq[s * 128 + 64]; }
            wa = GATEL[(size_t)tok * 128 + lane] * gelu_erf(da * SU[ea >> 12]) * SV[ea >> 12]; wb = GATEL[(size_t)tok * 128 + 64 + lane] * gelu_erf(db * SU[eb >> 12]) * SV[eb >> 12]; }
        float acc[16];
#pragma unroll
        for (int j = 0; j < 16; ++j) acc[j] = 0.f;
#define VA_LOAD(rb, B) do { _Pragma("unroll") for (int i = 0; i < 8; ++i) { const unsigned eo = (unsigned)pair_get(ea, eb, 16 * (B) + 2 * i, half4); rb[i] = *(const u32x4*)(vbase + eo); } } while (0)
#define VA_COMP(rb, B) do { _Pragma("unroll") for (int i = 0; i < 8; ++i) { const float w = __int_as_float(pair_get(__float_as_int(wa), __float_as_int(wb), 16 * (B) + 2 * i, half4)); const unsigned wv[4] = {rb[i].x, rb[i].y, rb[i].z, rb[i].w}; \
        _Pragma("unroll") for (int q = 0; q < 4; ++q) { const f32x2 lo = __builtin_amdgcn_cvt_pk_f32_fp8((int)wv[q], false), hi = __builtin_amdgcn_cvt_pk_f32_fp8((int)wv[q], true); \
            acc[4 * q + 0] = fmaf(w, lo.x, acc[4 * q + 0]); acc[4 * q + 1] = fmaf(w, lo.y, acc[4 * q + 1]); acc[4 * q + 2] = fmaf(w, hi.x, acc[4 * q + 2]); acc[4 * q + 3] = fmaf(w, hi.y, acc[4 * q + 3]); } } } while (0)
        u32x4 ra[8], rc[8];
        VA_LOAD(ra, 0);
#pragma unroll 1
        for (int b = 0; b < 8; b += 2) {
            VA_LOAD(rc, b + 1);
            __builtin_amdgcn_sched_barrier(0);
            VA_COMP(ra, b);
            __builtin_amdgcn_sched_barrier(0);
            if (b + 2 < 8) VA_LOAD(ra, b + 2);
            __builtin_amdgcn_sched_barrier(0);
            VA_COMP(rc, b + 1);
            __builtin_amdgcn_sched_barrier(0);
        }
#undef VA_LOAD
#undef VA_COMP
        float o[8];
#pragma unroll
        for (int j = 0; j < 8; ++j) { const float mine = half ? acc[8 + j] : acc[j], give = half ? acc[j] : acc[8 + j];
            const auto sw = __builtin_amdgcn_permlane32_swap(__float_as_uint(give), __float_as_uint(give), false, false); const unsigned s0 = sw[0], s1 = sw[1];
            o[j] = mine + __uint_as_float(half ? s0 : s1); }
        f32x4* hp = (f32x4*)(H + (size_t)tok * D + 512 * x + 16 * l32 + 8 * half);
        f32x4 h0 = hp[0], h1 = hp[1];
        h0[0] += o[0]; h0[1] += o[1]; h0[2] += o[2]; h0[3] += o[3]; h1[0] += o[4]; h1[1] += o[5]; h1[2] += o[6]; h1[3] += o[7];
        hp[0] = h0; hp[1] = h1;
    }
}

__device__ __forceinline__ void phase_final(const float* gain, float* out, unsigned char* ws, int G) {
    int tid = threadIdx.x; asm volatile("" : "+v"(tid)); const int lane = tid & 63, wid = __builtin_amdgcn_readfirstlane(tid >> 6);
    const float* H = (const float*)(ws + WS_H);
    f32x4 gv[16];
#pragma unroll
    for (int j = 0; j < 16; ++j) gv[j] = ((const f32x4*)gain)[lane + 64 * j];
    const int r0 = blockIdx.x * NWAVES + wid, RS = G * NWAVES;
    if (r0 >= MX) return;
#define PF_LOAD(v, R) do { const f32x4* src_ = (const f32x4*)(H + (size_t)(R) * D) + lane; _Pragma("unroll") for (int j = 0; j < 16; ++j) v[j] = src_[64 * j]; } while (0)
#define PF_ROW(v, R) do { float s_ = 0.f; _Pragma("unroll") for (int j = 0; j < 16; ++j) s_ += (v[j][0] * v[j][0] + v[j][1] * v[j][1]) + (v[j][2] * v[j][2] + v[j][3] * v[j][3]); \
        s_ = sum64(s_); const float inv_ = rsqrtf(s_ * (1.0f / D) + NORM_EPS); f32x4* dst_ = (f32x4*)(out + (size_t)(R) * D) + lane; \
        _Pragma("unroll") for (int j = 0; j < 16; ++j) dst_[64 * j] = v[j] * inv_ * gv[j]; } while (0)
    f32x4 va[16], vb[16];
    PF_LOAD(va, r0);
#pragma unroll 1
    for (int r = r0; r < MX; r += 2 * RS) {
        const int r1 = r + RS, r2 = r + 2 * RS;
        PF_LOAD(vb, r1 < MX ? r1 : r);
        __builtin_amdgcn_sched_barrier(0);
        PF_ROW(va, r);
        __builtin_amdgcn_sched_barrier(0);
        PF_LOAD(va, r2 < MX ? r2 : r);
        __builtin_amdgcn_sched_barrier(0);
        if (r1 < MX) PF_ROW(vb, r1);
        __builtin_amdgcn_sched_barrier(0);
    }
#undef PF_LOAD
#undef PF_ROW
}

constexpr int NS32 = 32;
__device__ __forceinline__ int lane_get(int va, int vb, int p_hi, int addr_lo) {
    int addr = ((8 * p_hi) & 63) * 4 + addr_lo; asm volatile("" : "+v"(addr)); return __builtin_amdgcn_ds_bpermute(addr, p_hi < 8 ? va : vb); }

__device__ __forceinline__ void phase_udot32(unsigned char* ws, int layer, int G) {
    int tid = threadIdx.x; asm volatile("" : "+v"(tid)); const int lane = tid & 63, wid = __builtin_amdgcn_readfirstlane(tid >> 6);
    const int x = blockIdx.x & 7, g = (blockIdx.x >> 3) * NWAVES + wid, NG = (G >> 3) * NWAVES, r8 = lane >> 3, c8 = lane & 7, r84 = r8 * 4;
    const int* EIDL = (const int*)(ws + WS_EIDL); const bf16_t* HB = (const bf16_t*)(ws + WS_HB); float* DOTP = (float*)(ws + WS_DOTP);
    const unsigned char* tbl = ws + WS_PU + (size_t)layer * NEXP * D + 16 * c8;
    const int taddr = (8 * (lane & 7) + (lane >> 3)) * 4;
#pragma unroll 1
    for (int sp = 0; sp < NS32 / 8; ++sp) {
        const int slice = x + 8 * sp;
        const unsigned char* ubase = tbl + 128 * slice;
        int ea = 0, eb = 0; u32x4 h0 = {0u, 0u, 0u, 0u}, h1 = h0;
        if (g < MROWS) { ea = EIDL[(size_t)g * 128 + lane]; eb = EIDL[(size_t)g * 128 + 64 + lane]; const u32x4* hp8 = (const u32x4*)(HB + (size_t)g * D + 128 * slice + 16 * c8); h0 = hp8[0]; h1 = hp8[1]; }
#pragma unroll 1
        for (int tok = g; tok < MROWS; tok += NG) {
            unsigned eo[16];
#pragma unroll
            for (int i = 0; i < 16; ++i) eo[i] = (unsigned)lane_get(ea, eb, i, r84);
            __builtin_amdgcn_sched_barrier(0);
            u32x4 rb[16];
#pragma unroll
            for (int i = 0; i < 16; ++i) rb[i] = *(const u32x4*)(ubase + eo[i]);
            const unsigned hq[8] = {h0.x, h0.y, h0.z, h0.w, h1.x, h1.y, h1.z, h1.w};
            const int nt = tok + NG;
            if (nt < MROWS) { ea = EIDL[(size_t)nt * 128 + lane]; eb = EIDL[(size_t)nt * 128 + 64 + lane]; const u32x4* hp8 = (const u32x4*)(HB + (size_t)nt * D + 128 * slice + 16 * c8); h0 = hp8[0]; h1 = hp8[1]; }
            __builtin_amdgcn_sched_barrier(0);
            float v0 = 0.f, v1 = 0.f;
#pragma unroll
            for (int hh = 0; hh < 2; ++hh) {
                float d0 = dot16_fp8_bf16(rb[8 * hh + 0], hq), d1 = dot16_fp8_bf16(rb[8 * hh + 1], hq), d2 = dot16_fp8_bf16(rb[8 * hh + 2], hq), d3 = dot16_fp8_bf16(rb[8 * hh + 3], hq),
                      d4 = dot16_fp8_bf16(rb[8 * hh + 4], hq), d5 = dot16_fp8_bf16(rb[8 * hh + 5], hq), d6 = dot16_fp8_bf16(rb[8 * hh + 6], hq), d7 = dot16_fp8_bf16(rb[8 * hh + 7], hq);
                asm volatile("s_nop 1\n\t" PEER_DPP8("quad_perm:[1,0,3,2] row_mask:0xf bank_mask:0xf bound_ctrl:1") PEER_DPP8("quad_perm:[2,3,0,1] row_mask:0xf bank_mask:0xf bound_ctrl:1")
                             PEER_DPP8("row_half_mirror row_mask:0xf bank_mask:0xf bound_ctrl:1") : "+v"(d0), "+v"(d1), "+v"(d2), "+v"(d3), "+v"(d4), "+v"(d5), "+v"(d6), "+v"(d7));
                float v = d0; v = c8 == 1 ? d1 : v; v = c8 == 2 ? d2 : v; v = c8 == 3 ? d3 : v; v = c8 == 4 ? d4 : v; v = c8 == 5 ? d5 : v; v = c8 == 6 ? d6 : v; v = c8 == 7 ? d7 : v;
                if (hh == 0) v0 = v; else v1 = v;
            }
            float* dp = DOTP + ((size_t)tok * NS32 + slice) * 128;
            dp[lane] = __int_as_float(__builtin_amdgcn_ds_bpermute(taddr, __float_as_int(v0))); dp[64 + lane] = __int_as_float(__builtin_amdgcn_ds_bpermute(taddr, __float_as_int(v1)));
        }
    }
}

template <int NSL>
__device__ __forceinline__ void phase_pw(unsigned char* ws, int layer, int G) {
    int tid = threadIdx.x; asm volatile("" : "+v"(tid)); const int lane = tid & 63, wid = __builtin_amdgcn_readfirstlane(tid >> 6);
    const int* EIDL = (const int*)(ws + WS_EIDL); const float* GATEL = (const float*)(ws + WS_GATEL); const float* DOTP = (const float*)(ws + WS_DOTP); float* WL = (float*)(ws + WS_WL);
    const float* SU = (const float*)(ws + WS_SU) + layer * NEXP; const float* SV = (const float*)(ws + WS_SV) + layer * NEXP; const float* HS = (const float*)(ws + WS_HS);
    for (int it0 = blockIdx.x * NWAVES + wid; it0 < MROWS * 2; it0 += 2 * G * NWAVES) {
        const int it1 = it0 + G * NWAVES; const bool v1 = it1 < MROWS * 2; const int it1c = v1 ? it1 : it0;
        const size_t o0 = (size_t)(it0 >> 1) * 128 + (it0 & 1) * 64 + lane, o1 = (size_t)(it1c >> 1) * 128 + (it1c & 1) * 64 + lane;
        const float* dq0 = DOTP + (size_t)(it0 >> 1) * NSL * 128 + (it0 & 1) * 64 + lane; const float* dq1 = DOTP + (size_t)(it1c >> 1) * NSL * 128 + (it1c & 1) * 64 + lane;
        float ds0[NSL], ds1[NSL];
#pragma unroll
        for (int s = 0; s < NSL; ++s) { ds0[s] = dq0[s * 128]; ds1[s] = dq1[s * 128]; }
        const int e0 = EIDL[o0] >> 12, e1 = EIDL[o1] >> 12; const float g0 = GATEL[o0], g1 = GATEL[o1];
        const float su0 = SU[e0], sv0 = SV[e0], su1 = SU[e1], sv1 = SV[e1];
        float d0 = 0.f, d1 = 0.f;
#pragma unroll
        for (int s = 0; s < NSL; ++s) { d0 += ds0[s]; d1 += ds1[s]; }
        { const _Float16 h0 = (_Float16)(g0 * gelu_erf(d0 * su0) * sv0), h1 = (_Float16)(g1 * gelu_erf(d1 * su1) * sv1);
          const unsigned p0 = ((unsigned)e0 << 16) | (unsigned)__builtin_bit_cast(unsigned short, h0), p1 = ((unsigned)e1 << 16) | (unsigned)__builtin_bit_cast(unsigned short, h1);
          unsigned* WLT = (unsigned*)(ws + WS_HB8);
          ((unsigned*)WL)[o0] = p0; WLT[(size_t)((it0 & 1) * 64 + lane) * MROWS + (it0 >> 1)] = p0;
          if (v1) { ((unsigned*)WL)[o1] = p1; WLT[(size_t)((it1 & 1) * 64 + lane) * MROWS + (it1 >> 1)] = p1; } }
    }
}

template <bool DRY = false>
__device__ __forceinline__ void phase_vacc32(unsigned char* ws, int layer, int G) {
    int tid = threadIdx.x; asm volatile("" : "+v"(tid)); const int lane = tid & 63, wid = __builtin_amdgcn_readfirstlane(tid >> 6);
    const int x = blockIdx.x & 7, g = (blockIdx.x >> 3) * NWAVES + wid, NG = (G >> 3) * NWAVES, r8 = lane >> 3, c8 = lane & 7, r84 = r8 * 4;
    const int* EIDL = (const int*)(ws + WS_EIDL); const float* WL = (const float*)(ws + WS_WL); float* H = (float*)(ws + (DRY ? WS_WAG : WS_H));
    const unsigned char* tbl = ws + WS_PV + (size_t)layer * NEXP * D + 16 * c8;
    const int h5 = lane >> 5, h4 = (lane >> 4) & 1, h3 = (lane >> 3) & 1, xaddr = (lane ^ 8) << 2;
    {
        constexpr int NIT = (NS32 / 8) * MROWS;
        int ea = 0, eb = 0; float wa = 0.f, wb = 0.f;
        if (g < NIT) { ea = EIDL[(size_t)g * 128 + lane]; eb = EIDL[(size_t)g * 128 + 64 + lane]; wa = WL[(size_t)g * 128 + lane]; wb = WL[(size_t)g * 128 + 64 + lane]; }
#pragma unroll 1
        for (int item = g; item < NIT; item += NG) {
            const int sp = item / MROWS, tok = item - sp * MROWS, slice = x + 8 * sp;
            const unsigned char* vbase = tbl + 128 * slice;
            u32x4 rb[16]; float wv_[16];
            unsigned eo[16];
#pragma unroll
            for (int i = 0; i < 16; ++i) eo[i] = (unsigned)lane_get(ea, eb, i, r84);
            __builtin_amdgcn_sched_barrier(0);
#pragma unroll
            for (int i = 0; i < 16; ++i) rb[i] = *(const u32x4*)(vbase + eo[i]);
            __builtin_amdgcn_sched_barrier(0);
#pragma unroll
            for (int i = 0; i < 16; ++i) wv_[i] = __int_as_float(lane_get(__float_as_int(wa), __float_as_int(wb), i, r84));
            const int ni = item + NG;
            if (ni < NIT) { const int nt = ni - (ni / MROWS) * MROWS; ea = EIDL[(size_t)nt * 128 + lane]; eb = EIDL[(size_t)nt * 128 + 64 + lane]; wa = WL[(size_t)nt * 128 + lane]; wb = WL[(size_t)nt * 128 + 64 + lane]; }
            __builtin_amdgcn_sched_barrier(0);
            float acc[16];
#pragma unroll
            for (int j = 0; j < 16; ++j) acc[j] = 0.f;
#pragma unroll
            for (int i = 0; i < 16; ++i) { const float w = wv_[i]; const unsigned wv[4] = {rb[i].x, rb[i].y, rb[i].z, rb[i].w};
#pragma unroll
                for (int q = 0; q < 4; ++q) { const f32x2 lo = __builtin_amdgcn_cvt_pk_f32_fp8((int)wv[q], false), hi = __builtin_amdgcn_cvt_pk_f32_fp8((int)wv[q], true);
                    acc[4 * q + 0] = fmaf(w, lo.x, acc[4 * q + 0]); acc[4 * q + 1] = fmaf(w, lo.y, acc[4 * q + 1]); acc[4 * q + 2] = fmaf(w, hi.x, acc[4 * q + 2]); acc[4 * q + 3] = fmaf(w, hi.y, acc[4 * q + 3]); } }
            float o8[8], o4[4], o2[2];
#pragma unroll
            for (int j = 0; j < 8; ++j) { const auto sw = __builtin_amdgcn_permlane32_swap(__float_as_uint(acc[j]), __float_as_uint(acc[8 + j]), false, false); const unsigned s0 = sw[0], s1 = sw[1]; o8[j] = __uint_as_float(s0) + __uint_as_float(s1); }
#pragma unroll
            for (int j = 0; j < 4; ++j) { const auto sw = __builtin_amdgcn_permlane16_swap(__float_as_uint(o8[j]), __float_as_uint(o8[4 + j]), false, false); const unsigned s0 = sw[0], s1 = sw[1]; o4[j] = __uint_as_float(s0) + __uint_as_float(s1); }
#pragma unroll
            for (int j = 0; j < 2; ++j) { const float keep = h3 ? o4[2 + j] : o4[j], give = h3 ? o4[j] : o4[2 + j]; o2[j] = keep + __int_as_float(__builtin_amdgcn_ds_bpermute(xaddr, __float_as_int(give))); }
            f32x2* hp = (f32x2*)(H + (size_t)tok * D + 128 * slice + 16 * c8 + 2 * r8);
            f32x2 hv = *hp; hv[0] += o2[0]; hv[1] += o2[1]; *hp = hv;
        }
    }
    (void)h5; (void)h4;
}

typedef _Float16 h16x2 __attribute__((ext_vector_type(2)));
template <bool DRY = false>
__device__ __forceinline__ void phase_vacc32d(unsigned char* ws, int layer, int G) {
    int tid = threadIdx.x; asm volatile("" : "+v"(tid)); const int lane = tid & 63, wid = __builtin_amdgcn_readfirstlane(tid >> 6);
    const int x = blockIdx.x & 7, g = (blockIdx.x >> 3) * NWAVES + wid, NG = (G >> 3) * NWAVES, r8 = lane >> 3, c8 = lane & 7, r84 = r8 * 4;
    const unsigned* WLP = (const unsigned*)(ws + WS_WL);
    float* H = (float*)(ws + (DRY ? WS_WAG : WS_H));
    const unsigned char* tbl = ws + WS_PV + (size_t)layer * NEXP * D + 16 * c8;
    const int h3 = (lane >> 3) & 1, xaddr = (lane ^ 8) << 2;
    constexpr int NIT = (NS32 / 8) * MROWS;
#define VD_IDS(pw, IT) do { const int t_ = (IT) - ((IT) / MROWS) * MROWS; const unsigned* wp_ = WLP + (size_t)t_ * 128 + r8 * 16 + (lane & 3); \
        pw[0] = wp_[0]; pw[1] = wp_[4]; pw[2] = wp_[8]; pw[3] = wp_[12]; } while (0)
#define VD_ISSUE(rb, pk, hv, hp, pw, IT) do { const int sp_ = (IT) / MROWS, t_ = (IT) - sp_ * MROWS, sl_ = x + 8 * sp_; const unsigned char* vb_ = tbl + 128 * sl_; \
        _Pragma("unroll") for (int k = 0; k < 4; ++k) { pk[4 * k + 0] = dppu<0x00>(pw[k]); pk[4 * k + 1] = dppu<0x55>(pw[k]); pk[4 * k + 2] = dppu<0xAA>(pw[k]); pk[4 * k + 3] = dppu<0xFF>(pw[k]); }     \
        _Pragma("unroll") for (int i = 0; i < 16; ++i) rb[i] = *(const u32x4*)(vb_ + ((pk[i] >> 16) << 12)); \
        hp = (f32x2*)(H + (size_t)t_ * D + 128 * sl_ + 16 * c8 + 2 * r8); hv = *hp; } while (0)
#define VD_COMP(rb, wv, hv, hp, VALID) do { h16x2 ah[8]; \
        _Pragma("unroll") for (int j = 0; j < 8; ++j) ah[j] = (h16x2){(_Float16)0.f, (_Float16)0.f}; \
        _Pragma("unroll") for (int i = 0; i < 16; ++i) { const h16x2 w2 = __builtin_bit_cast(h16x2, __builtin_amdgcn_perm(wv[i], wv[i], 0x01000100u)); const unsigned q_[4] = {rb[i].x, rb[i].y, rb[i].z, rb[i].w}; \
            _Pragma("unroll") for (int q = 0; q < 4; ++q) { const h16x2 lo = __builtin_bit_cast(h16x2, __builtin_amdgcn_perm(0u, q_[q], 0x010c000cu)), hi = __builtin_bit_cast(h16x2, __builtin_amdgcn_perm(0u, q_[q], 0x030c020cu)); \
                ah[2 * q + 0] = w2 * lo + ah[2 * q + 0]; ah[2 * q + 1] = w2 * hi + ah[2 * q + 1]; } } \
        float acc[16]; \
        _Pragma("unroll") for (int j = 0; j < 8; ++j) { const h16x2 t_ = ah[j]; const _Float16 t0 = t_[0], t1 = t_[1]; acc[2 * j] = (float)t0; acc[2 * j + 1] = (float)t1; } \
        float o8[8], o4[4], o2[2]; \
        _Pragma("unroll") for (int j = 0; j < 8; ++j) { const auto sw = __builtin_amdgcn_permlane32_swap(__float_as_uint(acc[j]), __float_as_uint(acc[8 + j]), false, false); const unsigned s0 = sw[0], s1 = sw[1]; o8[j] = __uint_as_float(s0) + __uint_as_float(s1); } \
        _Pragma("unroll") for (int j = 0; j < 4; ++j) { const auto sw = __builtin_amdgcn_permlane16_swap(__float_as_uint(o8[j]), __float_as_uint(o8[4 + j]), false, false); const unsigned s0 = sw[0], s1 = sw[1]; o4[j] = __uint_as_float(s0) + __uint_as_float(s1); } \
        _Pragma("unroll") for (int j = 0; j < 2; ++j) { const float keep = h3 ? o4[2 + j] : o4[j], give = h3 ? o4[j] : o4[2 + j]; o2[j] = keep + __int_as_float(__builtin_amdgcn_ds_bpermute(xaddr, __float_as_int(give))); } \
        f32x2 hn_ = hv; hn_[0] += o2[0]; hn_[1] += o2[1]; if (VALID) *hp = hn_; } while (0)
    if (g >= NIT) return;
    u32x4 ra[16], rc[16]; unsigned pka[16], pkc[16]; f32x2 hva, hvc; f32x2* hpa; f32x2* hpc;
    unsigned pw0[4], pw1[4];
    VD_IDS(pw0, g);
    { const int i1c = g + NG < NIT ? g + NG : g; VD_IDS(pw1, i1c); }
    VD_ISSUE(ra, pka, hva, hpa, pw0, g);
#pragma unroll 1
    for (int item = g; item < NIT; item += 2 * NG) {
        const int i1 = item + NG, i2 = item + 2 * NG, i3 = item + 3 * NG;
        const bool v1 = i1 < NIT;
        const int i1c = v1 ? i1 : item, i2c = i2 < NIT ? i2 : item, i3c = i3 < NIT ? i3 : item;
        VD_IDS(pw0, i2c);
        __builtin_amdgcn_sched_barrier(0);
        VD_ISSUE(rc, pkc, hvc, hpc, pw1, i1c);
        __builtin_amdgcn_sched_barrier(0);
        VD_COMP(ra, pka, hva, hpa, true);
        __builtin_amdgcn_sched_barrier(0);
        VD_IDS(pw1, i3c);
        __builtin_amdgcn_sched_barrier(0);
        VD_ISSUE(ra, pka, hva, hpa, pw0, i2c);
        __builtin_amdgcn_sched_barrier(0);
        VD_COMP(rc, pkc, hvc, hpc, v1);
        __builtin_amdgcn_sched_barrier(0);
    }
#undef VD_IDS
#undef VD_ISSUE
#undef VD_COMP
}

template <bool DRY = false>
__device__ __forceinline__ void phase_vaccL(unsigned char* ws, LAS unsigned char* lds, int layer, int G) {
    int tid = threadIdx.x; asm volatile("" : "+v"(tid)); const int lane = tid & 63, wid = __builtin_amdgcn_readfirstlane(tid >> 6);
    const unsigned* WLT = (const unsigned*)(ws + WS_WL); float* H = (float*)(ws + (DRY ? WS_WAG : WS_H));
    const unsigned char* pvt = ws + WS_PV + (size_t)layer * NEXP * D;
    constexpr int NTB = (MROWS + 63) / 64;
#define VL_LOAD(wr, C) do { _Pragma("unroll") for (int i = 0; i < 16; ++i) wr[i] = wp[(size_t)((C) * 16 + i) * MROWS]; } while (0)
#define VL_CHUNK(wr) do { u32x2 v_[16]; \
        _Pragma("unroll") for (int i = 0; i < 16; ++i) v_[i] = *(const LAS u32x2*)(lds + ((wr[i] >> 16) << 3)); \
        h16x2 a0 = {(_Float16)0.f, (_Float16)0.f}, a1 = a0, a2 = a0, a3 = a0; \
        _Pragma("unroll") for (int i = 0; i < 16; ++i) { const h16x2 w2 = __builtin_bit_cast(h16x2, __builtin_amdgcn_perm(wr[i], wr[i], 0x01000100u)); \
            a0 = w2 * __builtin_bit_cast(h16x2, __builtin_amdgcn_perm(0u, v_[i].x, 0x010c000cu)) + a0; a1 = w2 * __builtin_bit_cast(h16x2, __builtin_amdgcn_perm(0u, v_[i].x, 0x030c020cu)) + a1; \
            a2 = w2 * __builtin_bit_cast(h16x2, __builtin_amdgcn_perm(0u, v_[i].y, 0x010c000cu)) + a2; a3 = w2 * __builtin_bit_cast(h16x2, __builtin_amdgcn_perm(0u, v_[i].y, 0x030c020cu)) + a3; } \
        { const _Float16 t0 = a0[0], t1 = a0[1], t2 = a1[0], t3 = a1[1], t4 = a2[0], t5 = a2[1], t6 = a3[0], t7 = a3[1]; \
          accf[0] += (float)t0; accf[1] += (float)t1; accf[2] += (float)t2; accf[3] += (float)t3; accf[4] += (float)t4; accf[5] += (float)t5; accf[6] += (float)t6; accf[7] += (float)t7; } } while (0)
    for (int cg = blockIdx.x; cg < D / 8; cg += G) {
        __syncthreads();
        { const u32x4* src = (const u32x4*)(pvt + (size_t)cg * (NEXP * 8)) + tid; u32x4 t_[16];
#pragma unroll
          for (int i = 0; i < 16; ++i) t_[i] = src[512 * i];
#pragma unroll
          for (int i = 0; i < 16; ++i) ((LAS u32x4*)lds)[tid + 512 * i] = t_[i]; }
        __syncthreads();
#pragma unroll 1
        for (int tb = wid; tb < NTB; tb += NWAVES) {
            const int tok = tb * 64 + lane; const bool valid = tok < MROWS; const int tokc = valid ? tok : MROWS - 1;
            const unsigned* wp = WLT + tokc;
            f32x4* hp = (f32x4*)(H + (size_t)tokc * D + cg * 8); const f32x4 h0 = hp[0], h1 = hp[1];
            float accf[8];
#pragma unroll
            for (int j = 0; j < 8; ++j) accf[j] = 0.f;
            unsigned wa[16], wb[16];
            VL_LOAD(wa, 0);
#pragma unroll 1
            for (int c = 0; c < 8; c += 2) {
                VL_LOAD(wb, c + 1);
                __builtin_amdgcn_sched_barrier(0);
                VL_CHUNK(wa);
                __builtin_amdgcn_sched_barrier(0);
                VL_LOAD(wa, (c + 2) & 7);
                __builtin_amdgcn_sched_barrier(0);
                VL_CHUNK(wb);
                __builtin_amdgcn_sched_barrier(0);
            }
            if (valid) { hp[0] = h0 + (f32x4){accf[0], accf[1], accf[2], accf[3]}; hp[1] = h1 + (f32x4){accf[4], accf[5], accf[6], accf[7]}; }
        }
    }
#undef VL_LOAD
#undef VL_CHUNK
}

template <bool RUN_L = true, bool RUN_G = true, bool DRY = false>
__device__ __forceinline__ void phase_vaccH(unsigned char* ws, LAS unsigned char* lds, int layer, int G) {
    int tid = threadIdx.x; asm volatile("" : "+v"(tid)); const int lane = tid & 63, wid = __builtin_amdgcn_readfirstlane(tid >> 6);
    float* H = (float*)(ws + (DRY ? WS_WAG : WS_H));
    const unsigned char* pvl = ws + WS_PV + (size_t)layer * NEXP * D;
    const unsigned char* pvg = pvl + (size_t)NEXP * 2048;
    constexpr int NTB = (MROWS + 63) / 64, NGRP = 2048 / 8;
    bool first = true;
    for (int cg = blockIdx.x; cg < NGRP; cg += G) {
        __syncthreads();
        { const u32x4* src = (const u32x4*)(pvl + (size_t)cg * (NEXP * 8)) + tid; u32x4 t_[16];
#pragma unroll
          for (int i = 0; i < 16; ++i) t_[i] = src[512 * i];
#pragma unroll
          for (int i = 0; i < 16; ++i) ((LAS u32x4*)lds)[tid + 512 * i] = t_[i]; }
        __syncthreads();
        if (wid < 4) { if (RUN_L) {
            const unsigned* WLT = (const unsigned*)(ws + WS_HB8);
#define VL_LOAD(wr, C) do { _Pragma("unroll") for (int i = 0; i < 16; ++i) wr[i] = wp[(size_t)((C) * 16 + i) * MROWS]; } while (0)
#define VL_CHUNK(wr) do { u32x2 v_[16]; \
        _Pragma("unroll") for (int i = 0; i < 16; ++i) v_[i] = *(const LAS u32x2*)(lds + ((wr[i] >> 16) << 3)); \
        h16x2 a0 = {(_Float16)0.f, (_Float16)0.f}, a1 = a0, a2 = a0, a3 = a0; \
        _Pragma("unroll") for (int i = 0; i < 16; ++i) { const h16x2 w2 = __builtin_bit_cast(h16x2, __builtin_amdgcn_perm(wr[i], wr[i], 0x01000100u)); \
            a0 = w2 * __builtin_bit_cast(h16x2, __builtin_amdgcn_perm(0u, v_[i].x, 0x010c000cu)) + a0; a1 = w2 * __builtin_bit_cast(h16x2, __builtin_amdgcn_perm(0u, v_[i].x, 0x030c020cu)) + a1; \
            a2 = w2 * __builtin_bit_cast(h16x2, __builtin_amdgcn_perm(0u, v_[i].y, 0x010c000cu)) + a2; a3 = w2 * __builtin_bit_cast(h16x2, __builtin_amdgcn_perm(0u, v_[i].y, 0x030c020cu)) + a3; } \
        { const _Float16 t0 = a0[0], t1 = a0[1], t2 = a1[0], t3 = a1[1], t4 = a2[0], t5 = a2[1], t6 = a3[0], t7 = a3[1]; \
          accf[0] += (float)t0; accf[1] += (float)t1; accf[2] += (float)t2; accf[3] += (float)t3; accf[4] += (float)t4; accf[5] += (float)t5; accf[6] += (float)t6; accf[7] += (float)t7; } } while (0)
#pragma unroll 1
            for (int tb = wid; tb < NTB; tb += 4) {
                const int tok = tb * 64 + lane; const bool valid = tok < MROWS; const int tokc = valid ? tok : MROWS - 1;
                const unsigned* wp = WLT + tokc;
                f32x4* hp = (f32x4*)(H + (size_t)tokc * D + cg * 8); const f32x4 h0 = hp[0], h1 = hp[1];
                float accf[8];
#pragma unroll
                for (int j = 0; j < 8; ++j) accf[j] = 0.f;
                unsigned wa[16], wb[16];
                VL_LOAD(wa, 0);
#pragma unroll 1
                for (int c = 0; c < 8; c += 2) {
                    VL_LOAD(wb, c + 1);
                    __builtin_amdgcn_sched_barrier(0);
                    VL_CHUNK(wa);
                    __builtin_amdgcn_sched_barrier(0);
                    VL_LOAD(wa, (c + 2) & 7);
                    __builtin_amdgcn_sched_barrier(0);
                    VL_CHUNK(wb);
                    __builtin_amdgcn_sched_barrier(0);
                }
                if (valid) { hp[0] = h0 + (f32x4){accf[0], accf[1], accf[2], accf[3]}; hp[1] = h1 + (f32x4){accf[4], accf[5], accf[6], accf[7]}; }
            }
#undef VL_LOAD
#undef VL_CHUNK
        } } else if (first && RUN_G) {
            const int x = blockIdx.x & 7, g = (blockIdx.x >> 3) * 4 + (wid - 4), NG = (G >> 3) * 4, r8 = lane >> 3, c8 = lane & 7;
            const unsigned* WLP = (const unsigned*)(ws + WS_WL);
            const unsigned char* tbl = pvg + 16 * c8;
            const int h3 = (lane >> 3) & 1, xaddr = (lane ^ 8) << 2;
            constexpr int NIT = 2 * MROWS;
#define VD_IDS(pw, IT) do { const int t_ = (IT) - ((IT) / MROWS) * MROWS; const unsigned* wp_ = WLP + (size_t)t_ * 128 + r8 * 16 + (lane & 3); \
        pw[0] = wp_[0]; pw[1] = wp_[4]; pw[2] = wp_[8]; pw[3] = wp_[12]; } while (0)
#define VD_ISSUE(rb, pk, hv, hp, pw, IT) do { const int sp_ = (IT) / MROWS, t_ = (IT) - sp_ * MROWS, sl_ = x + 8 * sp_; const unsigned char* vb_ = tbl + 128 * sl_; \
        _Pragma("unroll") for (int k = 0; k < 4; ++k) { pk[4 * k + 0] = dppu<0x00>(pw[k]); pk[4 * k + 1] = dppu<0x55>(pw[k]); pk[4 * k + 2] = dppu<0xAA>(pw[k]); pk[4 * k + 3] = dppu<0xFF>(pw[k]); } \
        _Pragma("unroll") for (int i = 0; i < 16; ++i) rb[i] = *(const u32x4*)(vb_ + ((pk[i] >> 16) << 11)); \
        hp = (f32x2*)(H + (size_t)t_ * D + 2048 + 128 * sl_ + 16 * c8 + 2 * r8); hv = *hp; } while (0)
#define VD_COMP(rb, wv, hv, hp, VALID) do { h16x2 ah[8]; \
        _Pragma("unroll") for (int j = 0; j < 8; ++j) ah[j] = (h16x2){(_Float16)0.f, (_Float16)0.f}; \
        _Pragma("unroll") for (int i = 0; i < 16; ++i) { const h16x2 w2 = __builtin_bit_cast(h16x2, __builtin_amdgcn_perm(wv[i], wv[i], 0x01000100u)); const unsigned q_[4] = {rb[i].x, rb[i].y, rb[i].z, rb[i].w}; \
            _Pragma("unroll") for (int q = 0; q < 4; ++q) { const h16x2 lo = __builtin_bit_cast(h16x2, __builtin_amdgcn_perm(0u, q_[q], 0x010c000cu)), hi = __builtin_bit_cast(h16x2, __builtin_amdgcn_perm(0u, q_[q], 0x030c020cu)); \
                ah[2 * q + 0] = w2 * lo + ah[2 * q + 0]; ah[2 * q + 1] = w2 * hi + ah[2 * q + 1]; } } \
        float acc[16]; \
        _Pragma("unroll") for (int j = 0; j < 8; ++j) { const h16x2 t_ = ah[j]; const _Float16 t0 = t_[0], t1 = t_[1]; acc[2 * j] = (float)t0; acc[2 * j + 1] = (float)t1; } \
        float o8[8], o4[4], o2[2]; \
        _Pragma("unroll") for (int j = 0; j < 8; ++j) { const auto sw = __builtin_amdgcn_permlane32_swap(__float_as_uint(acc[j]), __float_as_uint(acc[8 + j]), false, false); const unsigned s0 = sw[0], s1 = sw[1]; o8[j] = __uint_as_float(s0) + __uint_as_float(s1); } \
        _Pragma("unroll") for (int j = 0; j < 4; ++j) { const auto sw = __builtin_amdgcn_permlane16_swap(__float_as_uint(o8[j]), __float_as_uint(o8[4 + j]), false, false); const unsigned s0 = sw[0], s1 = sw[1]; o4[j] = __uint_as_float(s0) + __uint_as_float(s1); } \
        _Pragma("unroll") for (int j = 0; j < 2; ++j) { const float keep = h3 ? o4[2 + j] : o4[j], give = h3 ? o4[j] : o4[2 + j]; o2[j] = keep + __int_as_float(__builtin_amdgcn_ds_bpermute(xaddr, __float_as_int(give))); } \
        f32x2 hn_ = hv; hn_[0] += o2[0]; hn_[1] += o2[1]; if (VALID) *hp = hn_; } while (0)
            if (g < NIT) {
                u32x4 ra[16], rc[16]; unsigned pka[16], pkc[16]; f32x2 hva, hvc; f32x2* hpa; f32x2* hpc;
                unsigned pw0[4], pw1[4];
                VD_IDS(pw0, g);
                { const int i1c = g + NG < NIT ? g + NG : g; VD_IDS(pw1, i1c); }
                VD_ISSUE(ra, pka, hva, hpa, pw0, g);
#pragma unroll 1
                for (int item = g; item < NIT; item += 2 * NG) {
                    const int i1 = item + NG, i2 = item + 2 * NG, i3 = item + 3 * NG;
                    const bool v1 = i1 < NIT;
                    const int i1c = v1 ? i1 : item, i2c = i2 < NIT ? i2 : item, i3c = i3 < NIT ? i3 : item;
                    VD_IDS(pw0, i2c);
                    __builtin_amdgcn_sched_barrier(0);
                    VD_ISSUE(rc, pkc, hvc, hpc, pw1, i1c);
                    __builtin_amdgcn_sched_barrier(0);
                    VD_COMP(ra, pka, hva, hpa, true);
                    __builtin_amdgcn_sched_barrier(0);
                    VD_IDS(pw1, i3c);
                    __builtin_amdgcn_sched_barrier(0);
                    VD_ISSUE(ra, pka, hva, hpa, pw0, i2c);
                    __builtin_amdgcn_sched_barrier(0);
                    VD_COMP(rc, pkc, hvc, hpc, v1);
                    __builtin_amdgcn_sched_barrier(0);
                }
            }
#undef VD_IDS
#undef VD_ISSUE
#undef VD_COMP
        }
        first = false;
    }
}

__device__ __forceinline__ void phase_udot32m(unsigned char* ws, int layer, int G) {
    int tid = threadIdx.x; asm volatile("" : "+v"(tid)); const int lane = tid & 63, wid = __builtin_amdgcn_readfirstlane(tid >> 6);
    const int x = blockIdx.x & 7, g = (blockIdx.x >> 3) * NWAVES + wid, NG = (G >> 3) * NWAVES, fr = lane & 15, fq = lane >> 4;
    const int* EIDL = (const int*)(ws + WS_EIDL); float* DOTP = (float*)(ws + WS_DOTP);
    const unsigned char* tbl = ws + WS_PU + (size_t)layer * NEXP * D + 16 * fq;
    const unsigned char* hb8 = ws + WS_HB8 + 16 * fq;
    typedef long i64x2 __attribute__((ext_vector_type(2)));
#pragma unroll 1
    for (int sp = 0; sp < NS32 / 8; ++sp) {
        const int slice = x + 8 * sp;
        const unsigned char* ubase = tbl + 128 * slice;
        int eo[8]; i64x2 hb0 = {0, 0}, hb1 = {0, 0};
#pragma unroll
        for (int b = 0; b < 8; ++b) eo[b] = 0;
        if (g < MROWS) {
#pragma unroll
            for (int b = 0; b < 8; ++b) eo[b] = EIDL[(size_t)g * 128 + 16 * b + fr];
            hb0 = *(const i64x2*)(hb8 + (size_t)g * D + 128 * slice); hb1 = *(const i64x2*)(hb8 + (size_t)g * D + 128 * slice + 64); }
#pragma unroll 1
        for (int tok = g; tok < MROWS; tok += NG) {
            i64x2 r0[8], r1[8];
#pragma unroll
            for (int b = 0; b < 8; ++b) { const unsigned char* rp = ubase + (unsigned)eo[b]; r0[b] = *(const i64x2*)rp; r1[b] = *(const i64x2*)(rp + 64); }
            const i64x2 c0 = hb0, c1 = hb1;
            const int nt = tok + NG;
            if (nt < MROWS) {
#pragma unroll
                for (int b = 0; b < 8; ++b) eo[b] = EIDL[(size_t)nt * 128 + 16 * b + fr];
                hb0 = *(const i64x2*)(hb8 + (size_t)nt * D + 128 * slice); hb1 = *(const i64x2*)(hb8 + (size_t)nt * D + 128 * slice + 64); }
            __builtin_amdgcn_sched_barrier(0);
            float* dp = DOTP + ((size_t)tok * NS32 + slice) * 128 + 4 * fq;
#pragma unroll
            for (int b = 0; b < 8; ++b) { f32x4 acc = (f32x4){0.f, 0.f, 0.f, 0.f};
                acc = __builtin_amdgcn_mfma_f32_16x16x32_fp8_fp8(r0[b][0], c0[0], acc, 0, 0, 0); acc = __builtin_amdgcn_mfma_f32_16x16x32_fp8_fp8(r0[b][1], c0[1], acc, 0, 0, 0);
                acc = __builtin_amdgcn_mfma_f32_16x16x32_fp8_fp8(r1[b][0], c1[0], acc, 0, 0, 0); acc = __builtin_amdgcn_mfma_f32_16x16x32_fp8_fp8(r1[b][1], c1[1], acc, 0, 0, 0);
                if (fr == 0) *(f32x4*)(dp + 16 * b) = acc; }
        }
    }
}

__device__ __forceinline__ void phase_udot32p(unsigned char* ws, int layer, int G) {
    int tid = threadIdx.x; asm volatile("" : "+v"(tid)); const int lane = tid & 63, wid = __builtin_amdgcn_readfirstlane(tid >> 6);
    const int x = blockIdx.x & 7, g = (blockIdx.x >> 3) * NWAVES + wid, NG = (G >> 3) * NWAVES, r8 = lane >> 3, c8 = lane & 7, r84 = r8 * 4;
    const int* EIDL = (const int*)(ws + WS_EIDL); const bf16_t* HB = (const bf16_t*)(ws + WS_HB); float* DOTP = (float*)(ws + WS_DOTP);
    const unsigned char* tbl = ws + WS_PU + (size_t)layer * NEXP * D + 16 * c8;
    const int taddr = (8 * (lane & 7) + (lane >> 3)) * 4;
#define UP_IDS(T) do { ea = EIDL[(size_t)(T) * 128 + lane]; eb = EIDL[(size_t)(T) * 128 + 64 + lane]; const u32x4* hp8_ = (const u32x4*)(HB + (size_t)(T) * D + 128 * slice + 16 * c8); h0 = hp8_[0]; h1 = hp8_[1]; } while (0)
#define UP_ISSUE(rb, hq) do { unsigned eo_[16]; _Pragma("unroll") for (int i = 0; i < 16; ++i) eo_[i] = (unsigned)lane_get(ea, eb, i, r84); \
        hq[0] = h0.x; hq[1] = h0.y; hq[2] = h0.z; hq[3] = h0.w; hq[4] = h1.x; hq[5] = h1.y; hq[6] = h1.z; hq[7] = h1.w; \
        _Pragma("unroll") for (int i = 0; i < 16; ++i) rb[i] = *(const u32x4*)(ubase + eo_[i]); } while (0)
#define UP_COMP(rb, hq, T) do { float v0 = 0.f, v1 = 0.f; _Pragma("unroll") for (int hh = 0; hh < 2; ++hh) { \
            float d0 = dot16_fp8_bf16(rb[8 * hh + 0], hq), d1 = dot16_fp8_bf16(rb[8 * hh + 1], hq), d2 = dot16_fp8_bf16(rb[8 * hh + 2], hq), d3 = dot16_fp8_bf16(rb[8 * hh + 3], hq), \
                  d4 = dot16_fp8_bf16(rb[8 * hh + 4], hq), d5 = dot16_fp8_bf16(rb[8 * hh + 5], hq), d6 = dot16_fp8_bf16(rb[8 * hh + 6], hq), d7 = dot16_fp8_bf16(rb[8 * hh + 7], hq); \
            asm volatile("s_nop 1\n\t" PEER_DPP8("quad_perm:[1,0,3,2] row_mask:0xf bank_mask:0xf bound_ctrl:1") PEER_DPP8("quad_perm:[2,3,0,1] row_mask:0xf bank_mask:0xf bound_ctrl:1") \
                         PEER_DPP8("row_half_mirror row_mask:0xf bank_mask:0xf bound_ctrl:1") : "+v"(d0), "+v"(d1), "+v"(d2), "+v"(d3), "+v"(d4), "+v"(d5), "+v"(d6), "+v"(d7)); \
            float v = d0; v = c8 == 1 ? d1 : v; v = c8 == 2 ? d2 : v; v = c8 == 3 ? d3 : v; v = c8 == 4 ? d4 : v; v = c8 == 5 ? d5 : v; v = c8 == 6 ? d6 : v; v = c8 == 7 ? d7 : v; \
            if (hh == 0) v0 = v; else v1 = v; } \
        float* dp_ = DOTP + ((size_t)(T) * NS32 + slice) * 128; \
        dp_[lane] = __int_as_float(__builtin_amdgcn_ds_bpermute(taddr, __float_as_int(v0))); dp_[64 + lane] = __int_as_float(__builtin_amdgcn_ds_bpermute(taddr, __float_as_int(v1))); } while (0)
#pragma unroll 1
    for (int sp = 0; sp < NS32 / 8; ++sp) {
        const int slice = x + 8 * sp;
        const unsigned char* ubase = tbl + 128 * slice;
        if (g >= MROWS) continue;
        int ea, eb; u32x4 h0, h1; u32x4 ra[16], rc[16]; unsigned qa[8], qc[8];
        UP_IDS(g); UP_ISSUE(ra, qa);
        if (g + NG < MROWS) UP_IDS(g + NG);
#pragma unroll 1
        for (int tok = g; tok < MROWS; tok += 2 * NG) {
            const int t1 = tok + NG, t2 = tok + 2 * NG;
            if (t1 < MROWS) { UP_ISSUE(rc, qc); if (t2 < MROWS) UP_IDS(t2); }
            __builtin_amdgcn_sched_barrier(0);
            UP_COMP(ra, qa, tok);
            __builtin_amdgcn_sched_barrier(0);
            if (t1 < MROWS) {
                if (t2 < MROWS) { UP_ISSUE(ra, qa); if (t2 + NG < MROWS) UP_IDS(t2 + NG); }
                __builtin_amdgcn_sched_barrier(0);
                UP_COMP(rc, qc, t1);
                __builtin_amdgcn_sched_barrier(0);
            }
        }
    }
#undef UP_IDS
#undef UP_ISSUE
#undef UP_COMP
}

template <bool DRY = false>
__device__ __forceinline__ void phase_vacc32p(unsigned char* ws, int layer, int G) {
    int tid = threadIdx.x; asm volatile("" : "+v"(tid)); const int lane = tid & 63, wid = __builtin_amdgcn_readfirstlane(tid >> 6);
    const int x = blockIdx.x & 7, g = (blockIdx.x >> 3) * NWAVES + wid, NG = (G >> 3) * NWAVES, r8 = lane >> 3, c8 = lane & 7, r84 = r8 * 4;
    const int* EIDL = (const int*)(ws + WS_EIDL); const float* WL = (const float*)(ws + WS_WL); float* H = (float*)(ws + (DRY ? WS_WAG : WS_H));
    const unsigned char* tbl = ws + WS_PV + (size_t)layer * NEXP * D + 16 * c8;
    const int h3 = (lane >> 3) & 1, xaddr = (lane ^ 8) << 2;
#define VP_IDS(T) do { ea = EIDL[(size_t)(T) * 128 + lane]; eb = EIDL[(size_t)(T) * 128 + 64 + lane]; wa = WL[(size_t)(T) * 128 + lane]; wb = WL[(size_t)(T) * 128 + 64 + lane]; } while (0)
#define VP_ISSUE(rb, wv) do { unsigned eo_[16]; _Pragma("unroll") for (int i = 0; i < 16; ++i) { eo_[i] = (unsigned)lane_get(ea, eb, i, r84); wv[i] = __int_as_float(lane_get(__float_as_int(wa), __float_as_int(wb), i, r84)); } \
        _Pragma("unroll") for (int i = 0; i < 16; ++i) rb[i] = *(const u32x4*)(vbase + eo_[i]); } while (0)
#define VP_COMP(rb, wvv, T) do { float acc[16]; _Pragma("unroll") for (int j = 0; j < 16; ++j) acc[j] = 0.f; \
        _Pragma("unroll") for (int i = 0; i < 16; ++i) { const float w = wvv[i]; const unsigned wv_[4] = {rb[i].x, rb[i].y, rb[i].z, rb[i].w}; \
            _Pragma("unroll") for (int q = 0; q < 4; ++q) { const f32x2 lo = __builtin_amdgcn_cvt_pk_f32_fp8((int)wv_[q], false), hi = __builtin_amdgcn_cvt_pk_f32_fp8((int)wv_[q], true); \
                acc[4 * q + 0] = fmaf(w, lo.x, acc[4 * q + 0]); acc[4 * q + 1] = fmaf(w, lo.y, acc[4 * q + 1]); acc[4 * q + 2] = fmaf(w, hi.x, acc[4 * q + 2]); acc[4 * q + 3] = fmaf(w, hi.y, acc[4 * q + 3]); } } \
        float o8[8], o4[4], o2[2]; \
        _Pragma("unroll") for (int j = 0; j < 8; ++j) { const auto sw = __builtin_amdgcn_permlane32_swap(__float_as_uint(acc[j]), __float_as_uint(acc[8 + j]), false, false); const unsigned s0 = sw[0], s1 = sw[1]; o8[j] = __uint_as_float(s0) + __uint_as_float(s1); } \
        _Pragma("unroll") for (int j = 0; j < 4; ++j) { const auto sw = __builtin_amdgcn_permlane16_swap(__float_as_uint(o8[j]), __float_as_uint(o8[4 + j]), false, false); const unsigned s0 = sw[0], s1 = sw[1]; o4[j] = __uint_as_float(s0) + __uint_as_float(s1); } \
        _Pragma("unroll") for (int j = 0; j < 2; ++j) { const float keep = h3 ? o4[2 + j] : o4[j], give = h3 ? o4[j] : o4[2 + j]; o2[j] = keep + __int_as_float(__builtin_amdgcn_ds_bpermute(xaddr, __float_as_int(give))); } \
        f32x2* hp_ = (f32x2*)(H + (size_t)(T) * D + 128 * slice + 16 * c8 + 2 * r8); f32x2 hv = *hp_; hv[0] += o2[0]; hv[1] += o2[1]; *hp_ = hv; } while (0)
#pragma unroll 1
    for (int sp = 0; sp < NS32 / 8; ++sp) {
        const int slice = x + 8 * sp;
        const unsigned char* vbase = tbl + 128 * slice;
        if (g >= MROWS) continue;
        int ea, eb; float wa, wb; u32x4 ra[16], rc[16]; float wva[16], wvc[16];
        VP_IDS(g); VP_ISSUE(ra, wva);
        if (g + NG < MROWS) VP_IDS(g + NG);
#pragma unroll 1
        for (int tok = g; tok < MROWS; tok += 2 * NG) {
            const int t1 = tok + NG, t2 = tok + 2 * NG;
            if (t1 < MROWS) { VP_ISSUE(rc, wvc); if (t2 < MROWS) VP_IDS(t2); }
            __builtin_amdgcn_sched_barrier(0);
            VP_COMP(ra, wva, tok);
            __builtin_amdgcn_sched_barrier(0);
            if (t1 < MROWS) {
                if (t2 < MROWS) { VP_ISSUE(ra, wva); if (t2 + NG < MROWS) VP_IDS(t2 + NG); }
                __builtin_amdgcn_sched_barrier(0);
                VP_COMP(rc, wvc, t1);
                __builtin_amdgcn_sched_barrier(0);
            }
        }
    }
#undef VP_IDS
#undef VP_ISSUE
#undef VP_COMP
}
#define MK_PER_PHASE 0
#ifndef PROBE_DUP
#define PROBE_DUP 0
#endif
#ifndef MK_PER_PHASE
#define MK_PER_PHASE 0
#endif
constexpr int NPHASE = 21;
#ifndef S5_SHARE_V
#define S5_SHARE_V 30000
#endif
constexpr int S5_SHARE = S5_SHARE_V;
#ifndef P4_L1_LO_V
#define P4_L1_LO_V 32768
#endif
constexpr int P4_L1_LO = P4_L1_LO_V;
#ifndef KSPLIT_OUT_V
#define KSPLIT_OUT_V 2048
#endif
constexpr int KSPLIT_OUT = KSPLIT_OUT_V;
struct Args { const float* in[34]; float* out; unsigned char* ws; int ph_lo, ph_hi; };

__global__ void __launch_bounds__(NTHREADS, 2) fwd(Args args) {
    extern __shared__ __attribute__((aligned(16))) unsigned char lds_raw[];
    LAS unsigned char* lds = (LAS unsigned char*)lds_raw;
    const int tid = threadIdx.x, G = gridDim.x, cblk = blockIdx.x;
    unsigned char* ws = args.ws;
    volatile LAS unsigned* MISC = (volatile LAS unsigned*)(lds + MISC_OFF);
    if (tid < 64) MISC[tid] = 0u;
    __syncthreads();
    const int lo = args.ph_lo, hi = args.ph_hi;
    unsigned* barw = (unsigned*)(ws + WS_CTL) + CW_BAR;
    XcdBarrier bar; bar.bar = barw; bar.x = 0; bar.st = nullptr;
    if (hi - lo > 1) bar = xcd_barrier_post(barw, MISC + 8);
#ifndef PH_MASK
#define PH_MASK 0x1fffff
#endif
#define IN(k) (((PH_MASK >> (k)) & 1) && lo <= (k) && (k) < hi)
#define SEAM(k) do { if ((k) + 1 < hi) xcd_barrier(bar); } while (0)
    bf16_t* HB = (bf16_t*)(ws + WS_HB); float* H = (float*)(ws + WS_H);

    if (IN(0)) {
#if (PROBE_DUP & 1)
        phase_prologue<1>(args.in, ws, lds, G);
#endif
#if (PROBE_DUP & 131072)
        phase_prologue<2>(args.in, ws, lds, G);
#endif
        phase_prologue(args.in, ws, lds, G); SEAM(0); }
    if (IN(1)) { pg8::Gemm g{HB, (const bf16_t*)(ws + WS_W1T), D, D, D}; pg8::StaticOrder S; S.init(MX / 256, ZLD / 256, G, cblk);
        EpiBf16 E{(bf16_t*)(ws + WS_Z), ZLD, nullptr};
#if (PROBE_DUP & 2)
        pg8::gemm_phase<EpiBf16, pg8::StaticOrder, true>(lds, g, S, E);
#endif
        pg8::gemm_phase<EpiBf16, pg8::StaticOrder, true>(lds, g, S, E);
        pg8::gemm_tail(HB + (size_t)MX * D, g, ZLD / 256, S, E, lds);
        {
            const int nunits = (MX / 256) * (ZLD / 256), nfull = nunits - (nunits / G) * G;
            int tid2 = threadIdx.x; asm volatile("" : "+v"(tid2)); const int w2 = __builtin_amdgcn_readfirstlane(tid2 >> 6);
            if (nfull > 0 && nfull < G) { if (cblk >= nfull) { early_weights(args.in, ws, (LAS float*)(lds + w2 * 16384), (cblk - nfull) * NWAVES + w2, (G - nfull) * NWAVES, (size_t)(cblk - nfull) * NTHREADS + tid2, (size_t)(G - nfull) * NTHREADS, tid2 & 63);
                                                                late_weights<2>(args.in, ws, (LAS float*)(lds + w2 * 16384), (cblk - nfull) * NWAVES + w2, (G - nfull) * NWAVES, tid2 & 63); } }
            else { early_weights(args.in, ws, (LAS float*)(lds + w2 * 16384), cblk * NWAVES + w2, G * NWAVES, (size_t)cblk * NTHREADS + tid2, (size_t)G * NTHREADS, tid2 & 63);
                   late_weights<2>(args.in, ws, (LAS float*)(lds + w2 * 16384), cblk * NWAVES + w2, G * NWAVES, tid2 & 63); } }
        SEAM(1); }
    if (IN(2)) {
#if (PROBE_DUP & 4)
        phase_prep(args.in[8], ws, G);
#endif
        phase_prep(args.in[8], ws, G); SEAM(2);
#if (PROBE_DUP & 4096)
        for (int r = 0; r < 20; ++r) xcd_barrier(bar);
#endif
    }
    if (IN(3)) {
        { pg8::Gemm g{(const bf16_t*)(ws + WS_LA), (const bf16_t*)(ws + WS_BTL), 512, 256, 256}; pg8::StaticOrder S; S.init(MX / 256, 24, G, cblk, 16, 256);
          EpiF32 E{(float*)(ws + WS_WAG), WAGLD, 0, nullptr, nullptr};
          pg8::gemm_phase<EpiF32, pg8::StaticOrder, true>(lds, g, S, E);
          pg8::gemm_tail((const bf16_t*)(ws + WS_LA) + (size_t)MX * 512, g, 24, S, E, lds); }
        { pg8::Gemm g{(const bf16_t*)(ws + WS_PM), (const bf16_t*)(ws + WS_BTP), 2048, 512, 512}; pg8::StaticOrder S; S.init(MX / 256, 8, G, cblk, 2, 512);
          EpiBf16 E{(bf16_t*)(ws + WS_Y), D, args.in[7]};
          pg8::gemm_phase<EpiBf16, pg8::StaticOrder, true>(lds, g, S, E);
          pg8::gemm_tail((const bf16_t*)(ws + WS_PM) + (size_t)MX * 2048, g, 8, S, E, lds); }
        SEAM(3); }
    if (IN(4)) {
#if (PROBE_DUP & 16)
        phase_rwkv<2>(args.in, ws, lds, G);
#endif
#if (PROBE_DUP & 32)
        phase_rwkv<1>(args.in, ws, lds, G);
#endif
        if (G >= 256) {
            if (cblk < 128) phase_rwkv(args.in, ws, lds, G);
            else { const int G2 = G - 128, c2 = cblk - 128;
                { pg8::Gemm g{(const bf16_t*)(ws + WS_Y), (const bf16_t*)(ws + WS_WOT), D, D, KSPLIT_OUT}; pg8::StaticOrder S; S.init(MX / 256, D / 256, G2, c2);
                  EpiF32 E{H, D, 1, args.in[0], args.in[1]};
                  pg8::gemm_phase<EpiF32, pg8::StaticOrder, true>(lds, g, S, E);
                  pg8::gemm_tail((const bf16_t*)(ws + WS_Y) + (size_t)MX * D, g, D / 256, S, E, lds); }
                { int tid2 = threadIdx.x; asm volatile("" : "+v"(tid2)); const int w2 = __builtin_amdgcn_readfirstlane(tid2 >> 6);
                  peer_convert(args.in, ws, c2 * NWAVES + w2, G2 * NWAVES, tid2 & 63, 0, 0, NEXP);
                  peer_convert_v<8>(args.in, ws, lds + w2 * 16384, c2 * NWAVES + w2, G2 * NWAVES, tid2 & 63, 0);
                  peer_convert_v<8>(args.in, ws, lds + w2 * 16384, c2 * NWAVES + w2, G2 * NWAVES, tid2 & 63, 1);
                  late_weights<0>(args.in, ws, (LAS float*)(lds + w2 * 16384), c2 * NWAVES + w2, G2 * NWAVES, tid2 & 63);
#if (PROBE_DUP & 64)
                  late_weights<0>(args.in, ws, (LAS float*)(lds + w2 * 16384), c2 * NWAVES + w2, G2 * NWAVES, tid2 & 63);
                  late_weights<0>(args.in, ws, (LAS float*)(lds + w2 * 16384), c2 * NWAVES + w2, G2 * NWAVES, tid2 & 63);
#endif
                } }
        } else {
            phase_rwkv(args.in, ws, lds, G);
            { pg8::Gemm g{(const bf16_t*)(ws + WS_Y), (const bf16_t*)(ws + WS_WOT), D, D, KSPLIT_OUT}; pg8::StaticOrder S; S.init(MX / 256, D / 256, G, cblk);
              EpiF32 E{H, D, 1, args.in[0], args.in[1]};
              pg8::gemm_phase<EpiF32, pg8::StaticOrder, true>(lds, g, S, E);
              pg8::gemm_tail((const bf16_t*)(ws + WS_Y) + (size_t)MX * D, g, D / 256, S, E, lds); }
            { int tid2 = threadIdx.x; asm volatile("" : "+v"(tid2)); const int w2 = __builtin_amdgcn_readfirstlane(tid2 >> 6);
              peer_convert(args.in, ws, cblk * NWAVES + w2, G * NWAVES, tid2 & 63, 0, 0, NEXP);
              peer_convert_v<8>(args.in, ws, lds + w2 * 16384, cblk * NWAVES + w2, G * NWAVES, tid2 & 63, 0);
              peer_convert_v<8>(args.in, ws, lds + w2 * 16384, cblk * NWAVES + w2, G * NWAVES, tid2 & 63, 1);
              late_weights<0>(args.in, ws, (LAS float*)(lds + w2 * 16384), cblk * NWAVES + w2, G * NWAVES, tid2 & 63); }
        }
        SEAM(4); }
    if (IN(5)) { pg8::Gemm g{(const bf16_t*)(ws + WS_Y) + KSPLIT_OUT, (const bf16_t*)(ws + WS_WOT) + KSPLIT_OUT, D, D, D - KSPLIT_OUT}; pg8::StaticOrder S; S.init(MX / 256, D / 256, G, cblk);
        EpiF32 E{H, D, 1, nullptr, nullptr};
        pg8::gemm_phase<EpiF32, pg8::StaticOrder, true>(lds, g, S, E);
        pg8::gemm_tail((const bf16_t*)(ws + WS_Y) + (size_t)MX * D + KSPLIT_OUT, g, D / 256, S, E, lds); SEAM(5); }
    if (IN(6)) { phase_norm<false, true>(ws, G, args.in[3]); SEAM(6); }
    if (IN(7)) { pg8::Gemm g{HB, (const bf16_t*)(ws + WS_WST), D, D, D}; pg8::StaticOrder S; S.init(MX / 256, 8, G, cblk);
        EpiF32 E{(float*)(ws + WS_SC), 2048, 0, nullptr, nullptr};
        pg8::gemm_phase<EpiF32, pg8::StaticOrder, true>(lds, g, S, E);
        pg8::gemm_tail(HB + (size_t)MX * D, g, 8, S, E, lds); SEAM(7); }
    if (IN(8)) {
#if (PROBE_DUP & 256)
        phase_topk(ws, G);
#endif
        phase_topk(ws, G); SEAM(8); }
    if (IN(9)) {
#if (PROBE_DUP & 512)
        phase_udot(ws, 0, G);
#endif
        phase_udot(ws, 0, G); SEAM(9); }
    if (IN(10)) { phase_pw<8>(ws, 0, G); xcd_barrier(bar);
#if (PROBE_DUP & 2048)
        phase_vaccH<true, false, true>(ws, lds, 0, G);
#endif
#if (PROBE_DUP & 1048576)
        phase_vaccH<false, true, true>(ws, lds, 0, G);
#endif
        phase_vaccH(ws, lds, 0, G); SEAM(10); }
    if (IN(11)) { phase_norm<false>(ws, G); SEAM(11); }
    if (IN(12)) { pg8::Gemm g{HB, (const bf16_t*)(ws + WS_WIO), D, D, D}; pg8::StaticOrder S; S.init(MX / 256, 8, G, cblk);
        EpiBf16 E{(bf16_t*)(ws + WS_U), 2048, nullptr};
        pg8::gemm_phase<EpiBf16, pg8::StaticOrder, true>(lds, g, S, E);
        pg8::gemm_tail(HB + (size_t)MX * D, g, 8, S, E, lds); SEAM(12); }
    if (IN(13)) {
        phase_s5p(args.in, ws, lds, G);
        { int tid2 = threadIdx.x; asm volatile("" : "+v"(tid2)); const int w2 = __builtin_amdgcn_readfirstlane(tid2 >> 6);
          if (w2 >= 4) { peer_convert(args.in, ws, cblk * 4 + (w2 - 4), G * 4, tid2 & 63, 1, 0, NEXP);
                         late_weights<1>(args.in, ws, (LAS float*)(lds + 65536 + (w2 - 4) * 8704), cblk * 4 + (w2 - 4), G * 4, tid2 & 63); } }
        SEAM(13); }
    if (IN(14)) { pg8::Gemm g{(const bf16_t*)(ws + WS_YS), (const bf16_t*)(ws + WS_WGT), 2048, 2048, 2048}; pg8::StaticOrder S; S.init(MX / 256, 32, G, cblk);
        EpiGlu E{H};
        pg8::gemm_phase<EpiGlu, pg8::StaticOrder, true>(lds, g, S, E);
        pg8::gemm_tail((const bf16_t*)(ws + WS_YS) + (size_t)MX * 2048, g, 32, S, E, lds); SEAM(14); }
    if (IN(15)) { phase_norm<false, true>(ws, G, args.in[3] + D); SEAM(15); }
    if (IN(16)) { pg8::Gemm g{HB, (const bf16_t*)(ws + WS_WST) + (size_t)2048 * D, D, D, D}; pg8::StaticOrder S; S.init(MX / 256, 8, G, cblk);
        EpiF32 E{(float*)(ws + WS_SC), 2048, 0, nullptr, nullptr};
        pg8::gemm_phase<EpiF32, pg8::StaticOrder, true>(lds, g, S, E);
        pg8::gemm_tail(HB + (size_t)MX * D, g, 8, S, E, lds); SEAM(16); }
    if (IN(17)) { phase_topk(ws, G); SEAM(17); }
    if (IN(18)) { phase_udot(ws, 1, G); SEAM(18); }
    if (IN(19)) { phase_pw<8>(ws, 1, G); xcd_barrier(bar); phase_vaccH(ws, lds, 1, G); SEAM(19); }
    if (IN(20)) {
#if (PROBE_DUP & 262144)
        { int t3 = threadIdx.x; asm volatile("" : "+v"(t3)); unsigned a[8];
#pragma unroll
          for (int j = 0; j < 8; ++j) a[j] = (unsigned)(t3 + j) * 0x01010101u;
#pragma unroll 2
          for (int i = 0; i < 1024; ++i) {
#pragma unroll
              for (int j = 0; j < 8; ++j) { const f32x2 r = __builtin_amdgcn_cvt_pk_f32_fp8((int)a[j], false); a[j] ^= __float_as_uint(r.x) >> 9; } }
          ((unsigned*)(ws + WS_WAG))[(size_t)cblk * NTHREADS + t3] = a[0] ^ a[1] ^ a[2] ^ a[3] ^ a[4] ^ a[5] ^ a[6] ^ a[7]; }
#endif
#if (PROBE_DUP & 524288)
        { int t3 = threadIdx.x; asm volatile("" : "+v"(t3)); float a = (float)t3;
#pragma unroll 16
          for (int i = 0; i < 8192; ++i) { const float r = fmaf(a, 1.0001f, 0.5f); a = __uint_as_float(__float_as_uint(r) ^ (__float_as_uint(a) >> 9)); }
          ((float*)(ws + WS_WAG))[(size_t)cblk * NTHREADS + t3] = a; }
#endif
        phase_final(args.in[4], args.out, ws, G); }
#undef IN
#undef SEAM
}

extern "C" void kernel_launch(void* const* d_in, const int* in_sizes, int n_in, void* d_out, int out_size, void* d_ws, size_t ws_size, hipStream_t stream) {
    static int grid = 0;
    if (grid == 0) {
        if (n_in != 34 || out_size != MX * D || ws_size < WS_END) { fprintf(stderr, "kernel_launch: unexpected shapes (n_in %d, out %d, ws %zu < %zu); nothing launched\n", n_in, out_size, ws_size, (size_t)WS_END); grid = -1; return; }
        int dev = 0, cus = 0, per_cu = 0;
        if (hipGetDevice(&dev) != hipSuccess || hipDeviceGetAttribute(&cus, hipDeviceAttributeMultiprocessorCount, dev) != hipSuccess) { grid = -1; return; }
        if (hipFuncSetAttribute((const void*)fwd, hipFuncAttributeMaxDynamicSharedMemorySize, LDS_BYTES) != hipSuccess) { fprintf(stderr, "kernel_launch: hipFuncSetAttribute failed\n"); grid = -1; return; }
        if (hipOccupancyMaxActiveBlocksPerMultiprocessor(&per_cu, (const void*)fwd, NTHREADS, LDS_BYTES) != hipSuccess || per_cu < 1) { fprintf(stderr, "kernel_launch: occupancy query reports %d workgroups per CU\n", per_cu); }
        (void)hipGetLastError();
        grid = cus;
        if (grid % 8 != 0) { fprintf(stderr, "kernel_launch: %d CUs: the PEER slicing needs a multiple of 8 workgroups\n", grid); grid = (grid / 8) * 8; if (grid < 8) { grid = -1; return; } }
    }
    if (grid < 0) return;
    (void)hipMemsetAsync((char*)d_ws + WS_CTL, 0, CTL_ZERO_BYTES, stream);
    Args a{};
    for (int i = 0; i < 34; ++i) a.in[i] = (const float*)d_in[i];
    a.out = (float*)d_out; a.ws = (unsigned char*)d_ws;
#if MK_PER_PHASE
    for (int p = 0; p < NPHASE; ++p) { a.ph_lo = p; a.ph_hi = p + 1; hipLaunchKernelGGL(fwd, dim3(grid), dim3(NTHREADS), LDS_BYTES, stream, a); }
#else
    a.ph_lo = 0; a.ph_hi = NPHASE; hipLaunchKernelGGL(fwd, dim3(grid), dim3(NTHREADS), LDS_BYTES, stream, a);
#endif
}
```

```cpp
#include <hip/hip_runtime.h>
#include <cstdio>
#include <cstdint>

#define LAS __attribute__((address_space(3)))
typedef unsigned short bf16_t;
typedef short bf16x8 __attribute__((ext_vector_type(8)));
typedef __bf16 bf16x2 __attribute__((ext_vector_type(2)));
typedef float f32x4 __attribute__((ext_vector_type(4)));
typedef float f32x2 __attribute__((ext_vector_type(2)));
typedef unsigned u32x4 __attribute__((ext_vector_type(4)));
typedef unsigned u32x2 __attribute__((ext_vector_type(2)));

__device__ __forceinline__ unsigned f2bf(float f) { unsigned u = __builtin_bit_cast(unsigned, f); return (u + 0x7fffu + ((u >> 16) & 1u)) >> 16; }
__device__ __forceinline__ unsigned pk2(float lo, float hi) { return f2bf(lo) | (f2bf(hi) << 16); }
__device__ __forceinline__ unsigned cvt_pk_bf16(float lo, float hi) { unsigned r; asm volatile("v_cvt_pk_bf16_f32 %0, %1, %2" : "=v"(r) : "v"(lo), "v"(hi)); return r; }
__device__ __forceinline__ float bflo(unsigned w) { return __builtin_bit_cast(float, w << 16); }
__device__ __forceinline__ float bfhi(unsigned w) { return __builtin_bit_cast(float, w & 0xffff0000u); }
__device__ __forceinline__ float bf2f(bf16_t b) { return __builtin_bit_cast(float, ((unsigned)b) << 16); }
__device__ __forceinline__ float dot2(unsigned a, unsigned b, float acc) { return __builtin_amdgcn_fdot2_f32_bf16(__builtin_bit_cast(bf16x2, a), __builtin_bit_cast(bf16x2, b), acc, false); }
template <int CTRL> __device__ __forceinline__ float dppf(float x) { return __builtin_bit_cast(float, __builtin_amdgcn_mov_dpp(__builtin_bit_cast(int, x), CTRL, 0xf, 0xf, true)); }
template <int CTRL> __device__ __forceinline__ unsigned dppu(unsigned x) { return (unsigned)__builtin_amdgcn_mov_dpp((int)x, CTRL, 0xf, 0xf, true); }
constexpr int DPP_XOR1 = 0xB1, DPP_XOR2 = 0x4E, DPP_HMIRROR = 0x141, DPP_MIRROR = 0x140;
__device__ __forceinline__ float sum8(float x) { x += dppf<DPP_XOR1>(x); x += dppf<DPP_XOR2>(x); x += dppf<DPP_HMIRROR>(x); return x; }
__device__ __forceinline__ float sum16(float x) { x = sum8(x); x += dppf<DPP_MIRROR>(x); return x; }
__device__ __forceinline__ float sum64(float x) {
    x = sum16(x);
    { const auto s = __builtin_amdgcn_permlane16_swap(__float_as_uint(x), __float_as_uint(x), false, false); const unsigned a = s[0], b = s[1]; x = __uint_as_float(a) + __uint_as_float(b); }
    { const auto t = __builtin_amdgcn_permlane32_swap(__float_as_uint(x), __float_as_uint(x), false, false); const unsigned a = t[0], b = t[1]; x = __uint_as_float(a) + __uint_as_float(b); }
    return x;
}
__device__ __forceinline__ unsigned umax_u(unsigned a, unsigned b) { return a > b ? a : b; }
__device__ __forceinline__ unsigned max64u(unsigned x) {
    x = umax_u(x, dppu<DPP_XOR1>(x)); x = umax_u(x, dppu<DPP_XOR2>(x)); x = umax_u(x, dppu<DPP_HMIRROR>(x)); x = umax_u(x, dppu<DPP_MIRROR>(x));
    auto s = __builtin_amdgcn_permlane16_swap(x, x, false, false); x = umax_u(s[0], s[1]);
    auto t = __builtin_amdgcn_permlane32_swap(x, x, false, false); return umax_u(t[0], t[1]);
}
__device__ __forceinline__ float gelu_erf(float v) { return 0.5f * v * (1.0f + erff(v * 0.70710678118654752f)); }
__device__ __forceinline__ float erf_as(float x) {
    const float ax = fabsf(x), t = __builtin_amdgcn_rcpf(fmaf(0.3275911f, ax, 1.0f));
    float pl = fmaf(1.061405429f, t, -1.453152027f); pl = fmaf(pl, t, 1.421413741f); pl = fmaf(pl, t, -0.284496736f); pl = fmaf(pl, t, 0.254829592f); pl *= t;
    const float e = __builtin_amdgcn_exp2f(-1.4426950408889634f * ax * ax);
    return copysignf(fmaf(-pl, e, 1.0f), x);
}
__device__ __forceinline__ float gelu_erf_fast(float v) { return 0.5f * v * (1.0f + erf_as(v * 0.70710678118654752f)); }
__device__ __forceinline__ float sigmoidf_(float v) { return __builtin_amdgcn_rcpf(1.0f + __expf(-v)); }
#define DBG_SKIP 0
#define PROBE_DUP 0
#define GPROBE_MODE 0
namespace pg8 {
#define PG8_LAS __attribute__((address_space(3)))
constexpr int BM = 256, BK = 64, HALF = 128, HTB = HALF * BK * 2  , STAGE_BYTES = 8 * HTB, NXCD = 8, WGM = 8;

__host__ __device__ __forceinline__ int lds_byte(int r, int c) { const int st = (r >> 4) * 2 + (c >> 5), rr = r & 15, cc = c & 31, ob = rr * 64 + cc * 2; return st * 1024 + (ob ^ (((ob >> 9) & 1) << 5)); }
__host__ __device__ __forceinline__ void stage_rc(int b, int& R, int& C) { const int st = b / 1024, sb = b % 1024, swz = sb ^ (((sb >> 9) & 1) << 5); R = (st >> 1) * 16 + swz / 64; C = (st & 1) * 32 + (swz % 64) / 2; }
__host__ __device__ __forceinline__ int perm32(int rho) { const int n = rho >> 4, i = rho & 15; return 8 * (i >> 2) + 4 * n + (i & 3); }

struct Unit { int pm, pn; };
struct Gemm { const bf16_t* A; const bf16_t* Bt; int lda, ldb, K; };

struct StaticOrder {
    int nM, nN, nwg, G, c, kdiv, kmul, bmod;
    __device__ void init(int nM_, int nN_, int G_, int c_, int kdiv_ = 1 << 30, int kmul_ = 0, int bmod_ = 0) { nM = nM_; nN = nN_; nwg = nM * nN; G = G_; c = c_; kdiv = kdiv_; kmul = kmul_; bmod = bmod_; }
    __device__ bool next(int i, Unit& u) const {
        const long L = (long)i * G + c; if (L >= nwg) return false;
        int wgid = (int)L; { const int q = nwg / NXCD, r = nwg % NXCD, xcd = wgid % NXCD, off = wgid / NXCD; wgid = (xcd < r ? xcd * (q + 1) : r * (q + 1) + (xcd - r) * q) + off; }
        const int nig = WGM * nN, gid = wgid / nig, fm = gid * WGM, gsz = (nM - fm) < WGM ? (nM - fm) : WGM;
        u.pm = fm + ((wgid % nig) % gsz); u.pn = (wgid % nig) / gsz; return true;
    }
    __device__ __forceinline__ int koff(const Unit& u) const { return (u.pn / kdiv) * kmul; }
    __device__ __forceinline__ size_t boff(const Unit& u, size_t tstepB) const { return bmod ? (size_t)(u.pn % bmod) * tstepB + (size_t)koff(u) * 2 : (size_t)u.pn * tstepB; }
};

template <class Epi, class Sched, bool ALIGN_EPI>
__device__ __forceinline__ void gemm_phase(PG8_LAS unsigned char* lds, const Gemm g, const Sched& S, const Epi& E) {
    int tid = threadIdx.x; asm volatile("" : "+v"(tid));
    const int wid = __builtin_amdgcn_readfirstlane(tid >> 6), lane = tid & 63, wr = wid >> 2, wc = wid & 3, fr = lane & 15, fq = lane >> 4;
    const int K = g.K, nt = K / BK;
    unsigned voffA[2], voffB[2];
#pragma unroll
    for (int i = 0; i < 2; ++i) { int R, C; stage_rc(tid * 16 + i * 8192, R, C); const int Rb = Epi::PERM ? ((R & ~31) + perm32(R & 31)) : R;
        voffA[i] = (unsigned)(R * g.lda + C) * 2u; voffB[i] = (unsigned)(Rb * g.ldb + C) * 2u; }
    const size_t kstep = (size_t)(BK * 2);
    const size_t hstepA = (size_t)HALF * g.lda * 2, hstepB = (size_t)HALF * g.ldb * 2;
    const size_t tstepA = 2 * hstepA, tstepB = 2 * hstepB;
    const unsigned ldsw = (unsigned)wid * 1024u;
    const int aoff = lds_byte(wr * 64 + fr, fq * 8), boff = lds_byte(wc * 32 + fr, fq * 8);
#define PG8_SA(b, h) (((b) * 2 + (h)) * HTB)
#define PG8_SB(b, h) ((4 + (b) * 2 + (h)) * HTB)
#define PG8_STAGE(bufoff, gbase, voff) do { _Pragma("unroll") for (int _i = 0; _i < 2; ++_i) \
        __builtin_amdgcn_global_load_lds((const unsigned*)((const char*)(gbase) + (voff)[_i]), (PG8_LAS unsigned*)(lds + (bufoff) + ldsw + _i * 8192), 16, 0, 0); } while (0)
#define PG8_LDA(dst, b, h) do { _Pragma("unroll") for (int m = 0; m < 4; ++m) _Pragma("unroll") for (int k = 0; k < 2; ++k) dst[m][k] = *(const PG8_LAS bf16x8*)(lds + PG8_SA(b, h) + aoff + m * 2048 + k * 1024); } while (0)
#define PG8_LDB(dst, b, h) do { _Pragma("unroll") for (int n = 0; n < 2; ++n) _Pragma("unroll") for (int k = 0; k < 2; ++k) dst[n][k] = *(const PG8_LAS bf16x8*)(lds + PG8_SB(b, h) + boff + n * 2048 + k * 1024); } while (0)
#define PG8_MMA(ai, bj, At, Bt) do { __builtin_amdgcn_s_setprio(1); _Pragma("unroll") for (int m = 0; m < 4; ++m) _Pragma("unroll") for (int n = 0; n < 2; ++n) _Pragma("unroll") for (int k = 0; k < 2; ++k) \
        acc[ai][bj][m][n] = __builtin_amdgcn_mfma_f32_16x16x32_bf16(Bt[n][k], At[m][k], acc[ai][bj][m][n], 0, 0, 0); __builtin_amdgcn_s_setprio(0); } while (0)
#define PG8_WAIT_V(n) asm volatile("s_waitcnt vmcnt(" #n ")" ::: "memory")
#define PG8_WAIT_L(n) asm volatile("s_waitcnt lgkmcnt(" #n ")" ::: "memory")
#define PG8_BAR __builtin_amdgcn_s_barrier()
#define PG8_SCHED __builtin_amdgcn_sched_barrier(0)
    Unit cur, nxt; int ui = 0;
    if (!S.next(0, cur)) return;
    f32x4 acc[2][2][4][2];
#pragma unroll
    for (int a = 0; a < 2; ++a)
#pragma unroll
        for (int b = 0; b < 2; ++b)
#pragma unroll
            for (int m = 0; m < 4; ++m)
#pragma unroll
                for (int n = 0; n < 2; ++n) acc[a][b][m][n] = (f32x4){0.f, 0.f, 0.f, 0.f};
    bf16x8 At[4][2], B0[2][2], B1[2][2];
    const char* cA = (const char*)g.A + (size_t)cur.pm * tstepA + (size_t)S.koff(cur) * 2; const char* cB = (const char*)g.Bt + (size_t)cur.pn * tstepB;
    PG8_STAGE(PG8_SB(0, 0), cB, voffB); PG8_STAGE(PG8_SB(0, 1), cB + hstepB, voffB); PG8_STAGE(PG8_SA(0, 0), cA, voffA); PG8_STAGE(PG8_SA(0, 1), cA + hstepA, voffA);
    if (wr == 1) PG8_BAR;
    PG8_WAIT_V(2); PG8_BAR;
    PG8_STAGE(PG8_SB(1, 0), cB + kstep, voffB); PG8_STAGE(PG8_SA(1, 0), cA + kstep, voffA); PG8_STAGE(PG8_SB(1, 1), cB + hstepB + kstep, voffB);
    PG8_WAIT_V(6); PG8_BAR;
    for (;;) {
        const bool has_next = S.next(ui + 1, nxt);
        const char* nA = has_next ? (const char*)g.A + (size_t)nxt.pm * tstepA + (size_t)S.koff(nxt) * 2 : cA; const char* nB = has_next ? (const char*)g.Bt + (size_t)nxt.pn * tstepB : cB;
        for (int t = 0; t < nt; t += 2) {
            const bool last = (t == nt - 2);
            const char* a1 = cA + (size_t)(t + 1) * kstep;
            const char* a2 = last ? nA : cA + (size_t)(t + 2) * kstep; const char* b2 = last ? nB : cB + (size_t)(t + 2) * kstep;
            const char* a3 = a2 + kstep; const char* b3 = b2 + kstep;
            PG8_LDB(B0, 0, 0); PG8_LDB(B1, 0, 1); PG8_SCHED; PG8_LDA(At, 0, 0); PG8_STAGE(PG8_SA(1, 1), a1 + hstepA, voffA);
            PG8_WAIT_V(8); PG8_WAIT_L(0); PG8_BAR; PG8_MMA(0, 0, At, B0); PG8_MMA(0, 1, At, B1); PG8_BAR; PG8_SCHED;
            PG8_LDA(At, 0, 1); PG8_STAGE(PG8_SB(0, 0), b2, voffB); PG8_STAGE(PG8_SB(0, 1), b2 + hstepB, voffB); PG8_STAGE(PG8_SA(0, 0), a2, voffA);
            PG8_WAIT_V(8); PG8_WAIT_L(0); PG8_BAR; PG8_MMA(1, 0, At, B0); PG8_MMA(1, 1, At, B1); PG8_BAR; PG8_SCHED;
            PG8_LDB(B0, 1, 0); PG8_LDB(B1, 1, 1); PG8_SCHED; PG8_LDA(At, 1, 0); PG8_STAGE(PG8_SA(0, 1), a2 + hstepA, voffA);
            PG8_WAIT_V(8); PG8_WAIT_L(0); PG8_BAR; PG8_MMA(0, 0, At, B0); PG8_MMA(0, 1, At, B1); PG8_BAR; PG8_SCHED;
            PG8_LDA(At, 1, 1); PG8_STAGE(PG8_SB(1, 0), b3, voffB); PG8_STAGE(PG8_SB(1, 1), b3 + hstepB, voffB); PG8_STAGE(PG8_SA(1, 0), a3, voffA);
            PG8_WAIT_V(8); PG8_WAIT_L(0); PG8_BAR; PG8_MMA(1, 0, At, B0); PG8_MMA(1, 1, At, B1); PG8_BAR; PG8_SCHED;
        }
        if constexpr (ALIGN_EPI) { if (wr == 0) PG8_BAR; }
        E(acc, cur, wr, wc, fr, fq);
        if (!has_next) break;
#pragma unroll
        for (int a = 0; a < 2; ++a)
#pragma unroll
            for (int b = 0; b < 2; ++b)
#pragma unroll
                for (int m = 0; m < 4; ++m)
#pragma unroll
                    for (int n = 0; n < 2; ++n) acc[a][b][m][n] = (f32x4){0.f, 0.f, 0.f, 0.f};
        cur = nxt; cA = nA; cB = nB; ++ui;
        if constexpr (ALIGN_EPI) { if (wr == 1) PG8_BAR; }
    }
    PG8_WAIT_V(0);
    if constexpr (!ALIGN_EPI) { if (wr == 0) PG8_BAR; }
    PG8_BAR;
#undef PG8_SA
#undef PG8_SB
#undef PG8_STAGE
#undef PG8_LDA
#undef PG8_LDB
#undef PG8_MMA
}

template <class Epi, class Sched>
__device__ __forceinline__ void gemm_tail(const bf16_t* A16, const Gemm g, int nN, const Sched& S, const Epi& E, LAS unsigned char* lds) {
    int tid = threadIdx.x; asm volatile("" : "+v"(tid));
    const int wid = __builtin_amdgcn_readfirstlane(tid >> 6), lane = tid & 63, fr = lane & 15, fq = lane >> 4;
    LAS f32x4* red = (LAS f32x4*)lds;
    const int kw = g.K >> 3, kb = wid * kw;
    for (int item = S.G - 1 - S.c; item < nN * 8; item += S.G) {
        const int pn = item >> 3, strip = item & 7;
        Unit u; u.pm = 0; u.pn = pn;
        const bf16_t* a = A16 + (size_t)fr * g.lda + S.koff(u) + fq * 8 + kb;
        const bf16_t* b0 = g.Bt + (size_t)(pn * 256 + 16 * strip + fr) * g.ldb + fq * 8 + kb;
        const bf16_t* b1 = b0 + (size_t)128 * g.ldb;
        f32x4 acc0 = (f32x4){0.f, 0.f, 0.f, 0.f}, acc1 = acc0;
#pragma unroll 8
        for (int k0 = 0; k0 < kw; k0 += 32) {
            const bf16x8 af = *(const bf16x8*)(a + k0), w0 = *(const bf16x8*)(b0 + k0), w1 = *(const bf16x8*)(b1 + k0);
            acc0 = __builtin_amdgcn_mfma_f32_16x16x32_bf16(w0, af, acc0, 0, 0, 0);
            acc1 = __builtin_amdgcn_mfma_f32_16x16x32_bf16(w1, af, acc1, 0, 0, 0);
        }
        red[(wid * 2 + 0) * 64 + lane] = acc0; red[(wid * 2 + 1) * 64 + lane] = acc1;
        __syncthreads();
        if (wid == 0) {
#pragma unroll
            for (int w = 1; w < 8; ++w) { acc0 = acc0 + red[(w * 2 + 0) * 64 + lane]; acc1 = acc1 + red[(w * 2 + 1) * 64 + lane]; }
            E.tail(fr, pn, 16 * strip + 4 * fq, acc0, acc1);
        }
        __syncthreads();
    }
}
#undef PG8_WAIT_V
#undef PG8_WAIT_L
#undef PG8_BAR
#undef PG8_SCHED
}
#define XB_TMO      128
#define XB_XCNT(j)  (256  + 64 * (j))
#define XB_XSUB(j)  (1280 + 64 * (j))
#define XB_XGEN(j)  (2304 + 64 * (j))
#define XB_TOP      3328
#define XB_TOPGEN   3392
#define XCD_BAR_WORDS 3456
#define XB_SPIN_CAP (1u << 18)

__device__ __forceinline__ unsigned xb_ld(unsigned* p)              { return __hip_atomic_load(p, __ATOMIC_RELAXED, __HIP_MEMORY_SCOPE_AGENT); }
__device__ __forceinline__ unsigned xb_add(unsigned* p, unsigned v) { return __hip_atomic_fetch_add(p, v, __ATOMIC_RELAXED, __HIP_MEMORY_SCOPE_AGENT); }
__device__ __forceinline__ unsigned xb_xcc_id() { return (unsigned)__builtin_amdgcn_s_getreg((3 << 11) | 20) & 0xFu; }
#define XB_SPIN(cond, bar) do { unsigned _sp = 0; while (cond) { __builtin_amdgcn_s_sleep(1); \
    if ((++_sp & 255u) == 0u) { if (xb_ld(&(bar)[XB_TMO])) break; if (_sp > XB_SPIN_CAP) { atomicAdd(&(bar)[XB_TMO], 1u); break; } } } } while (0)

struct XcdBarrier {
    unsigned* bar; unsigned x;
    volatile LAS unsigned* st;
};

__device__ __forceinline__ XcdBarrier xcd_barrier_post(unsigned* bar, volatile LAS unsigned* st) {
    XcdBarrier b; b.bar = bar; b.x = xb_xcc_id(); b.st = st;
    if (threadIdx.x == 0) (void)xb_add(&bar[XB_XCNT(b.x)], 1u);
    return b;
}
__device__ __forceinline__ void xcd_barrier_complete(unsigned* bar, unsigned x, unsigned& nloc, unsigned& nx) {
    const unsigned G = gridDim.x * gridDim.y * gridDim.z;
    unsigned sum, cnt, mine, sp = 0u;
    for (;;) {
        sum = 0u; cnt = 0u; mine = 0u;
#pragma unroll
        for (unsigned j = 0; j < 16; ++j) { const unsigned c = xb_ld(&bar[XB_XCNT(j)]); sum += c; cnt += (c > 0u) ? 1u : 0u; mine = (j == x) ? c : mine; }
        if (sum == G) break;
        __builtin_amdgcn_s_sleep(1);
        if ((++sp & 255u) == 0u) { if (xb_ld(&bar[XB_TMO])) break; if (sp > XB_SPIN_CAP) { atomicAdd(&bar[XB_TMO], 1u); break; } }
    }
    nloc = mine > 0u ? mine : 1u; nx = cnt > 0u ? cnt : 1u;
}

__device__ __forceinline__ void xcd_barrier(const XcdBarrier& b) {
    asm volatile("s_waitcnt vmcnt(0)" ::: "memory");
    __syncthreads();
    if (threadIdx.x == 0) {
        unsigned* bar = b.bar;
        __builtin_amdgcn_s_waitcnt(0);
        unsigned nloc = b.st[0], nx = b.st[1];
        if (nloc == 0u) { xcd_barrier_complete(bar, b.x, nloc, nx); b.st[0] = nloc; b.st[1] = nx; }
        const unsigned old = xb_add(&bar[XB_XSUB(b.x)], 1u);
        const unsigned gen = old / nloc;
        if (old + 1u == (gen + 1u) * nloc) {
            __builtin_amdgcn_fence(__ATOMIC_RELEASE, "agent");
            asm volatile("s_waitcnt vmcnt(0)" ::: "memory");
            const unsigned og = xb_add(&bar[XB_TOP], 1u);
            const unsigned tg = og / nx;
            if (og + 1u == (tg + 1u) * nx) xb_add(&bar[XB_TOPGEN], 1u);
            else XB_SPIN(xb_ld(&bar[XB_TOPGEN]) == tg, bar);
            __builtin_amdgcn_fence(__ATOMIC_ACQUIRE, "agent");
            xb_add(&bar[XB_XGEN(b.x)], 1u);
            asm volatile("s_waitcnt vmcnt(0)" ::: "memory");
        } else {
            XB_SPIN(xb_ld(&bar[XB_XGEN(b.x)]) == gen, bar);
            __builtin_amdgcn_fence(__ATOMIC_ACQUIRE, "agent");
            asm volatile("s_waitcnt vmcnt(0)" ::: "memory");
        }
    }
    __syncthreads();
}
constexpr int D = 4096, NB = 4, SEQ = 2048, NMETA = 16, LSEQ = SEQ + NMETA;
constexpr int MX = NB * SEQ;
constexpr int MROWS = MX + NMETA;
constexpr float NORM_EPS = 1e-6f, GN_EPS = 64e-5f;
constexpr int ZC = 8640, ZLD = 8704;
constexpr int ZR = 2048, ZK = 4096, ZV = 6144, ZWL = 8192, ZAL = 8288, ZGL = 8384;
constexpr int NHEAD = 32, HDIM = 64;
constexpr int WAGLD = 6144;
constexpr int NEXP = 16384;
__device__ __forceinline__ int rowof(int b, int pos) { return pos < NMETA ? MX + pos : b * SEQ + pos - NMETA; }

constexpr size_t MiB = 1u << 20;
constexpr size_t wsal(size_t x) { return (x + 4095) & ~(size_t)4095; }
constexpr size_t WS_CTL = 0, CTL_ZERO_BYTES = 1 * MiB;
constexpr size_t WS_W1T = 1 * MiB;
constexpr size_t WS_WOT = WS_W1T + wsal((size_t)ZLD * D * 2);
constexpr size_t WS_WIO = WS_WOT + wsal((size_t)D * D * 2);
constexpr size_t WS_WGT = WS_WIO + wsal((size_t)2048 * D * 2);
constexpr size_t WS_WST = WS_WGT + wsal((size_t)8192 * 2048 * 2);
constexpr size_t WS_BTP = WS_WST + wsal((size_t)2 * 2048 * D * 2);
constexpr size_t WS_BTL = WS_BTP + wsal((size_t)2048 * 512 * 2);
constexpr size_t WS_PU  = WS_BTL + wsal((size_t)6144 * 256 * 2);
constexpr size_t WS_PV  = WS_PU + wsal((size_t)2 * NEXP * D);
constexpr size_t WS_SU  = WS_PV + wsal((size_t)2 * NEXP * D);
constexpr size_t WS_SV  = WS_SU + wsal((size_t)2 * NEXP * 4);
constexpr size_t WS_H   = WS_SV + wsal((size_t)2 * NEXP * 4);
constexpr size_t WS_HB  = WS_H + wsal((size_t)MROWS * D * 4);
constexpr size_t WS_Z   = WS_HB + wsal((size_t)MROWS * D * 2);
constexpr size_t WS_PM  = WS_Z + wsal((size_t)MROWS * ZLD * 2);
constexpr size_t WS_LA  = WS_PM + wsal((size_t)MROWS * 2048 * 2);
constexpr size_t WS_WAG = WS_LA + wsal((size_t)MROWS * 512 * 2);
constexpr size_t WS_Y   = WS_WAG + wsal((size_t)MROWS * WAGLD * 4);
constexpr size_t WS_SC  = WS_Y + wsal((size_t)MROWS * D * 2);
constexpr size_t WS_U   = WS_SC + wsal((size_t)MROWS * 2048 * 4);
constexpr size_t WS_YS  = WS_U + wsal((size_t)MROWS * 2048 * 2);
constexpr size_t WS_EIDL = WS_YS + wsal((size_t)MROWS * 2048 * 2);
constexpr size_t WS_GATEL = WS_EIDL + wsal((size_t)MROWS * 128 * 4);
constexpr size_t WS_DOTP = WS_GATEL + wsal((size_t)MROWS * 128 * 4);
constexpr size_t WS_WL = WS_DOTP + wsal((size_t)MROWS * 4096 * 4);
constexpr size_t WS_HB8 = WS_WL + wsal((size_t)MROWS * 128 * 4);
constexpr size_t WS_HS = WS_HB8 + wsal((size_t)MROWS * D);
constexpr size_t WS_END = WS_HS + wsal((size_t)MROWS * 4);
constexpr int CW_BAR = 4096;

constexpr int LDS_BYTES = 163840;
constexpr int SCR_BYTES = 131072;
constexpr int MISC_OFF = SCR_BYTES;
constexpr int RED_OFF = MISC_OFF + 256;
constexpr int BONUS_OFF = MISC_OFF + 512;

struct EpiBf16 {
    static constexpr bool PERM = true;
    bf16_t* O; int ldc; const float* colscale;
    __device__ __forceinline__ void operator()(const f32x4 (&acc)[2][2][4][2], const pg8::Unit& u, int wr, int wc, int fr, int fq) const {
        const int row0 = u.pm * 256 + wr * 64 + fr, col0 = u.pn * 256 + wc * 32 + 8 * fq;
        f32x4 sv[2][2];
#pragma unroll
        for (int bj = 0; bj < 2; ++bj)
#pragma unroll
            for (int n = 0; n < 2; ++n) sv[bj][n] = colscale ? *(const f32x4*)(colscale + col0 + bj * 128 + 4 * n) : (f32x4){1.f, 1.f, 1.f, 1.f};
#pragma unroll
        for (int ai = 0; ai < 2; ++ai)
#pragma unroll
            for (int m = 0; m < 4; ++m) { bf16_t* rowp = O + (size_t)(row0 + ai * 128 + m * 16) * ldc + col0;
#pragma unroll
                for (int bj = 0; bj < 2; ++bj) { const f32x4 v0 = acc[ai][bj][m][0] * sv[bj][0], v1 = acc[ai][bj][m][1] * sv[bj][1];
                    u32x4 w; w.x = cvt_pk_bf16(v0[0], v0[1]); w.y = cvt_pk_bf16(v0[2], v0[3]); w.z = cvt_pk_bf16(v1[0], v1[1]); w.w = cvt_pk_bf16(v1[2], v1[3]);
                    *(u32x4*)(rowp + bj * 128) = w; } }
    }
    __device__ __forceinline__ void tail(int r, int pn, int c4, f32x4 lo, f32x4 hi) const {
        const int col = pn * 256 + c4; bf16_t* rowp = O + (size_t)(MX + r) * ldc + col;
        if (colscale) { lo = lo * *(const f32x4*)(colscale + col); hi = hi * *(const f32x4*)(colscale + col + 128); }
        u32x2 a, b; a.x = cvt_pk_bf16(lo[0], lo[1]); a.y = cvt_pk_bf16(lo[2], lo[3]); b.x = cvt_pk_bf16(hi[0], hi[1]); b.y = cvt_pk_bf16(hi[2], hi[3]);
        *(u32x2*)rowp = a; *(u32x2*)(rowp + 128) = b;
    }
};
struct EpiF32 {
    static constexpr bool PERM = false;
    float* C; int ldc; int accum; const float* base; const float* base_tail;
    __device__ __forceinline__ void operator()(const f32x4 (&acc)[2][2][4][2], const pg8::Unit& u, int wr, int wc, int fr, int fq) const {
        const int row0 = u.pm * 256 + wr * 64 + fr, col0 = u.pn * 256 + wc * 32 + 4 * fq;
        const float* bs = base ? base : C;
        if (accum) {
#pragma unroll
            for (int ai = 0; ai < 2; ++ai)
#pragma unroll
                for (int mh = 0; mh < 2; ++mh) { f32x4 t[2][2][2];
#pragma unroll
                    for (int ml = 0; ml < 2; ++ml) { const size_t ro = (size_t)(row0 + ai * 128 + (2 * mh + ml) * 16) * ldc + col0;
#pragma unroll
                        for (int bj = 0; bj < 2; ++bj)
#pragma unroll
                            for (int n = 0; n < 2; ++n) t[ml][bj][n] = *(const f32x4*)(bs + ro + bj * 128 + n * 16); }
#pragma unroll
                    for (int ml = 0; ml < 2; ++ml) { const size_t ro = (size_t)(row0 + ai * 128 + (2 * mh + ml) * 16) * ldc + col0;
#pragma unroll
                        for (int bj = 0; bj < 2; ++bj)
#pragma unroll
                            for (int n = 0; n < 2; ++n) *(f32x4*)(C + ro + bj * 128 + n * 16) = acc[ai][bj][2 * mh + ml][n] + t[ml][bj][n]; } }
        } else {
#pragma unroll
            for (int ai = 0; ai < 2; ++ai)
#pragma unroll
                for (int m = 0; m < 4; ++m) { const size_t ro = (size_t)(row0 + ai * 128 + m * 16) * ldc + col0;
#pragma unroll
                    for (int bj = 0; bj < 2; ++bj)
#pragma unroll
                        for (int n = 0; n < 2; ++n) *(f32x4*)(C + ro + bj * 128 + n * 16) = acc[ai][bj][m][n]; }
        }
    }
    __device__ __forceinline__ void tail(int r, int pn, int c4, f32x4 lo, f32x4 hi) const {
        const size_t co = (size_t)pn * 256 + c4; float* rowp = C + (size_t)(MX + r) * ldc + co; const float* bp = base_tail ? base_tail + (size_t)r * ldc + co : rowp;
        if (accum) { lo = lo + *(const f32x4*)bp; hi = hi + *(const f32x4*)(bp + 128); }
        *(f32x4*)rowp = lo; *(f32x4*)(rowp + 128) = hi;
    }
};
__device__ __forceinline__ float decay_of(float x) {
    const float y = -x, sp = fmaxf(y, 0.f) + __logf(1.0f + __expf(-fabsf(y)));
    return __expf(-__expf(-sp - 0.5f));
}
#ifndef DBG_SKIP
#define DBG_SKIP 0
#endif
struct EpiGlu {
    static constexpr bool PERM = false;
    float* H;
    __device__ __forceinline__ void operator()(const f32x4 (&acc)[2][2][4][2], const pg8::Unit& u, int wr, int wc, int fr, int fq) const {
        const int row0 = u.pm * 256 + wr * 64 + fr, col0 = u.pn * 128 + wc * 32 + 4 * fq;
#pragma unroll
        for (int ai = 0; ai < 2; ++ai) { f32x4 t[4][2];
#pragma unroll
            for (int m = 0; m < 4; ++m)
#pragma unroll
                for (int n = 0; n < 2; ++n) t[m][n] = *(const f32x4*)(H + (size_t)(row0 + ai * 128 + m * 16) * D + col0 + n * 16);
#pragma unroll
            for (int m = 0; m < 4; ++m)
#pragma unroll
                for (int n = 0; n < 2; ++n) { const f32x4 ga = acc[ai][0][m][n], gb = acc[ai][1][m][n]; f32x4 v = t[m][n];
                    if (!(DBG_SKIP & 2)) { v[0] += ga[0] * sigmoidf_(gb[0]); v[1] += ga[1] * sigmoidf_(gb[1]); v[2] += ga[2] * sigmoidf_(gb[2]); v[3] += ga[3] * sigmoidf_(gb[3]); }
                    *(f32x4*)(H + (size_t)(row0 + ai * 128 + m * 16) * D + col0 + n * 16) = v; } }
    }
    __device__ __forceinline__ void tail(int r, int pn, int c4, f32x4 lo, f32x4 hi) const {
        f32x4* p = (f32x4*)(H + (size_t)(MX + r) * D + pn * 128 + c4); f32x4 v = *p;
        v[0] += lo[0] * sigmoidf_(hi[0]); v[1] += lo[1] * sigmoidf_(hi[1]); v[2] += lo[2] * sigmoidf_(hi[2]); v[3] += lo[3] * sigmoidf_(hi[3]); *p = v;
    }
};
#define LDS_WAIT() asm volatile("s_waitcnt lgkmcnt(0)" ::: "memory")
constexpr int NWAVES = 8, NTHREADS = 512;

template <bool SCALE>
__device__ __forceinline__ void transpose_item(const float* W, int ldw, int k0, int n0, const float* scale, bf16_t* dst, int dld, int drow0, LAS float* scr, int lane) {
    float v[32];
#pragma unroll
    for (int i = 0; i < 32; ++i) { const int kk = 2 * i + (lane >> 5); v[i] = W[(size_t)(k0 + kk) * ldw + n0 + (lane & 31)]; }
    const int c = lane & 7;
    f32x4 s0 = {1.f, 1.f, 1.f, 1.f}, s1 = s0;
    if (SCALE) { s0 = *(const f32x4*)(scale + k0 + 8 * c); s1 = *(const f32x4*)(scale + k0 + 8 * c + 4); }
#pragma unroll
    for (int i = 0; i < 32; ++i) { const int kk = 2 * i + (lane >> 5); scr[kk * 33 + (lane & 31)] = v[i]; }
    LDS_WAIT();
#pragma unroll
    for (int j = 0; j < 4; ++j) { const int n = (lane >> 3) + 8 * j; const LAS float* s = scr + (8 * c) * 33 + n;
        u32x4 o; o.x = pk2(s[0 * 33] * s0[0], s[1 * 33] * s0[1]); o.y = pk2(s[2 * 33] * s0[2], s[3 * 33] * s0[3]); o.z = pk2(s[4 * 33] * s1[0], s[5 * 33] * s1[1]); o.w = pk2(s[6 * 33] * s1[2], s[7 * 33] * s1[3]);
        *(u32x4*)(dst + (size_t)(drow0 + n) * dld + k0 + 8 * c) = o; }
    LDS_WAIT();
}
__device__ __forceinline__ void norm_row(const float* src, float* cpy, bf16_t* dstb, int lane) {
    f32x4 v[16]; float s = 0.f;
#pragma unroll
    for (int j = 0; j < 16; ++j) { v[j] = ((const f32x4*)src)[lane + 64 * j]; s += (v[j][0] * v[j][0] + v[j][1] * v[j][1]) + (v[j][2] * v[j][2] + v[j][3] * v[j][3]); }
    s = sum64(s);
    const float inv = rsqrtf(s * (1.0f / D) + NORM_EPS);
#pragma unroll
    for (int j = 0; j < 16; ++j) { if (cpy) ((f32x4*)cpy)[lane + 64 * j] = v[j];
        u32x2 o; o.x = cvt_pk_bf16(v[j][0] * inv, v[j][1] * inv); o.y = cvt_pk_bf16(v[j][2] * inv, v[j][3] * inv); ((u32x2*)dstb)[lane + 64 * j] = o; }
}
__device__ __forceinline__ bf16x8 cvt8(const float* p) {
    const f32x4 a = *(const f32x4*)p, b = *(const f32x4*)(p + 4);
    u32x4 o; o.x = pk2(a[0], a[1]); o.y = pk2(a[2], a[3]); o.z = pk2(b[0], b[1]); o.w = pk2(b[2], b[3]);
    return __builtin_bit_cast(bf16x8, o);
}

__device__ __forceinline__ void peer_row_load(f32x4 (&v)[16], const float* const (&in)[34], int it, int layer, int lane) {
    const int tbl = it >= NEXP, r = it - tbl * NEXP + layer * NEXP;
    const f32x4* src = (const f32x4*)((tbl ? in[33] : in[32]) + (size_t)r * D) + lane;
#pragma unroll
    for (int j = 0; j < 16; ++j) v[j] = src[64 * j];
}
__device__ __forceinline__ void peer_row_store(const f32x4 (&v)[16], unsigned char* ws, int it, int layer, int lane) {
    const int tbl = it >= NEXP, r = it - tbl * NEXP + layer * NEXP;
    float am = 0.f;
#pragma unroll
    for (int j = 0; j < 16; ++j) am = fmaxf(fmaxf(am, fmaxf(fabsf(v[j][0]), fabsf(v[j][1]))), fmaxf(fabsf(v[j][2]), fabsf(v[j][3])));
    am = __uint_as_float(max64u(__float_as_uint(am)));
    const float q = am > 0.f ? 256.0f / am : 0.f;
    unsigned* dst = (unsigned*)(ws + (tbl ? WS_PV : WS_PU) + (size_t)r * D) + lane;
    if (tbl) {
        const int rl = it - NEXP;
        unsigned char* pvl = ws + WS_PV + (size_t)layer * NEXP * D + (size_t)rl * 8 + (lane & 1) * 4;
        unsigned char* pvg = ws + WS_PV + (size_t)layer * NEXP * D + (size_t)NEXP * 2048 + (size_t)rl * 2048 + 4 * lane;
#pragma unroll
        for (int j = 0; j < 16; ++j) { int w = __builtin_amdgcn_cvt_pk_bf8_f32(v[j][0] * q, v[j][1] * q, 0, false); w = __builtin_amdgcn_cvt_pk_bf8_f32(v[j][2] * q, v[j][3] * q, w, true);
            if (j < 8) *(unsigned*)(pvl + (size_t)((lane >> 1) + 32 * j) * (NEXP * 8)) = (unsigned)w;
            else *(unsigned*)(pvg + 256 * (j - 8)) = (unsigned)w; }
    } else {
#pragma unroll
        for (int j = 0; j < 16; ++j) { int w = __builtin_amdgcn_cvt_pk_fp8_f32(v[j][0] * q, v[j][1] * q, 0, false); w = __builtin_amdgcn_cvt_pk_fp8_f32(v[j][2] * q, v[j][3] * q, w, true); dst[64 * j] = (unsigned)w; }
    }
    if (lane == 0) ((float*)(ws + (tbl ? WS_SV : WS_SU)))[r] = am * (1.0f / 256.0f);
}
template <int R>
__device__ __forceinline__ void peer_vrow(const f32x4 (&v)[16], unsigned char* ws, LAS unsigned char* tile, int rl, int rr, int layer, int lane) {
    float am = 0.f;
#pragma unroll
    for (int j = 0; j < 16; ++j) am = fmaxf(fmaxf(am, fmaxf(fabsf(v[j][0]), fabsf(v[j][1]))), fmaxf(fabsf(v[j][2]), fabsf(v[j][3])));
    am = __uint_as_float(max64u(__float_as_uint(am)));
    const float q = am > 0.f ? 256.0f / am : 0.f;
    unsigned char* pvg = ws + WS_PV + (size_t)layer * NEXP * D + (size_t)NEXP * 2048 + (size_t)rl * 2048 + 4 * lane;
#pragma unroll
    for (int j = 0; j < 16; ++j) { int w = __builtin_amdgcn_cvt_pk_bf8_f32(v[j][0] * q, v[j][1] * q, 0, false); w = __builtin_amdgcn_cvt_pk_bf8_f32(v[j][2] * q, v[j][3] * q, w, true);
        if (j < 8) *(LAS unsigned*)(tile + rr * 2048 + 4 * (lane + 64 * j)) = (unsigned)w;
        else *(unsigned*)(pvg + 256 * (j - 8)) = (unsigned)w; }
    if (lane == 0) ((float*)(ws + WS_SV))[layer * NEXP + rl] = am * (1.0f / 256.0f);
}
template <int R>
__device__ __forceinline__ void peer_convert_v(const float* const (&in)[34], unsigned char* ws, LAS unsigned char* tile, int gw, int NGW, int lane, int layer) {
    f32x4 va[16], vb[16];
#pragma unroll 1
    for (int blk = gw; blk < NEXP / R; blk += NGW) {
        const int row0 = blk * R;
        peer_row_load(va, in, NEXP + row0, layer, lane);
#pragma unroll
        for (int rr = 0; rr < R; rr += 2) {
            peer_row_load(vb, in, NEXP + row0 + rr + 1, layer, lane);
            __builtin_amdgcn_sched_barrier(0);
            peer_vrow<R>(va, ws, tile, row0 + rr, rr, layer, lane);
            __builtin_amdgcn_sched_barrier(0);
            if (rr + 2 < R) peer_row_load(va, in, NEXP + row0 + rr + 2, layer, lane);
            __builtin_amdgcn_sched_barrier(0);
            peer_vrow<R>(vb, ws, tile, row0 + rr + 1, rr + 1, layer, lane);
            __builtin_amdgcn_sched_barrier(0);
        }
        LDS_WAIT();
        unsigned char* pvl = ws + WS_PV + (size_t)layer * NEXP * D + (size_t)row0 * 8;
#pragma unroll
        for (int m = 0; m < 4; ++m) { const int grp = lane + 64 * m; u32x2 t_[R];
#pragma unroll
            for (int rr = 0; rr < R; ++rr) t_[rr] = *(const LAS u32x2*)(tile + rr * 2048 + 8 * grp);
#pragma unroll
            for (int rr = 0; rr < R; rr += 2) *(u32x4*)(pvl + (size_t)grp * (NEXP * 8) + rr * 8) = (u32x4){t_[rr].x, t_[rr].y, t_[rr + 1].x, t_[rr + 1].y}; }
        LDS_WAIT();
    }
}
__device__ __forceinline__ void peer_convert(const float* const (&in)[34], unsigned char* ws, int gw, int NGW, int lane, int only_layer, int it_lo = 0, int it_hi = 2 * NEXP) {
    f32x4 va[16], vb[16];
    if (it_lo + gw >= it_hi) return;
    peer_row_load(va, in, it_lo + gw, only_layer, lane);
#pragma unroll 1
    for (int it = it_lo + gw; it < it_hi; it += 2 * NGW) {
        const int it1 = it + NGW, it2 = it + 2 * NGW;
        peer_row_load(vb, in, it1 < it_hi ? it1 : it, only_layer, lane);
        __builtin_amdgcn_sched_barrier(0);
        peer_row_store(va, ws, it, only_layer, lane);
        __builtin_amdgcn_sched_barrier(0);
        peer_row_load(va, in, it2 < it_hi ? it2 : it, only_layer, lane);
        __builtin_amdgcn_sched_barrier(0);
        if (it1 < it_hi) peer_row_store(vb, ws, it1, only_layer, lane);
        __builtin_amdgcn_sched_barrier(0);
    }
}


template <int PARTS = 3>
__device__ __forceinline__ void phase_prologue(const float* const (&in)[34], unsigned char* ws, LAS unsigned char* lds, int G) {
    int tid = threadIdx.x; asm volatile("" : "+v"(tid)); const int lane = tid & 63, wid = __builtin_amdgcn_readfirstlane(tid >> 6);
    const int gw = blockIdx.x * NWAVES + wid, NGW = G * NWAVES;
    const size_t gt = (size_t)blockIdx.x * NTHREADS + tid, NT = (size_t)G * NTHREADS;
    LAS float* scr = (LAS float*)(lds + wid * 16384);
    bf16_t* W1T = (bf16_t*)(ws + WS_W1T);
    constexpr int I1 = (D / 64) * (ZC / 32);
    if (PARTS & 1) for (int r = gw; r < I1; r += NGW) { const int kb = r % (D / 64), n0 = (r / (D / 64)) * 32;     transpose_item<true>(in[5], ZC, kb * 64, n0, in[2], W1T, D, n0, scr, lane); }
    for (size_t i = gt; i < (size_t)(ZLD - ZC) * D / 8; i += NT) ((u32x4*)(W1T + (size_t)ZC * D))[i] = (u32x4){0u, 0u, 0u, 0u};
    if (PARTS & 2) { bf16_t* HB = (bf16_t*)(ws + WS_HB);
      for (int r = gw; r < MROWS; r += NGW) { const float* src = r < MX ? in[0] + (size_t)r * D : in[1] + (size_t)(r - MX) * D; norm_row(src, nullptr, HB + (size_t)r * D, lane); } }
}
__device__ __forceinline__ void early_weights(const float* const (&in)[34], unsigned char* ws, LAS float* scr, int gw, int NGW, size_t gt, size_t NT, int lane) {
    bf16_t* WOT = (bf16_t*)(ws + WS_WOT); bf16_t* BTP = (bf16_t*)(ws + WS_BTP); bf16_t* BTL = (bf16_t*)(ws + WS_BTL);
    constexpr int I2 = (D / 64) * (D / 32), I5 = 4 * (512 / 64) * (512 / 32);
    for (int it = gw; it < I2 + I5; it += NGW) {
        int r = it;
        if (r < I2) { const int kb = r % (D / 64), n0 = (r / (D / 64)) * 32; transpose_item<false>(in[19], D, kb * 64, n0, nullptr, WOT, D, n0, scr, lane); continue; } r -= I2;
        { const int grp = r / 128, rr = r % 128, kb = rr % 8, n0 = (rr / 8) * 32; transpose_item<false>(in[6] + (size_t)grp * 512 * 512, 512, kb * 64, n0, nullptr, BTP, 512, grp * 512 + n0, scr, lane); }
    }
    for (size_t i = gt; i < (size_t)6144 * 256; i += NT) { const int k = (int)(i / 6144), n = (int)(i % 6144), reg = n >> 11, c = n & 2047; float v = 0.f;
        if (reg == 0) { if (k < 96) v = in[10][(size_t)k * 2048 + c]; }
        else if (reg == 1) { if (k >= 128 && k < 224) v = in[12][(size_t)(k - 128) * 2048 + c]; }
        else v = in[13][(size_t)k * 2048 + c];
        BTL[(size_t)n * 256 + k] = (bf16_t)f2bf(v); }
}
template <int PART>
__device__ __forceinline__ void late_weights(const float* const (&in)[34], unsigned char* ws, LAS float* scr, int gw, int NGW, int lane) {
    bf16_t* WIO = (bf16_t*)(ws + WS_WIO); bf16_t* WGT = (bf16_t*)(ws + WS_WGT); bf16_t* WST = (bf16_t*)(ws + WS_WST);
    constexpr int I3 = (D / 64) * (2048 / 32), I4 = (2048 / 64) * (8192 / 32);
    if (PART == 0) {
        for (int r = gw; r < I3; r += NGW) { const int kb = r % (D / 64), n0 = (r / (D / 64)) * 32; transpose_item<true>(in[20], 2048, kb * 64, n0, in[2] + D, WIO, D, n0, scr, lane); }
    } else if (PART == 2) {
        for (int r = gw; r < I4; r += NGW) { const int kb = r % (2048 / 64), n0 = (r / (2048 / 64)) * 32;
            const int half = n0 >= 4096, c = n0 - half * 4096, drow = (c >> 7) * 256 + half * 128 + (c & 127);
            transpose_item<false>(in[29], 8192, kb * 64, n0, nullptr, WGT, 2048, drow, scr, lane); }
    }
    if (PART < 2) { const int fr = lane & 15, fq = lane >> 4, layer = PART;
      for (int it = gw; it < 16 * 256; it += NGW) {
        const int hp = (it >> 8) & 15, d0 = (it & 255) * 16;
        const float* wq = in[30] + (size_t)layer * D * 2048 + (size_t)(d0 + fr) * 2048 + hp * 128 + fq * 8;
        const float* sk = in[31] + ((size_t)(layer * 16 + hp) * 128 + fr) * 128 + fq * 8;
        f32x4 acc[8]; f32x4 ra[2], rb[8][2];
#pragma unroll
        for (int kt = 0; kt < 8; ++kt) acc[kt] = (f32x4){0.f, 0.f, 0.f, 0.f};
#pragma unroll
        for (int ks = 0; ks < 4; ++ks) {
            if (ks == 0) { ra[0] = *(const f32x4*)(wq); ra[1] = *(const f32x4*)(wq + 4);
#pragma unroll
                for (int kt = 0; kt < 8; ++kt) { rb[kt][0] = *(const f32x4*)(sk + (size_t)kt * 16 * 128); rb[kt][1] = *(const f32x4*)(sk + (size_t)kt * 16 * 128 + 4); } }
            u32x4 ao; ao.x = pk2(ra[0][0], ra[0][1]); ao.y = pk2(ra[0][2], ra[0][3]); ao.z = pk2(ra[1][0], ra[1][1]); ao.w = pk2(ra[1][2], ra[1][3]);
            u32x4 bo[8];
#pragma unroll
            for (int kt = 0; kt < 8; ++kt) { bo[kt].x = pk2(rb[kt][0][0], rb[kt][0][1]); bo[kt].y = pk2(rb[kt][0][2], rb[kt][0][3]); bo[kt].z = pk2(rb[kt][1][0], rb[kt][1][1]); bo[kt].w = pk2(rb[kt][1][2], rb[kt][1][3]); }
            __builtin_amdgcn_sched_barrier(0);
            if (ks < 3) { ra[0] = *(const f32x4*)(wq + (ks + 1) * 32); ra[1] = *(const f32x4*)(wq + (ks + 1) * 32 + 4);
#pragma unroll
                for (int kt = 0; kt < 8; ++kt) { rb[kt][0] = *(const f32x4*)(sk + (size_t)kt * 16 * 128 + (ks + 1) * 32); rb[kt][1] = *(const f32x4*)(sk + (size_t)kt * 16 * 128 + (ks + 1) * 32 + 4); } }
            __builtin_amdgcn_sched_barrier(0);
#pragma unroll
            for (int kt = 0; kt < 8; ++kt) acc[kt] = __builtin_amdgcn_mfma_f32_16x16x32_bf16(__builtin_bit_cast(bf16x8, ao), __builtin_bit_cast(bf16x8, bo[kt]), acc[kt], 0, 0, 0);
            __builtin_amdgcn_sched_barrier(0);
        }
#pragma unroll
        for (int kt = 0; kt < 8; ++kt) { const f32x4 v = acc[kt]; u32x2 o; o.x = cvt_pk_bf16(v[0], v[1]); o.y = cvt_pk_bf16(v[2], v[3]);
            *(u32x2*)(WST + ((size_t)layer * 2048 + hp * 128 + kt * 16 + fr) * D + d0 + 4 * fq) = o; }
      } }
}

template <bool FP8, bool GAIN = false>
__device__ __forceinline__ void phase_norm(unsigned char* ws, int G, const float* gain = nullptr) {
    int tid = threadIdx.x; asm volatile("" : "+v"(tid)); const int lane = tid & 63, wid = __builtin_amdgcn_readfirstlane(tid >> 6);
    const float* H = (const float*)(ws + WS_H); bf16_t* HB = (bf16_t*)(ws + WS_HB);
    f32x4 gv[16];
    if (GAIN) {
#pragma unroll
        for (int j = 0; j < 16; ++j) gv[j] = ((const f32x4*)gain)[lane + 64 * j]; }
    const int r0 = blockIdx.x * NWAVES + wid, RS = G * NWAVES;
    if (r0 >= MROWS) return;
#define PN_LOAD(v, R) do { const f32x4* src_ = (const f32x4*)(H + (size_t)(R) * D) + lane; _Pragma("unroll") for (int j = 0; j < 16; ++j) v[j] = src_[64 * j]; } while (0)
#define PN_ROW(v, R) do { float s_ = 0.f; _Pragma("unroll") for (int j = 0; j < 16; ++j) s_ += (v[j][0] * v[j][0] + v[j][1] * v[j][1]) + (v[j][2] * v[j][2] + v[j][3] * v[j][3]); \
        s_ = sum64(s_); const float inv_ = rsqrtf(s_ * (1.0f / D) + NORM_EPS); u32x2* dstb_ = (u32x2*)(HB + (size_t)(R) * D) + lane; \
        _Pragma("unroll") for (int j = 0; j < 16; ++j) { f32x4 w_ = v[j] * inv_; if (GAIN) w_ = w_ * gv[j]; u32x2 o_; o_.x = cvt_pk_bf16(w_[0], w_[1]); o_.y = cvt_pk_bf16(w_[2], w_[3]); dstb_[64 * j] = o_; } } while (0)
    f32x4 va[16], vb[16];
    PN_LOAD(va, r0);
#pragma unroll 1
    for (int r = r0; r < MROWS; r += 2 * RS) {
        const int r1 = r + RS, r2 = r + 2 * RS;
        PN_LOAD(vb, r1 < MROWS ? r1 : r);
        __builtin_amdgcn_sched_barrier(0);
        PN_ROW(va, r);
        __builtin_amdgcn_sched_barrier(0);
        PN_LOAD(va, r2 < MROWS ? r2 : r);
        __builtin_amdgcn_sched_barrier(0);
        if (r1 < MROWS) PN_ROW(vb, r1);
        __builtin_amdgcn_sched_barrier(0);
    }
#undef PN_LOAD
#undef PN_ROW
}

__device__ __forceinline__ float zl_get(const float* ZL, int r, int c) { const float* p = ZL + (size_t)r * 2048 + c; return r < MX ? (p[0] + p[512]) + (p[1024] + p[1536]) : p[0]; }
__device__ __forceinline__ void phase_prep(const float* mu, unsigned char* ws, int G) {
    int tid = threadIdx.x; asm volatile("" : "+v"(tid));
    const bf16_t* Z = (const bf16_t*)(ws + WS_Z); bf16_t* PM = (bf16_t*)(ws + WS_PM); bf16_t* LA = (bf16_t*)(ws + WS_LA); const float* ZL = (const float*)(ws + WS_WAG);
    const int c4 = tid * 4, grp = c4 >> 9, w = 2 << grp;
    float msk[16];
#pragma unroll
    for (int i = 0; i < 16; ++i) msk[i] = i < w ? 1.f : 0.f;
    for (int it = blockIdx.x; it < NB * 129; it += G) {
        const int b = it / 129, blk = it % 129; if (b > 0 && blk == 0) continue;
        const int p0 = blk * 16;
        float zz[31][4];
        u32x2 zq[31];
#pragma unroll
        for (int i = 0; i < 31; ++i) { const int pos = p0 - 15 + i; zq[i] = *(const u32x2*)(Z + (size_t)rowof(b, pos < 0 ? 0 : pos) * ZLD + c4); }
#pragma unroll
        for (int i = 0; i < 31; ++i) { const int pos = p0 - 15 + i; const u32x2 q = pos >= 0 ? zq[i] : (u32x2){0u, 0u}; zz[i][0] = bflo(q.x); zz[i][1] = bfhi(q.x); zz[i][2] = bflo(q.y); zz[i][3] = bfhi(q.y); }
#pragma unroll
        for (int t = 0; t < 16; ++t) { const int pos = p0 + t; float s[4] = {0.f, 0.f, 0.f, 0.f};
#pragma unroll
            for (int i = 0; i < 16; ++i) {
#pragma unroll
                for (int e = 0; e < 4; ++e) s[e] = fmaf(zz[15 + t - i][e], msk[i], s[e]); }
            const float ic = 1.0f / (float)(pos + 1 < w ? pos + 1 : w);
            u32x2 o; o.x = cvt_pk_bf16(s[0] * ic - zz[15 + t][0], s[1] * ic - zz[15 + t][1]); o.y = cvt_pk_bf16(s[2] * ic - zz[15 + t][2], s[3] * ic - zz[15 + t][3]);
            *(u32x2*)(PM + (size_t)rowof(b, pos) * 2048 + c4) = o; }
    }
    {   const int k = tid;
        int zc = -1, kind = 0;
        if (k < 96) { zc = ZWL + k; kind = 1; } else if (k >= 128 && k < 224) { zc = ZAL + k - 128; kind = 2; } else if (k >= 256) { zc = ZGL + k - 256; kind = 3; }
        const int zcc = zc >= 0 ? zc : 0; const float muv = zc >= 0 ? mu[zc - 2048] : 0.f;
        for (int row0 = blockIdx.x * 4; row0 < MROWS; row0 += G * 4) {
            float z[4], zp[4];
#pragma unroll
            for (int u = 0; u < 4; ++u) { const int row = row0 + u;
                int prow; if (row >= MX) prow = row > MX ? row - 1 : -1; else prow = (row & (SEQ - 1)) ? row - 1 : MX + NMETA - 1;
                z[u] = bf2f(Z[(size_t)row * ZLD + zcc]); zp[u] = bf2f(Z[(size_t)(prow >= 0 ? prow : row) * ZLD + zcc]); if (prow < 0) zp[u] = 0.f; }
#pragma unroll
            for (int u = 0; u < 4; ++u) { const float sh = z[u] + (zp[u] - z[u]) * muv;
                float v = kind == 1 ? tanhf(sh) : (kind == 2 ? sh : sigmoidf_(sh)); if (zc < 0) v = 0.f;
                LA[(size_t)(row0 + u) * 512 + k] = (bf16_t)f2bf(v); }
        }
    }
}

__device__ __forceinline__ float vmul(float a, float b) { float d; asm("v_mul_f32 %0, %1, %2" : "=v"(d) : "v"(a), "v"(b)); return d; }
__device__ __forceinline__ float vfma(float a, float b, float c) { float d; asm("v_fma_f32 %0, %1, %2, %3" : "=v"(d) : "v"(a), "v"(b), "v"(c)); return d; }
__device__ __forceinline__ float vfnma(float a, float b, float c) { float d; asm("v_fma_f32 %0, -%1, %2, %3" : "=v"(d) : "v"(a), "v"(b), "v"(c)); return d; }
struct RwkvRegs { u32x2 zr, zk, zv, pr, pk, pv, dec, a, g; };
__device__ __forceinline__ void rwkv_load(RwkvRegs& R, const bf16_t* Z, const bf16_t* WAG, int b, int h, int pos, int j4, f32x4 w0v, f32x4 a0v) {
    const u32x2 z0 = {0u, 0u};
    if (pos < LSEQ) { const int row = rowof(b, pos); const bf16_t* zp = Z + (size_t)row * ZLD + h * 64 + j4;
        R.zr = *(const u32x2*)(zp + ZR); R.zk = *(const u32x2*)(zp + ZK); R.zv = *(const u32x2*)(zp + ZV);
        if (pos > 0) { const bf16_t* pp = Z + (size_t)rowof(b, pos - 1) * ZLD + h * 64 + j4; R.pr = *(const u32x2*)(pp + ZR); R.pk = *(const u32x2*)(pp + ZK); R.pv = *(const u32x2*)(pp + ZV); }
        else { R.pr = z0; R.pk = z0; R.pv = z0; }
        const bf16_t* wp = WAG + (size_t)row * WAGLD + h * 64 + j4; R.dec = *(const u32x2*)wp; R.a = *(const u32x2*)(wp + 2048); R.g = *(const u32x2*)(wp + 4096);

    } else { R.zr = z0; R.zk = z0; R.zv = z0; R.pr = z0; R.pk = z0; R.pv = z0; R.dec = z0; R.a = z0; R.g = z0; }
}
__device__ __forceinline__ f32x4 unpack4(u32x2 q) { return (f32x4){bflo(q.x), bfhi(q.x), bflo(q.y), bfhi(q.y)}; }
template <int MODE = 0>
__device__ __forceinline__ void phase_rwkv(const float* const (&in)[34], unsigned char* ws, LAS unsigned char* lds, int G) {
    int tid = threadIdx.x; asm volatile("" : "+v"(tid)); const int lane = tid & 63, wid = __builtin_amdgcn_readfirstlane(tid >> 6);
    const bf16_t* Z = (const bf16_t*)(ws + WS_Z); const bf16_t* WAG = (const bf16_t*)(ws + WS_WAG); bf16_t* Y = (bf16_t*)(ws + (MODE ? WS_SC : WS_Y));
    const int tt = tid >> 4, q = tid & 15, j4 = q * 4;
    const int cgi = lane & 15, rg = lane >> 4, myrow = wid * 8 + 2 * rg;
    LAS float* bonus = (LAS float*)(lds + BONUS_OFF);
    for (int chain = blockIdx.x; chain < NB * NHEAD; chain += G) {
        const int b = chain >> 5, h = chain & 31;
        const float* mu = in[8];
        const f32x4 mur = *(const f32x4*)(mu + h * 64 + j4), muk = *(const f32x4*)(mu + 2048 + h * 64 + j4), muv = *(const f32x4*)(mu + 4096 + h * 64 + j4);
        const f32x4 kk_ = *(const f32x4*)(in[14] + h * 64 + j4), ka_ = *(const f32x4*)(in[15] + h * 64 + j4), rk_ = *(const f32x4*)(in[16] + h * 64 + j4);
        const f32x4 gng = *(const f32x4*)(in[17] + h * 64 + j4), gnb = *(const f32x4*)(in[18] + h * 64 + j4);
        float S0[4], S1[4];
#pragma unroll
        for (int j = 0; j < 4; ++j) { S0[j] = 0.f; S1[j] = 0.f; }
        const f32x4 w0v = *(const f32x4*)(in[9] + h * 64 + j4), a0v = *(const f32x4*)(in[11] + h * 64 + j4);
        RwkvRegs R; rwkv_load(R, Z, WAG, b, h, tt, j4, w0v, a0v);
        const int nchunk = (LSEQ + 31) / 32;
        for (int c = 0; c < nchunk; ++c) {
            LAS float* buf = (LAS float*)(lds + (c & 1) * 65536);
            LAS float* bon = bonus + (c & 1) * 96;
            {
                const f32x4 zr = unpack4(R.zr), zk = unpack4(R.zk), zv = unpack4(R.zv), pr = unpack4(R.pr), pk = unpack4(R.pk), pv = unpack4(R.pv);
                f32x4 dec = unpack4(R.dec) + w0v, av = unpack4(R.a) + a0v;
#pragma unroll
                for (int e = 0; e < 4; ++e) { dec[e] = decay_of(dec[e]); av[e] = sigmoidf_(av[e]); }
                const f32x4 r = zr + (pr - zr) * mur, k = zk + (pk - zk) * muk, v = zv + (pv - zv) * muv;
                const f32x4 kr = k * kk_;
                const float ss = sum16((kr[0] * kr[0] + kr[1] * kr[1]) + (kr[2] * kr[2] + kr[3] * kr[3]));
                const float inrm = rsqrtf(fmaxf(ss, 1e-24f));
                const f32x4 kk = kr * inrm;
                const f32x4 km = k * (1.0f + (av - 1.0f) * ka_);
                const f32x4 kka = kk * av;
                const f32x4 rb = r * km * rk_;
                const float bs = sum16((rb[0] + rb[1]) + (rb[2] + rb[3]));
                const f32x4 rka = r * kka, rkm = r * km;
                const float c1 = sum16((rka[0] + rka[1]) + (rka[2] + rka[3])), c2 = sum16((rkm[0] + rkm[1]) + (rkm[2] + rkm[3]));
                const int o = tt * 64 + j4;
                *(LAS f32x4*)(buf + 0 * 2048 + o) = r * dec; *(LAS f32x4*)(buf + 1 * 2048 + o) = dec; *(LAS f32x4*)(buf + 2 * 2048 + o) = km; *(LAS f32x4*)(buf + 3 * 2048 + o) = v;
                *(LAS f32x4*)(buf + 4 * 2048 + o) = kk; *(LAS f32x4*)(buf + 5 * 2048 + o) = kka; *(LAS f32x4*)(buf + 6 * 2048 + o) = unpack4(R.g);
                if (q == 0) { bon[tt] = bs; bon[32 + tt] = c1; bon[64 + tt] = c2; }
            }
            __syncthreads();
            if (c + 1 < nchunk) rwkv_load(R, Z, WAG, b, h, (c + 1) * 32 + tt, j4, w0v, a0v);
            const int nst = (LSEQ - c * 32) < 32 ? (LSEQ - c * 32) : 32;
            {   const LAS float* p = buf + cgi * 4;
                const LAS float* pv = buf + 3 * 2048 + myrow;
                LAS float* py = buf + 7 * 2048 + myrow;
#define RW_LOAD(r4, d4, m4, k4, a4, v2, cc, T) do { const LAS float* q_ = p + (T) * 64; r4 = *(const LAS f32x4*)(q_); d4 = *(const LAS f32x4*)(q_ + 2048); m4 = *(const LAS f32x4*)(q_ + 4096); \
        k4 = *(const LAS f32x4*)(q_ + 8192); a4 = *(const LAS f32x4*)(q_ + 10240); v2 = *(const LAS f32x2*)(pv + (T) * 64); cc = (f32x2){bon[32 + (T)], bon[64 + (T)]}; } while (0)
#define RW_DPP4(ctrl) "v_add_f32_dpp %0, %0, %0 " ctrl " row_mask:0xf bank_mask:0xf bound_ctrl:1\n\tv_add_f32_dpp %1, %1, %1 " ctrl " row_mask:0xf bank_mask:0xf bound_ctrl:1\n\t" \
                      "v_add_f32_dpp %2, %2, %2 " ctrl " row_mask:0xf bank_mask:0xf bound_ctrl:1\n\tv_add_f32_dpp %3, %3, %3 " ctrl " row_mask:0xf bank_mask:0xf bound_ctrl:1\n\t"
#define RW_STEP(r4, d4, m4, k4, a4, v2, cc, T) do { \
        float e0 = vmul(S0[0], k4[0]), e1 = vmul(S1[0], k4[0]), e2 = vmul(S0[0], r4[0]), e3 = vmul(S1[0], r4[0]);     \
        float w00 = vmul(S0[0], d4[0]), w10 = vmul(S1[0], d4[0]); \
        e0 = vfma(S0[1], k4[1], e0); e1 = vfma(S1[1], k4[1], e1); e2 = vfma(S0[1], r4[1], e2); e3 = vfma(S1[1], r4[1], e3); \
        float w01 = vmul(S0[1], d4[1]), w11 = vmul(S1[1], d4[1]); \
        e0 = vfma(S0[2], k4[2], e0); e1 = vfma(S1[2], k4[2], e1); e2 = vfma(S0[2], r4[2], e2); e3 = vfma(S1[2], r4[2], e3); \
        float w02 = vmul(S0[2], d4[2]), w12 = vmul(S1[2], d4[2]); \
        e0 = vfma(S0[3], k4[3], e0); e1 = vfma(S1[3], k4[3], e1); e2 = vfma(S0[3], r4[3], e2); e3 = vfma(S1[3], r4[3], e3); \
        float w03 = vmul(S0[3], d4[3]), w13 = vmul(S1[3], d4[3]); \
        w00 = vfma(v2[0], m4[0], w00); w10 = vfma(v2[1], m4[0], w10); w01 = vfma(v2[0], m4[1], w01); w11 = vfma(v2[1], m4[1], w11); \
        w02 = vfma(v2[0], m4[2], w02); w12 = vfma(v2[1], m4[2], w12); w03 = vfma(v2[0], m4[3], w03); w13 = vfma(v2[1], m4[3], w13); \
        asm volatile("s_nop 1\n\t" RW_DPP4("quad_perm:[1,0,3,2]") RW_DPP4("quad_perm:[2,3,0,1]") RW_DPP4("row_half_mirror") RW_DPP4("row_mirror") : "+v"(e0), "+v"(e1), "+v"(e2), "+v"(e3)); \
        S0[0] = vfnma(e0, a4[0], w00); S1[0] = vfnma(e1, a4[0], w10); S0[1] = vfnma(e0, a4[1], w01); S1[1] = vfnma(e1, a4[1], w11); \
        S0[2] = vfnma(e0, a4[2], w02); S1[2] = vfnma(e1, a4[2], w12); S0[3] = vfnma(e0, a4[3], w03); S1[3] = vfnma(e1, a4[3], w13); \
        if (cgi == 0) { const float y0 = vfnma(e0, cc[0], vfma(v2[0], cc[1], e2)), y1 = vfnma(e1, cc[0], vfma(v2[1], cc[1], e3)); *(LAS f32x2*)(py + (T) * 64) = (f32x2){y0, y1}; } } while (0)
                f32x4 Ar, Ad, Am, Ak, Aa, Br, Bd, Bm, Bk, Ba; f32x2 Av, Bv, Ac, Bc;
                RW_LOAD(Ar, Ad, Am, Ak, Aa, Av, Ac, 0);
                for (int t = 0; t < (MODE == 1 ? 0 : nst); t += 2) {
                    RW_LOAD(Br, Bd, Bm, Bk, Ba, Bv, Bc, t + 1);
                    __builtin_amdgcn_sched_barrier(0);
                    RW_STEP(Ar, Ad, Am, Ak, Aa, Av, Ac, t);
                    __builtin_amdgcn_sched_barrier(0);
                    RW_LOAD(Ar, Ad, Am, Ak, Aa, Av, Ac, (t + 2) & 31);
                    __builtin_amdgcn_sched_barrier(0);
                    RW_STEP(Br, Bd, Bm, Bk, Ba, Bv, Bc, t + 1);
                    __builtin_amdgcn_sched_barrier(0);
                }
#undef RW_LOAD
#undef RW_STEP
#undef RW_DPP4
            }
            __syncthreads();
            {
                const int pos = c * 32 + tt;
                const int o = tt * 64 + j4;
                const f32x4 y = *(const LAS f32x4*)(buf + 7 * 2048 + o), v = *(const LAS f32x4*)(buf + 3 * 2048 + o), g = *(const LAS f32x4*)(buf + 6 * 2048 + o);
                const float mean = sum16((y[0] + y[1]) + (y[2] + y[3])) * (1.0f / 64.0f);
                const f32x4 dy = y - mean;
                const float var = sum16((dy[0] * dy[0] + dy[1] * dy[1]) + (dy[2] * dy[2] + dy[3] * dy[3])) * (1.0f / 64.0f);
                const float rs = rsqrtf(var + GN_EPS), bs = bon[tt];
#if (DBG_SKIP & 4)
                const f32x4 out = (f32x4){0.f, 0.f, 0.f, 0.f};
#else
                const f32x4 out = (dy * rs * gng + gnb + v * bs) * g;
#endif
                if (pos < LSEQ && (b == 0 || pos >= NMETA)) { u32x2 w; w.x = cvt_pk_bf16(out[0], out[1]); w.y = cvt_pk_bf16(out[2], out[3]);
                    *(u32x2*)(Y + (size_t)rowof(b, pos) * D + 2048 + h * 64 + j4) = w; }
            }
        }
        __syncthreads();
    }
}

__device__ __forceinline__ void phase_s5(const float* const (&in)[34], unsigned char* ws, LAS unsigned char* lds, int G) {
    int tid = threadIdx.x; asm volatile("" : "+v"(tid)); const int lane = tid & 63, wid = __builtin_amdgcn_readfirstlane(tid >> 6), fr = lane & 15, fq = lane >> 4;
    if (wid >= 2) return;
    const bf16_t* U = (const bf16_t*)(ws + WS_U); bf16_t* YS = (bf16_t*)(ws + WS_YS);
    LAS unsigned char* wl = lds + wid * 32768;
    LAS bf16_t* BB = (LAS bf16_t*)wl;
    LAS float* BU0 = (LAS float*)(wl + 4096);
    LAS unsigned char* XB = wl + 4096 + 2 * 16 * 132 * 4;
    constexpr int NCK = LSEQ / 16;
    for (int chain = blockIdx.x * 2 + wid; chain < NB * 128; chain += G * 2) {
        const int b = chain >> 7, g = chain & 127, p = lane;
        const float lr = in[21][g * 64 + p], li = in[22][g * 64 + p], dt = expf(in[23][g]);
        const float mag = expf(lr * dt); float sn, cs; sincosf(li * dt, &sn, &cs);
        const float ar = mag * cs, ai = mag * sn, den = lr * lr + li * li;
        const float f_r = ((ar - 1.0f) * lr + ai * li) / den, f_i = (ai * lr - (ar - 1.0f) * li) / den;
        {   const float* br = in[24] + (size_t)(g * 64 + p) * 16; const float* bi = in[25] + (size_t)(g * 64 + p) * 16;
            unsigned wre[8], wim[8];
#pragma unroll
            for (int c = 0; c < 16; c += 2) { const float r0 = br[c], i0 = bi[c], r1 = br[c + 1], i1 = bi[c + 1];
                wre[c >> 1] = pk2(f_r * r0 - f_i * i0, f_r * r1 - f_i * i1); wim[c >> 1] = pk2(f_r * i0 + f_i * r0, f_r * i1 + f_i * r1); }
            *(LAS u32x4*)(BB + (2 * p) * 16) = (u32x4){wre[0], wre[1], wre[2], wre[3]}; *(LAS u32x4*)(BB + (2 * p) * 16 + 8) = (u32x4){wre[4], wre[5], wre[6], wre[7]};
            *(LAS u32x4*)(BB + (2 * p + 1) * 16) = (u32x4){wim[0], wim[1], wim[2], wim[3]}; *(LAS u32x4*)(BB + (2 * p + 1) * 16 + 8) = (u32x4){wim[4], wim[5], wim[6], wim[7]};
        }
        LDS_WAIT();
        bf16x8 bop[8];
#pragma unroll
        for (int nt = 0; nt < 8; ++nt) { u32x4 z = {0u, 0u, 0u, 0u}; if (fq < 2) z = *(const LAS u32x4*)(BB + (nt * 16 + fr) * 16 + fq * 8); bop[nt] = __builtin_bit_cast(bf16x8, z); }
        bf16x8 cop[4];
#pragma unroll
        for (int ks = 0; ks < 4; ++ks) { const size_t o = (size_t)(g * 16 + fr) * 64 + ks * 16 + fq * 4;
            const f32x4 cr = *(const f32x4*)(in[26] + o), ci = *(const f32x4*)(in[27] + o);
            u32x4 w; w.x = pk2(cr[0], -ci[0]); w.y = pk2(cr[1], -ci[1]); w.z = pk2(cr[2], -ci[2]); w.w = pk2(cr[3], -ci[3]); cop[ks] = __builtin_bit_cast(bf16x8, w); }
        const f32x4 dsk = *(const f32x4*)(in[28] + g * 16 + 4 * fq);
        float xr = 0.f, xi = 0.f;
        u32x4 uz1 = {0u, 0u, 0u, 0u}, uz2 = {0u, 0u, 0u, 0u}; u32x2 usk0, usk1, usk2, uskp = {0u, 0u}; f32x4 ya = {0.f, 0.f, 0.f, 0.f}, yb = {0.f, 0.f, 0.f, 0.f};
        {
            const bf16_t* ur0 = U + (size_t)rowof(b, fr) * 2048 + g * 16; u32x4 uz0 = {0u, 0u, 0u, 0u}; if (fq < 2) uz0 = *(const u32x4*)(ur0 + fq * 8); usk0 = *(const u32x2*)(ur0 + 4 * fq);
            const bf16_t* ur1 = U + (size_t)rowof(b, 16 + fr) * 2048 + g * 16; if (fq < 2) uz1 = *(const u32x4*)(ur1 + fq * 8); usk1 = *(const u32x2*)(ur1 + 4 * fq);
            const bf16x8 uop = __builtin_bit_cast(bf16x8, uz0);
#pragma unroll
            for (int nt = 0; nt < 8; ++nt) { const f32x4 acc = __builtin_amdgcn_mfma_f32_16x16x32_bf16(uop, bop[nt], (f32x4){0.f, 0.f, 0.f, 0.f}, 0, 0, 0);
#pragma unroll
                for (int i = 0; i < 4; ++i) BU0[(4 * fq + i) * 132 + nt * 16 + fr] = acc[i]; }
            LDS_WAIT();
        }
#pragma unroll 1
        for (int ck = 0; ck < NCK; ++ck) {
            LAS float* BUc = BU0 + (ck & 1) * (16 * 132); LAS float* BUn = BU0 + ((ck + 1) & 1) * (16 * 132);
            usk2 = usk1;
            if (ck + 2 < NCK) { const bf16_t* ur = U + (size_t)rowof(b, (ck + 2) * 16 + fr) * 2048 + g * 16; if (fq < 2) uz2 = *(const u32x4*)(ur + fq * 8); usk2 = *(const u32x2*)(ur + 4 * fq); }
            f32x2 bu[16];
#pragma unroll
            for (int t = 0; t < 16; ++t) bu[t] = *(const LAS f32x2*)(BUc + t * 132 + 2 * p);
            if (ck > 0) {
                const int pos = (ck - 1) * 16 + fr;
                f32x4 yv = (ya + yb) + unpack4(uskp) * dsk;
                yv[0] = gelu_erf_fast(yv[0]); yv[1] = gelu_erf_fast(yv[1]); yv[2] = gelu_erf_fast(yv[2]); yv[3] = gelu_erf_fast(yv[3]);
                if (b == 0 || pos >= NMETA) { u32x2 o; o.x = cvt_pk_bf16(yv[0], yv[1]); o.y = cvt_pk_bf16(yv[2], yv[3]); *(u32x2*)(YS + (size_t)rowof(b, pos) * 2048 + g * 16 + 4 * fq) = o; }
            }
            f32x4 accn[8];
            const bf16x8 uop = __builtin_bit_cast(bf16x8, uz1);
            __builtin_amdgcn_sched_barrier(0);
#pragma unroll
            for (int t = 0; t < 16; ++t) { const float nr = vfma(ar, xr, vfnma(ai, xi, bu[t][0])), ni = vfma(ar, xi, vfma(ai, xr, bu[t][1])); xr = nr; xi = ni;
                *(LAS unsigned*)(XB + t * 272 + p * 4) = cvt_pk_bf16(nr, ni);
                if (t & 1) accn[t >> 1] = __builtin_amdgcn_mfma_f32_16x16x32_bf16(uop, bop[t >> 1], (f32x4){0.f, 0.f, 0.f, 0.f}, 0, 0, 0);
                __builtin_amdgcn_sched_barrier(0); }
            if (ck + 1 < NCK) {
#pragma unroll
                for (int nt = 0; nt < 8; ++nt) {
#pragma unroll
                    for (int i = 0; i < 4; ++i) BUn[(4 * fq + i) * 132 + nt * 16 + fr] = accn[nt][i]; } }
            LDS_WAIT();
            { const bf16x8 x0 = *(const LAS bf16x8*)(XB + fr * 272 + 0 * 64 + fq * 16), x1 = *(const LAS bf16x8*)(XB + fr * 272 + 1 * 64 + fq * 16);
              const bf16x8 x2 = *(const LAS bf16x8*)(XB + fr * 272 + 2 * 64 + fq * 16), x3 = *(const LAS bf16x8*)(XB + fr * 272 + 3 * 64 + fq * 16);
              ya = __builtin_amdgcn_mfma_f32_16x16x32_bf16(cop[0], x0, (f32x4){0.f, 0.f, 0.f, 0.f}, 0, 0, 0); yb = __builtin_amdgcn_mfma_f32_16x16x32_bf16(cop[1], x1, (f32x4){0.f, 0.f, 0.f, 0.f}, 0, 0, 0);
              ya = __builtin_amdgcn_mfma_f32_16x16x32_bf16(cop[2], x2, ya, 0, 0, 0); yb = __builtin_amdgcn_mfma_f32_16x16x32_bf16(cop[3], x3, yb, 0, 0, 0); }
            LDS_WAIT();
            uskp = usk0; usk0 = usk1; usk1 = usk2; uz1 = uz2;
        }
        {
            const int pos = (NCK - 1) * 16 + fr;
            f32x4 yv = (ya + yb) + unpack4(uskp) * dsk;
            yv[0] = gelu_erf_fast(yv[0]); yv[1] = gelu_erf_fast(yv[1]); yv[2] = gelu_erf_fast(yv[2]); yv[3] = gelu_erf_fast(yv[3]);
            if (b == 0 || pos >= NMETA) { u32x2 o; o.x = cvt_pk_bf16(yv[0], yv[1]); o.y = cvt_pk_bf16(yv[2], yv[3]); *(u32x2*)(YS + (size_t)rowof(b, pos) * 2048 + g * 16 + 4 * fq) = o; }
        }
    }
}

#define S5_SPIN(ptr, need) do { while ((int)(*(volatile LAS unsigned*)(ptr)) < (int)(need)) __builtin_amdgcn_s_sleep(1); } while (0)
__device__ __forceinline__ void phase_s5p(const float* const (&in)[34], unsigned char* ws, LAS unsigned char* lds, int G) {
    int tid = threadIdx.x; asm volatile("" : "+v"(tid)); const int lane = tid & 63, wid = __builtin_amdgcn_readfirstlane(tid >> 6), fr = lane & 15, fq = lane >> 4;
    if (tid < 4) *(volatile LAS unsigned*)(lds + (tid >> 1) * 32768 + 29696 + (tid & 1) * 4) = 0u;
    __syncthreads();
    if (wid >= 4) return;
    const int slot = wid & 1; const bool producer = wid < 2;
    const bf16_t* U = (const bf16_t*)(ws + WS_U); bf16_t* YS = (bf16_t*)(ws + WS_YS);
    LAS unsigned char* wl = lds + slot * 32768;
    LAS bf16_t* BB = (LAS bf16_t*)wl;
    LAS float* BU0 = (LAS float*)(wl + 4096);
    LAS unsigned char* XB0 = wl + 4096 + 2 * 16 * 132 * 4;
    LAS unsigned char* fprod = wl + 29696; LAS unsigned char* fcons = wl + 29700;
    constexpr int NCK = LSEQ / 16;
    int base = 0;
    for (int chain = blockIdx.x * 2 + slot; chain < NB * 128; chain += G * 2, base += NCK) {
        const int b = chain >> 7, g = chain & 127, p = lane;
        if (producer) {
            const float lr = in[21][g * 64 + p], li = in[22][g * 64 + p], dt = expf(in[23][g]);
            const float mag = expf(lr * dt); float sn, cs; sincosf(li * dt, &sn, &cs);
            const float ar = mag * cs, ai = mag * sn, den = lr * lr + li * li;
            const float f_r = ((ar - 1.0f) * lr + ai * li) / den, f_i = (ai * lr - (ar - 1.0f) * li) / den;
            {   const float* br = in[24] + (size_t)(g * 64 + p) * 16; const float* bi = in[25] + (size_t)(g * 64 + p) * 16;
                unsigned wre[8], wim[8];
#pragma unroll
                for (int c = 0; c < 16; c += 2) { const float r0 = br[c], i0 = bi[c], r1 = br[c + 1], i1 = bi[c + 1];
                    wre[c >> 1] = pk2(f_r * r0 - f_i * i0, f_r * r1 - f_i * i1); wim[c >> 1] = pk2(f_r * i0 + f_i * r0, f_r * i1 + f_i * r1); }
                *(LAS u32x4*)(BB + (2 * p) * 16) = (u32x4){wre[0], wre[1], wre[2], wre[3]}; *(LAS u32x4*)(BB + (2 * p) * 16 + 8) = (u32x4){wre[4], wre[5], wre[6], wre[7]};
                *(LAS u32x4*)(BB + (2 * p + 1) * 16) = (u32x4){wim[0], wim[1], wim[2], wim[3]}; *(LAS u32x4*)(BB + (2 * p + 1) * 16 + 8) = (u32x4){wim[4], wim[5], wim[6], wim[7]};
            }
            LDS_WAIT();
            bf16x8 bop[8];
#pragma unroll
            for (int nt = 0; nt < 8; ++nt) { u32x4 z = {0u, 0u, 0u, 0u}; if (fq < 2) z = *(const LAS u32x4*)(BB + (nt * 16 + fr) * 16 + fq * 8); bop[nt] = __builtin_bit_cast(bf16x8, z); }
            float xr = 0.f, xi = 0.f;
            u32x4 uz1 = {0u, 0u, 0u, 0u}, uz2 = {0u, 0u, 0u, 0u};
            {   const bf16_t* ur0 = U + (size_t)rowof(b, fr) * 2048 + g * 16; u32x4 uz0 = {0u, 0u, 0u, 0u}; if (fq < 2) uz0 = *(const u32x4*)(ur0 + fq * 8);
                const bf16_t* ur1 = U + (size_t)rowof(b, 16 + fr) * 2048 + g * 16; if (fq < 2) uz1 = *(const u32x4*)(ur1 + fq * 8);
                const bf16x8 uop = __builtin_bit_cast(bf16x8, uz0);
#pragma unroll
                for (int nt = 0; nt < 8; ++nt) { const f32x4 acc = __builtin_amdgcn_mfma_f32_16x16x32_bf16(uop, bop[nt], (f32x4){0.f, 0.f, 0.f, 0.f}, 0, 0, 0);
#pragma unroll
                    for (int i = 0; i < 4; ++i) BU0[(4 * fq + i) * 132 + nt * 16 + fr] = acc[i]; }
                LDS_WAIT();
            }
#pragma unroll 1
            for (int ck = 0; ck < NCK; ++ck) {
                LAS float* BUc = BU0 + (ck & 1) * (16 * 132); LAS float* BUn = BU0 + ((ck + 1) & 1) * (16 * 132); LAS unsigned char* XB = XB0 + (ck & 1) * 4352;
                { const int pc = ck + 2 < NCK ? ck + 2 : ck; const bf16_t* ur = U + (size_t)rowof(b, pc * 16 + fr) * 2048 + g * 16; if (fq < 2) uz2 = *(const u32x4*)(ur + fq * 8); }
                f32x2 bu[16];
#pragma unroll
                for (int t = 0; t < 16; ++t) bu[t] = *(const LAS f32x2*)(BUc + t * 132 + 2 * p);
                if (ck >= 2) S5_SPIN(fcons, base + ck - 1);
                f32x4 accn[8];
                const bf16x8 uop = __builtin_bit_cast(bf16x8, uz1);
                __builtin_amdgcn_sched_barrier(0);
#pragma unroll
                for (int t = 0; t < 16; ++t) { const float nr = vfma(ar, xr, vfnma(ai, xi, bu[t][0])), ni = vfma(ar, xi, vfma(ai, xr, bu[t][1])); xr = nr; xi = ni;
                    *(LAS unsigned*)(XB + t * 272 + p * 4) = cvt_pk_bf16(nr, ni);
                    if (t & 1) accn[t >> 1] = __builtin_amdgcn_mfma_f32_16x16x32_bf16(uop, bop[t >> 1], (f32x4){0.f, 0.f, 0.f, 0.f}, 0, 0, 0);
                    __builtin_amdgcn_sched_barrier(0); }
                if (ck + 1 < NCK) {
#pragma unroll
                    for (int nt = 0; nt < 8; ++nt) {
#pragma unroll
                        for (int i = 0; i < 4; ++i) BUn[(4 * fq + i) * 132 + nt * 16 + fr] = accn[nt][i]; } }
                LDS_WAIT();
                *(volatile LAS unsigned*)fprod = (unsigned)(base + ck + 1);
                uz1 = uz2;
            }
        } else {
            bf16x8 cop[4];
#pragma unroll
            for (int ks = 0; ks < 4; ++ks) { const size_t o = (size_t)(g * 16 + fr) * 64 + ks * 16 + fq * 4;
                const f32x4 cr = *(const f32x4*)(in[26] + o), ci = *(const f32x4*)(in[27] + o);
                u32x4 w; w.x = pk2(cr[0], -ci[0]); w.y = pk2(cr[1], -ci[1]); w.z = pk2(cr[2], -ci[2]); w.w = pk2(cr[3], -ci[3]); cop[ks] = __builtin_bit_cast(bf16x8, w); }
            const f32x4 dsk = *(const f32x4*)(in[28] + g * 16 + 4 * fq);
            u32x2 uskn = *(const u32x2*)(U + (size_t)rowof(b, fr) * 2048 + g * 16 + 4 * fq);
#pragma unroll 1
            for (int ck = 0; ck < NCK; ++ck) {
                const u32x2 usk = uskn;
                { const int pc = ck + 1 < NCK ? ck + 1 : ck; uskn = *(const u32x2*)(U + (size_t)rowof(b, pc * 16 + fr) * 2048 + g * 16 + 4 * fq); }
                S5_SPIN(fprod, base + ck + 1);
                LAS unsigned char* XB = XB0 + (ck & 1) * 4352;
                const bf16x8 x0 = *(const LAS bf16x8*)(XB + fr * 272 + 0 * 64 + fq * 16), x1 = *(const LAS bf16x8*)(XB + fr * 272 + 1 * 64 + fq * 16);
                const bf16x8 x2 = *(const LAS bf16x8*)(XB + fr * 272 + 2 * 64 + fq * 16), x3 = *(const LAS bf16x8*)(XB + fr * 272 + 3 * 64 + fq * 16);
                LDS_WAIT();
                *(volatile LAS unsigned*)fcons = (unsigned)(base + ck + 1);
                f32x4 ya = __builtin_amdgcn_mfma_f32_16x16x32_bf16(cop[0], x0, (f32x4){0.f, 0.f, 0.f, 0.f}, 0, 0, 0), yb = __builtin_amdgcn_mfma_f32_16x16x32_bf16(cop[1], x1, (f32x4){0.f, 0.f, 0.f, 0.f}, 0, 0, 0);
                ya = __builtin_amdgcn_mfma_f32_16x16x32_bf16(cop[2], x2, ya, 0, 0, 0); yb = __builtin_amdgcn_mfma_f32_16x16x32_bf16(cop[3], x3, yb, 0, 0, 0);
                const int pos = ck * 16 + fr;
                f32x4 yv = (ya + yb) + unpack4(usk) * dsk;
                yv[0] = gelu_erf_fast(yv[0]); yv[1] = gelu_erf_fast(yv[1]); yv[2] = gelu_erf_fast(yv[2]); yv[3] = gelu_erf_fast(yv[3]);
                if (b == 0 || pos >= NMETA) { u32x2 o; o.x = cvt_pk_bf16(yv[0], yv[1]); o.y = cvt_pk_bf16(yv[2], yv[3]); *(u32x2*)(YS + (size_t)rowof(b, pos) * 2048 + g * 16 + 4 * fq) = o; }
            }
        }
    }
}

__device__ __forceinline__ unsigned ordkey(float v) { const unsigned u = __builtin_bit_cast(unsigned, v); return (u & 0x80000000u) ? ~u : (u | 0x80000000u); }
__device__ __forceinline__ float unord(unsigned k) { const unsigned u = (k & 0x80000000u) ? (k & 0x7fffffffu) : ~k; return __builtin_bit_cast(float, u); }
#ifndef EXP_UR
#define EXP_UR 4
#endif
#ifndef EXP_VR
#define EXP_VR 4
#endif
constexpr int UR = EXP_UR, VR = EXP_VR;
template <bool FINAL, bool DRY = false>
__device__ __forceinline__ void phase_expert(const float* fgain, float* out, unsigned char* ws, LAS unsigned char* lds, int layer, int G) {
    int tid = threadIdx.x; asm volatile("" : "+v"(tid)); const int lane = tid & 63, wid = __builtin_amdgcn_readfirstlane(tid >> 6);
    const float* SC = (const float*)(ws + WS_SC); float* H = (float*)(ws + WS_H); bf16_t* HB = (bf16_t*)(ws + WS_HB);
    const unsigned char* PU = ws + WS_PU + (size_t)layer * NEXP * D; const unsigned char* PV = ws + WS_PV + (size_t)layer * NEXP * D;
    const float* SU = (const float*)(ws + WS_SU) + layer * NEXP; const float* SV = (const float*)(ws + WS_SV) + layer * NEXP;
    LAS float* part = (LAS float*)lds;
    LAS float* red = (LAS float*)(lds + RED_OFF);
    for (int tok = blockIdx.x; tok < MROWS; tok += G) {
        const float* sc = SC + (size_t)tok * 2048 + wid * 256;
        float s12[2]; int i12[2];
#pragma unroll
        for (int hf = 0; hf < 2; ++hf) {
            const float v0 = sc[hf * 128 + lane], v1 = sc[hf * 128 + 64 + lane];
            unsigned k0 = (ordkey(v0) & ~127u) | (unsigned)(127 - lane), k1 = (ordkey(v1) & ~127u) | (unsigned)(63 - lane);
            float sv = 0.f; int si = 0;
#pragma unroll 1
            for (int k = 0; k < 16; ++k) { const unsigned w = max64u(umax_u(k0, k1)); if (lane == k) { sv = unord(w & ~127u); si = 127 - (int)(w & 127u); } if (k0 == w) k0 = 0u; if (k1 == w) k1 = 0u; }
            s12[hf] = sv; i12[hf] = si;
        }
        const float c1 = __shfl(s12[0], lane >> 2);
        unsigned ck[4];
#pragma unroll
        for (int jj = 0; jj < 4; ++jj) { const int j = (lane & 3) * 4 + jj; const float c2 = __shfl(s12[1], j); ck[jj] = (ordkey(c1 + c2) & ~255u) | (unsigned)(255 - ((lane >> 2) * 16 + j)); }
        float ts = 0.f; int tp = 0;
#pragma unroll 1
        for (int k = 0; k < 16; ++k) { const unsigned w = max64u(umax_u(umax_u(ck[0], ck[1]), umax_u(ck[2], ck[3]))); if (lane == k) { ts = unord(w & ~255u); tp = 255 - (int)(w & 255u); }
#pragma unroll
            for (int jj = 0; jj < 4; ++jj) if (ck[jj] == w) ck[jj] = 0u; }
        const int e1 = __shfl(i12[0], tp >> 4), e2 = __shfl(i12[1], tp & 15);
        const int eid = e1 * 128 + e2;
        float mx = ts; mx = fmaxf(mx, dppf<DPP_XOR1>(mx)); mx = fmaxf(mx, dppf<DPP_XOR2>(mx)); mx = fmaxf(mx, dppf<DPP_HMIRROR>(mx)); mx = fmaxf(mx, dppf<DPP_MIRROR>(mx));
        const float ex = __expf(ts - mx), gate = ex / sum16(ex);
        float su = 0.f, sv = 0.f; if (lane < 16) { su = SU[eid]; sv = SV[eid]; }
        float hbf[4][16];
#pragma unroll
        for (int j = 0; j < 4; ++j) { const u32x4* hp8 = (const u32x4*)(HB + (size_t)tok * D + j * 1024 + 16 * lane); const u32x4 h0 = hp8[0], h1 = hp8[1];
            hbf[j][0] = bflo(h0.x); hbf[j][1] = bfhi(h0.x); hbf[j][2] = bflo(h0.y); hbf[j][3] = bfhi(h0.y); hbf[j][4] = bflo(h0.z); hbf[j][5] = bfhi(h0.z); hbf[j][6] = bflo(h0.w); hbf[j][7] = bfhi(h0.w);
            hbf[j][8] = bflo(h1.x); hbf[j][9] = bfhi(h1.x); hbf[j][10] = bflo(h1.y); hbf[j][11] = bfhi(h1.y); hbf[j][12] = bflo(h1.z); hbf[j][13] = bfhi(h1.z); hbf[j][14] = bflo(h1.w); hbf[j][15] = bfhi(h1.w); }
        float wgt = 0.f;
        {   u32x4 rb[UR][4];
#pragma unroll
            for (int kk = 0; kk < UR; ++kk) { const int e = __builtin_amdgcn_readlane(eid, kk); const u32x4* up = (const u32x4*)(PU + (size_t)e * D) + lane;
#pragma unroll
                for (int j = 0; j < 4; ++j) rb[kk][j] = up[64 * j]; }
#pragma unroll 1
            for (int k4 = 0; k4 < 16; k4 += UR) {
#pragma unroll
                for (int kk = 0; kk < UR; ++kk) { float d0 = 0.f, d1 = 0.f;
#pragma unroll
                    for (int j = 0; j < 4; ++j) { const unsigned wv[4] = {rb[kk][j].x, rb[kk][j].y, rb[kk][j].z, rb[kk][j].w};
#pragma unroll
                        for (int q = 0; q < 4; ++q) { const f32x2 lo = __builtin_amdgcn_cvt_pk_f32_fp8((int)wv[q], false), hi = __builtin_amdgcn_cvt_pk_f32_fp8((int)wv[q], true);
                            d0 = fmaf(lo.x, hbf[j][4 * q + 0], d0); d1 = fmaf(lo.y, hbf[j][4 * q + 1], d1); d0 = fmaf(hi.x, hbf[j][4 * q + 2], d0); d1 = fmaf(hi.y, hbf[j][4 * q + 3], d1); } }
                    __builtin_amdgcn_sched_barrier(0);
                    if (k4 + UR < 16) { const int e = __builtin_amdgcn_readlane(eid, k4 + UR + kk); const u32x4* up = (const u32x4*)(PU + (size_t)e * D) + lane;
#pragma unroll
                        for (int j = 0; j < 4; ++j) rb[kk][j] = up[64 * j]; }
                    const float dt = sum64(d0 + d1);
                    if (lane == k4 + kk) wgt = gate * gelu_erf(dt * su) * sv;
                    __builtin_amdgcn_sched_barrier(0); }
            }
        }
        float acc[4][16];
#pragma unroll
        for (int j = 0; j < 4; ++j)
#pragma unroll
            for (int e = 0; e < 16; ++e) acc[j][e] = 0.f;
        {   u32x4 rb[VR][4];
#pragma unroll
            for (int kk = 0; kk < VR; ++kk) { const int e = __builtin_amdgcn_readlane(eid, kk); const u32x4* vp = (const u32x4*)(PV + (size_t)e * D) + lane;
#pragma unroll
                for (int j = 0; j < 4; ++j) rb[kk][j] = vp[64 * j]; }
#pragma unroll 1
            for (int k4 = 0; k4 < 16; k4 += VR) {
#pragma unroll
                for (int kk = 0; kk < VR; ++kk) { const float w = __builtin_bit_cast(float, __builtin_amdgcn_readlane(__builtin_bit_cast(int, wgt), k4 + kk));
#pragma unroll
                    for (int j = 0; j < 4; ++j) { const unsigned wv[4] = {rb[kk][j].x, rb[kk][j].y, rb[kk][j].z, rb[kk][j].w};
#pragma unroll
                        for (int q = 0; q < 4; ++q) { const f32x2 lo = __builtin_amdgcn_cvt_pk_f32_fp8((int)wv[q], false), hi = __builtin_amdgcn_cvt_pk_f32_fp8((int)wv[q], true);
                            acc[j][4 * q + 0] = fmaf(w, lo.x, acc[j][4 * q + 0]); acc[j][4 * q + 1] = fmaf(w, lo.y, acc[j][4 * q + 1]); acc[j][4 * q + 2] = fmaf(w, hi.x, acc[j][4 * q + 2]); acc[j][4 * q + 3] = fmaf(w, hi.y, acc[j][4 * q + 3]); } }
                    __builtin_amdgcn_sched_barrier(0);
                    if (k4 + VR < 16) { const int e = __builtin_amdgcn_readlane(eid, k4 + VR + kk); const u32x4* vp = (const u32x4*)(PV + (size_t)e * D) + lane;
#pragma unroll
                        for (int j = 0; j < 4; ++j) rb[kk][j] = vp[64 * j]; }
                    __builtin_amdgcn_sched_barrier(0); }
            }
        }
#pragma unroll
        for (int j = 0; j < 4; ++j)
#pragma unroll
            for (int q = 0; q < 4; ++q) *(LAS f32x4*)(part + ((wid * 16 + j * 4 + q) * 64 + lane) * 4) = (f32x4){acc[j][4 * q + 0], acc[j][4 * q + 1], acc[j][4 * q + 2], acc[j][4 * q + 3]};
        __syncthreads();
        {   f32x4 a = (f32x4){0.f, 0.f, 0.f, 0.f}, c = a;
            const int pj = tid >> 7, pl = (tid >> 1) & 63, pq = (tid & 1) * 2;
#pragma unroll
            for (int w = 0; w < 8; ++w) { a = a + *(const LAS f32x4*)(part + ((w * 16 + pj * 4 + pq) * 64 + pl) * 4); c = c + *(const LAS f32x4*)(part + ((w * 16 + pj * 4 + pq + 1) * 64 + pl) * 4); }
            f32x4* hp = (f32x4*)(H + (size_t)tok * D + 8 * tid);
#if (DBG_SKIP & 1)
            a = hp[0]; c = hp[1];
#elif (DBG_SKIP & 8)
            a = a * 0.5f + hp[0]; c = c * 0.5f + hp[1];
#else
            a = a + hp[0]; c = c + hp[1];
#endif
            if (!FINAL && !DRY) { hp[0] = a; hp[1] = c; }
            float ss = (a[0] * a[0] + a[1] * a[1]) + (a[2] * a[2] + a[3] * a[3]) + (c[0] * c[0] + c[1] * c[1]) + (c[2] * c[2] + c[3] * c[3]);
            ss = sum64(ss);
            if (lane == 0) red[wid] = ss;
            __syncthreads();
            float tot = 0.f;
#pragma unroll
            for (int w = 0; w < 8; ++w) tot += red[w];
            const float inv = rsqrtf(tot * (1.0f / D) + NORM_EPS);
            if (DRY) { if (inv == 123.456f) red[9] = inv; }
            else if (!FINAL) { u32x4 o; o.x = cvt_pk_bf16(a[0] * inv, a[1] * inv); o.y = cvt_pk_bf16(a[2] * inv, a[3] * inv); o.z = cvt_pk_bf16(c[0] * inv, c[1] * inv); o.w = cvt_pk_bf16(c[2] * inv, c[3] * inv);
                *(u32x4*)(HB + (size_t)tok * D + 8 * tid) = o; }
            else if (tok < MX) { const f32x4 g0 = *(const f32x4*)(fgain + 8 * tid), g1 = *(const f32x4*)(fgain + 8 * tid + 4);
                f32x4* op = (f32x4*)(out + (size_t)tok * D + 8 * tid); op[0] = a * inv * g0; op[1] = c * inv * g1; }
        }
        __syncthreads();
    }
}
#define PEER_DPP8(ctrl) "v_add_f32_dpp %0, %0, %0 " ctrl "\n\tv_add_f32_dpp %1, %1, %1 " ctrl "\n\tv_add_f32_dpp %2, %2, %2 " ctrl "\n\tv_add_f32_dpp %3, %3, %3 " ctrl "\n\t" \
                        "v_add_f32_dpp %4, %4, %4 " ctrl "\n\tv_add_f32_dpp %5, %5, %5 " ctrl "\n\tv_add_f32_dpp %6, %6, %6 " ctrl "\n\tv_add_f32_dpp %7, %7, %7 " ctrl "\n\t"

template <int CTRL> __device__ __forceinline__ unsigned rowmax_step(unsigned x) { const unsigned y = dppu<CTRL>(x); return x > y ? x : y; }
__device__ __forceinline__ unsigned rowmax16(unsigned x) { x = rowmax_step<DPP_XOR1>(x); x = rowmax_step<DPP_XOR2>(x); x = rowmax_step<DPP_HMIRROR>(x); x = rowmax_step<DPP_MIRROR>(x); return x; }
__device__ __forceinline__ void phase_topk(unsigned char* ws, int G) {
    int tid = threadIdx.x; asm volatile("" : "+v"(tid)); const int lane = tid & 63, wid = __builtin_amdgcn_readfirstlane(tid >> 6);
    const float* SC = (const float*)(ws + WS_SC); int* EIDL = (int*)(ws + WS_EIDL); float* GATEL = (float*)(ws + WS_GATEL);
    const int l16 = lane & 15, row = lane >> 4;
    float ca[8], cb[8];
    { const int it0 = blockIdx.x * NWAVES + wid;
      if (it0 < MROWS * 2) { const float* sc = SC + (size_t)(it0 >> 1) * 2048 + ((it0 & 1) * 4 + row) * 256 + l16;
#pragma unroll
          for (int j = 0; j < 8; ++j) { ca[j] = sc[16 * j]; cb[j] = sc[128 + 16 * j]; } } }
    for (int it = blockIdx.x * NWAVES + wid; it < MROWS * 2; it += G * NWAVES) {
        const int tok = it >> 1, h = (it & 1) * 4 + row;
        unsigned ka[8], kb[8];
#pragma unroll
        for (int j = 0; j < 8; ++j) { ka[j] = (ordkey(ca[j]) & ~127u) | (unsigned)(127 - (16 * j + l16)); kb[j] = (ordkey(cb[j]) & ~127u) | (unsigned)(127 - (16 * j + l16)); }
        { const int nit = it + G * NWAVES;
          if (nit < MROWS * 2) { const float* sc = SC + (size_t)(nit >> 1) * 2048 + ((nit & 1) * 4 + row) * 256 + l16;
#pragma unroll
              for (int j = 0; j < 8; ++j) { ca[j] = sc[16 * j]; cb[j] = sc[128 + 16 * j]; } } }
        __builtin_amdgcn_sched_barrier(0);
        float s1 = 0.f, s2 = 0.f; int i1 = 0, i2 = 0;
#pragma unroll 1
        for (int k = 0; k < 16; ++k) {
            unsigned ma = umax_u(umax_u(umax_u(ka[0], ka[1]), umax_u(ka[2], ka[3])), umax_u(umax_u(ka[4], ka[5]), umax_u(ka[6], ka[7])));
            unsigned mb = umax_u(umax_u(umax_u(kb[0], kb[1]), umax_u(kb[2], kb[3])), umax_u(umax_u(kb[4], kb[5]), umax_u(kb[6], kb[7])));
            ma = rowmax16(ma); mb = rowmax16(mb);
            if (l16 == k) { s1 = unord(ma & ~127u); i1 = 127 - (int)(ma & 127u); s2 = unord(mb & ~127u); i2 = 127 - (int)(mb & 127u); }
#pragma unroll
            for (int j = 0; j < 8; ++j) { ka[j] = ka[j] == ma ? 0u : ka[j]; kb[j] = kb[j] == mb ? 0u : kb[j]; }
        }
        unsigned ck[16];
        { const int s2i = __float_as_int(s2);
#define TK_CAND(n) { const int j = (l16 - (n)) & 15; const float c2 = (n) == 0 ? s2 : __shfl(s2, (lane & 48) + j); \
            ck[n] = (ordkey(s1 + c2) & ~255u) | (unsigned)(255 - (l16 * 16 + j)); }
          TK_CAND(0) TK_CAND(1) TK_CAND(2) TK_CAND(3) TK_CAND(4) TK_CAND(5) TK_CAND(6) TK_CAND(7) TK_CAND(8) TK_CAND(9) TK_CAND(10) TK_CAND(11) TK_CAND(12) TK_CAND(13) TK_CAND(14) TK_CAND(15)
#undef TK_CAND
        }
        float ts = 0.f; int tp = 0;
#pragma unroll 1
        for (int k = 0; k < 16; ++k) {
            unsigned m = umax_u(umax_u(umax_u(umax_u(ck[0], ck[1]), umax_u(ck[2], ck[3])), umax_u(umax_u(ck[4], ck[5]), umax_u(ck[6], ck[7]))),
                                umax_u(umax_u(umax_u(ck[8], ck[9]), umax_u(ck[10], ck[11])), umax_u(umax_u(ck[12], ck[13]), umax_u(ck[14], ck[15]))));
            m = rowmax16(m);
            if (l16 == k) { ts = unord(m & ~255u); tp = 255 - (int)(m & 255u); }
#pragma unroll
            for (int j = 0; j < 16; ++j) ck[j] = ck[j] == m ? 0u : ck[j];
        }
        const int e1 = __shfl(i1, (lane & 48) + (tp >> 4)), e2 = __shfl(i2, (lane & 48) + (tp & 15));
        float mx = ts; mx = fmaxf(mx, dppf<DPP_XOR1>(mx)); mx = fmaxf(mx, dppf<DPP_XOR2>(mx)); mx = fmaxf(mx, dppf<DPP_HMIRROR>(mx)); mx = fmaxf(mx, dppf<DPP_MIRROR>(mx));
        const float ex = __expf(ts - mx), gate = ex / sum16(ex);
        EIDL[(size_t)tok * 128 + h * 16 + l16] = (e1 * 128 + e2) * D;   GATEL[(size_t)tok * 128 + h * 16 + l16] = gate;
    }
}

__device__ __forceinline__ float dot16_fp8(const u32x4 r, const float (&h)[16]) {
    const unsigned wv[4] = {r.x, r.y, r.z, r.w}; float d0 = 0.f, d1 = 0.f;
#pragma unroll
    for (int q = 0; q < 4; ++q) { const f32x2 lo = __builtin_amdgcn_cvt_pk_f32_fp8((int)wv[q], false), hi = __builtin_amdgcn_cvt_pk_f32_fp8((int)wv[q], true);
        d0 = fmaf(lo.x, h[4 * q + 0], d0); d1 = fmaf(lo.y, h[4 * q + 1], d1); d0 = fmaf(hi.x, h[4 * q + 2], d0); d1 = fmaf(hi.y, h[4 * q + 3], d1); }
    return d0 + d1;
}
typedef __bf16 pbf2 __attribute__((ext_vector_type(2)));
__device__ __forceinline__ float dot16_fp8_bf16(const u32x4 r, const unsigned (&h)[8]) {
    const unsigned wv[4] = {r.x, r.y, r.z, r.w}; float d0 = 0.f, d1 = 0.f;
#pragma unroll
    for (int q = 0; q < 4; ++q) { const pbf2 lo = __builtin_amdgcn_cvt_scalef32_pk_bf16_fp8(wv[q], 1.0f, false), hi = __builtin_amdgcn_cvt_scalef32_pk_bf16_fp8(wv[q], 1.0f, true);
        d0 = __builtin_amdgcn_fdot2_f32_bf16(lo, __builtin_bit_cast(pbf2, h[2 * q]), d0, false); d1 = __builtin_amdgcn_fdot2_f32_bf16(hi, __builtin_bit_cast(pbf2, h[2 * q + 1]), d1, false); }
    return d0 + d1;
}
__device__ __forceinline__ int pair_get(int va, int vb, int p, int half4) { int addr = ((p & 63) << 2) + half4; asm volatile("" : "+v"(addr));
    return __builtin_amdgcn_ds_bpermute(addr, p < 64 ? va : vb); }
typedef _Float16 h16x2u __attribute__((ext_vector_type(2)));
__device__ __forceinline__ float dot16_bf8_f16(const u32x4 r, const h16x2u (&h)[8]) {
    const unsigned wv[4] = {r.x, r.y, r.z, r.w}; float d0 = 0.f, d1 = 0.f;
#pragma unroll
    for (int q = 0; q < 4; ++q) { const h16x2u lo = __builtin_bit_cast(h16x2u, __builtin_amdgcn_perm(0u, wv[q], 0x010c000cu)), hi = __builtin_bit_cast(h16x2u, __builtin_amdgcn_perm(0u, wv[q], 0x030c020cu));
        d0 = __builtin_amdgcn_fdot2(lo, h[2 * q], d0, false); d1 = __builtin_amdgcn_fdot2(hi, h[2 * q + 1], d1, false); }
    return d0 + d1;
}
__device__ __forceinline__ void phase_udot(unsigned char* ws, int layer, int G) {
    int tid = threadIdx.x; asm volatile("" : "+v"(tid)); const int lane = tid & 63, wid = __builtin_amdgcn_readfirstlane(tid >> 6);
    const int x = blockIdx.x & 7, g = (blockIdx.x >> 3) * NWAVES + wid, NG = (G >> 3) * NWAVES, half = lane >> 5, l32 = lane & 31, half4 = half * 4;
    const int* EIDL = (const int*)(ws + WS_EIDL); const bf16_t* HB = (const bf16_t*)(ws + WS_HB); float* DOTP = (float*)(ws + WS_DOTP);
    const unsigned char* ubase = ws + WS_PU + (size_t)layer * NEXP * D + 512 * x + 16 * l32;
    if (g >= MROWS) return;
    int ean = EIDL[(size_t)g * 128 + lane], ebn = EIDL[(size_t)g * 128 + 64 + lane];
    u32x4 h0n, h1n; { const u32x4* hp8 = (const u32x4*)(HB + (size_t)g * D + 512 * x + 16 * l32); h0n = hp8[0]; h1n = hp8[1]; }
#pragma unroll 1
    for (int tok = g; tok < MROWS; tok += NG) {
        const int ea = ean, eb = ebn;
        const unsigned hh[8] = {h0n.x, h0n.y, h0n.z, h0n.w, h1n.x, h1n.y, h1n.z, h1n.w};
        { const int tn = tok + NG < MROWS ? tok + NG : tok;
          ean = EIDL[(size_t)tn * 128 + lane]; ebn = EIDL[(size_t)tn * 128 + 64 + lane];
          const u32x4* hp8 = (const u32x4*)(HB + (size_t)tn * D + 512 * x + 16 * l32); h0n = hp8[0]; h1n = hp8[1]; }
        float* dp = DOTP + ((size_t)tok * 8 + x) * 128;
#define UD_LOAD(rb, B) do { unsigned eo_[8]; _Pragma("unroll") for (int i = 0; i < 8; ++i) eo_[i] = (unsigned)pair_get(ea, eb, 16 * (B) + 2 * i, half4); __builtin_amdgcn_sched_barrier(0); \
        _Pragma("unroll") for (int i = 0; i < 8; ++i) rb[i] = *(const u32x4*)(ubase + eo_[i]); } while (0)
#define UD_COMP(rb, B) do { float d0 = dot16_fp8_bf16(rb[0], hh), d1 = dot16_fp8_bf16(rb[1], hh), d2 = dot16_fp8_bf16(rb[2], hh), d3 = dot16_fp8_bf16(rb[3], hh), d4 = dot16_fp8_bf16(rb[4], hh), d5 = dot16_fp8_bf16(rb[5], hh), d6 = dot16_fp8_bf16(rb[6], hh), d7 = dot16_fp8_bf16(rb[7], hh); \
        asm volatile("s_nop 1\n\t" PEER_DPP8("quad_perm:[1,0,3,2] row_mask:0xf bank_mask:0xf bound_ctrl:1") PEER_DPP8("quad_perm:[2,3,0,1] row_mask:0xf bank_mask:0xf bound_ctrl:1") \
                     PEER_DPP8("row_half_mirror row_mask:0xf bank_mask:0xf bound_ctrl:1") PEER_DPP8("row_mirror row_mask:0xf bank_mask:0xf bound_ctrl:1") PEER_DPP8("row_bcast:15 row_mask:0xa bank_mask:0xf") \
                     : "+v"(d0), "+v"(d1), "+v"(d2), "+v"(d3), "+v"(d4), "+v"(d5), "+v"(d6), "+v"(d7)); \
        const int li = lane & 15; float v = d0; v = li == 1 ? d1 : v; v = li == 2 ? d2 : v; v = li == 3 ? d3 : v; v = li == 4 ? d4 : v; v = li == 5 ? d5 : v; v = li == 6 ? d6 : v; v = li == 7 ? d7 : v; \
        if ((lane & 16) && li < 8) dp[16 * (B) + 2 * li + half] = v; } while (0)
        u32x4 ra[8], rc[8];
        UD_LOAD(ra, 0);
#pragma unroll
        for (int b = 0; b < 8; b += 2) {
            UD_LOAD(rc, b + 1);
            __builtin_amdgcn_sched_barrier(0);
            UD_COMP(ra, b);
            __builtin_amdgcn_sched_barrier(0);
            if (b + 2 < 8) UD_LOAD(ra, b + 2);
            __builtin_amdgcn_sched_barrier(0);
            UD_COMP(rc, b + 1);
            __builtin_amdgcn_sched_barrier(0);
        }
#undef UD_LOAD
#undef UD_COMP
    }
}

__device__ __forceinline__ void phase_vacc(unsigned char* ws, int layer, int G) {
    int tid = threadIdx.x; asm volatile("" : "+v"(tid)); const int lane = tid & 63, wid = __builtin_amdgcn_readfirstlane(tid >> 6);
    const int x = blockIdx.x & 7, g = (blockIdx.x >> 3) * NWAVES + wid, NG = (G >> 3) * NWAVES, half = lane >> 5, l32 = lane & 31, half4 = half * 4;
    const int* EIDL = (const int*)(ws + WS_EIDL); const float* GATEL = (const float*)(ws + WS_GATEL); const float* DOTP = (const float*)(ws + WS_DOTP); float* H = (float*)(ws + WS_H);
    const float* SU = (const float*)(ws + WS_SU) + layer * NEXP; const float* SV = (const float*)(ws + WS_SV) + layer * NEXP; const float* HS = (const float*)(ws + WS_HS);
    const unsigned char* vbase = ws + WS_PV + (size_t)layer * NEXP * D + 512 * x + 16 * l32;
    for (int tok = g; tok < MROWS; tok += NG) {
        const int ea = EIDL[(size_t)tok * 128 + lane], eb = EIDL[(size_t)tok * 128 + 64 + lane];
        float wa, wb;
        {   const float* dq = DOTP + (size_t)tok * 1024 + lane; float da = 0.f, db = 0.f;
#pragma unroll
            for (int s = 0; s < 8; ++s) { da += dq[s * 128]; db += dq[s * 128 + 64]; }
            wa = GATEL[(size_t)tok * 128 + lane] * gelu_erf(da * SU[ea >> 12]) * SV[ea >> 12]; wb = GATEL[(size_t)tok * 128 + 64 + lane] * gelu_erf(db * SU[eb >> 12]) * SV[eb >> 12]; }
        float acc[16];
#pragma unroll
        for (int j = 0; j < 16; ++j) acc[j] = 0.f;
#define VA_LOAD(rb, B) do { _Pragma("unroll") for (int i = 0; i < 8; ++i) { const unsigned eo = (unsigned)pair_get(ea, eb, 16 * (B) + 2 * i, half4); rb[i] = *(const u32x4*)(vbase + eo); } } while (0)
#define VA_COMP(rb, B) do { _Pragma("unroll") for (int i = 0; i < 8; ++i) { const float w = __int_as_float(pair_get(__float_as_int(wa), __float_as_int(wb), 16 * (B) + 2 * i, half4)); const unsigned wv[4] = {rb[i].x, rb[i].y, rb[i].z, rb[i].w}; \
        _Pragma("unroll") for (int q = 0; q < 4; ++q) { const f32x2 lo = __builtin_amdgcn_cvt_pk_f32_fp8((int)wv[q], false), hi = __builtin_amdgcn_cvt_pk_f32_fp8((int)wv[q], true); \
            acc[4 * q + 0] = fmaf(w, lo.x, acc[4 * q + 0]); acc[4 * q + 1] = fmaf(w, lo.y, acc[4 * q + 1]); acc[4 * q + 2] = fmaf(w, hi.x, acc[4 * q + 2]); acc[4 * q + 3] = fmaf(w, hi.y, acc[4 * q + 3]); } } } while (0)
        u32x4 ra[8], rc[8];
        VA_LOAD(ra, 0);
#pragma unroll 1
        for (int b = 0; b < 8; b += 2) {
            VA_LOAD(rc, b + 1);
            __builtin_amdgcn_sched_barrier(0);
            VA_COMP(ra, b);
            __builtin_amdgcn_sched_barrier(0);
            if (b + 2 < 8) VA_LOAD(ra, b + 2);
            __builtin_amdgcn_sched_barrier(0);
            VA_COMP(rc, b + 1);
            __builtin_amdgcn_sched_barrier(0);
        }
#undef VA_LOAD
#undef VA_COMP
        float o[8];
#pragma unroll
        for (int j = 0; j < 8; ++j) { const float mine = half ? acc[8 + j] : acc[j], give = half ? acc[j] : acc[8 + j];
            const auto sw = __builtin_amdgcn_permlane32_swap(__float_as_uint(give), __float_as_uint(give), false, false); const unsigned s0 = sw[0], s1 = sw[1];
            o[j] = mine + __uint_as_float(half ? s0 : s1); }
        f32x4* hp = (f32x4*)(H + (size_t)tok * D + 512 * x + 16 * l32 + 8 * half);
        f32x4 h0 = hp[0], h1 = hp[1];
        h0[0] += o[0]; h0[1] += o[1]; h0[2] += o[2]; h0[3] += o[3]; h1[0] += o[4]; h1[1] += o[5]; h1[2] += o[6]; h1[3] += o[7];
        hp[0] = h0; hp[1] = h1;
    }
}

__device__ __forceinline__ void phase_final(const float* gain, float* out, unsigned char* ws, int G) {
    int tid = threadIdx.x; asm volatile("" : "+v"(tid)); const int lane = tid & 63, wid = __builtin_amdgcn_readfirstlane(tid >> 6);
    const float* H = (const float*)(ws + WS_H);
    f32x4 gv[16];
#pragma unroll
    for (int j = 0; j < 16; ++j) gv[j] = ((const f32x4*)gain)[lane + 64 * j];
    const int r0 = blockIdx.x * NWAVES + wid, RS = G * NWAVES;
    if (r0 >= MX) return;
#define PF_LOAD(v, R) do { const f32x4* src_ = (const f32x4*)(H + (size_t)(R) * D) + lane; _Pragma("unroll") for (int j = 0; j < 16; ++j) v[j] = src_[64 * j]; } while (0)
#define PF_ROW(v, R) do { float s_ = 0.f; _Pragma("unroll") for (int j = 0; j < 16; ++j) s_ += (v[j][0] * v[j][0] + v[j][1] * v[j][1]) + (v[j][2] * v[j][2] + v[j][3] * v[j][3]); \
        s_ = sum64(s_); const float inv_ = rsqrtf(s_ * (1.0f / D) + NORM_EPS); f32x4* dst_ = (f32x4*)(out + (size_t)(R) * D) + lane; \
        _Pragma("unroll") for (int j = 0; j < 16; ++j) dst_[64 * j] = v[j] * inv_ * gv[j]; } while (0)
    f32x4 va[16], vb[16];
    PF_LOAD(va, r0);
#pragma unroll 1
    for (int r = r0; r < MX; r += 2 * RS) {
        const int r1 = r + RS, r2 = r + 2 * RS;
        PF_LOAD(vb, r1 < MX ? r1 : r);
        __builtin_amdgcn_sched_barrier(0);
        PF_ROW(va, r);
        __builtin_amdgcn_sched_barrier(0);
        PF_LOAD(va, r2 < MX ? r2 : r);
        __builtin_amdgcn_sched_barrier(0);
        if (r1 < MX) PF_ROW(vb, r1);
        __builtin_amdgcn_sched_barrier(0);
    }
#undef PF_LOAD
#undef PF_ROW
}

constexpr int NS32 = 32;
__device__ __forceinline__ int lane_get(int va, int vb, int p_hi, int addr_lo) {
    int addr = ((8 * p_hi) & 63) * 4 + addr_lo; asm volatile("" : "+v"(addr)); return __builtin_amdgcn_ds_bpermute(addr, p_hi < 8 ? va : vb); }

__device__ __forceinline__ void phase_udot32(unsigned char* ws, int layer, int G) {
    int tid = threadIdx.x; asm volatile("" : "+v"(tid)); const int lane = tid & 63, wid = __builtin_amdgcn_readfirstlane(tid >> 6);
    const int x = blockIdx.x & 7, g = (blockIdx.x >> 3) * NWAVES + wid, NG = (G >> 3) * NWAVES, r8 = lane >> 3, c8 = lane & 7, r84 = r8 * 4;
    const int* EIDL = (const int*)(ws + WS_EIDL); const bf16_t* HB = (const bf16_t*)(ws + WS_HB); float* DOTP = (float*)(ws + WS_DOTP);
    const unsigned char* tbl = ws + WS_PU + (size_t)layer * NEXP * D + 16 * c8;
    const int taddr = (8 * (lane & 7) + (lane >> 3)) * 4;
#pragma unroll 1
    for (int sp = 0; sp < NS32 / 8; ++sp) {
        const int slice = x + 8 * sp;
        const unsigned char* ubase = tbl + 128 * slice;
        int ea = 0, eb = 0; u32x4 h0 = {0u, 0u, 0u, 0u}, h1 = h0;
        if (g < MROWS) { ea = EIDL[(size_t)g * 128 + lane]; eb = EIDL[(size_t)g * 128 + 64 + lane]; const u32x4* hp8 = (const u32x4*)(HB + (size_t)g * D + 128 * slice + 16 * c8); h0 = hp8[0]; h1 = hp8[1]; }
#pragma unroll 1
        for (int tok = g; tok < MROWS; tok += NG) {
            unsigned eo[16];
#pragma unroll
            for (int i = 0; i < 16; ++i) eo[i] = (unsigned)lane_get(ea, eb, i, r84);
            __builtin_amdgcn_sched_barrier(0);
            u32x4 rb[16];
#pragma unroll
            for (int i = 0; i < 16; ++i) rb[i] = *(const u32x4*)(ubase + eo[i]);
            const unsigned hq[8] = {h0.x, h0.y, h0.z, h0.w, h1.x, h1.y, h1.z, h1.w};
            const int nt = tok + NG;
            if (nt < MROWS) { ea = EIDL[(size_t)nt * 128 + lane]; eb = EIDL[(size_t)nt * 128 + 64 + lane]; const u32x4* hp8 = (const u32x4*)(HB + (size_t)nt * D + 128 * slice + 16 * c8); h0 = hp8[0]; h1 = hp8[1]; }
            __builtin_amdgcn_sched_barrier(0);
            float v0 = 0.f, v1 = 0.f;
#pragma unroll
            for (int hh = 0; hh < 2; ++hh) {
                float d0 = dot16_fp8_bf16(rb[8 * hh + 0], hq), d1 = dot16_fp8_bf16(rb[8 * hh + 1], hq), d2 = dot16_fp8_bf16(rb[8 * hh + 2], hq), d3 = dot16_fp8_bf16(rb[8 * hh + 3], hq),
                      d4 = dot16_fp8_bf16(rb[8 * hh + 4], hq), d5 = dot16_fp8_bf16(rb[8 * hh + 5], hq), d6 = dot16_fp8_bf16(rb[8 * hh + 6], hq), d7 = dot16_fp8_bf16(rb[8 * hh + 7], hq);
                asm volatile("s_nop 1\n\t" PEER_DPP8("quad_perm:[1,0,3,2] row_mask:0xf bank_mask:0xf bound_ctrl:1") PEER_DPP8("quad_perm:[2,3,0,1] row_mask:0xf bank_mask:0xf bound_ctrl:1")
                             PEER_DPP8("row_half_mirror row_mask:0xf bank_mask:0xf bound_ctrl:1") : "+v"(d0), "+v"(d1), "+v"(d2), "+v"(d3), "+v"(d4), "+v"(d5), "+v"(d6), "+v"(d7));
                float v = d0; v = c8 == 1 ? d1 : v; v = c8 == 2 ? d2 : v; v = c8 == 3 ? d3 : v; v = c8 == 4 ? d4 : v; v = c8 == 5 ? d5 : v; v = c8 == 6 ? d6 : v; v = c8 == 7 ? d7 : v;
                if (hh == 0) v0 = v; else v1 = v;
            }
            float* dp = DOTP + ((size_t)tok * NS32 + slice) * 128;
            dp[lane] = __int_as_float(__builtin_amdgcn_ds_bpermute(taddr, __float_as_int(v0))); dp[64 + lane] = __int_as_float(__builtin_amdgcn_ds_bpermute(taddr, __float_as_int(v1)));
        }
    }
}

template <int NSL>
__device__ __forceinline__ void phase_pw(unsigned char* ws, int layer, int G) {
    int tid = threadIdx.x; asm volatile("" : "+v"(tid)); const int lane = tid & 63, wid = __builtin_amdgcn_readfirstlane(tid >> 6);
    const int* EIDL = (const int*)(ws + WS_EIDL); const float* GATEL = (const float*)(ws + WS_GATEL); const float* DOTP = (const float*)(ws + WS_DOTP); float* WL = (float*)(ws + WS_WL);
    const float* SU = (const float*)(ws + WS_SU) + layer * NEXP; const float* SV = (const float*)(ws + WS_SV) + layer * NEXP; const float* HS = (const float*)(ws + WS_HS);
    for (int it0 = blockIdx.x * NWAVES + wid; it0 < MROWS * 2; it0 += 2 * G * NWAVES) {
        const int it1 = it0 + G * NWAVES; const bool v1 = it1 < MROWS * 2; const int it1c = v1 ? it1 : it0;
        const size_t o0 = (size_t)(it0 >> 1) * 128 + (it0 & 1) * 64 + lane, o1 = (size_t)(it1c >> 1) * 128 + (it1c & 1) * 64 + lane;
        const float* dq0 = DOTP + (size_t)(it0 >> 1) * NSL * 128 + (it0 & 1) * 64 + lane; const float* dq1 = DOTP + (size_t)(it1c >> 1) * NSL * 128 + (it1c & 1) * 64 + lane;
        float ds0[NSL], ds1[NSL];
#pragma unroll
        for (int s = 0; s < NSL; ++s) { ds0[s] = dq0[s * 128]; ds1[s] = dq1[s * 128]; }
        const int e0 = EIDL[o0] >> 12, e1 = EIDL[o1] >> 12; const float g0 = GATEL[o0], g1 = GATEL[o1];
        const float su0 = SU[e0], sv0 = SV[e0], su1 = SU[e1], sv1 = SV[e1];
        float d0 = 0.f, d1 = 0.f;
#pragma unroll
        for (int s = 0; s < NSL; ++s) { d0 += ds0[s]; d1 += ds1[s]; }
        { const _Float16 h0 = (_Float16)(g0 * gelu_erf(d0 * su0) * sv0), h1 = (_Float16)(g1 * gelu_erf(d1 * su1) * sv1);
          const unsigned p0 = ((unsigned)e0 << 16) | (unsigned)__builtin_bit_cast(unsigned short, h0), p1 = ((unsigned)e1 << 16) | (unsigned)__builtin_bit_cast(unsigned short, h1);
          unsigned* WLT = (unsigned*)(ws + WS_HB8);
          ((unsigned*)WL)[o0] = p0; WLT[(size_t)((it0 & 1) * 64 + lane) * MROWS + (it0 >> 1)] = p0;
          if (v1) { ((unsigned*)WL)[o1] = p1; WLT[(size_t)((it1 & 1) * 64 + lane) * MROWS + (it1 >> 1)] = p1; } }
    }
}

template <bool DRY = false>
__device__ __forceinline__ void phase_vacc32(unsigned char* ws, int layer, int G) {
    int tid = threadIdx.x; asm volatile("" : "+v"(tid)); const int lane = tid & 63, wid = __builtin_amdgcn_readfirstlane(tid >> 6);
    const int x = blockIdx.x & 7, g = (blockIdx.x >> 3) * NWAVES + wid, NG = (G >> 3) * NWAVES, r8 = lane >> 3, c8 = lane & 7, r84 = r8 * 4;
    const int* EIDL = (const int*)(ws + WS_EIDL); const float* WL = (const float*)(ws + WS_WL); float* H = (float*)(ws + (DRY ? WS_WAG : WS_H));
    const unsigned char* tbl = ws + WS_PV + (size_t)layer * NEXP * D + 16 * c8;
    const int h5 = lane >> 5, h4 = (lane >> 4) & 1, h3 = (lane >> 3) & 1, xaddr = (lane ^ 8) << 2;
    {
        constexpr int NIT = (NS32 / 8) * MROWS;
        int ea = 0, eb = 0; float wa = 0.f, wb = 0.f;
        if (g < NIT) { ea = EIDL[(size_t)g * 128 + lane]; eb = EIDL[(size_t)g * 128 + 64 + lane]; wa = WL[(size_t)g * 128 + lane]; wb = WL[(size_t)g * 128 + 64 + lane]; }
#pragma unroll 1
        for (int item = g; item < NIT; item += NG) {
            const int sp = item / MROWS, tok = item - sp * MROWS, slice = x + 8 * sp;
            const unsigned char* vbase = tbl + 128 * slice;
            u32x4 rb[16]; float wv_[16];
            unsigned eo[16];
#pragma unroll
            for (int i = 0; i < 16; ++i) eo[i] = (unsigned)lane_get(ea, eb, i, r84);
            __builtin_amdgcn_sched_barrier(0);
#pragma unroll
            for (int i = 0; i < 16; ++i) rb[i] = *(const u32x4*)(vbase + eo[i]);
            __builtin_amdgcn_sched_barrier(0);
#pragma unroll
            for (int i = 0; i < 16; ++i) wv_[i] = __int_as_float(lane_get(__float_as_int(wa), __float_as_int(wb), i, r84));
            const int ni = item + NG;
            if (ni < NIT) { const int nt = ni - (ni / MROWS) * MROWS; ea = EIDL[(size_t)nt * 128 + lane]; eb = EIDL[(size_t)nt * 128 + 64 + lane]; wa = WL[(size_t)nt * 128 + lane]; wb = WL[(size_t)nt * 128 + 64 + lane]; }
            __builtin_amdgcn_sched_barrier(0);
            float acc[16];
#pragma unroll
            for (int j = 0; j < 16; ++j) acc[j] = 0.f;
#pragma unroll
            for (int i = 0; i < 16; ++i) { const float w = wv_[i]; const unsigned wv[4] = {rb[i].x, rb[i].y, rb[i].z, rb[i].w};
#pragma unroll
                for (int q = 0; q < 4; ++q) { const f32x2 lo = __builtin_amdgcn_cvt_pk_f32_fp8((int)wv[q], false), hi = __builtin_amdgcn_cvt_pk_f32_fp8((int)wv[q], true);
                    acc[4 * q + 0] = fmaf(w, lo.x, acc[4 * q + 0]); acc[4 * q + 1] = fmaf(w, lo.y, acc[4 * q + 1]); acc[4 * q + 2] = fmaf(w, hi.x, acc[4 * q + 2]); acc[4 * q + 3] = fmaf(w, hi.y, acc[4 * q + 3]); } }
            float o8[8], o4[4], o2[2];
#pragma unroll
            for (int j = 0; j < 8; ++j) { const auto sw = __builtin_amdgcn_permlane32_swap(__float_as_uint(acc[j]), __float_as_uint(acc[8 + j]), false, false); const unsigned s0 = sw[0], s1 = sw[1]; o8[j] = __uint_as_float(s0) + __uint_as_float(s1); }
#pragma unroll
            for (int j = 0; j < 4; ++j) { const auto sw = __builtin_amdgcn_permlane16_swap(__float_as_uint(o8[j]), __float_as_uint(o8[4 + j]), false, false); const unsigned s0 = sw[0], s1 = sw[1]; o4[j] = __uint_as_float(s0) + __uint_as_float(s1); }
#pragma unroll
            for (int j = 0; j < 2; ++j) { const float keep = h3 ? o4[2 + j] : o4[j], give = h3 ? o4[j] : o4[2 + j]; o2[j] = keep + __int_as_float(__builtin_amdgcn_ds_bpermute(xaddr, __float_as_int(give))); }
            f32x2* hp = (f32x2*)(H + (size_t)tok * D + 128 * slice + 16 * c8 + 2 * r8);
            f32x2 hv = *hp; hv[0] += o2[0]; hv[1] += o2[1]; *hp = hv;
        }
    }
    (void)h5; (void)h4;
}

typedef _Float16 h16x2 __attribute__((ext_vector_type(2)));
template <bool DRY = false>
__device__ __forceinline__ void phase_vacc32d(unsigned char* ws, int layer, int G) {
    int tid = threadIdx.x; asm volatile("" : "+v"(tid)); const int lane = tid & 63, wid = __builtin_amdgcn_readfirstlane(tid >> 6);
    const int x = blockIdx.x & 7, g = (blockIdx.x >> 3) * NWAVES + wid, NG = (G >> 3) * NWAVES, r8 = lane >> 3, c8 = lane & 7, r84 = r8 * 4;
    const unsigned* WLP = (const unsigned*)(ws + WS_WL);
    float* H = (float*)(ws + (DRY ? WS_WAG : WS_H));
    const unsigned char* tbl = ws + WS_PV + (size_t)layer * NEXP * D + 16 * c8;
    const int h3 = (lane >> 3) & 1, xaddr = (lane ^ 8) << 2;
    constexpr int NIT = (NS32 / 8) * MROWS;
#define VD_IDS(pw, IT) do { const int t_ = (IT) - ((IT) / MROWS) * MROWS; const unsigned* wp_ = WLP + (size_t)t_ * 128 + r8 * 16 + (lane & 3); \
        pw[0] = wp_[0]; pw[1] = wp_[4]; pw[2] = wp_[8]; pw[3] = wp_[12]; } while (0)
#define VD_ISSUE(rb, pk, hv, hp, pw, IT) do { const int sp_ = (IT) / MROWS, t_ = (IT) - sp_ * MROWS, sl_ = x + 8 * sp_; const unsigned char* vb_ = tbl + 128 * sl_; \
        _Pragma("unroll") for (int k = 0; k < 4; ++k) { pk[4 * k + 0] = dppu<0x00>(pw[k]); pk[4 * k + 1] = dppu<0x55>(pw[k]); pk[4 * k + 2] = dppu<0xAA>(pw[k]); pk[4 * k + 3] = dppu<0xFF>(pw[k]); }     \
        _Pragma("unroll") for (int i = 0; i < 16; ++i) rb[i] = *(const u32x4*)(vb_ + ((pk[i] >> 16) << 12)); \
        hp = (f32x2*)(H + (size_t)t_ * D + 128 * sl_ + 16 * c8 + 2 * r8); hv = *hp; } while (0)
#define VD_COMP(rb, wv, hv, hp, VALID) do { h16x2 ah[8]; \
        _Pragma("unroll") for (int j = 0; j < 8; ++j) ah[j] = (h16x2){(_Float16)0.f, (_Float16)0.f}; \
        _Pragma("unroll") for (int i = 0; i < 16; ++i) { const h16x2 w2 = __builtin_bit_cast(h16x2, __builtin_amdgcn_perm(wv[i], wv[i], 0x01000100u)); const unsigned q_[4] = {rb[i].x, rb[i].y, rb[i].z, rb[i].w}; \
            _Pragma("unroll") for (int q = 0; q < 4; ++q) { const h16x2 lo = __builtin_bit_cast(h16x2, __builtin_amdgcn_perm(0u, q_[q], 0x010c000cu)), hi = __builtin_bit_cast(h16x2, __builtin_amdgcn_perm(0u, q_[q], 0x030c020cu)); \
                ah[2 * q + 0] = w2 * lo + ah[2 * q + 0]; ah[2 * q + 1] = w2 * hi + ah[2 * q + 1]; } } \
        float acc[16]; \
        _Pragma("unroll") for (int j = 0; j < 8; ++j) { const h16x2 t_ = ah[j]; const _Float16 t0 = t_[0], t1 = t_[1]; acc[2 * j] = (float)t0; acc[2 * j + 1] = (float)t1; } \
        float o8[8], o4[4], o2[2]; \
        _Pragma("unroll") for (int j = 0; j < 8; ++j) { const auto sw = __builtin_amdgcn_permlane32_swap(__float_as_uint(acc[j]), __float_as_uint(acc[8 + j]), false, false); const unsigned s0 = sw[0], s1 = sw[1]; o8[j] = __uint_as_float(s0) + __uint_as_float(s1); } \
        _Pragma("unroll") for (int j = 0; j < 4; ++j) { const auto sw = __builtin_amdgcn_permlane16_swap(__float_as_uint(o8[j]), __float_as_uint(o8[4 + j]), false, false); const unsigned s0 = sw[0], s1 = sw[1]; o4[j] = __uint_as_float(s0) + __uint_as_float(s1); } \
        _Pragma("unroll") for (int j = 0; j < 2; ++j) { const float keep = h3 ? o4[2 + j] : o4[j], give = h3 ? o4[j] : o4[2 + j]; o2[j] = keep + __int_as_float(__builtin_amdgcn_ds_bpermute(xaddr, __float_as_int(give))); } \
        f32x2 hn_ = hv; hn_[0] += o2[0]; hn_[1] += o2[1]; if (VALID) *hp = hn_; } while (0)
    if (g >= NIT) return;
    u32x4 ra[16], rc[16]; unsigned pka[16], pkc[16]; f32x2 hva, hvc; f32x2* hpa; f32x2* hpc;
    unsigned pw0[4], pw1[4];
    VD_IDS(pw0, g);
    { const int i1c = g + NG < NIT ? g + NG : g; VD_IDS(pw1, i1c); }
    VD_ISSUE(ra, pka, hva, hpa, pw0, g);
#pragma unroll 1
    for (int item = g; item < NIT; item += 2 * NG) {
        const int i1 = item + NG, i2 = item + 2 * NG, i3 = item + 3 * NG;
        const bool v1 = i1 < NIT;
        const int i1c = v1 ? i1 : item, i2c = i2 < NIT ? i2 : item, i3c = i3 < NIT ? i3 : item;
        VD_IDS(pw0, i2c);
        __builtin_amdgcn_sched_barrier(0);
        VD_ISSUE(rc, pkc, hvc, hpc, pw1, i1c);
        __builtin_amdgcn_sched_barrier(0);
        VD_COMP(ra, pka, hva, hpa, true);
        __builtin_amdgcn_sched_barrier(0);
        VD_IDS(pw1, i3c);
        __builtin_amdgcn_sched_barrier(0);
        VD_ISSUE(ra, pka, hva, hpa, pw0, i2c);
        __builtin_amdgcn_sched_barrier(0);
        VD_COMP(rc, pkc, hvc, hpc, v1);
        __builtin_amdgcn_sched_barrier(0);
    }
#undef VD_IDS
#undef VD_ISSUE
#undef VD_COMP
}

template <bool DRY = false>
__device__ __forceinline__ void phase_vaccL(unsigned char* ws, LAS unsigned char* lds, int layer, int G) {
    int tid = threadIdx.x; asm volatile("" : "+v"(tid)); const int lane = tid & 63, wid = __builtin_amdgcn_readfirstlane(tid >> 6);
    const unsigned* WLT = (const unsigned*)(ws + WS_WL); float* H = (float*)(ws + (DRY ? WS_WAG : WS_H));
    const unsigned char* pvt = ws + WS_PV + (size_t)layer * NEXP * D;
    constexpr int NTB = (MROWS + 63) / 64;
#define VL_LOAD(wr, C) do { _Pragma("unroll") for (int i = 0; i < 16; ++i) wr[i] = wp[(size_t)((C) * 16 + i) * MROWS]; } while (0)
#define VL_CHUNK(wr) do { u32x2 v_[16]; \
        _Pragma("unroll") for (int i = 0; i < 16; ++i) v_[i] = *(const LAS u32x2*)(lds + ((wr[i] >> 16) << 3)); \
        h16x2 a0 = {(_Float16)0.f, (_Float16)0.f}, a1 = a0, a2 = a0, a3 = a0; \
        _Pragma("unroll") for (int i = 0; i < 16; ++i) { const h16x2 w2 = __builtin_bit_cast(h16x2, __builtin_amdgcn_perm(wr[i], wr[i], 0x01000100u)); \
            a0 = w2 * __builtin_bit_cast(h16x2, __builtin_amdgcn_perm(0u, v_[i].x, 0x010c000cu)) + a0; a1 = w2 * __builtin_bit_cast(h16x2, __builtin_amdgcn_perm(0u, v_[i].x, 0x030c020cu)) + a1; \
            a2 = w2 * __builtin_bit_cast(h16x2, __builtin_amdgcn_perm(0u, v_[i].y, 0x010c000cu)) + a2; a3 = w2 * __builtin_bit_cast(h16x2, __builtin_amdgcn_perm(0u, v_[i].y, 0x030c020cu)) + a3; } \
        { const _Float16 t0 = a0[0], t1 = a0[1], t2 = a1[0], t3 = a1[1], t4 = a2[0], t5 = a2[1], t6 = a3[0], t7 = a3[1]; \
          accf[0] += (float)t0; accf[1] += (float)t1; accf[2] += (float)t2; accf[3] += (float)t3; accf[4] += (float)t4; accf[5] += (float)t5; accf[6] += (float)t6; accf[7] += (float)t7; } } while (0)
    for (int cg = blockIdx.x; cg < D / 8; cg += G) {
        __syncthreads();
        { const u32x4* src = (const u32x4*)(pvt + (size_t)cg * (NEXP * 8)) + tid; u32x4 t_[16];
#pragma unroll
          for (int i = 0; i < 16; ++i) t_[i] = src[512 * i];
#pragma unroll
          for (int i = 0; i < 16; ++i) ((LAS u32x4*)lds)[tid + 512 * i] = t_[i]; }
        __syncthreads();
#pragma unroll 1
        for (int tb = wid; tb < NTB; tb += NWAVES) {
            const int tok = tb * 64 + lane; const bool valid = tok < MROWS; const int tokc = valid ? tok : MROWS - 1;
            const unsigned* wp = WLT + tokc;
            f32x4* hp = (f32x4*)(H + (size_t)tokc * D + cg * 8); const f32x4 h0 = hp[0], h1 = hp[1];
            float accf[8];
#pragma unroll
            for (int j = 0; j < 8; ++j) accf[j] = 0.f;
            unsigned wa[16], wb[16];
            VL_LOAD(wa, 0);
#pragma unroll 1
            for (int c = 0; c < 8; c += 2) {
                VL_LOAD(wb, c + 1);
                __builtin_amdgcn_sched_barrier(0);
                VL_CHUNK(wa);
                __builtin_amdgcn_sched_barrier(0);
                VL_LOAD(wa, (c + 2) & 7);
                __builtin_amdgcn_sched_barrier(0);
                VL_CHUNK(wb);
                __builtin_amdgcn_sched_barrier(0);
            }
            if (valid) { hp[0] = h0 + (f32x4){accf[0], accf[1], accf[2], accf[3]}; hp[1] = h1 + (f32x4){accf[4], accf[5], accf[6], accf[7]}; }
        }
    }
#undef VL_LOAD
#undef VL_CHUNK
}

template <bool RUN_L = true, bool RUN_G = true, bool DRY = false>
__device__ __forceinline__ void phase_vaccH(unsigned char* ws, LAS unsigned char* lds, int layer, int G) {
    int tid = threadIdx.x; asm volatile("" : "+v"(tid)); const int lane = tid & 63, wid = __builtin_amdgcn_readfirstlane(tid >> 6);
    float* H = (float*)(ws + (DRY ? WS_WAG : WS_H));
    const unsigned char* pvl = ws + WS_PV + (size_t)layer * NEXP * D;
    const unsigned char* pvg = pvl + (size_t)NEXP * 2048;
    constexpr int NTB = (MROWS + 63) / 64, NGRP = 2048 / 8;
    bool first = true;
    for (int cg = blockIdx.x; cg < NGRP; cg += G) {
        __syncthreads();
        { const u32x4* src = (const u32x4*)(pvl + (size_t)cg * (NEXP * 8)) + tid; u32x4 t_[16];
#pragma unroll
          for (int i = 0; i < 16; ++i) t_[i] = src[512 * i];
#pragma unroll
          for (int i = 0; i < 16; ++i) ((LAS u32x4*)lds)[tid + 512 * i] = t_[i]; }
        __syncthreads();
        if (wid < 4) { if (RUN_L) {
            const unsigned* WLT = (const unsigned*)(ws + WS_HB8);
#define VL_LOAD(wr, C) do { _Pragma("unroll") for (int i = 0; i < 16; ++i) wr[i] = wp[(size_t)((C) * 16 + i) * MROWS]; } while (0)
#define VL_CHUNK(wr) do { u32x2 v_[16]; \
        _Pragma("unroll") for (int i = 0; i < 16; ++i) v_[i] = *(const LAS u32x2*)(lds + ((wr[i] >> 16) << 3)); \
        h16x2 a0 = {(_Float16)0.f, (_Float16)0.f}, a1 = a0, a2 = a0, a3 = a0; \
        _Pragma("unroll") for (int i = 0; i < 16; ++i) { const h16x2 w2 = __builtin_bit_cast(h16x2, __builtin_amdgcn_perm(wr[i], wr[i], 0x01000100u)); \
            a0 = w2 * __builtin_bit_cast(h16x2, __builtin_amdgcn_perm(0u, v_[i].x, 0x010c000cu)) + a0; a1 = w2 * __builtin_bit_cast(h16x2, __builtin_amdgcn_perm(0u, v_[i].x, 0x030c020cu)) + a1; \
            a2 = w2 * __builtin_bit_cast(h16x2, __builtin_amdgcn_perm(0u, v_[i].y, 0x010c000cu)) + a2; a3 = w2 * __builtin_bit_cast(h16x2, __builtin_amdgcn_perm(0u, v_[i].y, 0x030c020cu)) + a3; } \
        { const _Float16 t0 = a0[0], t1 = a0[1], t2 = a1[0], t3 = a1[1], t4 = a2[0], t5 = a2[1], t6 = a3[0], t7 = a3[1]; \
          accf[0] += (float)t0; accf[1] += (float)t1; accf[2] += (float)t2; accf[3] += (float)t3; accf[4] += (float)t4; accf[5] += (float)t5; accf[6] += (float)t6; accf[7] += (float)t7; } } while (0)
#pragma unroll 1
            for (int tb = wid; tb < NTB; tb += 4) {
                const int tok = tb * 64 + lane; const bool valid = tok < MROWS; const int tokc = valid ? tok : MROWS - 1;
                const unsigned* wp = WLT + tokc;
                f32x4* hp = (f32x4*)(H + (size_t)tokc * D + cg * 8); const f32x4 h0 = hp[0], h1 = hp[1];
                float accf[8];
#pragma unroll
                for (int j = 0; j < 8; ++j) accf[j] = 0.f;
                unsigned wa[16], wb[16];
                VL_LOAD(wa, 0);
#pragma unroll 1
                for (int c = 0; c < 8; c += 2) {
                    VL_LOAD(wb, c + 1);
                    __builtin_amdgcn_sched_barrier(0);
                    VL_CHUNK(wa);
                    __builtin_amdgcn_sched_barrier(0);
                    VL_LOAD(wa, (c + 2) & 7);
                    __builtin_amdgcn_sched_barrier(0);
                    VL_CHUNK(wb);
                    __builtin_amdgcn_sched_barrier(0);
                }
                if (valid) { hp[0] = h0 + (f32x4){accf[0], accf[1], accf[2], accf[3]}; hp[1] = h1 + (f32x4){accf[4], accf[5], accf[6], accf[7]}; }
            }
#undef VL_LOAD
#undef VL_CHUNK
        } } else if (first && RUN_G) {
            const int x = blockIdx.x & 7, g = (blockIdx.x >> 3) * 4 + (wid - 4), NG = (G >> 3) * 4, r8 = lane >> 3, c8 = lane & 7;
            const unsigned* WLP = (const unsigned*)(ws + WS_WL);
            const unsigned char* tbl = pvg + 16 * c8;
            const int h3 = (lane >> 3) & 1, xaddr = (lane ^ 8) << 2;
            constexpr int NIT = 2 * MROWS;
#define VD_IDS(pw, IT) do { const int t_ = (IT) - ((IT) / MROWS) * MROWS; const unsigned* wp_ = WLP + (size_t)t_ * 128 + r8 * 16 + (lane & 3); \
        pw[0] = wp_[0]; pw[1] = wp_[4]; pw[2] = wp_[8]; pw[3] = wp_[12]; } while (0)
#define VD_ISSUE(rb, pk, hv, hp, pw, IT) do { const int sp_ = (IT) / MROWS, t_ = (IT) - sp_ * MROWS, sl_ = x + 8 * sp_; const unsigned char* vb_ = tbl + 128 * sl_; \
        _Pragma("unroll") for (int k = 0; k < 4; ++k) { pk[4 * k + 0] = dppu<0x00>(pw[k]); pk[4 * k + 1] = dppu<0x55>(pw[k]); pk[4 * k + 2] = dppu<0xAA>(pw[k]); pk[4 * k + 3] = dppu<0xFF>(pw[k]); } \
        _Pragma("unroll") for (int i = 0; i < 16; ++i) rb[i] = *(const u32x4*)(vb_ + ((pk[i] >> 16) << 11)); \
        hp = (f32x2*)(H + (size_t)t_ * D + 2048 + 128 * sl_ + 16 * c8 + 2 * r8); hv = *hp; } while (0)
#define VD_COMP(rb, wv, hv, hp, VALID) do { h16x2 ah[8]; \
        _Pragma("unroll") for (int j = 0; j < 8; ++j) ah[j] = (h16x2){(_Float16)0.f, (_Float16)0.f}; \
        _Pragma("unroll") for (int i = 0; i < 16; ++i) { const h16x2 w2 = __builtin_bit_cast(h16x2, __builtin_amdgcn_perm(wv[i], wv[i], 0x01000100u)); const unsigned q_[4] = {rb[i].x, rb[i].y, rb[i].z, rb[i].w}; \
            _Pragma("unroll") for (int q = 0; q < 4; ++q) { const h16x2 lo = __builtin_bit_cast(h16x2, __builtin_amdgcn_perm(0u, q_[q], 0x010c000cu)), hi = __builtin_bit_cast(h16x2, __builtin_amdgcn_perm(0u, q_[q], 0x030c020cu)); \
                ah[2 * q + 0] = w2 * lo + ah[2 * q + 0]; ah[2 * q + 1] = w2 * hi + ah[2 * q + 1]; } } \
        float acc[16]; \
        _Pragma("unroll") for (int j = 0; j < 8; ++j) { const h16x2 t_ = ah[j]; const _Float16 t0 = t_[0], t1 = t_[1]; acc[2 * j] = (float)t0; acc[2 * j + 1] = (float)t1; } \
        float o8[8], o4[4], o2[2]; \
        _Pragma("unroll") for (int j = 0; j < 8; ++j) { const auto sw = __builtin_amdgcn_permlane32_swap(__float_as_uint(acc[j]), __float_as_uint(acc[8 + j]), false, false); const unsigned s0 = sw[0], s1 = sw[1]; o8[j] = __uint_as_float(s0) + __uint_as_float(s1); } \
        _Pragma("unroll") for (int j = 0; j < 4; ++j) { const auto sw = __builtin_amdgcn_permlane16_swap(__float_as_uint(o8[j]), __float_as_uint(o8[4 + j]), false, false); const unsigned s0 = sw[0], s1 = sw[1]; o4[j] = __uint_as_float(s0) + __uint_as_float(s1); } \
        _Pragma("unroll") for (int j = 0; j < 2; ++j) { const float keep = h3 ? o4[2 + j] : o4[j], give = h3 ? o4[j] : o4[2 + j]; o2[j] = keep + __int_as_float(__builtin_amdgcn_ds_bpermute(xaddr, __float_as_int(give))); } \
        f32x2 hn_ = hv; hn_[0] += o2[0]; hn_[1] += o2[1]; if (VALID) *hp = hn_; } while (0)
            if (g < NIT) {
                u32x4 ra[16], rc[16]; unsigned pka[16], pkc[16]; f32x2 hva, hvc; f32x2* hpa; f32x2* hpc;
                unsigned pw0[4], pw1[4];
                VD_IDS(pw0, g);
                { const int i1c = g + NG < NIT ? g + NG : g; VD_IDS(pw1, i1c); }
                VD_ISSUE(ra, pka, hva, hpa, pw0, g);
#pragma unroll 1
                for (int item = g; item < NIT; item += 2 * NG) {
                    const int i1 = item + NG, i2 = item + 2 * NG, i3 = item + 3 * NG;
                    const bool v1 = i1 < NIT;
                    const int i1c = v1 ? i1 : item, i2c = i2 < NIT ? i2 : item, i3c = i3 < NIT ? i3 : item;
                    VD_IDS(pw0, i2c);
                    __builtin_amdgcn_sched_barrier(0);
                    VD_ISSUE(rc, pkc, hvc, hpc, pw1, i1c);
                    __builtin_amdgcn_sched_barrier(0);
                    VD_COMP(ra, pka, hva, hpa, true);
                    __builtin_amdgcn_sched_barrier(0);
                    VD_IDS(pw1, i3c);
                    __builtin_amdgcn_sched_barrier(0);
                    VD_ISSUE(ra, pka, hva, hpa, pw0, i2c);
                    __builtin_amdgcn_sched_barrier(0);
                    VD_COMP(rc, pkc, hvc, hpc, v1);
                    __builtin_amdgcn_sched_barrier(0);
                }
            }
#undef VD_IDS
#undef VD_ISSUE
#undef VD_COMP
        }
        first = false;
    }
}

__device__ __forceinline__ void phase_udot32m(unsigned char* ws, int layer, int G) {
    int tid = threadIdx.x; asm volatile("" : "+v"(tid)); const int lane = tid & 63, wid = __builtin_amdgcn_readfirstlane(tid >> 6);
    const int x = blockIdx.x & 7, g = (blockIdx.x >> 3) * NWAVES + wid, NG = (G >> 3) * NWAVES, fr = lane & 15, fq = lane >> 4;
    const int* EIDL = (const int*)(ws + WS_EIDL); float* DOTP = (float*)(ws + WS_DOTP);
    const unsigned char* tbl = ws + WS_PU + (size_t)layer * NEXP * D + 16 * fq;
    const unsigned char* hb8 = ws + WS_HB8 + 16 * fq;
    typedef long i64x2 __attribute__((ext_vector_type(2)));
#pragma unroll 1
    for (int sp = 0; sp < NS32 / 8; ++sp) {
        const int slice = x + 8 * sp;
        const unsigned char* ubase = tbl + 128 * slice;
        int eo[8]; i64x2 hb0 = {0, 0}, hb1 = {0, 0};
#pragma unroll
        for (int b = 0; b < 8; ++b) eo[b] = 0;
        if (g < MROWS) {
#pragma unroll
            for (int b = 0; b < 8; ++b) eo[b] = EIDL[(size_t)g * 128 + 16 * b + fr];
            hb0 = *(const i64x2*)(hb8 + (size_t)g * D + 128 * slice); hb1 = *(const i64x2*)(hb8 + (size_t)g * D + 128 * slice + 64); }
#pragma unroll 1
        for (int tok = g; tok < MROWS; tok += NG) {
            i64x2 r0[8], r1[8];
#pragma unroll
            for (int b = 0; b < 8; ++b) { const unsigned char* rp = ubase + (unsigned)eo[b]; r0[b] = *(const i64x2*)rp; r1[b] = *(const i64x2*)(rp + 64); }
            const i64x2 c0 = hb0, c1 = hb1;
            const int nt = tok + NG;
            if (nt < MROWS) {
#pragma unroll
                for (int b = 0; b < 8; ++b) eo[b] = EIDL[(size_t)nt * 128 + 16 * b + fr];
                hb0 = *(const i64x2*)(hb8 + (size_t)nt * D + 128 * slice); hb1 = *(const i64x2*)(hb8 + (size_t)nt * D + 128 * slice + 64); }
            __builtin_amdgcn_sched_barrier(0);
            float* dp = DOTP + ((size_t)tok * NS32 + slice) * 128 + 4 * fq;
#pragma unroll
            for (int b = 0; b < 8; ++b) { f32x4 acc = (f32x4){0.f, 0.f, 0.f, 0.f};
                acc = __builtin_amdgcn_mfma_f32_16x16x32_fp8_fp8(r0[b][0], c0[0], acc, 0, 0, 0); acc = __builtin_amdgcn_mfma_f32_16x16x32_fp8_fp8(r0[b][1], c0[1], acc, 0, 0, 0);
                acc = __builtin_amdgcn_mfma_f32_16x16x32_fp8_fp8(r1[b][0], c1[0], acc, 0, 0, 0); acc = __builtin_amdgcn_mfma_f32_16x16x32_fp8_fp8(r1[b][1], c1[1], acc, 0, 0, 0);
                if (fr == 0) *(f32x4*)(dp + 16 * b) = acc; }
        }
    }
}

__device__ __forceinline__ void phase_udot32p(unsigned char* ws, int layer, int G) {
    int tid = threadIdx.x; asm volatile("" : "+v"(tid)); const int lane = tid & 63, wid = __builtin_amdgcn_readfirstlane(tid >> 6);
    const int x = blockIdx.x & 7, g = (blockIdx.x >> 3) * NWAVES + wid, NG = (G >> 3) * NWAVES, r8 = lane >> 3, c8 = lane & 7, r84 = r8 * 4;
    const int* EIDL = (const int*)(ws + WS_EIDL); const bf16_t* HB = (const bf16_t*)(ws + WS_HB); float* DOTP = (float*)(ws + WS_DOTP);
    const unsigned char* tbl = ws + WS_PU + (size_t)layer * NEXP * D + 16 * c8;
    const int taddr = (8 * (lane & 7) + (lane >> 3)) * 4;
#define UP_IDS(T) do { ea = EIDL[(size_t)(T) * 128 + lane]; eb = EIDL[(size_t)(T) * 128 + 64 + lane]; const u32x4* hp8_ = (const u32x4*)(HB + (size_t)(T) * D + 128 * slice + 16 * c8); h0 = hp8_[0]; h1 = hp8_[1]; } while (0)
#define UP_ISSUE(rb, hq) do { unsigned eo_[16]; _Pragma("unroll") for (int i = 0; i < 16; ++i) eo_[i] = (unsigned)lane_get(ea, eb, i, r84); \
        hq[0] = h0.x; hq[1] = h0.y; hq[2] = h0.z; hq[3] = h0.w; hq[4] = h1.x; hq[5] = h1.y; hq[6] = h1.z; hq[7] = h1.w; \
        _Pragma("unroll") for (int i = 0; i < 16; ++i) rb[i] = *(const u32x4*)(ubase + eo_[i]); } while (0)
#define UP_COMP(rb, hq, T) do { float v0 = 0.f, v1 = 0.f; _Pragma("unroll") for (int hh = 0; hh < 2; ++hh) { \
            float d0 = dot16_fp8_bf16(rb[8 * hh + 0], hq), d1 = dot16_fp8_bf16(rb[8 * hh + 1], hq), d2 = dot16_fp8_bf16(rb[8 * hh + 2], hq), d3 = dot16_fp8_bf16(rb[8 * hh + 3], hq), \
                  d4 = dot16_fp8_bf16(rb[8 * hh + 4], hq), d5 = dot16_fp8_bf16(rb[8 * hh + 5], hq), d6 = dot16_fp8_bf16(rb[8 * hh + 6], hq), d7 = dot16_fp8_bf16(rb[8 * hh + 7], hq); \
            asm volatile("s_nop 1\n\t" PEER_DPP8("quad_perm:[1,0,3,2] row_mask:0xf bank_mask:0xf bound_ctrl:1") PEER_DPP8("quad_perm:[2,3,0,1] row_mask:0xf bank_mask:0xf bound_ctrl:1") \
                         PEER_DPP8("row_half_mirror row_mask:0xf bank_mask:0xf bound_ctrl:1") : "+v"(d0), "+v"(d1), "+v"(d2), "+v"(d3), "+v"(d4), "+v"(d5), "+v"(d6), "+v"(d7)); \
            float v = d0; v = c8 == 1 ? d1 : v; v = c8 == 2 ? d2 : v; v = c8 == 3 ? d3 : v; v = c8 == 4 ? d4 : v; v = c8 == 5 ? d5 : v; v = c8 == 6 ? d6 : v; v = c8 == 7 ? d7 : v; \
            if (hh == 0) v0 = v; else v1 = v; } \
        float* dp_ = DOTP + ((size_t)(T) * NS32 + slice) * 128; \
        dp_[lane] = __int_as_float(__builtin_amdgcn_ds_bpermute(taddr, __float_as_int(v0))); dp_[64 + lane] = __int_as_float(__builtin_amdgcn_ds_bpermute(taddr, __float_as_int(v1))); } while (0)
#pragma unroll 1
    for (int sp = 0; sp < NS32 / 8; ++sp) {
        const int slice = x + 8 * sp;
        const unsigned char* ubase = tbl + 128 * slice;
        if (g >= MROWS) continue;
        int ea, eb; u32x4 h0, h1; u32x4 ra[16], rc[16]; unsigned qa[8], qc[8];
        UP_IDS(g); UP_ISSUE(ra, qa);
        if (g + NG < MROWS) UP_IDS(g + NG);
#pragma unroll 1
        for (int tok = g; tok < MROWS; tok += 2 * NG) {
            const int t1 = tok + NG, t2 = tok + 2 * NG;
            if (t1 < MROWS) { UP_ISSUE(rc, qc); if (t2 < MROWS) UP_IDS(t2); }
            __builtin_amdgcn_sched_barrier(0);
            UP_COMP(ra, qa, tok);
            __builtin_amdgcn_sched_barrier(0);
            if (t1 < MROWS) {
                if (t2 < MROWS) { UP_ISSUE(ra, qa); if (t2 + NG < MROWS) UP_IDS(t2 + NG); }
                __builtin_amdgcn_sched_barrier(0);
                UP_COMP(rc, qc, t1);
                __builtin_amdgcn_sched_barrier(0);
            }
        }
    }
#undef UP_IDS
#undef UP_ISSUE
#undef UP_COMP
}

template <bool DRY = false>
__device__ __forceinline__ void phase_vacc32p(unsigned char* ws, int layer, int G) {
    int tid = threadIdx.x; asm volatile("" : "+v"(tid)); const int lane = tid & 63, wid = __builtin_amdgcn_readfirstlane(tid >> 6);
    const int x = blockIdx.x & 7, g = (blockIdx.x >> 3) * NWAVES + wid, NG = (G >> 3) * NWAVES, r8 = lane >> 3, c8 = lane & 7, r84 = r8 * 4;
    const int* EIDL = (const int*)(ws + WS_EIDL); const float* WL = (const float*)(ws + WS_WL); float* H = (float*)(ws + (DRY ? WS_WAG : WS_H));
    const unsigned char* tbl = ws + WS_PV + (size_t)layer * NEXP * D + 16 * c8;
    const int h3 = (lane >> 3) & 1, xaddr = (lane ^ 8) << 2;
#define VP_IDS(T) do { ea = EIDL[(size_t)(T) * 128 + lane]; eb = EIDL[(size_t)(T) * 128 + 64 + lane]; wa = WL[(size_t)(T) * 128 + lane]; wb = WL[(size_t)(T) * 128 + 64 + lane]; } while (0)
#define VP_ISSUE(rb, wv) do { unsigned eo_[16]; _Pragma("unroll") for (int i = 0; i < 16; ++i) { eo_[i] = (unsigned)lane_get(ea, eb, i, r84); wv[i] = __int_as_float(lane_get(__float_as_int(wa), __float_as_int(wb), i, r84)); } \
        _Pragma("unroll") for (int i = 0; i < 16; ++i) rb[i] = *(const u32x4*)(vbase + eo_[i]); } while (0)
#define VP_COMP(rb, wvv, T) do { float acc[16]; _Pragma("unroll") for (int j = 0; j < 16; ++j) acc[j] = 0.f; \
        _Pragma("unroll") for (int i = 0; i < 16; ++i) { const float w = wvv[i]; const unsigned wv_[4] = {rb[i].x, rb[i].y, rb[i].z, rb[i].w}; \
            _Pragma("unroll") for (int q = 0; q < 4; ++q) { const f32x2 lo = __builtin_amdgcn_cvt_pk_f32_fp8((int)wv_[q], false), hi = __builtin_amdgcn_cvt_pk_f32_fp8((int)wv_[q], true); \
                acc[4 * q + 0] = fmaf(w, lo.x, acc[4 * q + 0]); acc[4 * q + 1] = fmaf(w, lo.y, acc[4 * q + 1]); acc[4 * q + 2] = fmaf(w, hi.x, acc[4 * q + 2]); acc[4 * q + 3] = fmaf(w, hi.y, acc[4 * q + 3]); } } \
        float o8[8], o4[4], o2[2]; \
        _Pragma("unroll") for (int j = 0; j < 8; ++j) { const auto sw = __builtin_amdgcn_permlane32_swap(__float_as_uint(acc[j]), __float_as_uint(acc[8 + j]), false, false); const unsigned s0 = sw[0], s1 = sw[1]; o8[j] = __uint_as_float(s0) + __uint_as_float(s1); } \
        _Pragma("unroll") for (int j = 0; j < 4; ++j) { const auto sw = __builtin_amdgcn_permlane16_swap(__float_as_uint(o8[j]), __float_as_uint(o8[4 + j]), false, false); const unsigned s0 = sw[0], s1 = sw[1]; o4[j] = __uint_as_float(s0) + __uint_as_float(s1); } \
        _Pragma("unroll") for (int j = 0; j < 2; ++j) { const float keep = h3 ? o4[2 + j] : o4[j], give = h3 ? o4[j] : o4[2 + j]; o2[j] = keep + __int_as_float(__builtin_amdgcn_ds_bpermute(xaddr, __float_as_int(give))); } \
        f32x2* hp_ = (f32x2*)(H + (size_t)(T) * D + 128 * slice + 16 * c8 + 2 * r8); f32x2 hv = *hp_; hv[0] += o2[0]; hv[1] += o2[1]; *hp_ = hv; } while (0)
#pragma unroll 1
    for (int sp = 0; sp < NS32 / 8; ++sp) {
        const int slice = x + 8 * sp;
        const unsigned char* vbase = tbl + 128 * slice;
        if (g >= MROWS) continue;
        int ea, eb; float wa, wb; u32x4 ra[16], rc[16]; float wva[16], wvc[16];
        VP_IDS(g); VP_ISSUE(ra, wva);
        if (g + NG < MROWS) VP_IDS(g + NG);
#pragma unroll 1
        for (int tok = g; tok < MROWS; tok += 2 * NG) {
            const int t1 = tok + NG, t2 = tok + 2 * NG;
            if (t1 < MROWS) { VP_ISSUE(rc, wvc); if (t2 < MROWS) VP_IDS(t2); }
            __builtin_amdgcn_sched_barrier(0);
            VP_COMP(ra, wva, tok);
            __builtin_amdgcn_sched_barrier(0);
            if (t1 < MROWS) {
                if (t2 < MROWS) { VP_ISSUE(ra, wva); if (t2 + NG < MROWS) VP_IDS(t2 + NG); }
                __builtin_amdgcn_sched_barrier(0);
                VP_COMP(rc, wvc, t1);
                __builtin_amdgcn_sched_barrier(0);
            }
        }
    }
#undef VP_IDS
#undef VP_ISSUE
#undef VP_COMP
}
#define MK_PER_PHASE 0
#ifndef PROBE_DUP
#define PROBE_DUP 0
#endif
#ifndef MK_PER_PHASE
#define MK_PER_PHASE 0
#endif
constexpr int NPHASE = 21;
#ifndef S5_SHARE_V
#define S5_SHARE_V 30000
#endif
constexpr int S5_SHARE = S5_SHARE_V;
#ifndef P4_L1_LO_V
#define P4_L1_LO_V 32768
#endif
constexpr int P4_L1_LO = P4_L1_LO_V;
#ifndef KSPLIT_OUT_V
#define KSPLIT_OUT_V 2048
#endif
constexpr int KSPLIT_OUT = KSPLIT_OUT_V;
struct Args { const float* in[34]; float* out; unsigned char* ws; int ph_lo, ph_hi; };

__global__ void __launch_bounds__(NTHREADS, 2) fwd(Args args) {
    extern __shared__ __attribute__((aligned(16))) unsigned char lds_raw[];
    LAS unsigned char* lds = (LAS unsigned char*)lds_raw;
    const int tid = threadIdx.x, G = gridDim.x, cblk = blockIdx.x;
    unsigned char* ws = args.ws;
    volatile LAS unsigned* MISC = (volatile LAS unsigned*)(lds + MISC_OFF);
    if (tid < 64) MISC[tid] = 0u;
    __syncthreads();
    const int lo = args.ph_lo, hi = args.ph_hi;
    unsigned* barw = (unsigned*)(ws + WS_CTL) + CW_BAR;
    XcdBarrier bar; bar.bar = barw; bar.x = 0; bar.st = nullptr;
    if (hi - lo > 1) bar = xcd_barrier_post(barw, MISC + 8);
#ifndef PH_MASK
#define PH_MASK 0x1fffff
#endif
#define IN(k) (((PH_MASK >> (k)) & 1) && lo <= (k) && (k) < hi)
#define SEAM(k) do { if ((k) + 1 < hi) xcd_barrier(bar); } while (0)
    bf16_t* HB = (bf16_t*)(ws + WS_HB); float* H = (float*)(ws + WS_H);

    if (IN(0)) {
#if (PROBE_DUP & 1)
        phase_prologue<1>(args.in, ws, lds, G);
#endif
#if (PROBE_DUP & 131072)
        phase_prologue<2>(args.in, ws, lds, G);
#endif
        phase_prologue(args.in, ws, lds, G); SEAM(0); }
    if (IN(1)) { pg8::Gemm g{HB, (const bf16_t*)(ws + WS_W1T), D, D, D}; pg8::StaticOrder S; S.init(MX / 256, ZLD / 256, G, cblk);
        EpiBf16 E{(bf16_t*)(ws + WS_Z), ZLD, nullptr};
#if (PROBE_DUP & 2)
        pg8::gemm_phase<EpiBf16, pg8::StaticOrder, true>(lds, g, S, E);
#endif
        pg8::gemm_phase<EpiBf16, pg8::StaticOrder, true>(lds, g, S, E);
        pg8::gemm_tail(HB + (size_t)MX * D, g, ZLD / 256, S, E, lds);
        {
            const int nunits = (MX / 256) * (ZLD / 256), nfull = nunits - (nunits / G) * G;
            int tid2 = threadIdx.x; asm volatile("" : "+v"(tid2)); const int w2 = __builtin_amdgcn_readfirstlane(tid2 >> 6);
            if (nfull > 0 && nfull < G) { if (cblk >= nfull) { early_weights(args.in, ws, (LAS float*)(lds + w2 * 16384), (cblk - nfull) * NWAVES + w2, (G - nfull) * NWAVES, (size_t)(cblk - nfull) * NTHREADS + tid2, (size_t)(G - nfull) * NTHREADS, tid2 & 63);
                                                                late_weights<2>(args.in, ws, (LAS float*)(lds + w2 * 16384), (cblk - nfull) * NWAVES + w2, (G - nfull) * NWAVES, tid2 & 63); } }
            else { early_weights(args.in, ws, (LAS float*)(lds + w2 * 16384), cblk * NWAVES + w2, G * NWAVES, (size_t)cblk * NTHREADS + tid2, (size_t)G * NTHREADS, tid2 & 63);
                   late_weights<2>(args.in, ws, (LAS float*)(lds + w2 * 16384), cblk * NWAVES + w2, G * NWAVES, tid2 & 63); } }
        SEAM(1); }
    if (IN(2)) {
#if (PROBE_DUP & 4)
        phase_prep(args.in[8], ws, G);
#endif
        phase_prep(args.in[8], ws, G); SEAM(2);
#if (PROBE_DUP & 4096)
        for (int r = 0; r < 20; ++r) xcd_barrier(bar);
#endif
    }
    if (IN(3)) {
        { pg8::Gemm g{(const bf16_t*)(ws + WS_LA), (const bf16_t*)(ws + WS_BTL), 512, 256, 256}; pg8::StaticOrder S; S.init(MX / 256, 24, G, cblk, 16, 256);
          EpiBf16 E{(bf16_t*)(ws + WS_WAG), WAGLD, nullptr};
          pg8::gemm_phase<EpiBf16, pg8::StaticOrder, true>(lds, g, S, E);
          pg8::gemm_tail((const bf16_t*)(ws + WS_LA) + (size_t)MX * 512, g, 24, S, E, lds); }
        { pg8::Gemm g{(const bf16_t*)(ws + WS_PM), (const bf16_t*)(ws + WS_BTP), 2048, 512, 512}; pg8::StaticOrder S; S.init(MX / 256, 8, G, cblk, 2, 512);
          EpiBf16 E{(bf16_t*)(ws + WS_Y), D, args.in[7]};
          pg8::gemm_phase<EpiBf16, pg8::StaticOrder, true>(lds, g, S, E);
          pg8::gemm_tail((const bf16_t*)(ws + WS_PM) + (size_t)MX * 2048, g, 8, S, E, lds); }
        SEAM(3); }
    if (IN(4)) {
#if (PROBE_DUP & 16)
        phase_rwkv<2>(args.in, ws, lds, G);
#endif
#if (PROBE_DUP & 32)
        phase_rwkv<1>(args.in, ws, lds, G);
#endif
        if (G >= 256) {
            if (cblk < 128) phase_rwkv(args.in, ws, lds, G);
            else { const int G2 = G - 128, c2 = cblk - 128;
                { pg8::Gemm g{(const bf16_t*)(ws + WS_Y), (const bf16_t*)(ws + WS_WOT), D, D, KSPLIT_OUT}; pg8::StaticOrder S; S.init(MX / 256, D / 256, G2, c2);
                  EpiF32 E{H, D, 1, args.in[0], args.in[1]};
                  pg8::gemm_phase<EpiF32, pg8::StaticOrder, true>(lds, g, S, E);
                  pg8::gemm_tail((const bf16_t*)(ws + WS_Y) + (size_t)MX * D, g, D / 256, S, E, lds); }
                { int tid2 = threadIdx.x; asm volatile("" : "+v"(tid2)); const int w2 = __builtin_amdgcn_readfirstlane(tid2 >> 6);
                  peer_convert(args.in, ws, c2 * NWAVES + w2, G2 * NWAVES, tid2 & 63, 0, 0, NEXP);
                  peer_convert_v<8>(args.in, ws, lds + w2 * 16384, c2 * NWAVES + w2, G2 * NWAVES, tid2 & 63, 0);
                  peer_convert_v<8>(args.in, ws, lds + w2 * 16384, c2 * NWAVES + w2, G2 * NWAVES, tid2 & 63, 1);
                  late_weights<0>(args.in, ws, (LAS float*)(lds + w2 * 16384), c2 * NWAVES + w2, G2 * NWAVES, tid2 & 63);
#if (PROBE_DUP & 64)
                  late_weights<0>(args.in, ws, (LAS float*)(lds + w2 * 16384), c2 * NWAVES + w2, G2 * NWAVES, tid2 & 63);
                  late_weights<0>(args.in, ws, (LAS float*)(lds + w2 * 16384), c2 * NWAVES + w2, G2 * NWAVES, tid2 & 63);
#endif
                } }
        } else {
            phase_rwkv(args.in, ws, lds, G);
            { pg8::Gemm g{(const bf16_t*)(ws + WS_Y), (const bf16_t*)(ws + WS_WOT), D, D, KSPLIT_OUT}; pg8::StaticOrder S; S.init(MX / 256, D / 256, G, cblk);
              EpiF32 E{H, D, 1, args.in[0], args.in[1]};
              pg8::gemm_phase<EpiF32, pg8::StaticOrder, true>(lds, g, S, E);
              pg8::gemm_tail((const bf16_t*)(ws + WS_Y) + (size_t)MX * D, g, D / 256, S, E, lds); }
            { int tid2 = threadIdx.x; asm volatile("" : "+v"(tid2)); const int w2 = __builtin_amdgcn_readfirstlane(tid2 >> 6);
              peer_convert(args.in, ws, cblk * NWAVES + w2, G * NWAVES, tid2 & 63, 0, 0, NEXP);
              peer_convert_v<8>(args.in, ws, lds + w2 * 16384, cblk * NWAVES + w2, G * NWAVES, tid2 & 63, 0);
              peer_convert_v<8>(args.in, ws, lds + w2 * 16384, cblk * NWAVES + w2, G * NWAVES, tid2 & 63, 1);
              late_weights<0>(args.in, ws, (LAS float*)(lds + w2 * 16384), cblk * NWAVES + w2, G * NWAVES, tid2 & 63); }
        }
        SEAM(4); }
    if (IN(5)) { pg8::Gemm g{(const bf16_t*)(ws + WS_Y) + KSPLIT_OUT, (const bf16_t*)(ws + WS_WOT) + KSPLIT_OUT, D, D, D - KSPLIT_OUT}; pg8::StaticOrder S; S.init(MX / 256, D / 256, G, cblk);
        EpiF32 E{H, D, 1, nullptr, nullptr};
        pg8::gemm_phase<EpiF32, pg8::StaticOrder, true>(lds, g, S, E);
        pg8::gemm_tail((const bf16_t*)(ws + WS_Y) + (size_t)MX * D + KSPLIT_OUT, g, D / 256, S, E, lds); SEAM(5); }
    if (IN(6)) { phase_norm<false, true>(ws, G, args.in[3]); SEAM(6); }
    if (IN(7)) { pg8::Gemm g{HB, (const bf16_t*)(ws + WS_WST), D, D, D}; pg8::StaticOrder S; S.init(MX / 256, 8, G, cblk);
        EpiF32 E{(float*)(ws + WS_SC), 2048, 0, nullptr, nullptr};
        pg8::gemm_phase<EpiF32, pg8::StaticOrder, true>(lds, g, S, E);
        pg8::gemm_tail(HB + (size_t)MX * D, g, 8, S, E, lds); SEAM(7); }
    if (IN(8)) {
#if (PROBE_DUP & 256)
        phase_topk(ws, G);
#endif
        phase_topk(ws, G); SEAM(8); }
    if (IN(9)) {
#if (PROBE_DUP & 512)
        phase_udot(ws, 0, G);
#endif
        phase_udot(ws, 0, G); SEAM(9); }
    if (IN(10)) { phase_pw<8>(ws, 0, G); xcd_barrier(bar);
#if (PROBE_DUP & 2048)
        phase_vaccH<true, false, true>(ws, lds, 0, G);
#endif
#if (PROBE_DUP & 1048576)
        phase_vaccH<false, true, true>(ws, lds, 0, G);
#endif
        phase_vaccH(ws, lds, 0, G); SEAM(10); }
    if (IN(11)) { phase_norm<false>(ws, G); SEAM(11); }
    if (IN(12)) { pg8::Gemm g{HB, (const bf16_t*)(ws + WS_WIO), D, D, D}; pg8::StaticOrder S; S.init(MX / 256, 8, G, cblk);
        EpiBf16 E{(bf16_t*)(ws + WS_U), 2048, nullptr};
        pg8::gemm_phase<EpiBf16, pg8::StaticOrder, true>(lds, g, S, E);
        pg8::gemm_tail(HB + (size_t)MX * D, g, 8, S, E, lds); SEAM(12); }
    if (IN(13)) {
        phase_s5p(args.in, ws, lds, G);
        { int tid2 = threadIdx.x; asm volatile("" : "+v"(tid2)); const int w2 = __builtin_amdgcn_readfirstlane(tid2 >> 6);
          if (w2 >= 4) { peer_convert(args.in, ws, cblk * 4 + (w2 - 4), G * 4, tid2 & 63, 1, 0, NEXP);
                         late_weights<1>(args.in, ws, (LAS float*)(lds + 65536 + (w2 - 4) * 8704), cblk * 4 + (w2 - 4), G * 4, tid2 & 63); } }
        SEAM(13); }
    if (IN(14)) { pg8::Gemm g{(const bf16_t*)(ws + WS_YS), (const bf16_t*)(ws + WS_WGT), 2048, 2048, 2048}; pg8::StaticOrder S; S.init(MX / 256, 32, G, cblk);
        EpiGlu E{H};
        pg8::gemm_phase<EpiGlu, pg8::StaticOrder, true>(lds, g, S, E);
        pg8::gemm_tail((const bf16_t*)(ws + WS_YS) + (size_t)MX * 2048, g, 32, S, E, lds); SEAM(14); }
    if (IN(15)) { phase_norm<false, true>(ws, G, args.in[3] + D); SEAM(15); }
    if (IN(16)) { pg8::Gemm g{HB, (const bf16_t*)(ws + WS_WST) + (size_t)2048 * D, D, D, D}; pg8::StaticOrder S; S.init(MX / 256, 8, G, cblk);
        EpiF32 E{(float*)(ws + WS_SC), 2048, 0, nullptr, nullptr};
        pg8::gemm_phase<EpiF32, pg8::StaticOrder, true>(lds, g, S, E);
        pg8::gemm_tail(HB + (size_t)MX * D, g, 8, S, E, lds); SEAM(16); }
    if (IN(17)) { phase_topk(ws, G); SEAM(17); }
    if (IN(18)) { phase_udot(ws, 1, G); SEAM(18); }
    if (IN(19)) { phase_pw<8>(ws, 1, G); xcd_barrier(bar); phase_vaccH(ws, lds, 1, G); SEAM(19); }
    if (IN(20)) {
#if (PROBE_DUP & 262144)
        { int t3 = threadIdx.x; asm volatile("" : "+v"(t3)); unsigned a[8];
#pragma unroll
          for (int j = 0; j < 8; ++j) a[j] = (unsigned)(t3 + j) * 0x01010101u;
#pragma unroll 2
          for (int i = 0; i < 1024; ++i) {
#pragma unroll
              for (int j = 0; j < 8; ++j) { const f32x2 r = __builtin_amdgcn_cvt_pk_f32_fp8((int)a[j], false); a[j] ^= __float_as_uint(r.x) >> 9; } }
          ((unsigned*)(ws + WS_WAG))[(size_t)cblk * NTHREADS + t3] = a[0] ^ a[1] ^ a[2] ^ a[3] ^ a[4] ^ a[5] ^ a[6] ^ a[7]; }
#endif
#if (PROBE_DUP & 524288)
        { int t3 = threadIdx.x; asm volatile("" : "+v"(t3)); float a = (float)t3;
#pragma unroll 16
          for (int i = 0; i < 8192; ++i) { const float r = fmaf(a, 1.0001f, 0.5f); a = __uint_as_float(__float_as_uint(r) ^ (__float_as_uint(a) >> 9)); }
          ((float*)(ws + WS_WAG))[(size_t)cblk * NTHREADS + t3] = a; }
#endif
        phase_final(args.in[4], args.out, ws, G); }
#undef IN
#undef SEAM
}

extern "C" void kernel_launch(void* const* d_in, const int* in_sizes, int n_in, void* d_out, int out_size, void* d_ws, size_t ws_size, hipStream_t stream) {
    static int grid = 0;
    if (grid == 0) {
        if (n_in != 34 || out_size != MX * D || ws_size < WS_END) { fprintf(stderr, "kernel_launch: unexpected shapes (n_in %d, out %d, ws %zu < %zu); nothing launched\n", n_in, out_size, ws_size, (size_t)WS_END); grid = -1; return; }
        int dev = 0, cus = 0, per_cu = 0;
        if (hipGetDevice(&dev) != hipSuccess || hipDeviceGetAttribute(&cus, hipDeviceAttributeMultiprocessorCount, dev) != hipSuccess) { grid = -1; return; }
        if (hipFuncSetAttribute((const void*)fwd, hipFuncAttributeMaxDynamicSharedMemorySize, LDS_BYTES) != hipSuccess) { fprintf(stderr, "kernel_launch: hipFuncSetAttribute failed\n"); grid = -1; return; }
        if (hipOccupancyMaxActiveBlocksPerMultiprocessor(&per_cu, (const void*)fwd, NTHREADS, LDS_BYTES) != hipSuccess || per_cu < 1) { fprintf(stderr, "kernel_launch: occupancy query reports %d workgroups per CU\n", per_cu); }
        (void)hipGetLastError();
        grid = cus;
        if (grid % 8 != 0) { fprintf(stderr, "kernel_launch: %d CUs: the PEER slicing needs a multiple of 8 workgroups\n", grid); grid = (grid / 8) * 8; if (grid < 8) { grid = -1; return; } }
    }
    if (grid < 0) return;
    (void)hipMemsetAsync((char*)d_ws + WS_CTL, 0, CTL_ZERO_BYTES, stream);
    Args a{};
    for (int i = 0; i < 34; ++i) a.in[i] = (const float*)d_in[i];
    a.out = (float*)d_out; a.ws = (unsigned char*)d_ws;
#if MK_PER_PHASE
    for (int p = 0; p < NPHASE; ++p) { a.ph_lo = p; a.ph_hi = p + 1; hipLaunchKernelGGL(fwd, dim3(grid), dim3(NTHREADS), LDS_BYTES, stream, a); }
#else
    a.ph_lo = 0; a.ph_hi = NPHASE; hipLaunchKernelGGL(fwd, dim3(grid), dim3(NTHREADS), LDS_BYTES, stream, a);
#endif
}
```

```cpp
#include <hip/hip_runtime.h>
#include <cstdio>
#include <cstdint>

#define LAS __attribute__((address_space(3)))
typedef unsigned short bf16_t;
typedef short bf16x8 __attribute__((ext_vector_type(8)));
typedef __bf16 bf16x2 __attribute__((ext_vector_type(2)));
typedef float f32x4 __attribute__((ext_vector_type(4)));
typedef float f32x2 __attribute__((ext_vector_type(2)));
typedef unsigned u32x4 __attribute__((ext_vector_type(4)));
typedef unsigned u32x2 __attribute__((ext_vector_type(2)));

__device__ __forceinline__ unsigned f2bf(float f) { unsigned u = __builtin_bit_cast(unsigned, f); return (u + 0x7fffu + ((u >> 16) & 1u)) >> 16; }
__device__ __forceinline__ unsigned pk2(float lo, float hi) { return f2bf(lo) | (f2bf(hi) << 16); }
__device__ __forceinline__ unsigned cvt_pk_bf16(float lo, float hi) { unsigned r; asm volatile("v_cvt_pk_bf16_f32 %0, %1, %2" : "=v"(r) : "v"(lo), "v"(hi)); return r; }
__device__ __forceinline__ float bflo(unsigned w) { return __builtin_bit_cast(float, w << 16); }
__device__ __forceinline__ float bfhi(unsigned w) { return __builtin_bit_cast(float, w & 0xffff0000u); }
__device__ __forceinline__ float bf2f(bf16_t b) { return __builtin_bit_cast(float, ((unsigned)b) << 16); }
__device__ __forceinline__ float dot2(unsigned a, unsigned b, float acc) { return __builtin_amdgcn_fdot2_f32_bf16(__builtin_bit_cast(bf16x2, a), __builtin_bit_cast(bf16x2, b), acc, false); }
template <int CTRL> __device__ __forceinline__ float dppf(float x) { return __builtin_bit_cast(float, __builtin_amdgcn_mov_dpp(__builtin_bit_cast(int, x), CTRL, 0xf, 0xf, true)); }
template <int CTRL> __device__ __forceinline__ unsigned dppu(unsigned x) { return (unsigned)__builtin_amdgcn_mov_dpp((int)x, CTRL, 0xf, 0xf, true); }
constexpr int DPP_XOR1 = 0xB1, DPP_XOR2 = 0x4E, DPP_HMIRROR = 0x141, DPP_MIRROR = 0x140;
__device__ __forceinline__ float sum8(float x) { x += dppf<DPP_XOR1>(x); x += dppf<DPP_XOR2>(x); x += dppf<DPP_HMIRROR>(x); return x; }
__device__ __forceinline__ float sum16(float x) { x = sum8(x); x += dppf<DPP_MIRROR>(x); return x; }
__device__ __forceinline__ float sum64(float x) {
    x = sum16(x);
    { const auto s = __builtin_amdgcn_permlane16_swap(__float_as_uint(x), __float_as_uint(x), false, false); const unsigned a = s[0], b = s[1]; x = __uint_as_float(a) + __uint_as_float(b); }
    { const auto t = __builtin_amdgcn_permlane32_swap(__float_as_uint(x), __float_as_uint(x), false, false); const unsigned a = t[0], b = t[1]; x = __uint_as_float(a) + __uint_as_float(b); }
    return x;
}
__device__ __forceinline__ unsigned umax_u(unsigned a, unsigned b) { return a > b ? a : b; }
__device__ __forceinline__ unsigned max64u(unsigned x) {
    x = umax_u(x, dppu<DPP_XOR1>(x)); x = umax_u(x, dppu<DPP_XOR2>(x)); x = umax_u(x, dppu<DPP_HMIRROR>(x)); x = umax_u(x, dppu<DPP_MIRROR>(x));
    auto s = __builtin_amdgcn_permlane16_swap(x, x, false, false); x = umax_u(s[0], s[1]);
    auto t = __builtin_amdgcn_permlane32_swap(x, x, false, false); return umax_u(t[0], t[1]);
}
__device__ __forceinline__ float gelu_erf(float v) { return 0.5f * v * (1.0f + erff(v * 0.70710678118654752f)); }
__device__ __forceinline__ float erf_as(float x) {
    const float ax = fabsf(x), t = __builtin_amdgcn_rcpf(fmaf(0.3275911f, ax, 1.0f));
    float pl = fmaf(1.061405429f, t, -1.453152027f); pl = fmaf(pl, t, 1.421413741f); pl = fmaf(pl, t, -0.284496736f); pl = fmaf(pl, t, 0.254829592f); pl *= t;
    const float e = __builtin_amdgcn_exp2f(-1.4426950408889634f * ax * ax);
    return copysignf(fmaf(-pl, e, 1.0f), x);
}
__device__ __forceinline__ float gelu_erf_fast(float v) { return 0.5f * v * (1.0f + erf_as(v * 0.70710678118654752f)); }
__device__ __forceinline__ float sigmoidf_(float v) { return __builtin_amdgcn_rcpf(1.0f + __expf(-v)); }
#define DBG_SKIP 0
#define PROBE_DUP 0
#define GPROBE_MODE 0
namespace pg8 {
#define PG8_LAS __attribute__((address_space(3)))
constexpr int BM = 256, BK = 64, HALF = 128, HTB = HALF * BK * 2  , STAGE_BYTES = 8 * HTB, NXCD = 8, WGM = 8;

__host__ __device__ __forceinline__ int lds_byte(int r, int c) { const int st = (r >> 4) * 2 + (c >> 5), rr = r & 15, cc = c & 31, ob = rr * 64 + cc * 2; return st * 1024 + (ob ^ (((ob >> 9) & 1) << 5)); }
__host__ __device__ __forceinline__ void stage_rc(int b, int& R, int& C) { const int st = b / 1024, sb = b % 1024, swz = sb ^ (((sb >> 9) & 1) << 5); R = (st >> 1) * 16 + swz / 64; C = (st & 1) * 32 + (swz % 64) / 2; }
__host__ __device__ __forceinline__ int perm32(int rho) { const int n = rho >> 4, i = rho & 15; return 8 * (i >> 2) + 4 * n + (i & 3); }

struct Unit { int pm, pn; };
struct Gemm { const bf16_t* A; const bf16_t* Bt; int lda, ldb, K; };

struct StaticOrder {
    int nM, nN, nwg, G, c, kdiv, kmul, bmod;
    __device__ void init(int nM_, int nN_, int G_, int c_, int kdiv_ = 1 << 30, int kmul_ = 0, int bmod_ = 0) { nM = nM_; nN = nN_; nwg = nM * nN; G = G_; c = c_; kdiv = kdiv_; kmul = kmul_; bmod = bmod_; }
    __device__ bool next(int i, Unit& u) const {
        const long L = (long)i * G + c; if (L >= nwg) return false;
        int wgid = (int)L; { const int q = nwg / NXCD, r = nwg % NXCD, xcd = wgid % NXCD, off = wgid / NXCD; wgid = (xcd < r ? xcd * (q + 1) : r * (q + 1) + (xcd - r) * q) + off; }
        const int nig = WGM * nN, gid = wgid / nig, fm = gid * WGM, gsz = (nM - fm) < WGM ? (nM - fm) : WGM;
        u.pm = fm + ((wgid % nig) % gsz); u.pn = (wgid % nig) / gsz; return true;
    }
    __device__ __forceinline__ int koff(const Unit& u) const { return (u.pn / kdiv) * kmul; }
    __device__ __forceinline__ size_t boff(const Unit& u, size_t tstepB) const { return bmod ? (size_t)(u.pn % bmod) * tstepB + (size_t)koff(u) * 2 : (size_t)u.pn * tstepB; }
};

template <class Epi, class Sched, bool ALIGN_EPI>
__device__ __forceinline__ void gemm_phase(PG8_LAS unsigned char* lds, const Gemm g, const Sched& S, const Epi& E) {
    int tid = threadIdx.x; asm volatile("" : "+v"(tid));
    const int wid = __builtin_amdgcn_readfirstlane(tid >> 6), lane = tid & 63, wr = wid >> 2, wc = wid & 3, fr = lane & 15, fq = lane >> 4;
    const int K = g.K, nt = K / BK;
    unsigned voffA[2], voffB[2];
#pragma unroll
    for (int i = 0; i < 2; ++i) { int R, C; stage_rc(tid * 16 + i * 8192, R, C); const int Rb = Epi::PERM ? ((R & ~31) + perm32(R & 31)) : R;
        voffA[i] = (unsigned)(R * g.lda + C) * 2u; voffB[i] = (unsigned)(Rb * g.ldb + C) * 2u; }
    const size_t kstep = (size_t)(BK * 2);
    const size_t hstepA = (size_t)HALF * g.lda * 2, hstepB = (size_t)HALF * g.ldb * 2;
    const size_t tstepA = 2 * hstepA, tstepB = 2 * hstepB;
    const unsigned ldsw = (unsigned)wid * 1024u;
    const int aoff = lds_byte(wr * 64 + fr, fq * 8), boff = lds_byte(wc * 32 + fr, fq * 8);
#define PG8_SA(b, h) (((b) * 2 + (h)) * HTB)
#define PG8_SB(b, h) ((4 + (b) * 2 + (h)) * HTB)
#define PG8_STAGE(bufoff, gbase, voff) do { _Pragma("unroll") for (int _i = 0; _i < 2; ++_i) \
        __builtin_amdgcn_global_load_lds((const unsigned*)((const char*)(gbase) + (voff)[_i]), (PG8_LAS unsigned*)(lds + (bufoff) + ldsw + _i * 8192), 16, 0, 0); } while (0)
#define PG8_LDA(dst, b, h) do { _Pragma("unroll") for (int m = 0; m < 4; ++m) _Pragma("unroll") for (int k = 0; k < 2; ++k) dst[m][k] = *(const PG8_LAS bf16x8*)(lds + PG8_SA(b, h) + aoff + m * 2048 + k * 1024); } while (0)
#define PG8_LDB(dst, b, h) do { _Pragma("unroll") for (int n = 0; n < 2; ++n) _Pragma("unroll") for (int k = 0; k < 2; ++k) dst[n][k] = *(const PG8_LAS bf16x8*)(lds + PG8_SB(b, h) + boff + n * 2048 + k * 1024); } while (0)
#define PG8_MMA(ai, bj, At, Bt) do { __builtin_amdgcn_s_setprio(1); _Pragma("unroll") for (int m = 0; m < 4; ++m) _Pragma("unroll") for (int n = 0; n < 2; ++n) _Pragma("unroll") for (int k = 0; k < 2; ++k) \
        acc[ai][bj][m][n] = __builtin_amdgcn_mfma_f32_16x16x32_bf16(Bt[n][k], At[m][k], acc[ai][bj][m][n], 0, 0, 0); __builtin_amdgcn_s_setprio(0); } while (0)
#define PG8_WAIT_V(n) asm volatile("s_waitcnt vmcnt(" #n ")" ::: "memory")
#define PG8_WAIT_L(n) asm volatile("s_waitcnt lgkmcnt(" #n ")" ::: "memory")
#define PG8_BAR __builtin_amdgcn_s_barrier()
#define PG8_SCHED __builtin_amdgcn_sched_barrier(0)
    Unit cur, nxt; int ui = 0;
    if (!S.next(0, cur)) return;
    f32x4 acc[2][2][4][2];
#pragma unroll
    for (int a = 0; a < 2; ++a)
#pragma unroll
        for (int b = 0; b < 2; ++b)
#pragma unroll
            for (int m = 0; m < 4; ++m)
#pragma unroll
                for (int n = 0; n < 2; ++n) acc[a][b][m][n] = (f32x4){0.f, 0.f, 0.f, 0.f};
    bf16x8 At[4][2], B0[2][2], B1[2][2];
    const char* cA = (const char*)g.A + (size_t)cur.pm * tstepA + (size_t)S.koff(cur) * 2; const char* cB = (const char*)g.Bt + (size_t)cur.pn * tstepB;
    PG8_STAGE(PG8_SB(0, 0), cB, voffB); PG8_STAGE(PG8_SB(0, 1), cB + hstepB, voffB); PG8_STAGE(PG8_SA(0, 0), cA, voffA); PG8_STAGE(PG8_SA(0, 1), cA + hstepA, voffA);
    if (wr == 1) PG8_BAR;
    PG8_WAIT_V(2); PG8_BAR;
    PG8_STAGE(PG8_SB(1, 0), cB + kstep, voffB); PG8_STAGE(PG8_SA(1, 0), cA + kstep, voffA); PG8_STAGE(PG8_SB(1, 1), cB + hstepB + kstep, voffB);
    PG8_WAIT_V(6); PG8_BAR;
    for (;;) {
        const bool has_next = S.next(ui + 1, nxt);
        const char* nA = has_next ? (const char*)g.A + (size_t)nxt.pm * tstepA + (size_t)S.koff(nxt) * 2 : cA; const char* nB = has_next ? (const char*)g.Bt + (size_t)nxt.pn * tstepB : cB;
        for (int t = 0; t < nt; t += 2) {
            const bool last = (t == nt - 2);
            const char* a1 = cA + (size_t)(t + 1) * kstep;
            const char* a2 = last ? nA : cA + (size_t)(t + 2) * kstep; const char* b2 = last ? nB : cB + (size_t)(t + 2) * kstep;
            const char* a3 = a2 + kstep; const char* b3 = b2 + kstep;
            PG8_LDB(B0, 0, 0); PG8_LDB(B1, 0, 1); PG8_SCHED; PG8_LDA(At, 0, 0); PG8_STAGE(PG8_SA(1, 1), a1 + hstepA, voffA);
            PG8_WAIT_V(8); PG8_WAIT_L(0); PG8_BAR; PG8_MMA(0, 0, At, B0); PG8_MMA(0, 1, At, B1); PG8_BAR; PG8_SCHED;
            PG8_LDA(At, 0, 1); PG8_STAGE(PG8_SB(0, 0), b2, voffB); PG8_STAGE(PG8_SB(0, 1), b2 + hstepB, voffB); PG8_STAGE(PG8_SA(0, 0), a2, voffA);
            PG8_WAIT_V(8); PG8_WAIT_L(0); PG8_BAR; PG8_MMA(1, 0, At, B0); PG8_MMA(1, 1, At, B1); PG8_BAR; PG8_SCHED;
            PG8_LDB(B0, 1, 0); PG8_LDB(B1, 1, 1); PG8_SCHED; PG8_LDA(At, 1, 0); PG8_STAGE(PG8_SA(0, 1), a2 + hstepA, voffA);
            PG8_WAIT_V(8); PG8_WAIT_L(0); PG8_BAR; PG8_MMA(0, 0, At, B0); PG8_MMA(0, 1, At, B1); PG8_BAR; PG8_SCHED;
            PG8_LDA(At, 1, 1); PG8_STAGE(PG8_SB(1, 0), b3, voffB); PG8_STAGE(PG8_SB(1, 1), b3 + hstepB, voffB); PG8_STAGE(PG8_SA(1, 0), a3, voffA);
            PG8_WAIT_V(8); PG8_WAIT_L(0); PG8_BAR; PG8_MMA(1, 0, At, B0); PG8_MMA(1, 1, At, B1); PG8_BAR; PG8_SCHED;
        }
        if constexpr (ALIGN_EPI) { if (wr == 0) PG8_BAR; }
        E(acc, cur, wr, wc, fr, fq);
        if (!has_next) break;
#pragma unroll
        for (int a = 0; a < 2; ++a)
#pragma unroll
            for (int b = 0; b < 2; ++b)
#pragma unroll
                for (int m = 0; m < 4; ++m)
#pragma unroll
                    for (int n = 0; n < 2; ++n) acc[a][b][m][n] = (f32x4){0.f, 0.f, 0.f, 0.f};
        cur = nxt; cA = nA; cB = nB; ++ui;
        if constexpr (ALIGN_EPI) { if (wr == 1) PG8_BAR; }
    }
    PG8_WAIT_V(0);
    if constexpr (!ALIGN_EPI) { if (wr == 0) PG8_BAR; }
    PG8_BAR;
#undef PG8_SA
#undef PG8_SB
#undef PG8_STAGE
#undef PG8_LDA
#undef PG8_LDB
#undef PG8_MMA
}

template <class Epi, class Sched>
__device__ __forceinline__ void gemm_tail(const bf16_t* A16, const Gemm g, int nN, const Sched& S, const Epi& E, LAS unsigned char* lds) {
    int tid = threadIdx.x; asm volatile("" : "+v"(tid));
    const int wid = __builtin_amdgcn_readfirstlane(tid >> 6), lane = tid & 63, fr = lane & 15, fq = lane >> 4;
    LAS f32x4* red = (LAS f32x4*)lds;
    const int kw = g.K >> 3, kb = wid * kw;
    for (int item = S.G - 1 - S.c; item < nN * 8; item += S.G) {
        const int pn = item >> 3, strip = item & 7;
        Unit u; u.pm = 0; u.pn = pn;
        const bf16_t* a = A16 + (size_t)fr * g.lda + S.koff(u) + fq * 8 + kb;
        const bf16_t* b0 = g.Bt + (size_t)(pn * 256 + 16 * strip + fr) * g.ldb + fq * 8 + kb;
        const bf16_t* b1 = b0 + (size_t)128 * g.ldb;
        f32x4 acc0 = (f32x4){0.f, 0.f, 0.f, 0.f}, acc1 = acc0;
#pragma unroll 8
        for (int k0 = 0; k0 < kw; k0 += 32) {
            const bf16x8 af = *(const bf16x8*)(a + k0), w0 = *(const bf16x8*)(b0 + k0), w1 = *(const bf16x8*)(b1 + k0);
            acc0 = __builtin_amdgcn_mfma_f32_16x16x32_bf16(w0, af, acc0, 0, 0, 0);
            acc1 = __builtin_amdgcn_mfma_f32_16x16x32_bf16(w1, af, acc1, 0, 0, 0);
        }
        red[(wid * 2 + 0) * 64 + lane] = acc0; red[(wid * 2 + 1) * 64 + lane] = acc1;
        __syncthreads();
        if (wid == 0) {
#pragma unroll
            for (int w = 1; w < 8; ++w) { acc0 = acc0 + red[(w * 2 + 0) * 64 + lane]; acc1 = acc1 + red[(w * 2 + 1) * 64 + lane]; }
            E.tail(fr, pn, 16 * strip + 4 * fq, acc0, acc1);
        }
        __syncthreads();
    }
}
#undef PG8_WAIT_V
#undef PG8_WAIT_L
#undef PG8_BAR
#undef PG8_SCHED
}
#define XB_TMO      128
#define XB_XCNT(j)  (256  + 64 * (j))
#define XB_XSUB(j)  (1280 + 64 * (j))
#define XB_XGEN(j)  (2304 + 64 * (j))
#define XB_TOP      3328
#define XB_TOPGEN   3392
#define XCD_BAR_WORDS 3456
#define XB_SPIN_CAP (1u << 18)

__device__ __forceinline__ unsigned xb_ld(unsigned* p)              { return __hip_atomic_load(p, __ATOMIC_RELAXED, __HIP_MEMORY_SCOPE_AGENT); }
__device__ __forceinline__ unsigned xb_add(unsigned* p, unsigned v) { return __hip_atomic_fetch_add(p, v, __ATOMIC_RELAXED, __HIP_MEMORY_SCOPE_AGENT); }
__device__ __forceinline__ unsigned xb_xcc_id() { return (unsigned)__builtin_amdgcn_s_getreg((3 << 11) | 20) & 0xFu; }
#define XB_SPIN(cond, bar) do { unsigned _sp = 0; while (cond) { __builtin_amdgcn_s_sleep(1); \
    if ((++_sp & 255u) == 0u) { if (xb_ld(&(bar)[XB_TMO])) break; if (_sp > XB_SPIN_CAP) { atomicAdd(&(bar)[XB_TMO], 1u); break; } } } } while (0)

struct XcdBarrier {
    unsigned* bar; unsigned x;
    volatile LAS unsigned* st;
};

__device__ __forceinline__ XcdBarrier xcd_barrier_post(unsigned* bar, volatile LAS unsigned* st) {
    XcdBarrier b; b.bar = bar; b.x = xb_xcc_id(); b.st = st;
    if (threadIdx.x == 0) (void)xb_add(&bar[XB_XCNT(b.x)], 1u);
    return b;
}
__device__ __forceinline__ void xcd_barrier_complete(unsigned* bar, unsigned x, unsigned& nloc, unsigned& nx) {
    const unsigned G = gridDim.x * gridDim.y * gridDim.z;
    unsigned sum, cnt, mine, sp = 0u;
    for (;;) {
        sum = 0u; cnt = 0u; mine = 0u;
#pragma unroll
        for (unsigned j = 0; j < 16; ++j) { const unsigned c = xb_ld(&bar[XB_XCNT(j)]); sum += c; cnt += (c > 0u) ? 1u : 0u; mine = (j == x) ? c : mine; }
        if (sum == G) break;
        __builtin_amdgcn_s_sleep(1);
        if ((++sp & 255u) == 0u) { if (xb_ld(&bar[XB_TMO])) break; if (sp > XB_SPIN_CAP) { atomicAdd(&bar[XB_TMO], 1u); break; } }
    }
    nloc = mine > 0u ? mine : 1u; nx = cnt > 0u ? cnt : 1u;
}

__device__ __forceinline__ void xcd_barrier(const XcdBarrier& b) {
    asm volatile("s_waitcnt vmcnt(0)" ::: "memory");
    __syncthreads();
    if (threadIdx.x == 0) {
        unsigned* bar = b.bar;
        __builtin_amdgcn_s_waitcnt(0);
        unsigned nloc = b.st[0], nx = b.st[1];
        if (nloc == 0u) { xcd_barrier_complete(bar, b.x, nloc, nx); b.st[0] = nloc; b.st[1] = nx; }
        const unsigned old = xb_add(&bar[XB_XSUB(b.x)], 1u);
        const unsigned gen = old / nloc;
        if (old + 1u == (gen + 1u) * nloc) {
            __builtin_amdgcn_fence(__ATOMIC_RELEASE, "agent");
            asm volatile("s_waitcnt vmcnt(0)" ::: "memory");
            const unsigned og = xb_add(&bar[XB_TOP], 1u);
            const unsigned tg = og / nx;
            if (og + 1u == (tg + 1u) * nx) xb_add(&bar[XB_TOPGEN], 1u);
            else XB_SPIN(xb_ld(&bar[XB_TOPGEN]) == tg, bar);
            __builtin_amdgcn_fence(__ATOMIC_ACQUIRE, "agent");
            xb_add(&bar[XB_XGEN(b.x)], 1u);
            asm volatile("s_waitcnt vmcnt(0)" ::: "memory");
        } else {
            XB_SPIN(xb_ld(&bar[XB_XGEN(b.x)]) == gen, bar);
            __builtin_amdgcn_fence(__ATOMIC_ACQUIRE, "agent");
            asm volatile("s_waitcnt vmcnt(0)" ::: "memory");
        }
    }
    __syncthreads();
}
constexpr int D = 4096, NB = 4, SEQ = 2048, NMETA = 16, LSEQ = SEQ + NMETA;
constexpr int MX = NB * SEQ;
constexpr int MROWS = MX + NMETA;
constexpr float NORM_EPS = 1e-6f, GN_EPS = 64e-5f;
constexpr int ZC = 8640, ZLD = 8704;
constexpr int ZR = 2048, ZK = 4096, ZV = 6144, ZWL = 8192, ZAL = 8288, ZGL = 8384;
constexpr int NHEAD = 32, HDIM = 64;
constexpr int WAGLD = 6144;
constexpr int NEXP = 16384;
__device__ __forceinline__ int rowof(int b, int pos) { return pos < NMETA ? MX + pos : b * SEQ + pos - NMETA; }

constexpr size_t MiB = 1u << 20;
constexpr size_t wsal(size_t x) { return (x + 4095) & ~(size_t)4095; }
constexpr size_t WS_CTL = 0, CTL_ZERO_BYTES = 1 * MiB;
constexpr size_t WS_W1T = 1 * MiB;
constexpr size_t WS_WOT = WS_W1T + wsal((size_t)ZLD * D * 2);
constexpr size_t WS_WIO = WS_WOT + wsal((size_t)D * D * 2);
constexpr size_t WS_WGT = WS_WIO + wsal((size_t)2048 * D * 2);
constexpr size_t WS_WST = WS_WGT + wsal((size_t)8192 * 2048 * 2);
constexpr size_t WS_BTP = WS_WST + wsal((size_t)2 * 2048 * D * 2);
constexpr size_t WS_BTL = WS_BTP + wsal((size_t)2048 * 512 * 2);
constexpr size_t WS_PU  = WS_BTL + wsal((size_t)6144 * 256 * 2);
constexpr size_t WS_PV  = WS_PU + wsal((size_t)2 * NEXP * D);
constexpr size_t WS_SU  = WS_PV + wsal((size_t)2 * NEXP * D);
constexpr size_t WS_SV  = WS_SU + wsal((size_t)2 * NEXP * 4);
constexpr size_t WS_H   = WS_SV + wsal((size_t)2 * NEXP * 4);
constexpr size_t WS_HB  = WS_H + wsal((size_t)MROWS * D * 4);
constexpr size_t WS_Z   = WS_HB + wsal((size_t)MROWS * D * 2);
constexpr size_t WS_PM  = WS_Z + wsal((size_t)MROWS * ZLD * 2);
constexpr size_t WS_LA  = WS_PM + wsal((size_t)MROWS * 2048 * 2);
constexpr size_t WS_WAG = WS_LA + wsal((size_t)MROWS * 512 * 2);
constexpr size_t WS_Y   = WS_WAG + wsal((size_t)MROWS * WAGLD * 4);
constexpr size_t WS_SC  = WS_Y + wsal((size_t)MROWS * D * 2);
constexpr size_t WS_U   = WS_SC + wsal((size_t)MROWS * 2048 * 4);
constexpr size_t WS_YS  = WS_U + wsal((size_t)MROWS * 2048 * 2);
constexpr size_t WS_EIDL = WS_YS + wsal((size_t)MROWS * 2048 * 2);
constexpr size_t WS_GATEL = WS_EIDL + wsal((size_t)MROWS * 128 * 4);
constexpr size_t WS_DOTP = WS_GATEL + wsal((size_t)MROWS * 128 * 4);
constexpr size_t WS_WL = WS_DOTP + wsal((size_t)MROWS * 4096 * 4);
constexpr size_t WS_HB8 = WS_WL + wsal((size_t)MROWS * 128 * 4);
constexpr size_t WS_HS = WS_HB8 + wsal((size_t)MROWS * D);
constexpr size_t WS_END = WS_HS + wsal((size_t)MROWS * 4);
constexpr int CW_BAR = 4096;

constexpr int LDS_BYTES = 163840;
constexpr int SCR_BYTES = 131072;
constexpr int MISC_OFF = SCR_BYTES;
constexpr int RED_OFF = MISC_OFF + 256;
constexpr int BONUS_OFF = MISC_OFF + 512;

struct EpiBf16 {
    static constexpr bool PERM = true;
    bf16_t* O; int ldc; const float* colscale;
    __device__ __forceinline__ void operator()(const f32x4 (&acc)[2][2][4][2], const pg8::Unit& u, int wr, int wc, int fr, int fq) const {
        const int row0 = u.pm * 256 + wr * 64 + fr, col0 = u.pn * 256 + wc * 32 + 8 * fq;
        f32x4 sv[2][2];
#pragma unroll
        for (int bj = 0; bj < 2; ++bj)
#pragma unroll
            for (int n = 0; n < 2; ++n) sv[bj][n] = colscale ? *(const f32x4*)(colscale + col0 + bj * 128 + 4 * n) : (f32x4){1.f, 1.f, 1.f, 1.f};
#pragma unroll
        for (int ai = 0; ai < 2; ++ai)
#pragma unroll
            for (int m = 0; m < 4; ++m) { bf16_t* rowp = O + (size_t)(row0 + ai * 128 + m * 16) * ldc + col0;
#pragma unroll
                for (int bj = 0; bj < 2; ++bj) { const f32x4 v0 = acc[ai][bj][m][0] * sv[bj][0], v1 = acc[ai][bj][m][1] * sv[bj][1];
                    u32x4 w; w.x = cvt_pk_bf16(v0[0], v0[1]); w.y = cvt_pk_bf16(v0[2], v0[3]); w.z = cvt_pk_bf16(v1[0], v1[1]); w.w = cvt_pk_bf16(v1[2], v1[3]);
                    *(u32x4*)(rowp + bj * 128) = w; } }
    }
    __device__ __forceinline__ void tail(int r, int pn, int c4, f32x4 lo, f32x4 hi) const {
        const int col = pn * 256 + c4; bf16_t* rowp = O + (size_t)(MX + r) * ldc + col;
        if (colscale) { lo = lo * *(const f32x4*)(colscale + col); hi = hi * *(const f32x4*)(colscale + col + 128); }
        u32x2 a, b; a.x = cvt_pk_bf16(lo[0], lo[1]); a.y = cvt_pk_bf16(lo[2], lo[3]); b.x = cvt_pk_bf16(hi[0], hi[1]); b.y = cvt_pk_bf16(hi[2], hi[3]);
        *(u32x2*)rowp = a; *(u32x2*)(rowp + 128) = b;
    }
};
struct EpiF32 {
    static constexpr bool PERM = false;
    float* C; int ldc; int accum; const float* base; const float* base_tail;
    __device__ __forceinline__ void operator()(const f32x4 (&acc)[2][2][4][2], const pg8::Unit& u, int wr, int wc, int fr, int fq) const {
        const int row0 = u.pm * 256 + wr * 64 + fr, col0 = u.pn * 256 + wc * 32 + 4 * fq;
        const float* bs = base ? base : C;
        if (accum) {
#pragma unroll
            for (int ai = 0; ai < 2; ++ai)
#pragma unroll
                for (int mh = 0; mh < 2; ++mh) { f32x4 t[2][2][2];
#pragma unroll
                    for (int ml = 0; ml < 2; ++ml) { const size_t ro = (size_t)(row0 + ai * 128 + (2 * mh + ml) * 16) * ldc + col0;
#pragma unroll
                        for (int bj = 0; bj < 2; ++bj)
#pragma unroll
                            for (int n = 0; n < 2; ++n) t[ml][bj][n] = *(const f32x4*)(bs + ro + bj * 128 + n * 16); }
#pragma unroll
                    for (int ml = 0; ml < 2; ++ml) { const size_t ro = (size_t)(row0 + ai * 128 + (2 * mh + ml) * 16) * ldc + col0;
#pragma unroll
                        for (int bj = 0; bj < 2; ++bj)
#pragma unroll
                            for (int n = 0; n < 2; ++n) *(f32x4*)(C + ro + bj * 128 + n * 16) = acc[ai][bj][2 * mh + ml][n] + t[ml][bj][n]; } }
        } else {
#pragma unroll
            for (int ai = 0; ai < 2; ++ai)
#pragma unroll
                for (int m = 0; m < 4; ++m) { const size_t ro = (size_t)(row0 + ai * 128 + m * 16) * ldc + col0;
#pragma unroll
                    for (int bj = 0; bj < 2; ++bj)
#pragma unroll
                        for (int n = 0; n < 2; ++n) *(f32x4*)(C + ro + bj * 128 + n * 16) = acc[ai][bj][m][n]; }
        }
    }
    __device__ __forceinline__ void tail(int r, int pn, int c4, f32x4 lo, f32x4 hi) const {
        const size_t co = (size_t)pn * 256 + c4; float* rowp = C + (size_t)(MX + r) * ldc + co; const float* bp = base_tail ? base_tail + (size_t)r * ldc + co : rowp;
        if (accum) { lo = lo + *(const f32x4*)bp; hi = hi + *(const f32x4*)(bp + 128); }
        *(f32x4*)rowp = lo; *(f32x4*)(rowp + 128) = hi;
    }
};
__device__ __forceinline__ float decay_of(float x) {
    const float sg = __builtin_amdgcn_rcpf(1.0f + __builtin_amdgcn_exp2f(-1.4426950408889634f * x));
    return __builtin_amdgcn_exp2f(-0.8750387749f * sg);
}
#ifndef DBG_SKIP
#define DBG_SKIP 0
#endif
struct EpiGlu {
    static constexpr bool PERM = false;
    float* H;
    __device__ __forceinline__ void operator()(const f32x4 (&acc)[2][2][4][2], const pg8::Unit& u, int wr, int wc, int fr, int fq) const {
        const int row0 = u.pm * 256 + wr * 64 + fr, col0 = u.pn * 128 + wc * 32 + 4 * fq;
#pragma unroll
        for (int ai = 0; ai < 2; ++ai) { f32x4 t[4][2];
#pragma unroll
            for (int m = 0; m < 4; ++m)
#pragma unroll
                for (int n = 0; n < 2; ++n) t[m][n] = *(const f32x4*)(H + (size_t)(row0 + ai * 128 + m * 16) * D + col0 + n * 16);
#pragma unroll
            for (int m = 0; m < 4; ++m)
#pragma unroll
                for (int n = 0; n < 2; ++n) { const f32x4 ga = acc[ai][0][m][n], gb = acc[ai][1][m][n]; f32x4 v = t[m][n];
                    if (!(DBG_SKIP & 2)) { v[0] += ga[0] * sigmoidf_(gb[0]); v[1] += ga[1] * sigmoidf_(gb[1]); v[2] += ga[2] * sigmoidf_(gb[2]); v[3] += ga[3] * sigmoidf_(gb[3]); }
                    *(f32x4*)(H + (size_t)(row0 + ai * 128 + m * 16) * D + col0 + n * 16) = v; } }
    }
    __device__ __forceinline__ void tail(int r, int pn, int c4, f32x4 lo, f32x4 hi) const {
        f32x4* p = (f32x4*)(H + (size_t)(MX + r) * D + pn * 128 + c4); f32x4 v = *p;
        v[0] += lo[0] * sigmoidf_(hi[0]); v[1] += lo[1] * sigmoidf_(hi[1]); v[2] += lo[2] * sigmoidf_(hi[2]); v[3] += lo[3] * sigmoidf_(hi[3]); *p = v;
    }
};
#define LDS_WAIT() asm volatile("s_waitcnt lgkmcnt(0)" ::: "memory")
constexpr int NWAVES = 8, NTHREADS = 512;

template <bool SCALE>
__device__ __forceinline__ void transpose_item(const float* W, int ldw, int k0, int n0, const float* scale, bf16_t* dst, int dld, int drow0, LAS float* scr, int lane) {
    float v[32];
#pragma unroll
    for (int i = 0; i < 32; ++i) { const int kk = 2 * i + (lane >> 5); v[i] = W[(size_t)(k0 + kk) * ldw + n0 + (lane & 31)]; }
    const int c = lane & 7;
    f32x4 s0 = {1.f, 1.f, 1.f, 1.f}, s1 = s0;
    if (SCALE) { s0 = *(const f32x4*)(scale + k0 + 8 * c); s1 = *(const f32x4*)(scale + k0 + 8 * c + 4); }
#pragma unroll
    for (int i = 0; i < 32; ++i) { const int kk = 2 * i + (lane >> 5); scr[kk * 33 + (lane & 31)] = v[i]; }
    LDS_WAIT();
#pragma unroll
    for (int j = 0; j < 4; ++j) { const int n = (lane >> 3) + 8 * j; const LAS float* s = scr + (8 * c) * 33 + n;
        u32x4 o; o.x = pk2(s[0 * 33] * s0[0], s[1 * 33] * s0[1]); o.y = pk2(s[2 * 33] * s0[2], s[3 * 33] * s0[3]); o.z = pk2(s[4 * 33] * s1[0], s[5 * 33] * s1[1]); o.w = pk2(s[6 * 33] * s1[2], s[7 * 33] * s1[3]);
        *(u32x4*)(dst + (size_t)(drow0 + n) * dld + k0 + 8 * c) = o; }
    LDS_WAIT();
}
__device__ __forceinline__ void norm_row(const float* src, float* cpy, bf16_t* dstb, int lane) {
    f32x4 v[16]; float s = 0.f;
#pragma unroll
    for (int j = 0; j < 16; ++j) { v[j] = ((const f32x4*)src)[lane + 64 * j]; s += (v[j][0] * v[j][0] + v[j][1] * v[j][1]) + (v[j][2] * v[j][2] + v[j][3] * v[j][3]); }
    s = sum64(s);
    const float inv = rsqrtf(s * (1.0f / D) + NORM_EPS);
#pragma unroll
    for (int j = 0; j < 16; ++j) { if (cpy) ((f32x4*)cpy)[lane + 64 * j] = v[j];
        u32x2 o; o.x = cvt_pk_bf16(v[j][0] * inv, v[j][1] * inv); o.y = cvt_pk_bf16(v[j][2] * inv, v[j][3] * inv); ((u32x2*)dstb)[lane + 64 * j] = o; }
}
__device__ __forceinline__ bf16x8 cvt8(const float* p) {
    const f32x4 a = *(const f32x4*)p, b = *(const f32x4*)(p + 4);
    u32x4 o; o.x = pk2(a[0], a[1]); o.y = pk2(a[2], a[3]); o.z = pk2(b[0], b[1]); o.w = pk2(b[2], b[3]);
    return __builtin_bit_cast(bf16x8, o);
}

__device__ __forceinline__ void peer_row_load(f32x4 (&v)[16], const float* const (&in)[34], int it, int layer, int lane) {
    const int tbl = it >= NEXP, r = it - tbl * NEXP + layer * NEXP;
    const f32x4* src = (const f32x4*)((tbl ? in[33] : in[32]) + (size_t)r * D) + lane;
#pragma unroll
    for (int j = 0; j < 16; ++j) v[j] = src[64 * j];
}
__device__ __forceinline__ void peer_row_store(const f32x4 (&v)[16], unsigned char* ws, int it, int layer, int lane) {
    const int tbl = it >= NEXP, r = it - tbl * NEXP + layer * NEXP;
    float am = 0.f;
#pragma unroll
    for (int j = 0; j < 16; ++j) am = fmaxf(fmaxf(am, fmaxf(fabsf(v[j][0]), fabsf(v[j][1]))), fmaxf(fabsf(v[j][2]), fabsf(v[j][3])));
    am = __uint_as_float(max64u(__float_as_uint(am)));
    const float q = am > 0.f ? 256.0f / am : 0.f;
    unsigned* dst = (unsigned*)(ws + (tbl ? WS_PV : WS_PU) + (size_t)r * D) + lane;
    if (tbl) {
        const int rl = it - NEXP;
        unsigned char* pvl = ws + WS_PV + (size_t)layer * NEXP * D + (size_t)rl * 8 + (lane & 1) * 4;
        unsigned char* pvg = ws + WS_PV + (size_t)layer * NEXP * D + (size_t)NEXP * 2048 + (size_t)rl * 2048 + 4 * lane;
#pragma unroll
        for (int j = 0; j < 16; ++j) { int w = __builtin_amdgcn_cvt_pk_bf8_f32(v[j][0] * q, v[j][1] * q, 0, false); w = __builtin_amdgcn_cvt_pk_bf8_f32(v[j][2] * q, v[j][3] * q, w, true);
            if (j < 8) *(unsigned*)(pvl + (size_t)((lane >> 1) + 32 * j) * (NEXP * 8)) = (unsigned)w;
            else *(unsigned*)(pvg + 256 * (j - 8)) = (unsigned)w; }
    } else {
#pragma unroll
        for (int j = 0; j < 16; ++j) { int w = __builtin_amdgcn_cvt_pk_fp8_f32(v[j][0] * q, v[j][1] * q, 0, false); w = __builtin_amdgcn_cvt_pk_fp8_f32(v[j][2] * q, v[j][3] * q, w, true); dst[64 * j] = (unsigned)w; }
    }
    if (lane == 0) ((float*)(ws + (tbl ? WS_SV : WS_SU)))[r] = am * (1.0f / 256.0f);
}
template <int R>
__device__ __forceinline__ void peer_vrow(const f32x4 (&v)[16], unsigned char* ws, LAS unsigned char* tile, int rl, int rr, int layer, int lane) {
    float am = 0.f;
#pragma unroll
    for (int j = 0; j < 16; ++j) am = fmaxf(fmaxf(am, fmaxf(fabsf(v[j][0]), fabsf(v[j][1]))), fmaxf(fabsf(v[j][2]), fabsf(v[j][3])));
    am = __uint_as_float(max64u(__float_as_uint(am)));
    const float q = am > 0.f ? 256.0f / am : 0.f;
    unsigned char* pvg = ws + WS_PV + (size_t)layer * NEXP * D + (size_t)NEXP * 2048 + (size_t)rl * 2048 + 4 * lane;
#pragma unroll
    for (int j = 0; j < 16; ++j) { int w = __builtin_amdgcn_cvt_pk_bf8_f32(v[j][0] * q, v[j][1] * q, 0, false); w = __builtin_amdgcn_cvt_pk_bf8_f32(v[j][2] * q, v[j][3] * q, w, true);
        if (j < 8) *(LAS unsigned*)(tile + rr * 2048 + 4 * (lane + 64 * j)) = (unsigned)w;
        else *(unsigned*)(pvg + 256 * (j - 8)) = (unsigned)w; }
    if (lane == 0) ((float*)(ws + WS_SV))[layer * NEXP + rl] = am * (1.0f / 256.0f);
}
template <int R>
__device__ __forceinline__ void peer_convert_v(const float* const (&in)[34], unsigned char* ws, LAS unsigned char* tile, int gw, int NGW, int lane, int layer) {
    f32x4 va[16], vb[16];
#pragma unroll 1
    for (int blk = gw; blk < NEXP / R; blk += NGW) {
        const int row0 = blk * R;
        peer_row_load(va, in, NEXP + row0, layer, lane);
#pragma unroll
        for (int rr = 0; rr < R; rr += 2) {
            peer_row_load(vb, in, NEXP + row0 + rr + 1, layer, lane);
            __builtin_amdgcn_sched_barrier(0);
            peer_vrow<R>(va, ws, tile, row0 + rr, rr, layer, lane);
            __builtin_amdgcn_sched_barrier(0);
            if (rr + 2 < R) peer_row_load(va, in, NEXP + row0 + rr + 2, layer, lane);
            __builtin_amdgcn_sched_barrier(0);
            peer_vrow<R>(vb, ws, tile, row0 + rr + 1, rr + 1, layer, lane);
            __builtin_amdgcn_sched_barrier(0);
        }
        LDS_WAIT();
        unsigned char* pvl = ws + WS_PV + (size_t)layer * NEXP * D + (size_t)row0 * 8;
#pragma unroll
        for (int m = 0; m < 4; ++m) { const int grp = lane + 64 * m; u32x2 t_[R];
#pragma unroll
            for (int rr = 0; rr < R; ++rr) t_[rr] = *(const LAS u32x2*)(tile + rr * 2048 + 8 * grp);
#pragma unroll
            for (int rr = 0; rr < R; rr += 2) *(u32x4*)(pvl + (size_t)grp * (NEXP * 8) + rr * 8) = (u32x4){t_[rr].x, t_[rr].y, t_[rr + 1].x, t_[rr + 1].y}; }
        LDS_WAIT();
    }
}
__device__ __forceinline__ void peer_convert(const float* const (&in)[34], unsigned char* ws, int gw, int NGW, int lane, int only_layer, int it_lo = 0, int it_hi = 2 * NEXP) {
    f32x4 va[16], vb[16];
    if (it_lo + gw >= it_hi) return;
    peer_row_load(va, in, it_lo + gw, only_layer, lane);
#pragma unroll 1
    for (int it = it_lo + gw; it < it_hi; it += 2 * NGW) {
        const int it1 = it + NGW, it2 = it + 2 * NGW;
        peer_row_load(vb, in, it1 < it_hi ? it1 : it, only_layer, lane);
        __builtin_amdgcn_sched_barrier(0);
        peer_row_store(va, ws, it, only_layer, lane);
        __builtin_amdgcn_sched_barrier(0);
        peer_row_load(va, in, it2 < it_hi ? it2 : it, only_layer, lane);
        __builtin_amdgcn_sched_barrier(0);
        if (it1 < it_hi) peer_row_store(vb, ws, it1, only_layer, lane);
        __builtin_amdgcn_sched_barrier(0);
    }
}


template <int PARTS = 3>
__device__ __forceinline__ void phase_prologue(const float* const (&in)[34], unsigned char* ws, LAS unsigned char* lds, int G) {
    int tid = threadIdx.x; asm volatile("" : "+v"(tid)); const int lane = tid & 63, wid = __builtin_amdgcn_readfirstlane(tid >> 6);
    const int gw = blockIdx.x * NWAVES + wid, NGW = G * NWAVES;
    const size_t gt = (size_t)blockIdx.x * NTHREADS + tid, NT = (size_t)G * NTHREADS;
    LAS float* scr = (LAS float*)(lds + wid * 16384);
    bf16_t* W1T = (bf16_t*)(ws + WS_W1T);
    constexpr int I1 = (D / 64) * (ZC / 32);
    if (PARTS & 1) for (int r = gw; r < I1; r += NGW) { const int kb = r % (D / 64), n0 = (r / (D / 64)) * 32;     transpose_item<true>(in[5], ZC, kb * 64, n0, in[2], W1T, D, n0, scr, lane); }
    for (size_t i = gt; i < (size_t)(ZLD - ZC) * D / 8; i += NT) ((u32x4*)(W1T + (size_t)ZC * D))[i] = (u32x4){0u, 0u, 0u, 0u};
    if (PARTS & 2) { bf16_t* HB = (bf16_t*)(ws + WS_HB);
      const int MAINR = (MROWS / NGW) * NGW;
      if ((int)blockIdx.x < MROWS - MAINR) {
          const int r = MAINR + blockIdx.x; const float* srow = r < MX ? in[0] + (size_t)r * D : in[1] + (size_t)(r - MX) * D; LAS float* red = (LAS float*)(lds + RED_OFF);
          const f32x4* src_ = (const f32x4*)srow + 128 * wid + lane; const f32x4 x0 = src_[0], x1 = src_[64];
          float s_ = (x0[0] * x0[0] + x0[1] * x0[1]) + (x0[2] * x0[2] + x0[3] * x0[3]) + (x1[0] * x1[0] + x1[1] * x1[1]) + (x1[2] * x1[2] + x1[3] * x1[3]);
          s_ = sum64(s_);
          if (lane == 0) red[wid] = s_;
          __syncthreads();
          float t_ = 0.f;
#pragma unroll
          for (int w = 0; w < NWAVES; ++w) t_ += red[w];
          const float inv_ = rsqrtf(t_ * (1.0f / D) + NORM_EPS);
          const f32x4 w0_ = x0 * inv_, w1_ = x1 * inv_;
          u32x2* dstb_ = (u32x2*)(HB + (size_t)r * D) + 128 * wid + lane;
          u32x2 o0_, o1_; o0_.x = cvt_pk_bf16(w0_[0], w0_[1]); o0_.y = cvt_pk_bf16(w0_[2], w0_[3]); o1_.x = cvt_pk_bf16(w1_[0], w1_[1]); o1_.y = cvt_pk_bf16(w1_[2], w1_[3]);
          dstb_[0] = o0_; dstb_[64] = o1_;
          __syncthreads();
      }
      for (int r = gw; r < MAINR; r += NGW) { const float* src = r < MX ? in[0] + (size_t)r * D : in[1] + (size_t)(r - MX) * D; norm_row(src, nullptr, HB + (size_t)r * D, lane); } }
}
__device__ __forceinline__ void early_weights(const float* const (&in)[34], unsigned char* ws, LAS float* scr, int gw, int NGW, size_t gt, size_t NT, int lane) {
    bf16_t* WOT = (bf16_t*)(ws + WS_WOT); bf16_t* BTP = (bf16_t*)(ws + WS_BTP); bf16_t* BTL = (bf16_t*)(ws + WS_BTL);
    constexpr int I2 = (D / 64) * (D / 32), I5 = 4 * (512 / 64) * (512 / 32);
    for (int it = gw; it < I2 + I5; it += NGW) {
        int r = it;
        if (r < I2) { const int kb = r % (D / 64), n0 = (r / (D / 64)) * 32; transpose_item<false>(in[19], D, kb * 64, n0, nullptr, WOT, D, n0, scr, lane); continue; } r -= I2;
        { const int grp = r / 128, rr = r % 128, kb = rr % 8, n0 = (rr / 8) * 32; transpose_item<false>(in[6] + (size_t)grp * 512 * 512, 512, kb * 64, n0, nullptr, BTP, 512, grp * 512 + n0, scr, lane); }
    }
    for (size_t i = gt; i < (size_t)6144 * 256; i += NT) { const int k = (int)(i / 6144), n = (int)(i % 6144), reg = n >> 11, c = n & 2047; float v = 0.f;
        if (reg == 0) { if (k < 96) v = in[10][(size_t)k * 2048 + c]; }
        else if (reg == 1) { if (k >= 128 && k < 224) v = in[12][(size_t)(k - 128) * 2048 + c]; }
        else v = in[13][(size_t)k * 2048 + c];
        BTL[(size_t)n * 256 + k] = (bf16_t)f2bf(v); }
}
template <int PART>
__device__ __forceinline__ void late_weights(const float* const (&in)[34], unsigned char* ws, LAS float* scr, int gw, int NGW, int lane) {
    bf16_t* WIO = (bf16_t*)(ws + WS_WIO); bf16_t* WGT = (bf16_t*)(ws + WS_WGT); bf16_t* WST = (bf16_t*)(ws + WS_WST);
    constexpr int I3 = (D / 64) * (2048 / 32), I4 = (2048 / 64) * (8192 / 32);
    if (PART == 0) {
        for (int r = gw; r < I3; r += NGW) { const int kb = r % (D / 64), n0 = (r / (D / 64)) * 32; transpose_item<true>(in[20], 2048, kb * 64, n0, in[2] + D, WIO, D, n0, scr, lane); }
    } else if (PART == 2) {
        for (int r = gw; r < I4; r += NGW) { const int kb = r % (2048 / 64), n0 = (r / (2048 / 64)) * 32;
            const int half = n0 >= 4096, c = n0 - half * 4096, drow = (c >> 7) * 256 + half * 128 + (c & 127);
            transpose_item<false>(in[29], 8192, kb * 64, n0, nullptr, WGT, 2048, drow, scr, lane); }
    }
    if (PART < 2) { const int fr = lane & 15, fq = lane >> 4, layer = PART;
      for (int it = gw; it < 16 * 256; it += NGW) {
        const int hp = (it >> 8) & 15, d0 = (it & 255) * 16;
        const float* wq = in[30] + (size_t)layer * D * 2048 + (size_t)(d0 + fr) * 2048 + hp * 128 + fq * 8;
        const float* sk = in[31] + ((size_t)(layer * 16 + hp) * 128 + fr) * 128 + fq * 8;
        f32x4 acc[8]; f32x4 ra[2], rb[8][2];
#pragma unroll
        for (int kt = 0; kt < 8; ++kt) acc[kt] = (f32x4){0.f, 0.f, 0.f, 0.f};
#pragma unroll
        for (int ks = 0; ks < 4; ++ks) {
            if (ks == 0) { ra[0] = *(const f32x4*)(wq); ra[1] = *(const f32x4*)(wq + 4);
#pragma unroll
                for (int kt = 0; kt < 8; ++kt) { rb[kt][0] = *(const f32x4*)(sk + (size_t)kt * 16 * 128); rb[kt][1] = *(const f32x4*)(sk + (size_t)kt * 16 * 128 + 4); } }
            u32x4 ao; ao.x = pk2(ra[0][0], ra[0][1]); ao.y = pk2(ra[0][2], ra[0][3]); ao.z = pk2(ra[1][0], ra[1][1]); ao.w = pk2(ra[1][2], ra[1][3]);
            u32x4 bo[8];
#pragma unroll
            for (int kt = 0; kt < 8; ++kt) { bo[kt].x = pk2(rb[kt][0][0], rb[kt][0][1]); bo[kt].y = pk2(rb[kt][0][2], rb[kt][0][3]); bo[kt].z = pk2(rb[kt][1][0], rb[kt][1][1]); bo[kt].w = pk2(rb[kt][1][2], rb[kt][1][3]); }
            __builtin_amdgcn_sched_barrier(0);
            if (ks < 3) { ra[0] = *(const f32x4*)(wq + (ks + 1) * 32); ra[1] = *(const f32x4*)(wq + (ks + 1) * 32 + 4);
#pragma unroll
                for (int kt = 0; kt < 8; ++kt) { rb[kt][0] = *(const f32x4*)(sk + (size_t)kt * 16 * 128 + (ks + 1) * 32); rb[kt][1] = *(const f32x4*)(sk + (size_t)kt * 16 * 128 + (ks + 1) * 32 + 4); } }
            __builtin_amdgcn_sched_barrier(0);
#pragma unroll
            for (int kt = 0; kt < 8; ++kt) acc[kt] = __builtin_amdgcn_mfma_f32_16x16x32_bf16(__builtin_bit_cast(bf16x8, ao), __builtin_bit_cast(bf16x8, bo[kt]), acc[kt], 0, 0, 0);
            __builtin_amdgcn_sched_barrier(0);
        }
#pragma unroll
        for (int kt = 0; kt < 8; ++kt) { const f32x4 v = acc[kt]; u32x2 o; o.x = cvt_pk_bf16(v[0], v[1]); o.y = cvt_pk_bf16(v[2], v[3]);
            *(u32x2*)(WST + ((size_t)layer * 2048 + hp * 128 + kt * 16 + fr) * D + d0 + 4 * fq) = o; }
      } }
}

template <bool FP8, bool GAIN = false>
__device__ __forceinline__ void phase_norm(unsigned char* ws, LAS unsigned char* lds, int G, const float* gain = nullptr) {
    int tid = threadIdx.x; asm volatile("" : "+v"(tid)); const int lane = tid & 63, wid = __builtin_amdgcn_readfirstlane(tid >> 6);
    const float* H = (const float*)(ws + WS_H); bf16_t* HB = (bf16_t*)(ws + WS_HB);
    f32x4 gv[16];
    if (GAIN) {
#pragma unroll
        for (int j = 0; j < 16; ++j) gv[j] = ((const f32x4*)gain)[lane + 64 * j]; }
    const int r0 = blockIdx.x * NWAVES + wid, RS = G * NWAVES, MAINR = (MROWS / RS) * RS;
    if ((int)blockIdx.x < MROWS - MAINR) {
        const int r = MAINR + blockIdx.x; LAS float* red = (LAS float*)(lds + RED_OFF);
        const f32x4* src_ = (const f32x4*)(H + (size_t)r * D) + 128 * wid + lane; const f32x4 x0 = src_[0], x1 = src_[64];
        float s_ = (x0[0] * x0[0] + x0[1] * x0[1]) + (x0[2] * x0[2] + x0[3] * x0[3]) + (x1[0] * x1[0] + x1[1] * x1[1]) + (x1[2] * x1[2] + x1[3] * x1[3]);
        s_ = sum64(s_);
        if (lane == 0) red[wid] = s_;
        __syncthreads();
        float t_ = 0.f;
#pragma unroll
        for (int w = 0; w < NWAVES; ++w) t_ += red[w];
        const float inv_ = rsqrtf(t_ * (1.0f / D) + NORM_EPS);
        f32x4 w0_ = x0 * inv_, w1_ = x1 * inv_;
        if (GAIN) { const f32x4* gp_ = (const f32x4*)gain + 128 * wid + lane; w0_ = w0_ * gp_[0]; w1_ = w1_ * gp_[64]; }
        u32x2* dstb_ = (u32x2*)(HB + (size_t)r * D) + 128 * wid + lane;
        u32x2 o0_, o1_; o0_.x = cvt_pk_bf16(w0_[0], w0_[1]); o0_.y = cvt_pk_bf16(w0_[2], w0_[3]); o1_.x = cvt_pk_bf16(w1_[0], w1_[1]); o1_.y = cvt_pk_bf16(w1_[2], w1_[3]);
        dstb_[0] = o0_; dstb_[64] = o1_;
        __syncthreads();
    }
    if (r0 >= MAINR) return;
#define PN_LOAD(v, R) do { const f32x4* src_ = (const f32x4*)(H + (size_t)(R) * D) + lane; _Pragma("unroll") for (int j = 0; j < 16; ++j) v[j] = src_[64 * j]; } while (0)
#define PN_ROW(v, R) do { float s_ = 0.f; _Pragma("unroll") for (int j = 0; j < 16; ++j) s_ += (v[j][0] * v[j][0] + v[j][1] * v[j][1]) + (v[j][2] * v[j][2] + v[j][3] * v[j][3]); \
        s_ = sum64(s_); const float inv_ = rsqrtf(s_ * (1.0f / D) + NORM_EPS); u32x2* dstb_ = (u32x2*)(HB + (size_t)(R) * D) + lane; \
        _Pragma("unroll") for (int j = 0; j < 16; ++j) { f32x4 w_ = v[j] * inv_; if (GAIN) w_ = w_ * gv[j]; u32x2 o_; o_.x = cvt_pk_bf16(w_[0], w_[1]); o_.y = cvt_pk_bf16(w_[2], w_[3]); dstb_[64 * j] = o_; } } while (0)
    f32x4 va[16], vb[16];
    PN_LOAD(va, r0);
#pragma unroll 1
    for (int r = r0; r < MAINR; r += 2 * RS) {
        const int r1 = r + RS, r2 = r + 2 * RS;
        PN_LOAD(vb, r1 < MAINR ? r1 : r);
        __builtin_amdgcn_sched_barrier(0);
        PN_ROW(va, r);
        __builtin_amdgcn_sched_barrier(0);
        PN_LOAD(va, r2 < MAINR ? r2 : r);
        __builtin_amdgcn_sched_barrier(0);
        if (r1 < MAINR) PN_ROW(vb, r1);
        __builtin_amdgcn_sched_barrier(0);
    }
#undef PN_LOAD
#undef PN_ROW
}

__device__ __forceinline__ float zl_get(const float* ZL, int r, int c) { const float* p = ZL + (size_t)r * 2048 + c; return r < MX ? (p[0] + p[512]) + (p[1024] + p[1536]) : p[0]; }
__device__ __forceinline__ void phase_prep(const float* mu, unsigned char* ws, int G) {
    int tid = threadIdx.x; asm volatile("" : "+v"(tid));
    const bf16_t* Z = (const bf16_t*)(ws + WS_Z); bf16_t* PM = (bf16_t*)(ws + WS_PM); bf16_t* LA = (bf16_t*)(ws + WS_LA); const float* ZL = (const float*)(ws + WS_WAG);
    const int c4 = tid * 4, grp = c4 >> 9, w = 2 << grp;
    float msk[16];
#pragma unroll
    for (int i = 0; i < 16; ++i) msk[i] = i < w ? 1.f : 0.f;
    for (int it = blockIdx.x; it < NB * 129; it += G) {
        const int b = it / 129, blk = it % 129; if (b > 0 && blk == 0) continue;
        const int p0 = blk * 16;
        float zz[31][4];
        u32x2 zq[31];
#pragma unroll
        for (int i = 0; i < 31; ++i) { const int pos = p0 - 15 + i; zq[i] = *(const u32x2*)(Z + (size_t)rowof(b, pos < 0 ? 0 : pos) * ZLD + c4); }
#pragma unroll
        for (int i = 0; i < 31; ++i) { const int pos = p0 - 15 + i; const u32x2 q = pos >= 0 ? zq[i] : (u32x2){0u, 0u}; zz[i][0] = bflo(q.x); zz[i][1] = bfhi(q.x); zz[i][2] = bflo(q.y); zz[i][3] = bfhi(q.y); }
#pragma unroll
        for (int t = 0; t < 16; ++t) { const int pos = p0 + t; float s[4] = {0.f, 0.f, 0.f, 0.f};
#pragma unroll
            for (int i = 0; i < 16; ++i) {
#pragma unroll
                for (int e = 0; e < 4; ++e) s[e] = fmaf(zz[15 + t - i][e], msk[i], s[e]); }
            const float ic = 1.0f / (float)(pos + 1 < w ? pos + 1 : w);
            u32x2 o; o.x = cvt_pk_bf16(s[0] * ic - zz[15 + t][0], s[1] * ic - zz[15 + t][1]); o.y = cvt_pk_bf16(s[2] * ic - zz[15 + t][2], s[3] * ic - zz[15 + t][3]);
            *(u32x2*)(PM + (size_t)rowof(b, pos) * 2048 + c4) = o; }
    }
    {   const int k = tid;
        int zc = -1, kind = 0;
        if (k < 96) { zc = ZWL + k; kind = 1; } else if (k >= 128 && k < 224) { zc = ZAL + k - 128; kind = 2; } else if (k >= 256) { zc = ZGL + k - 256; kind = 3; }
        const int zcc = zc >= 0 ? zc : 0; const float muv = zc >= 0 ? mu[zc - 2048] : 0.f;
        for (int row0 = blockIdx.x * 4; row0 < MROWS; row0 += G * 4) {
            float z[4], zp[4];
#pragma unroll
            for (int u = 0; u < 4; ++u) { const int row = row0 + u;
                int prow; if (row >= MX) prow = row > MX ? row - 1 : -1; else prow = (row & (SEQ - 1)) ? row - 1 : MX + NMETA - 1;
                z[u] = bf2f(Z[(size_t)row * ZLD + zcc]); zp[u] = bf2f(Z[(size_t)(prow >= 0 ? prow : row) * ZLD + zcc]); if (prow < 0) zp[u] = 0.f; }
#pragma unroll
            for (int u = 0; u < 4; ++u) { const float sh = z[u] + (zp[u] - z[u]) * muv;
                float v = kind == 1 ? tanhf(sh) : (kind == 2 ? sh : sigmoidf_(sh)); if (zc < 0) v = 0.f;
                LA[(size_t)(row0 + u) * 512 + k] = (bf16_t)f2bf(v); }
        }
    }
}

__device__ __forceinline__ float vmul(float a, float b) { float d; asm("v_mul_f32 %0, %1, %2" : "=v"(d) : "v"(a), "v"(b)); return d; }
__device__ __forceinline__ float vfma(float a, float b, float c) { float d; asm("v_fma_f32 %0, %1, %2, %3" : "=v"(d) : "v"(a), "v"(b), "v"(c)); return d; }
__device__ __forceinline__ float vfnma(float a, float b, float c) { float d; asm("v_fma_f32 %0, -%1, %2, %3" : "=v"(d) : "v"(a), "v"(b), "v"(c)); return d; }
struct RwkvRegs { u32x2 zr, zk, zv, pr, pk, pv; f32x4 dec, a, g; };
__device__ __forceinline__ void rwkv_load(RwkvRegs& R, const bf16_t* Z, const float* WAG, int b, int h, int pos, int j4, f32x4 w0v, f32x4 a0v) {
    const u32x2 z0 = {0u, 0u};
    if (pos < LSEQ) { const int row = rowof(b, pos); const bf16_t* zp = Z + (size_t)row * ZLD + h * 64 + j4;
        R.zr = *(const u32x2*)(zp + ZR); R.zk = *(const u32x2*)(zp + ZK); R.zv = *(const u32x2*)(zp + ZV);
        if (pos > 0) { const bf16_t* pp = Z + (size_t)rowof(b, pos - 1) * ZLD + h * 64 + j4; R.pr = *(const u32x2*)(pp + ZR); R.pk = *(const u32x2*)(pp + ZK); R.pv = *(const u32x2*)(pp + ZV); }
        else { R.pr = z0; R.pk = z0; R.pv = z0; }
        const float* wp = WAG + (size_t)row * WAGLD + h * 64 + j4; R.dec = *(const f32x4*)wp; R.a = *(const f32x4*)(wp + 2048); R.g = *(const f32x4*)(wp + 4096);

    } else { R.zr = z0; R.zk = z0; R.zv = z0; R.pr = z0; R.pk = z0; R.pv = z0; R.dec = (f32x4){0.f, 0.f, 0.f, 0.f}; R.a = R.dec; R.g = R.dec; }
}
__device__ __forceinline__ f32x4 unpack4(u32x2 q) { return (f32x4){bflo(q.x), bfhi(q.x), bflo(q.y), bfhi(q.y)}; }
template <int MODE = 0>
__device__ __forceinline__ void phase_rwkv(const float* const (&in)[34], unsigned char* ws, LAS unsigned char* lds, int G) {
    int tid = threadIdx.x; asm volatile("" : "+v"(tid)); const int lane = tid & 63, wid = __builtin_amdgcn_readfirstlane(tid >> 6);
    const bf16_t* Z = (const bf16_t*)(ws + WS_Z); const float* WAG = (const float*)(ws + WS_WAG); bf16_t* Y = (bf16_t*)(ws + (MODE ? WS_SC : WS_Y));
    const int tt = tid >> 4, q = tid & 15, j4 = q * 4;
    const int cgi = lane & 15, rg = lane >> 4, myrow = wid * 8 + 2 * rg;
    LAS float* bonus = (LAS float*)(lds + BONUS_OFF);
    for (int chain = blockIdx.x; chain < NB * NHEAD; chain += G) {
        const int b = chain >> 5, h = chain & 31;
        const float* mu = in[8];
        const f32x4 mur = *(const f32x4*)(mu + h * 64 + j4), muk = *(const f32x4*)(mu + 2048 + h * 64 + j4), muv = *(const f32x4*)(mu + 4096 + h * 64 + j4);
        const f32x4 kk_ = *(const f32x4*)(in[14] + h * 64 + j4), ka_ = *(const f32x4*)(in[15] + h * 64 + j4), rk_ = *(const f32x4*)(in[16] + h * 64 + j4);
        const f32x4 gng = *(const f32x4*)(in[17] + h * 64 + j4), gnb = *(const f32x4*)(in[18] + h * 64 + j4);
        float S0[4], S1[4];
#pragma unroll
        for (int j = 0; j < 4; ++j) { S0[j] = 0.f; S1[j] = 0.f; }
        const f32x4 w0v = *(const f32x4*)(in[9] + h * 64 + j4), a0v = *(const f32x4*)(in[11] + h * 64 + j4);
        RwkvRegs R; rwkv_load(R, Z, WAG, b, h, tt, j4, w0v, a0v);
        const int nchunk = (LSEQ + 31) / 32;
        for (int c = 0; c < nchunk; ++c) {
            LAS float* buf = (LAS float*)(lds + (c & 1) * 65536);
            LAS float* bon = bonus + (c & 1) * 96;
            {
                const f32x4 zr = unpack4(R.zr), zk = unpack4(R.zk), zv = unpack4(R.zv), pr = unpack4(R.pr), pk = unpack4(R.pk), pv = unpack4(R.pv);
                f32x4 dec = R.dec + w0v, av = R.a + a0v;
#pragma unroll
                for (int e = 0; e < 4; ++e) { dec[e] = decay_of(dec[e]); av[e] = sigmoidf_(av[e]); }
                const f32x4 r = zr + (pr - zr) * mur, k = zk + (pk - zk) * muk, v = zv + (pv - zv) * muv;
                const f32x4 kr = k * kk_;
                const float ss = sum16((kr[0] * kr[0] + kr[1] * kr[1]) + (kr[2] * kr[2] + kr[3] * kr[3]));
                const float inrm = rsqrtf(fmaxf(ss, 1e-24f));
                const f32x4 kk = kr * inrm;
                const f32x4 km = k * (1.0f + (av - 1.0f) * ka_);
                const f32x4 kka = kk * av;
                const f32x4 rb = r * km * rk_;
                const float bs = sum16((rb[0] + rb[1]) + (rb[2] + rb[3]));
                const f32x4 rka = r * kka, rkm = r * km;
                const float c1 = sum16((rka[0] + rka[1]) + (rka[2] + rka[3])), c2 = sum16((rkm[0] + rkm[1]) + (rkm[2] + rkm[3]));
                const int o = tt * 64 + j4;
                *(LAS f32x4*)(buf + 0 * 2048 + o) = r * dec; *(LAS f32x4*)(buf + 1 * 2048 + o) = dec; *(LAS f32x4*)(buf + 2 * 2048 + o) = km; *(LAS f32x4*)(buf + 3 * 2048 + o) = v;
                *(LAS f32x4*)(buf + 4 * 2048 + o) = kk; *(LAS f32x4*)(buf + 5 * 2048 + o) = kka; *(LAS f32x4*)(buf + 6 * 2048 + o) = R.g;
                if (q == 0) { bon[tt] = bs; bon[32 + tt] = c1; bon[64 + tt] = c2; }
            }
            __syncthreads();
            if (c + 1 < nchunk) rwkv_load(R, Z, WAG, b, h, (c + 1) * 32 + tt, j4, w0v, a0v);
            const int nst = (LSEQ - c * 32) < 32 ? (LSEQ - c * 32) : 32;
            {   const LAS float* p = buf + cgi * 4;
                const LAS float* pv = buf + 3 * 2048 + myrow;
                LAS float* py = buf + 7 * 2048 + myrow;
#define RW_LOAD(r4, d4, m4, k4, a4, v2, cc, T) do { const LAS float* q_ = p + (T) * 64; r4 = *(const LAS f32x4*)(q_); d4 = *(const LAS f32x4*)(q_ + 2048); m4 = *(const LAS f32x4*)(q_ + 4096); \
        k4 = *(const LAS f32x4*)(q_ + 8192); a4 = *(const LAS f32x4*)(q_ + 10240); v2 = *(const LAS f32x2*)(pv + (T) * 64); cc = (f32x2){bon[32 + (T)], bon[64 + (T)]}; } while (0)
#define RW_DPP4(ctrl) "v_add_f32_dpp %0, %0, %0 " ctrl " row_mask:0xf bank_mask:0xf bound_ctrl:1\n\tv_add_f32_dpp %1, %1, %1 " ctrl " row_mask:0xf bank_mask:0xf bound_ctrl:1\n\t" \
                      "v_add_f32_dpp %2, %2, %2 " ctrl " row_mask:0xf bank_mask:0xf bound_ctrl:1\n\tv_add_f32_dpp %3, %3, %3 " ctrl " row_mask:0xf bank_mask:0xf bound_ctrl:1\n\t"
#define RW_STEP(r4, d4, m4, k4, a4, v2, cc, T) do { \
        float e0 = vmul(S0[0], k4[0]), e1 = vmul(S1[0], k4[0]), e2 = vmul(S0[0], r4[0]), e3 = vmul(S1[0], r4[0]);     \
        float w00 = vmul(S0[0], d4[0]), w10 = vmul(S1[0], d4[0]); \
        e0 = vfma(S0[1], k4[1], e0); e1 = vfma(S1[1], k4[1], e1); e2 = vfma(S0[1], r4[1], e2); e3 = vfma(S1[1], r4[1], e3); \
        float w01 = vmul(S0[1], d4[1]), w11 = vmul(S1[1], d4[1]); \
        e0 = vfma(S0[2], k4[2], e0); e1 = vfma(S1[2], k4[2], e1); e2 = vfma(S0[2], r4[2], e2); e3 = vfma(S1[2], r4[2], e3); \
        float w02 = vmul(S0[2], d4[2]), w12 = vmul(S1[2], d4[2]); \
        e0 = vfma(S0[3], k4[3], e0); e1 = vfma(S1[3], k4[3], e1); e2 = vfma(S0[3], r4[3], e2); e3 = vfma(S1[3], r4[3], e3); \
        float w03 = vmul(S0[3], d4[3]), w13 = vmul(S1[3], d4[3]); \
        w00 = vfma(v2[0], m4[0], w00); w10 = vfma(v2[1], m4[0], w10); w01 = vfma(v2[0], m4[1], w01); w11 = vfma(v2[1], m4[1], w11); \
        w02 = vfma(v2[0], m4[2], w02); w12 = vfma(v2[1], m4[2], w12); w03 = vfma(v2[0], m4[3], w03); w13 = vfma(v2[1], m4[3], w13); \
        asm volatile("s_nop 1\n\t" RW_DPP4("quad_perm:[1,0,3,2]") RW_DPP4("quad_perm:[2,3,0,1]") RW_DPP4("row_half_mirror") RW_DPP4("row_mirror") : "+v"(e0), "+v"(e1), "+v"(e2), "+v"(e3)); \
        S0[0] = vfnma(e0, a4[0], w00); S1[0] = vfnma(e1, a4[0], w10); S0[1] = vfnma(e0, a4[1], w01); S1[1] = vfnma(e1, a4[1], w11); \
        S0[2] = vfnma(e0, a4[2], w02); S1[2] = vfnma(e1, a4[2], w12); S0[3] = vfnma(e0, a4[3], w03); S1[3] = vfnma(e1, a4[3], w13); \
        if (cgi == 0) { const float y0 = vfnma(e0, cc[0], vfma(v2[0], cc[1], e2)), y1 = vfnma(e1, cc[0], vfma(v2[1], cc[1], e3)); *(LAS f32x2*)(py + (T) * 64) = (f32x2){y0, y1}; } } while (0)
                f32x4 Ar, Ad, Am, Ak, Aa, Br, Bd, Bm, Bk, Ba; f32x2 Av, Bv, Ac, Bc;
                RW_LOAD(Ar, Ad, Am, Ak, Aa, Av, Ac, 0);
#define RW_PAIR(t) do { RW_LOAD(Br, Bd, Bm, Bk, Ba, Bv, Bc, (t) + 1); __builtin_amdgcn_sched_barrier(0); RW_STEP(Ar, Ad, Am, Ak, Aa, Av, Ac, (t)); __builtin_amdgcn_sched_barrier(0); \
        RW_LOAD(Ar, Ad, Am, Ak, Aa, Av, Ac, ((t) + 2) & 31); __builtin_amdgcn_sched_barrier(0); RW_STEP(Br, Bd, Bm, Bk, Ba, Bv, Bc, (t) + 1); __builtin_amdgcn_sched_barrier(0); } while (0)
                if (MODE != 1) {
                    RW_PAIR(0); RW_PAIR(2); RW_PAIR(4); RW_PAIR(6); RW_PAIR(8); RW_PAIR(10); RW_PAIR(12); RW_PAIR(14);
                    if (nst > 16) { RW_PAIR(16); RW_PAIR(18); RW_PAIR(20); RW_PAIR(22); RW_PAIR(24); RW_PAIR(26); RW_PAIR(28); RW_PAIR(30); }
                }
#undef RW_PAIR
#undef RW_LOAD
#undef RW_STEP
#undef RW_DPP4
            }
            __syncthreads();
            {
                const int pos = c * 32 + tt;
                const int o = tt * 64 + j4;
                const f32x4 y = *(const LAS f32x4*)(buf + 7 * 2048 + o), v = *(const LAS f32x4*)(buf + 3 * 2048 + o), g = *(const LAS f32x4*)(buf + 6 * 2048 + o);
                const float mean = sum16((y[0] + y[1]) + (y[2] + y[3])) * (1.0f / 64.0f);
                const f32x4 dy = y - mean;
                const float var = sum16((dy[0] * dy[0] + dy[1] * dy[1]) + (dy[2] * dy[2] + dy[3] * dy[3])) * (1.0f / 64.0f);
                const float rs = rsqrtf(var + GN_EPS), bs = bon[tt];
#if (DBG_SKIP & 4)
                const f32x4 out = (f32x4){0.f, 0.f, 0.f, 0.f};
#else
                const f32x4 out = (dy * rs * gng + gnb + v * bs) * g;
#endif
                if (pos < LSEQ && (b == 0 || pos >= NMETA)) { u32x2 w; w.x = cvt_pk_bf16(out[0], out[1]); w.y = cvt_pk_bf16(out[2], out[3]);
                    *(u32x2*)(Y + (size_t)rowof(b, pos) * D + 2048 + h * 64 + j4) = w; }
            }
        }
        __syncthreads();
    }
}

__device__ __forceinline__ void phase_s5(const float* const (&in)[34], unsigned char* ws, LAS unsigned char* lds, int G) {
    int tid = threadIdx.x; asm volatile("" : "+v"(tid)); const int lane = tid & 63, wid = __builtin_amdgcn_readfirstlane(tid >> 6), fr = lane & 15, fq = lane >> 4;
    if (wid >= 2) return;
    const bf16_t* U = (const bf16_t*)(ws + WS_U); bf16_t* YS = (bf16_t*)(ws + WS_YS);
    LAS unsigned char* wl = lds + wid * 32768;
    LAS bf16_t* BB = (LAS bf16_t*)wl;
    LAS float* BU0 = (LAS float*)(wl + 4096);
    LAS unsigned char* XB = wl + 4096 + 2 * 16 * 132 * 4;
    constexpr int NCK = LSEQ / 16;
    for (int chain = blockIdx.x * 2 + wid; chain < NB * 128; chain += G * 2) {
        const int b = chain >> 7, g = chain & 127, p = lane;
        const float lr = in[21][g * 64 + p], li = in[22][g * 64 + p], dt = expf(in[23][g]);
        const float mag = expf(lr * dt); float sn, cs; sincosf(li * dt, &sn, &cs);
        const float ar = mag * cs, ai = mag * sn, den = lr * lr + li * li;
        const float f_r = ((ar - 1.0f) * lr + ai * li) / den, f_i = (ai * lr - (ar - 1.0f) * li) / den;
        {   const float* br = in[24] + (size_t)(g * 64 + p) * 16; const float* bi = in[25] + (size_t)(g * 64 + p) * 16;
            unsigned wre[8], wim[8];
#pragma unroll
            for (int c = 0; c < 16; c += 2) { const float r0 = br[c], i0 = bi[c], r1 = br[c + 1], i1 = bi[c + 1];
                wre[c >> 1] = pk2(f_r * r0 - f_i * i0, f_r * r1 - f_i * i1); wim[c >> 1] = pk2(f_r * i0 + f_i * r0, f_r * i1 + f_i * r1); }
            *(LAS u32x4*)(BB + (2 * p) * 16) = (u32x4){wre[0], wre[1], wre[2], wre[3]}; *(LAS u32x4*)(BB + (2 * p) * 16 + 8) = (u32x4){wre[4], wre[5], wre[6], wre[7]};
            *(LAS u32x4*)(BB + (2 * p + 1) * 16) = (u32x4){wim[0], wim[1], wim[2], wim[3]}; *(LAS u32x4*)(BB + (2 * p + 1) * 16 + 8) = (u32x4){wim[4], wim[5], wim[6], wim[7]};
        }
        LDS_WAIT();
        bf16x8 bop[8];
#pragma unroll
        for (int nt = 0; nt < 8; ++nt) { u32x4 z = {0u, 0u, 0u, 0u}; if (fq < 2) z = *(const LAS u32x4*)(BB + (nt * 16 + fr) * 16 + fq * 8); bop[nt] = __builtin_bit_cast(bf16x8, z); }
        bf16x8 cop[4];
#pragma unroll
        for (int ks = 0; ks < 4; ++ks) { const size_t o = (size_t)(g * 16 + fr) * 64 + ks * 16 + fq * 4;
            const f32x4 cr = *(const f32x4*)(in[26] + o), ci = *(const f32x4*)(in[27] + o);
            u32x4 w; w.x = pk2(cr[0], -ci[0]); w.y = pk2(cr[1], -ci[1]); w.z = pk2(cr[2], -ci[2]); w.w = pk2(cr[3], -ci[3]); cop[ks] = __builtin_bit_cast(bf16x8, w); }
        const f32x4 dsk = *(const f32x4*)(in[28] + g * 16 + 4 * fq);
        float xr = 0.f, xi = 0.f;
        u32x4 uz1 = {0u, 0u, 0u, 0u}, uz2 = {0u, 0u, 0u, 0u}; u32x2 usk0, usk1, usk2, uskp = {0u, 0u}; f32x4 ya = {0.f, 0.f, 0.f, 0.f}, yb = {0.f, 0.f, 0.f, 0.f};
        {
            const bf16_t* ur0 = U + (size_t)rowof(b, fr) * 2048 + g * 16; u32x4 uz0 = {0u, 0u, 0u, 0u}; if (fq < 2) uz0 = *(const u32x4*)(ur0 + fq * 8); usk0 = *(const u32x2*)(ur0 + 4 * fq);
            const bf16_t* ur1 = U + (size_t)rowof(b, 16 + fr) * 2048 + g * 16; if (fq < 2) uz1 = *(const u32x4*)(ur1 + fq * 8); usk1 = *(const u32x2*)(ur1 + 4 * fq);
            const bf16x8 uop = __builtin_bit_cast(bf16x8, uz0);
#pragma unroll
            for (int nt = 0; nt < 8; ++nt) { const f32x4 acc = __builtin_amdgcn_mfma_f32_16x16x32_bf16(uop, bop[nt], (f32x4){0.f, 0.f, 0.f, 0.f}, 0, 0, 0);
#pragma unroll
                for (int i = 0; i < 4; ++i) BU0[(4 * fq + i) * 132 + nt * 16 + fr] = acc[i]; }
            LDS_WAIT();
        }
#pragma unroll 1
        for (int ck = 0; ck < NCK; ++ck) {
            LAS float* BUc = BU0 + (ck & 1) * (16 * 132); LAS float* BUn = BU0 + ((ck + 1) & 1) * (16 * 132);
            usk2 = usk1;
            if (ck + 2 < NCK) { const bf16_t* ur = U + (size_t)rowof(b, (ck + 2) * 16 + fr) * 2048 + g * 16; if (fq < 2) uz2 = *(const u32x4*)(ur + fq * 8); usk2 = *(const u32x2*)(ur + 4 * fq); }
            f32x2 bu[16];
#pragma unroll
            for (int t = 0; t < 16; ++t) bu[t] = *(const LAS f32x2*)(BUc + t * 132 + 2 * p);
            if (ck > 0) {
                const int pos = (ck - 1) * 16 + fr;
                f32x4 yv = (ya + yb) + unpack4(uskp) * dsk;
                yv[0] = gelu_erf_fast(yv[0]); yv[1] = gelu_erf_fast(yv[1]); yv[2] = gelu_erf_fast(yv[2]); yv[3] = gelu_erf_fast(yv[3]);
                if (b == 0 || pos >= NMETA) { u32x2 o; o.x = cvt_pk_bf16(yv[0], yv[1]); o.y = cvt_pk_bf16(yv[2], yv[3]); *(u32x2*)(YS + (size_t)rowof(b, pos) * 2048 + g * 16 + 4 * fq) = o; }
            }
            f32x4 accn[8];
            const bf16x8 uop = __builtin_bit_cast(bf16x8, uz1);
            __builtin_amdgcn_sched_barrier(0);
#pragma unroll
            for (int t = 0; t < 16; ++t) { const float nr = vfma(ar, xr, vfnma(ai, xi, bu[t][0])), ni = vfma(ar, xi, vfma(ai, xr, bu[t][1])); xr = nr; xi = ni;
                *(LAS unsigned*)(XB + t * 272 + p * 4) = cvt_pk_bf16(nr, ni);
                if (t & 1) accn[t >> 1] = __builtin_amdgcn_mfma_f32_16x16x32_bf16(uop, bop[t >> 1], (f32x4){0.f, 0.f, 0.f, 0.f}, 0, 0, 0);
                __builtin_amdgcn_sched_barrier(0); }
            if (ck + 1 < NCK) {
#pragma unroll
                for (int nt = 0; nt < 8; ++nt) {
#pragma unroll
                    for (int i = 0; i < 4; ++i) BUn[(4 * fq + i) * 132 + nt * 16 + fr] = accn[nt][i]; } }
            LDS_WAIT();
            { const bf16x8 x0 = *(const LAS bf16x8*)(XB + fr * 272 + 0 * 64 + fq * 16), x1 = *(const LAS bf16x8*)(XB + fr * 272 + 1 * 64 + fq * 16);
              const bf16x8 x2 = *(const LAS bf16x8*)(XB + fr * 272 + 2 * 64 + fq * 16), x3 = *(const LAS bf16x8*)(XB + fr * 272 + 3 * 64 + fq * 16);
              ya = __builtin_amdgcn_mfma_f32_16x16x32_bf16(cop[0], x0, (f32x4){0.f, 0.f, 0.f, 0.f}, 0, 0, 0); yb = __builtin_amdgcn_mfma_f32_16x16x32_bf16(cop[1], x1, (f32x4){0.f, 0.f, 0.f, 0.f}, 0, 0, 0);
              ya = __builtin_amdgcn_mfma_f32_16x16x32_bf16(cop[2], x2, ya, 0, 0, 0); yb = __builtin_amdgcn_mfma_f32_16x16x32_bf16(cop[3], x3, yb, 0, 0, 0); }
            LDS_WAIT();
            uskp = usk0; usk0 = usk1; usk1 = usk2; uz1 = uz2;
        }
        {
            const int pos = (NCK - 1) * 16 + fr;
            f32x4 yv = (ya + yb) + unpack4(uskp) * dsk;
            yv[0] = gelu_erf_fast(yv[0]); yv[1] = gelu_erf_fast(yv[1]); yv[2] = gelu_erf_fast(yv[2]); yv[3] = gelu_erf_fast(yv[3]);
            if (b == 0 || pos >= NMETA) { u32x2 o; o.x = cvt_pk_bf16(yv[0], yv[1]); o.y = cvt_pk_bf16(yv[2], yv[3]); *(u32x2*)(YS + (size_t)rowof(b, pos) * 2048 + g * 16 + 4 * fq) = o; }
        }
    }
}

#define S5_SPIN(ptr, need) do { while ((int)(*(volatile LAS unsigned*)(ptr)) < (int)(need)) __builtin_amdgcn_s_sleep(1); } while (0)
__device__ __forceinline__ void phase_s5p(const float* const (&in)[34], unsigned char* ws, LAS unsigned char* lds, int G) {
    int tid = threadIdx.x; asm volatile("" : "+v"(tid)); const int lane = tid & 63, wid = __builtin_amdgcn_readfirstlane(tid >> 6), fr = lane & 15, fq = lane >> 4;
    if (tid < 4) *(volatile LAS unsigned*)(lds + (tid >> 1) * 32768 + 29696 + (tid & 1) * 4) = 0u;
    __syncthreads();
    if (wid >= 4) return;
    const int slot = wid & 1; const bool producer = wid < 2;
    const bf16_t* U = (const bf16_t*)(ws + WS_U); bf16_t* YS = (bf16_t*)(ws + WS_YS);
    LAS unsigned char* wl = lds + slot * 32768;
    LAS bf16_t* BB = (LAS bf16_t*)wl;
    LAS float* BU0 = (LAS float*)(wl + 4096);
    LAS unsigned char* XB0 = wl + 4096 + 2 * 16 * 132 * 4;
    LAS unsigned char* fprod = wl + 29696; LAS unsigned char* fcons = wl + 29700;
    constexpr int NCK = LSEQ / 16;
    int base = 0;
    for (int chain = blockIdx.x * 2 + slot; chain < NB * 128; chain += G * 2, base += NCK) {
        const int b = chain >> 7, g = chain & 127, p = lane;
        if (producer) {
            const float lr = in[21][g * 64 + p], li = in[22][g * 64 + p], dt = expf(in[23][g]);
            const float mag = expf(lr * dt); float sn, cs; sincosf(li * dt, &sn, &cs);
            const float ar = mag * cs, ai = mag * sn, den = lr * lr + li * li;
            const float f_r = ((ar - 1.0f) * lr + ai * li) / den, f_i = (ai * lr - (ar - 1.0f) * li) / den;
            {   const float* br = in[24] + (size_t)(g * 64 + p) * 16; const float* bi = in[25] + (size_t)(g * 64 + p) * 16;
                unsigned wre[8], wim[8];
#pragma unroll
                for (int c = 0; c < 16; c += 2) { const float r0 = br[c], i0 = bi[c], r1 = br[c + 1], i1 = bi[c + 1];
                    wre[c >> 1] = pk2(f_r * r0 - f_i * i0, f_r * r1 - f_i * i1); wim[c >> 1] = pk2(f_r * i0 + f_i * r0, f_r * i1 + f_i * r1); }
                *(LAS u32x4*)(BB + (2 * p) * 16) = (u32x4){wre[0], wre[1], wre[2], wre[3]}; *(LAS u32x4*)(BB + (2 * p) * 16 + 8) = (u32x4){wre[4], wre[5], wre[6], wre[7]};
                *(LAS u32x4*)(BB + (2 * p + 1) * 16) = (u32x4){wim[0], wim[1], wim[2], wim[3]}; *(LAS u32x4*)(BB + (2 * p + 1) * 16 + 8) = (u32x4){wim[4], wim[5], wim[6], wim[7]};
            }
            LDS_WAIT();
            bf16x8 bop[8];
#pragma unroll
            for (int nt = 0; nt < 8; ++nt) { u32x4 z = {0u, 0u, 0u, 0u}; if (fq < 2) z = *(const LAS u32x4*)(BB + (nt * 16 + fr) * 16 + fq * 8); bop[nt] = __builtin_bit_cast(bf16x8, z); }
            float xr = 0.f, xi = 0.f;
            u32x4 uz1 = {0u, 0u, 0u, 0u}, uz2 = {0u, 0u, 0u, 0u};
            {   const bf16_t* ur0 = U + (size_t)rowof(b, fr) * 2048 + g * 16; u32x4 uz0 = {0u, 0u, 0u, 0u}; if (fq < 2) uz0 = *(const u32x4*)(ur0 + fq * 8);
                const bf16_t* ur1 = U + (size_t)rowof(b, 16 + fr) * 2048 + g * 16; if (fq < 2) uz1 = *(const u32x4*)(ur1 + fq * 8);
                const bf16x8 uop = __builtin_bit_cast(bf16x8, uz0);
#pragma unroll
                for (int nt = 0; nt < 8; ++nt) { const f32x4 acc = __builtin_amdgcn_mfma_f32_16x16x32_bf16(uop, bop[nt], (f32x4){0.f, 0.f, 0.f, 0.f}, 0, 0, 0);
#pragma unroll
                    for (int i = 0; i < 4; ++i) BU0[(4 * fq + i) * 132 + nt * 16 + fr] = acc[i]; }
                LDS_WAIT();
            }
#pragma unroll 1
            for (int ck = 0; ck < NCK; ++ck) {
                LAS float* BUc = BU0 + (ck & 1) * (16 * 132); LAS float* BUn = BU0 + ((ck + 1) & 1) * (16 * 132); LAS unsigned char* XB = XB0 + (ck & 1) * 4352;
                { const int pc = ck + 2 < NCK ? ck + 2 : ck; const bf16_t* ur = U + (size_t)rowof(b, pc * 16 + fr) * 2048 + g * 16; if (fq < 2) uz2 = *(const u32x4*)(ur + fq * 8); }
                f32x2 bu[16];
#pragma unroll
                for (int t = 0; t < 16; ++t) bu[t] = *(const LAS f32x2*)(BUc + t * 132 + 2 * p);
                if (ck >= 2) S5_SPIN(fcons, base + ck - 1);
                f32x4 accn[8];
                const bf16x8 uop = __builtin_bit_cast(bf16x8, uz1);
                __builtin_amdgcn_sched_barrier(0);
#pragma unroll
                for (int t = 0; t < 16; ++t) { const float nr = vfma(ar, xr, vfnma(ai, xi, bu[t][0])), ni = vfma(ar, xi, vfma(ai, xr, bu[t][1])); xr = nr; xi = ni;
                    *(LAS unsigned*)(XB + t * 272 + p * 4) = cvt_pk_bf16(nr, ni);
                    if (t & 1) accn[t >> 1] = __builtin_amdgcn_mfma_f32_16x16x32_bf16(uop, bop[t >> 1], (f32x4){0.f, 0.f, 0.f, 0.f}, 0, 0, 0);
                    __builtin_amdgcn_sched_barrier(0); }
                if (ck + 1 < NCK) {
#pragma unroll
                    for (int nt = 0; nt < 8; ++nt) {
#pragma unroll
                        for (int i = 0; i < 4; ++i) BUn[(4 * fq + i) * 132 + nt * 16 + fr] = accn[nt][i]; } }
                LDS_WAIT();
                *(volatile LAS unsigned*)fprod = (unsigned)(base + ck + 1);
                uz1 = uz2;
            }
        } else {
            bf16x8 cop[4];
#pragma unroll
            for (int ks = 0; ks < 4; ++ks) { const size_t o = (size_t)(g * 16 + fr) * 64 + ks * 16 + fq * 4;
                const f32x4 cr = *(const f32x4*)(in[26] + o), ci = *(const f32x4*)(in[27] + o);
                u32x4 w; w.x = pk2(cr[0], -ci[0]); w.y = pk2(cr[1], -ci[1]); w.z = pk2(cr[2], -ci[2]); w.w = pk2(cr[3], -ci[3]); cop[ks] = __builtin_bit_cast(bf16x8, w); }
            const f32x4 dsk = *(const f32x4*)(in[28] + g * 16 + 4 * fq);
            u32x2 uskn = *(const u32x2*)(U + (size_t)rowof(b, fr) * 2048 + g * 16 + 4 * fq);
#pragma unroll 1
            for (int ck = 0; ck < NCK; ++ck) {
                const u32x2 usk = uskn;
                { const int pc = ck + 1 < NCK ? ck + 1 : ck; uskn = *(const u32x2*)(U + (size_t)rowof(b, pc * 16 + fr) * 2048 + g * 16 + 4 * fq); }
                S5_SPIN(fprod, base + ck + 1);
                LAS unsigned char* XB = XB0 + (ck & 1) * 4352;
                const bf16x8 x0 = *(const LAS bf16x8*)(XB + fr * 272 + 0 * 64 + fq * 16), x1 = *(const LAS bf16x8*)(XB + fr * 272 + 1 * 64 + fq * 16);
                const bf16x8 x2 = *(const LAS bf16x8*)(XB + fr * 272 + 2 * 64 + fq * 16), x3 = *(const LAS bf16x8*)(XB + fr * 272 + 3 * 64 + fq * 16);
                LDS_WAIT();
                *(volatile LAS unsigned*)fcons = (unsigned)(base + ck + 1);
                f32x4 ya = __builtin_amdgcn_mfma_f32_16x16x32_bf16(cop[0], x0, (f32x4){0.f, 0.f, 0.f, 0.f}, 0, 0, 0), yb = __builtin_amdgcn_mfma_f32_16x16x32_bf16(cop[1], x1, (f32x4){0.f, 0.f, 0.f, 0.f}, 0, 0, 0);
                ya = __builtin_amdgcn_mfma_f32_16x16x32_bf16(cop[2], x2, ya, 0, 0, 0); yb = __builtin_amdgcn_mfma_f32_16x16x32_bf16(cop[3], x3, yb, 0, 0, 0);
                const int pos = ck * 16 + fr;
                f32x4 yv = (ya + yb) + unpack4(usk) * dsk;
                yv[0] = gelu_erf_fast(yv[0]); yv[1] = gelu_erf_fast(yv[1]); yv[2] = gelu_erf_fast(yv[2]); yv[3] = gelu_erf_fast(yv[3]);
                if (b == 0 || pos >= NMETA) { u32x2 o; o.x = cvt_pk_bf16(yv[0], yv[1]); o.y = cvt_pk_bf16(yv[2], yv[3]); *(u32x2*)(YS + (size_t)rowof(b, pos) * 2048 + g * 16 + 4 * fq) = o; }
            }
        }
    }
}

__device__ __forceinline__ unsigned ordkey(float v) { const unsigned u = __builtin_bit_cast(unsigned, v); return (u & 0x80000000u) ? ~u : (u | 0x80000000u); }
__device__ __forceinline__ float unord(unsigned k) { const unsigned u = (k & 0x80000000u) ? (k & 0x7fffffffu) : ~k; return __builtin_bit_cast(float, u); }
#ifndef EXP_UR
#define EXP_UR 4
#endif
#ifndef EXP_VR
#define EXP_VR 4
#endif
constexpr int UR = EXP_UR, VR = EXP_VR;
template <bool FINAL, bool DRY = false>
__device__ __forceinline__ void phase_expert(const float* fgain, float* out, unsigned char* ws, LAS unsigned char* lds, int layer, int G) {
    int tid = threadIdx.x; asm volatile("" : "+v"(tid)); const int lane = tid & 63, wid = __builtin_amdgcn_readfirstlane(tid >> 6);
    const float* SC = (const float*)(ws + WS_SC); float* H = (float*)(ws + WS_H); bf16_t* HB = (bf16_t*)(ws + WS_HB);
    const unsigned char* PU = ws + WS_PU + (size_t)layer * NEXP * D; const unsigned char* PV = ws + WS_PV + (size_t)layer * NEXP * D;
    const float* SU = (const float*)(ws + WS_SU) + layer * NEXP; const float* SV = (const float*)(ws + WS_SV) + layer * NEXP;
    LAS float* part = (LAS float*)lds;
    LAS float* red = (LAS float*)(lds + RED_OFF);
    for (int tok = blockIdx.x; tok < MROWS; tok += G) {
        const float* sc = SC + (size_t)tok * 2048 + wid * 256;
        float s12[2]; int i12[2];
#pragma unroll
        for (int hf = 0; hf < 2; ++hf) {
            const float v0 = sc[hf * 128 + lane], v1 = sc[hf * 128 + 64 + lane];
            unsigned k0 = (ordkey(v0) & ~127u) | (unsigned)(127 - lane), k1 = (ordkey(v1) & ~127u) | (unsigned)(63 - lane);
            float sv = 0.f; int si = 0;
#pragma unroll 1
            for (int k = 0; k < 16; ++k) { const unsigned w = max64u(umax_u(k0, k1)); if (lane == k) { sv = unord(w & ~127u); si = 127 - (int)(w & 127u); } if (k0 == w) k0 = 0u; if (k1 == w) k1 = 0u; }
            s12[hf] = sv; i12[hf] = si;
        }
        const float c1 = __shfl(s12[0], lane >> 2);
        unsigned ck[4];
#pragma unroll
        for (int jj = 0; jj < 4; ++jj) { const int j = (lane & 3) * 4 + jj; const float c2 = __shfl(s12[1], j); ck[jj] = (ordkey(c1 + c2) & ~255u) | (unsigned)(255 - ((lane >> 2) * 16 + j)); }
        float ts = 0.f; int tp = 0;
#pragma unroll 1
        for (int k = 0; k < 16; ++k) { const unsigned w = max64u(umax_u(umax_u(ck[0], ck[1]), umax_u(ck[2], ck[3]))); if (lane == k) { ts = unord(w & ~255u); tp = 255 - (int)(w & 255u); }
#pragma unroll
            for (int jj = 0; jj < 4; ++jj) if (ck[jj] == w) ck[jj] = 0u; }
        const int e1 = __shfl(i12[0], tp >> 4), e2 = __shfl(i12[1], tp & 15);
        const int eid = e1 * 128 + e2;
        float mx = ts; mx = fmaxf(mx, dppf<DPP_XOR1>(mx)); mx = fmaxf(mx, dppf<DPP_XOR2>(mx)); mx = fmaxf(mx, dppf<DPP_HMIRROR>(mx)); mx = fmaxf(mx, dppf<DPP_MIRROR>(mx));
        const float ex = __expf(ts - mx), gate = ex / sum16(ex);
        float su = 0.f, sv = 0.f; if (lane < 16) { su = SU[eid]; sv = SV[eid]; }
        float hbf[4][16];
#pragma unroll
        for (int j = 0; j < 4; ++j) { const u32x4* hp8 = (const u32x4*)(HB + (size_t)tok * D + j * 1024 + 16 * lane); const u32x4 h0 = hp8[0], h1 = hp8[1];
            hbf[j][0] = bflo(h0.x); hbf[j][1] = bfhi(h0.x); hbf[j][2] = bflo(h0.y); hbf[j][3] = bfhi(h0.y); hbf[j][4] = bflo(h0.z); hbf[j][5] = bfhi(h0.z); hbf[j][6] = bflo(h0.w); hbf[j][7] = bfhi(h0.w);
            hbf[j][8] = bflo(h1.x); hbf[j][9] = bfhi(h1.x); hbf[j][10] = bflo(h1.y); hbf[j][11] = bfhi(h1.y); hbf[j][12] = bflo(h1.z); hbf[j][13] = bfhi(h1.z); hbf[j][14] = bflo(h1.w); hbf[j][15] = bfhi(h1.w); }
        float wgt = 0.f;
        {   u32x4 rb[UR][4];
#pragma unroll
            for (int kk = 0; kk < UR; ++kk) { const int e = __builtin_amdgcn_readlane(eid, kk); const u32x4* up = (const u32x4*)(PU + (size_t)e * D) + lane;
#pragma unroll
                for (int j = 0; j < 4; ++j) rb[kk][j] = up[64 * j]; }
#pragma unroll 1
            for (int k4 = 0; k4 < 16; k4 += UR) {
#pragma unroll
                for (int kk = 0; kk < UR; ++kk) { float d0 = 0.f, d1 = 0.f;
#pragma unroll
                    for (int j = 0; j < 4; ++j) { const unsigned wv[4] = {rb[kk][j].x, rb[kk][j].y, rb[kk][j].z, rb[kk][j].w};
#pragma unroll
                        for (int q = 0; q < 4; ++q) { const f32x2 lo = __builtin_amdgcn_cvt_pk_f32_fp8((int)wv[q], false), hi = __builtin_amdgcn_cvt_pk_f32_fp8((int)wv[q], true);
                            d0 = fmaf(lo.x, hbf[j][4 * q + 0], d0); d1 = fmaf(lo.y, hbf[j][4 * q + 1], d1); d0 = fmaf(hi.x, hbf[j][4 * q + 2], d0); d1 = fmaf(hi.y, hbf[j][4 * q + 3], d1); } }
                    __builtin_amdgcn_sched_barrier(0);
                    if (k4 + UR < 16) { const int e = __builtin_amdgcn_readlane(eid, k4 + UR + kk); const u32x4* up = (const u32x4*)(PU + (size_t)e * D) + lane;
#pragma unroll
                        for (int j = 0; j < 4; ++j) rb[kk][j] = up[64 * j]; }
                    const float dt = sum64(d0 + d1);
                    if (lane == k4 + kk) wgt = gate * gelu_erf(dt * su) * sv;
                    __builtin_amdgcn_sched_barrier(0); }
            }
        }
        float acc[4][16];
#pragma unroll
        for (int j = 0; j < 4; ++j)
#pragma unroll
            for (int e = 0; e < 16; ++e) acc[j][e] = 0.f;
        {   u32x4 rb[VR][4];
#pragma unroll
            for (int kk = 0; kk < VR; ++kk) { const int e = __builtin_amdgcn_readlane(eid, kk); const u32x4* vp = (const u32x4*)(PV + (size_t)e * D) + lane;
#pragma unroll
                for (int j = 0; j < 4; ++j) rb[kk][j] = vp[64 * j]; }
#pragma unroll 1
            for (int k4 = 0; k4 < 16; k4 += VR) {
#pragma unroll
                for (int kk = 0; kk < VR; ++kk) { const float w = __builtin_bit_cast(float, __builtin_amdgcn_readlane(__builtin_bit_cast(int, wgt), k4 + kk));
#pragma unroll
                    for (int j = 0; j < 4; ++j) { const unsigned wv[4] = {rb[kk][j].x, rb[kk][j].y, rb[kk][j].z, rb[kk][j].w};
#pragma unroll
                        for (int q = 0; q < 4; ++q) { const f32x2 lo = __builtin_amdgcn_cvt_pk_f32_fp8((int)wv[q], false), hi = __builtin_amdgcn_cvt_pk_f32_fp8((int)wv[q], true);
                            acc[j][4 * q + 0] = fmaf(w, lo.x, acc[j][4 * q + 0]); acc[j][4 * q + 1] = fmaf(w, lo.y, acc[j][4 * q + 1]); acc[j][4 * q + 2] = fmaf(w, hi.x, acc[j][4 * q + 2]); acc[j][4 * q + 3] = fmaf(w, hi.y, acc[j][4 * q + 3]); } }
                    __builtin_amdgcn_sched_barrier(0);
                    if (k4 + VR < 16) { const int e = __builtin_amdgcn_readlane(eid, k4 + VR + kk); const u32x4* vp = (const u32x4*)(PV + (size_t)e * D) + lane;
#pragma unroll
                        for (int j = 0; j < 4; ++j) rb[kk][j] = vp[64 * j]; }
                    __builtin_amdgcn_sched_barrier(0); }
            }
        }
#pragma unroll
        for (int j = 0; j < 4; ++j)
#pragma unroll
            for (int q = 0; q < 4; ++q) *(LAS f32x4*)(part + ((wid * 16 + j * 4 + q) * 64 + lane) * 4) = (f32x4){acc[j][4 * q + 0], acc[j][4 * q + 1], acc[j][4 * q + 2], acc[j][4 * q + 3]};
        __syncthreads();
        {   f32x4 a = (f32x4){0.f, 0.f, 0.f, 0.f}, c = a;
            const int pj = tid >> 7, pl = (tid >> 1) & 63, pq = (tid & 1) * 2;
#pragma unroll
            for (int w = 0; w < 8; ++w) { a = a + *(const LAS f32x4*)(part + ((w * 16 + pj * 4 + pq) * 64 + pl) * 4); c = c + *(const LAS f32x4*)(part + ((w * 16 + pj * 4 + pq + 1) * 64 + pl) * 4); }
            f32x4* hp = (f32x4*)(H + (size_t)tok * D + 8 * tid);
#if (DBG_SKIP & 1)
            a = hp[0]; c = hp[1];
#elif (DBG_SKIP & 8)
            a = a * 0.5f + hp[0]; c = c * 0.5f + hp[1];
#else
            a = a + hp[0]; c = c + hp[1];
#endif
            if (!FINAL && !DRY) { hp[0] = a; hp[1] = c; }
            float ss = (a[0] * a[0] + a[1] * a[1]) + (a[2] * a[2] + a[3] * a[3]) + (c[0] * c[0] + c[1] * c[1]) + (c[2] * c[2] + c[3] * c[3]);
            ss = sum64(ss);
            if (lane == 0) red[wid] = ss;
            __syncthreads();
            float tot = 0.f;
#pragma unroll
            for (int w = 0; w < 8; ++w) tot += red[w];
            const float inv = rsqrtf(tot * (1.0f / D) + NORM_EPS);
            if (DRY) { if (inv == 123.456f) red[9] = inv; }
            else if (!FINAL) { u32x4 o; o.x = cvt_pk_bf16(a[0] * inv, a[1] * inv); o.y = cvt_pk_bf16(a[2] * inv, a[3] * inv); o.z = cvt_pk_bf16(c[0] * inv, c[1] * inv); o.w = cvt_pk_bf16(c[2] * inv, c[3] * inv);
                *(u32x4*)(HB + (size_t)tok * D + 8 * tid) = o; }
            else if (tok < MX) { const f32x4 g0 = *(const f32x4*)(fgain + 8 * tid), g1 = *(const f32x4*)(fgain + 8 * tid + 4);
                f32x4* op = (f32x4*)(out + (size_t)tok * D + 8 * tid); op[0] = a * inv * g0; op[1] = c * inv * g1; }
        }
        __syncthreads();
    }
}
#define PEER_DPP8(ctrl) "v_add_f32_dpp %0, %0, %0 " ctrl "\n\tv_add_f32_dpp %1, %1, %1 " ctrl "\n\tv_add_f32_dpp %2, %2, %2 " ctrl "\n\tv_add_f32_dpp %3, %3, %3 " ctrl "\n\t" \
                        "v_add_f32_dpp %4, %4, %4 " ctrl "\n\tv_add_f32_dpp %5, %5, %5 " ctrl "\n\tv_add_f32_dpp %6, %6, %6 " ctrl "\n\tv_add_f32_dpp %7, %7, %7 " ctrl "\n\t"

template <int CTRL> __device__ __forceinline__ unsigned rowmax_step(unsigned x) { const unsigned y = dppu<CTRL>(x); return x > y ? x : y; }
__device__ __forceinline__ unsigned rowmax16(unsigned x) { x = rowmax_step<DPP_XOR1>(x); x = rowmax_step<DPP_XOR2>(x); x = rowmax_step<DPP_HMIRROR>(x); x = rowmax_step<DPP_MIRROR>(x); return x; }
__device__ __forceinline__ void phase_topk(unsigned char* ws, int G) {
    int tid = threadIdx.x; asm volatile("" : "+v"(tid)); const int lane = tid & 63, wid = __builtin_amdgcn_readfirstlane(tid >> 6);
    const float* SC = (const float*)(ws + WS_SC); int* EIDL = (int*)(ws + WS_EIDL); float* GATEL = (float*)(ws + WS_GATEL);
    const int l16 = lane & 15, row = lane >> 4;
    float ca[8], cb[8];
    { const int it0 = blockIdx.x * NWAVES + wid;
      if (it0 < MROWS * 2) { const float* sc = SC + (size_t)(it0 >> 1) * 2048 + ((it0 & 1) * 4 + row) * 256 + l16;
#pragma unroll
          for (int j = 0; j < 8; ++j) { ca[j] = sc[16 * j]; cb[j] = sc[128 + 16 * j]; } } }
    for (int it = blockIdx.x * NWAVES + wid; it < MROWS * 2; it += G * NWAVES) {
        const int tok = it >> 1, h = (it & 1) * 4 + row;
        unsigned ka[8], kb[8];
#pragma unroll
        for (int j = 0; j < 8; ++j) { ka[j] = (ordkey(ca[j]) & ~127u) | (unsigned)(127 - (16 * j + l16)); kb[j] = (ordkey(cb[j]) & ~127u) | (unsigned)(127 - (16 * j + l16)); }
        { const int nit = it + G * NWAVES;
          if (nit < MROWS * 2) { const float* sc = SC + (size_t)(nit >> 1) * 2048 + ((nit & 1) * 4 + row) * 256 + l16;
#pragma unroll
              for (int j = 0; j < 8; ++j) { ca[j] = sc[16 * j]; cb[j] = sc[128 + 16 * j]; } } }
        __builtin_amdgcn_sched_barrier(0);
        float s1 = 0.f, s2 = 0.f; int i1 = 0, i2 = 0;
#pragma unroll 1
        for (int k = 0; k < 16; ++k) {
            unsigned ma = umax_u(umax_u(umax_u(ka[0], ka[1]), umax_u(ka[2], ka[3])), umax_u(umax_u(ka[4], ka[5]), umax_u(ka[6], ka[7])));
            unsigned mb = umax_u(umax_u(umax_u(kb[0], kb[1]), umax_u(kb[2], kb[3])), umax_u(umax_u(kb[4], kb[5]), umax_u(kb[6], kb[7])));
            ma = rowmax16(ma); mb = rowmax16(mb);
            if (l16 == k) { s1 = unord(ma & ~127u); i1 = 127 - (int)(ma & 127u); s2 = unord(mb & ~127u); i2 = 127 - (int)(mb & 127u); }
#pragma unroll
            for (int j = 0; j < 8; ++j) { ka[j] = ka[j] == ma ? 0u : ka[j]; kb[j] = kb[j] == mb ? 0u : kb[j]; }
        }
        unsigned ck[16];
        { const int s2i = __float_as_int(s2);
#define TK_CAND(n) { const int j = (l16 - (n)) & 15; const float c2 = (n) == 0 ? s2 : __shfl(s2, (lane & 48) + j); \
            ck[n] = (ordkey(s1 + c2) & ~255u) | (unsigned)(255 - (l16 * 16 + j)); }
          TK_CAND(0) TK_CAND(1) TK_CAND(2) TK_CAND(3) TK_CAND(4) TK_CAND(5) TK_CAND(6) TK_CAND(7) TK_CAND(8) TK_CAND(9) TK_CAND(10) TK_CAND(11) TK_CAND(12) TK_CAND(13) TK_CAND(14) TK_CAND(15)
#undef TK_CAND
        }
        float ts = 0.f; int tp = 0;
#pragma unroll 1
        for (int k = 0; k < 16; ++k) {
            unsigned m = umax_u(umax_u(umax_u(umax_u(ck[0], ck[1]), umax_u(ck[2], ck[3])), umax_u(umax_u(ck[4], ck[5]), umax_u(ck[6], ck[7]))),
                                umax_u(umax_u(umax_u(ck[8], ck[9]), umax_u(ck[10], ck[11])), umax_u(umax_u(ck[12], ck[13]), umax_u(ck[14], ck[15]))));
            m = rowmax16(m);
            if (l16 == k) { ts = unord(m & ~255u); tp = 255 - (int)(m & 255u); }
#pragma unroll
            for (int j = 0; j < 16; ++j) ck[j] = ck[j] == m ? 0u : ck[j];
        }
        const int e1 = __shfl(i1, (lane & 48) + (tp >> 4)), e2 = __shfl(i2, (lane & 48) + (tp & 15));
        float mx = ts; mx = fmaxf(mx, dppf<DPP_XOR1>(mx)); mx = fmaxf(mx, dppf<DPP_XOR2>(mx)); mx = fmaxf(mx, dppf<DPP_HMIRROR>(mx)); mx = fmaxf(mx, dppf<DPP_MIRROR>(mx));
        const float ex = __expf(ts - mx), gate = ex / sum16(ex);
        EIDL[(size_t)tok * 128 + h * 16 + l16] = (e1 * 128 + e2) * D;   GATEL[(size_t)tok * 128 + h * 16 + l16] = gate;
    }
}

__device__ __forceinline__ float dot16_fp8(const u32x4 r, const float (&h)[16]) {
    const unsigned wv[4] = {r.x, r.y, r.z, r.w}; float d0 = 0.f, d1 = 0.f;
#pragma unroll
    for (int q = 0; q < 4; ++q) { const f32x2 lo = __builtin_amdgcn_cvt_pk_f32_fp8((int)wv[q], false), hi = __builtin_amdgcn_cvt_pk_f32_fp8((int)wv[q], true);
        d0 = fmaf(lo.x, h[4 * q + 0], d0); d1 = fmaf(lo.y, h[4 * q + 1], d1); d0 = fmaf(hi.x, h[4 * q + 2], d0); d1 = fmaf(hi.y, h[4 * q + 3], d1); }
    return d0 + d1;
}
typedef __bf16 pbf2 __attribute__((ext_vector_type(2)));
__device__ __forceinline__ float dot16_fp8_bf16(const u32x4 r, const unsigned (&h)[8]) {
    const unsigned wv[4] = {r.x, r.y, r.z, r.w}; float d0 = 0.f, d1 = 0.f;
#pragma unroll
    for (int q = 0; q < 4; ++q) { const pbf2 lo = __builtin_amdgcn_cvt_scalef32_pk_bf16_fp8(wv[q], 1.0f, false), hi = __builtin_amdgcn_cvt_scalef32_pk_bf16_fp8(wv[q], 1.0f, true);
        d0 = __builtin_amdgcn_fdot2_f32_bf16(lo, __builtin_bit_cast(pbf2, h[2 * q]), d0, false); d1 = __builtin_amdgcn_fdot2_f32_bf16(hi, __builtin_bit_cast(pbf2, h[2 * q + 1]), d1, false); }
    return d0 + d1;
}
__device__ __forceinline__ int pair_get(int va, int vb, int p, int half4) { int addr = ((p & 63) << 2) + half4; asm volatile("" : "+v"(addr));
    return __builtin_amdgcn_ds_bpermute(addr, p < 64 ? va : vb); }
typedef _Float16 h16x2u __attribute__((ext_vector_type(2)));
__device__ __forceinline__ float dot16_bf8_f16(const u32x4 r, const h16x2u (&h)[8]) {
    const unsigned wv[4] = {r.x, r.y, r.z, r.w}; float d0 = 0.f, d1 = 0.f;
#pragma unroll
    for (int q = 0; q < 4; ++q) { const h16x2u lo = __builtin_bit_cast(h16x2u, __builtin_amdgcn_perm(0u, wv[q], 0x010c000cu)), hi = __builtin_bit_cast(h16x2u, __builtin_amdgcn_perm(0u, wv[q], 0x030c020cu));
        d0 = __builtin_amdgcn_fdot2(lo, h[2 * q], d0, false); d1 = __builtin_amdgcn_fdot2(hi, h[2 * q + 1], d1, false); }
    return d0 + d1;
}
__device__ __forceinline__ void phase_udot(unsigned char* ws, int layer, int G) {
    int tid = threadIdx.x; asm volatile("" : "+v"(tid)); const int lane = tid & 63, wid = __builtin_amdgcn_readfirstlane(tid >> 6);
    const int x = blockIdx.x & 7, g = (blockIdx.x >> 3) * NWAVES + wid, NG = (G >> 3) * NWAVES, half = lane >> 5, l32 = lane & 31, half4 = half * 4;
    const int* EIDL = (const int*)(ws + WS_EIDL); const bf16_t* HB = (const bf16_t*)(ws + WS_HB); float* DOTP = (float*)(ws + WS_DOTP);
    const unsigned char* ubase = ws + WS_PU + (size_t)layer * NEXP * D + 512 * x + 16 * l32;
    const int MAIN = (MROWS / NG) * NG;
    if (g >= MAIN) return;
    int ean = EIDL[(size_t)g * 128 + lane], ebn = EIDL[(size_t)g * 128 + 64 + lane];
    u32x4 h0n, h1n; { const u32x4* hp8 = (const u32x4*)(HB + (size_t)g * D + 512 * x + 16 * l32); h0n = hp8[0]; h1n = hp8[1]; }
#pragma unroll 1
    for (int tok = g; tok < MAIN; tok += NG) {
        const int ea = ean, eb = ebn;
        const unsigned hh[8] = {h0n.x, h0n.y, h0n.z, h0n.w, h1n.x, h1n.y, h1n.z, h1n.w};
        { const int tn = tok + NG < MAIN ? tok + NG : tok;
          ean = EIDL[(size_t)tn * 128 + lane]; ebn = EIDL[(size_t)tn * 128 + 64 + lane];
          const u32x4* hp8 = (const u32x4*)(HB + (size_t)tn * D + 512 * x + 16 * l32); h0n = hp8[0]; h1n = hp8[1]; }
        float* dp = DOTP + ((size_t)tok * 8 + x) * 128;
#define UD_LOAD(rb, B) do { unsigned eo_[8]; _Pragma("unroll") for (int i = 0; i < 8; ++i) eo_[i] = (unsigned)pair_get(ea, eb, 16 * (B) + 2 * i, half4); __builtin_amdgcn_sched_barrier(0); \
        _Pragma("unroll") for (int i = 0; i < 8; ++i) rb[i] = *(const u32x4*)(ubase + eo_[i]); } while (0)
#define UD_COMP(rb, B) do { float d0 = dot16_fp8_bf16(rb[0], hh), d1 = dot16_fp8_bf16(rb[1], hh), d2 = dot16_fp8_bf16(rb[2], hh), d3 = dot16_fp8_bf16(rb[3], hh), d4 = dot16_fp8_bf16(rb[4], hh), d5 = dot16_fp8_bf16(rb[5], hh), d6 = dot16_fp8_bf16(rb[6], hh), d7 = dot16_fp8_bf16(rb[7], hh); \
        asm volatile("s_nop 1\n\t" PEER_DPP8("quad_perm:[1,0,3,2] row_mask:0xf bank_mask:0xf bound_ctrl:1") PEER_DPP8("quad_perm:[2,3,0,1] row_mask:0xf bank_mask:0xf bound_ctrl:1") \
                     PEER_DPP8("row_half_mirror row_mask:0xf bank_mask:0xf bound_ctrl:1") PEER_DPP8("row_mirror row_mask:0xf bank_mask:0xf bound_ctrl:1") PEER_DPP8("row_bcast:15 row_mask:0xa bank_mask:0xf") \
                     : "+v"(d0), "+v"(d1), "+v"(d2), "+v"(d3), "+v"(d4), "+v"(d5), "+v"(d6), "+v"(d7)); \
        const int li = lane & 15; float v = d0; v = li == 1 ? d1 : v; v = li == 2 ? d2 : v; v = li == 3 ? d3 : v; v = li == 4 ? d4 : v; v = li == 5 ? d5 : v; v = li == 6 ? d6 : v; v = li == 7 ? d7 : v; \
        if ((lane & 16) && li < 8) dp[16 * (B) + 2 * li + half] = v; } while (0)
        u32x4 ra[8], rc[8];
        UD_LOAD(ra, 0);
#pragma unroll
        for (int b = 0; b < 8; b += 2) {
            UD_LOAD(rc, b + 1);
            __builtin_amdgcn_sched_barrier(0);
            UD_COMP(ra, b);
            __builtin_amdgcn_sched_barrier(0);
            if (b + 2 < 8) UD_LOAD(ra, b + 2);
            __builtin_amdgcn_sched_barrier(0);
            UD_COMP(rc, b + 1);
            __builtin_amdgcn_sched_barrier(0);
        }
    }
    for (int u = g; u < (MROWS - MAIN) * 8; u += NG) {
        const int tok = MAIN + (u >> 3), bt = u & 7;
        const int ea = EIDL[(size_t)tok * 128 + lane], eb = EIDL[(size_t)tok * 128 + 64 + lane];
        const u32x4* hp8 = (const u32x4*)(HB + (size_t)tok * D + 512 * x + 16 * l32); const u32x4 h0 = hp8[0], h1 = hp8[1];
        const unsigned hh[8] = {h0.x, h0.y, h0.z, h0.w, h1.x, h1.y, h1.z, h1.w};
        float* dp = DOTP + ((size_t)tok * 8 + x) * 128;
        u32x4 rt[8];
        { unsigned eo_[8];
#pragma unroll
          for (int i = 0; i < 8; ++i) eo_[i] = (unsigned)__builtin_amdgcn_ds_bpermute(((((16 * bt + 2 * i) & 63) << 2) + half4), bt < 4 ? ea : eb);
#pragma unroll
          for (int i = 0; i < 8; ++i) rt[i] = *(const u32x4*)(ubase + eo_[i]); }
        { float d0 = dot16_fp8_bf16(rt[0], hh), d1 = dot16_fp8_bf16(rt[1], hh), d2 = dot16_fp8_bf16(rt[2], hh), d3 = dot16_fp8_bf16(rt[3], hh), d4 = dot16_fp8_bf16(rt[4], hh), d5 = dot16_fp8_bf16(rt[5], hh), d6 = dot16_fp8_bf16(rt[6], hh), d7 = dot16_fp8_bf16(rt[7], hh);
          asm volatile("s_nop 1\n\t" PEER_DPP8("quad_perm:[1,0,3,2] row_mask:0xf bank_mask:0xf bound_ctrl:1") PEER_DPP8("quad_perm:[2,3,0,1] row_mask:0xf bank_mask:0xf bound_ctrl:1")
                       PEER_DPP8("row_half_mirror row_mask:0xf bank_mask:0xf bound_ctrl:1") PEER_DPP8("row_mirror row_mask:0xf bank_mask:0xf bound_ctrl:1") PEER_DPP8("row_bcast:15 row_mask:0xa bank_mask:0xf")
                       : "+v"(d0), "+v"(d1), "+v"(d2), "+v"(d3), "+v"(d4), "+v"(d5), "+v"(d6), "+v"(d7));
          const int li = lane & 15; float v = d0; v = li == 1 ? d1 : v; v = li == 2 ? d2 : v; v = li == 3 ? d3 : v; v = li == 4 ? d4 : v; v = li == 5 ? d5 : v; v = li == 6 ? d6 : v; v = li == 7 ? d7 : v;
          if ((lane & 16) && li < 8) dp[16 * bt + 2 * li + half] = v; }
    }
#undef UD_LOAD
#undef UD_COMP
}

__device__ __forceinline__ void phase_vacc(unsigned char* ws, int layer, int G) {
    int tid = threadIdx.x; asm volatile("" : "+v"(tid)); const int lane = tid & 63, wid = __builtin_amdgcn_readfirstlane(tid >> 6);
    const int x = blockIdx.x & 7, g = (blockIdx.x >> 3) * NWAVES + wid, NG = (G >> 3) * NWAVES, half = lane >> 5, l32 = lane & 31, half4 = half * 4;
    const int* EIDL = (const int*)(ws + WS_EIDL); const float* GATEL = (const float*)(ws + WS_GATEL); const float* DOTP = (const float*)(ws + WS_DOTP); float* H = (float*)(ws + WS_H);
    const float* SU = (const float*)(ws + WS_SU) + layer * NEXP; const float* SV = (const float*)(ws + WS_SV) + layer * NEXP; const float* HS = (const float*)(ws + WS_HS);
    const unsigned char* vbase = ws + WS_PV + (size_t)layer * NEXP * D + 512 * x + 16 * l32;
    for (int tok = g; tok < MROWS; tok += NG) {
        const int ea = EIDL[(size_t)tok * 128 + lane], eb = EIDL[(size_t)tok * 128 + 64 + lane];
        float wa, wb;
        {   const float* dq = DOTP + (size_t)tok * 1024 + lane; float da = 0.f, db = 0.f;
#pragma unroll
            for (int s = 0; s < 8; ++s) { da += dq[s * 128]; db += dq[s * 128 + 64]; }
            wa = GATEL[(size_t)tok * 128 + lane] * gelu_erf(da * SU[ea >> 12]) * SV[ea >> 12]; wb = GATEL[(size_t)tok * 128 + 64 + lane] * gelu_erf(db * SU[eb >> 12]) * SV[eb >> 12]; }
        float acc[16];
#pragma unroll
        for (int j = 0; j < 16; ++j) acc[j] = 0.f;
#define VA_LOAD(rb, B) do { _Pragma("unroll") for (int i = 0; i < 8; ++i) { const unsigned eo = (unsigned)pair_get(ea, eb, 16 * (B) + 2 * i, half4); rb[i] = *(const u32x4*)(vbase + eo); } } while (0)
#define VA_COMP(rb, B) do { _Pragma("unroll") for (int i = 0; i < 8; ++i) { const float w = __int_as_float(pair_get(__float_as_int(wa), __float_as_int(wb), 16 * (B) + 2 * i, half4)); const unsigned wv[4] = {rb[i].x, rb[i].y, rb[i].z, rb[i].w}; \
        _Pragma("unroll") for (int q = 0; q < 4; ++q) { const f32x2 lo = __builtin_amdgcn_cvt_pk_f32_fp8((int)wv[q], false), hi = __builtin_amdgcn_cvt_pk_f32_fp8((int)wv[q], true); \
            acc[4 * q + 0] = fmaf(w, lo.x, acc[4 * q + 0]); acc[4 * q + 1] = fmaf(w, lo.y, acc[4 * q + 1]); acc[4 * q + 2] = fmaf(w, hi.x, acc[4 * q + 2]); acc[4 * q + 3] = fmaf(w, hi.y, acc[4 * q + 3]); } } } while (0)
        u32x4 ra[8], rc[8];
        VA_LOAD(ra, 0);
#pragma unroll 1
        for (int b = 0; b < 8; b += 2) {
            VA_LOAD(rc, b + 1);
            __builtin_amdgcn_sched_barrier(0);
            VA_COMP(ra, b);
            __builtin_amdgcn_sched_barrier(0);
            if (b + 2 < 8) VA_LOAD(ra, b + 2);
            __builtin_amdgcn_sched_barrier(0);
            VA_COMP(rc, b + 1);
            __builtin_amdgcn_sched_barrier(0);
        }
#undef VA_LOAD
#undef VA_COMP
        float o[8];
#pragma unroll
        for (int j = 0; j < 8; ++j) { const float mine = half ? acc[8 + j] : acc[j], give = half ? acc[j] : acc[8 + j];
            const auto sw = __builtin_amdgcn_permlane32_swap(__float_as_uint(give), __float_as_uint(give), false, false); const unsigned s0 = sw[0], s1 = sw[1];
            o[j] = mine + __uint_as_float(half ? s0 : s1); }
        f32x4* hp = (f32x4*)(H + (size_t)tok * D + 512 * x + 16 * l32 + 8 * half);
        f32x4 h0 = hp[0], h1 = hp[1];
        h0[0] += o[0]; h0[1] += o[1]; h0[2] += o[2]; h0[3] += o[3]; h1[0] += o[4]; h1[1] += o[5]; h1[2] += o[6]; h1[3] += o[7];
        hp[0] = h0; hp[1] = h1;
    }
}

__device__ __forceinline__ void phase_final(const float* gain, float* out, unsigned char* ws, int G) {
    int tid = threadIdx.x; asm volatile("" : "+v"(tid)); const int lane = tid & 63, wid = __builtin_amdgcn_readfirstlane(tid >> 6);
    const float* H = (const float*)(ws + WS_H);
    f32x4 gv[16];
#pragma unroll
    for (int j = 0; j < 16; ++j) gv[j] = ((const f32x4*)gain)[lane + 64 * j];
    const int r0 = blockIdx.x * NWAVES + wid, RS = G * NWAVES;
    if (r0 >= MX) return;
#define PF_LOAD(v, R) do { const f32x4* src_ = (const f32x4*)(H + (size_t)(R) * D) + lane; _Pragma("unroll") for (int j = 0; j < 16; ++j) v[j] = src_[64 * j]; } while (0)
#define PF_ROW(v, R) do { float s_ = 0.f; _Pragma("unroll") for (int j = 0; j < 16; ++j) s_ += (v[j][0] * v[j][0] + v[j][1] * v[j][1]) + (v[j][2] * v[j][2] + v[j][3] * v[j][3]); \
        s_ = sum64(s_); const float inv_ = rsqrtf(s_ * (1.0f / D) + NORM_EPS); f32x4* dst_ = (f32x4*)(out + (size_t)(R) * D) + lane; \
        _Pragma("unroll") for (int j = 0; j < 16; ++j) dst_[64 * j] = v[j] * inv_ * gv[j]; } while (0)
    f32x4 va[16], vb[16];
    PF_LOAD(va, r0);
#pragma unroll 1
    for (int r = r0; r < MX; r += 2 * RS) {
        const int r1 = r + RS, r2 = r + 2 * RS;
        PF_LOAD(vb, r1 < MX ? r1 : r);
        __builtin_amdgcn_sched_barrier(0);
        PF_ROW(va, r);
        __builtin_amdgcn_sched_barrier(0);
        PF_LOAD(va, r2 < MX ? r2 : r);
        __builtin_amdgcn_sched_barrier(0);
        if (r1 < MX) PF_ROW(vb, r1);
        __builtin_amdgcn_sched_barrier(0);
    }
#undef PF_LOAD
#undef PF_ROW
}

constexpr int NS32 = 32;
__device__ __forceinline__ int lane_get(int va, int vb, int p_hi, int addr_lo) {
    int addr = ((8 * p_hi) & 63) * 4 + addr_lo; asm volatile("" : "+v"(addr)); return __builtin_amdgcn_ds_bpermute(addr, p_hi < 8 ? va : vb); }

__device__ __forceinline__ void phase_udot32(unsigned char* ws, int layer, int G) {
    int tid = threadIdx.x; asm volatile("" : "+v"(tid)); const int lane = tid & 63, wid = __builtin_amdgcn_readfirstlane(tid >> 6);
    const int x = blockIdx.x & 7, g = (blockIdx.x >> 3) * NWAVES + wid, NG = (G >> 3) * NWAVES, r8 = lane >> 3, c8 = lane & 7, r84 = r8 * 4;
    const int* EIDL = (const int*)(ws + WS_EIDL); const bf16_t* HB = (const bf16_t*)(ws + WS_HB); float* DOTP = (float*)(ws + WS_DOTP);
    const unsigned char* tbl = ws + WS_PU + (size_t)layer * NEXP * D + 16 * c8;
    const int taddr = (8 * (lane & 7) + (lane >> 3)) * 4;
#pragma unroll 1
    for (int sp = 0; sp < NS32 / 8; ++sp) {
        const int slice = x + 8 * sp;
        const unsigned char* ubase = tbl + 128 * slice;
        int ea = 0, eb = 0; u32x4 h0 = {0u, 0u, 0u, 0u}, h1 = h0;
        if (g < MROWS) { ea = EIDL[(size_t)g * 128 + lane]; eb = EIDL[(size_t)g * 128 + 64 + lane]; const u32x4* hp8 = (const u32x4*)(HB + (size_t)g * D + 128 * slice + 16 * c8); h0 = hp8[0]; h1 = hp8[1]; }
#pragma unroll 1
        for (int tok = g; tok < MROWS; tok += NG) {
            unsigned eo[16];
#pragma unroll
            for (int i = 0; i < 16; ++i) eo[i] = (unsigned)lane_get(ea, eb, i, r84);
            __builtin_amdgcn_sched_barrier(0);
            u32x4 rb[16];
#pragma unroll
            for (int i = 0; i < 16; ++i) rb[i] = *(const u32x4*)(ubase + eo[i]);
            const unsigned hq[8] = {h0.x, h0.y, h0.z, h0.w, h1.x, h1.y, h1.z, h1.w};
            const int nt = tok + NG;
            if (nt < MROWS) { ea = EIDL[(size_t)nt * 128 + lane]; eb = EIDL[(size_t)nt * 128 + 64 + lane]; const u32x4* hp8 = (const u32x4*)(HB + (size_t)nt * D + 128 * slice + 16 * c8); h0 = hp8[0]; h1 = hp8[1]; }
            __builtin_amdgcn_sched_barrier(0);
            float v0 = 0.f, v1 = 0.f;
#pragma unroll
            for (int hh = 0; hh < 2; ++hh) {
                float d0 = dot16_fp8_bf16(rb[8 * hh + 0], hq), d1 = dot16_fp8_bf16(rb[8 * hh + 1], hq), d2 = dot16_fp8_bf16(rb[8 * hh + 2], hq), d3 = dot16_fp8_bf16(rb[8 * hh + 3], hq),
                      d4 = dot16_fp8_bf16(rb[8 * hh + 4], hq), d5 = dot16_fp8_bf16(rb[8 * hh + 5], hq), d6 = dot16_fp8_bf16(rb[8 * hh + 6], hq), d7 = dot16_fp8_bf16(rb[8 * hh + 7], hq);
                asm volatile("s_nop 1\n\t" PEER_DPP8("quad_perm:[1,0,3,2] row_mask:0xf bank_mask:0xf bound_ctrl:1") PEER_DPP8("quad_perm:[2,3,0,1] row_mask:0xf bank_mask:0xf bound_ctrl:1")
                             PEER_DPP8("row_half_mirror row_mask:0xf bank_mask:0xf bound_ctrl:1") : "+v"(d0), "+v"(d1), "+v"(d2), "+v"(d3), "+v"(d4), "+v"(d5), "+v"(d6), "+v"(d7));
                float v = d0; v = c8 == 1 ? d1 : v; v = c8 == 2 ? d2 : v; v = c8 == 3 ? d3 : v; v = c8 == 4 ? d4 : v; v = c8 == 5 ? d5 : v; v = c8 == 6 ? d6 : v; v = c8 == 7 ? d7 : v;
                if (hh == 0) v0 = v; else v1 = v;
            }
            float* dp = DOTP + ((size_t)tok * NS32 + slice) * 128;
            dp[lane] = __int_as_float(__builtin_amdgcn_ds_bpermute(taddr, __float_as_int(v0))); dp[64 + lane] = __int_as_float(__builtin_amdgcn_ds_bpermute(taddr, __float_as_int(v1)));
        }
    }
}

template <int NSL>
__device__ __forceinline__ void phase_pw(unsigned char* ws, int layer, int G) {
    int tid = threadIdx.x; asm volatile("" : "+v"(tid)); const int lane = tid & 63, wid = __builtin_amdgcn_readfirstlane(tid >> 6);
    const int* EIDL = (const int*)(ws + WS_EIDL); const float* GATEL = (const float*)(ws + WS_GATEL); const float* DOTP = (const float*)(ws + WS_DOTP); float* WL = (float*)(ws + WS_WL);
    const float* SU = (const float*)(ws + WS_SU) + layer * NEXP; const float* SV = (const float*)(ws + WS_SV) + layer * NEXP; const float* HS = (const float*)(ws + WS_HS);
    for (int it0 = blockIdx.x * NWAVES + wid; it0 < MROWS * 2; it0 += 2 * G * NWAVES) {
        const int it1 = it0 + G * NWAVES; const bool v1 = it1 < MROWS * 2; const int it1c = v1 ? it1 : it0;
        const size_t o0 = (size_t)(it0 >> 1) * 128 + (it0 & 1) * 64 + lane, o1 = (size_t)(it1c >> 1) * 128 + (it1c & 1) * 64 + lane;
        const float* dq0 = DOTP + (size_t)(it0 >> 1) * NSL * 128 + (it0 & 1) * 64 + lane; const float* dq1 = DOTP + (size_t)(it1c >> 1) * NSL * 128 + (it1c & 1) * 64 + lane;
        float ds0[NSL], ds1[NSL];
#pragma unroll
        for (int s = 0; s < NSL; ++s) { ds0[s] = dq0[s * 128]; ds1[s] = dq1[s * 128]; }
        const int e0 = EIDL[o0] >> 12, e1 = EIDL[o1] >> 12; const float g0 = GATEL[o0], g1 = GATEL[o1];
        const float su0 = SU[e0], sv0 = SV[e0], su1 = SU[e1], sv1 = SV[e1];
        float d0 = 0.f, d1 = 0.f;
#pragma unroll
        for (int s = 0; s < NSL; ++s) { d0 += ds0[s]; d1 += ds1[s]; }
        { const _Float16 h0 = (_Float16)(g0 * gelu_erf(d0 * su0) * sv0), h1 = (_Float16)(g1 * gelu_erf(d1 * su1) * sv1);
          const unsigned p0 = ((unsigned)e0 << 16) | (unsigned)__builtin_bit_cast(unsigned short, h0), p1 = ((unsigned)e1 << 16) | (unsigned)__builtin_bit_cast(unsigned short, h1);
          unsigned* WLT = (unsigned*)(ws + WS_HB8);
          ((unsigned*)WL)[o0] = p0; WLT[(size_t)((it0 & 1) * 64 + lane) * MROWS + (it0 >> 1)] = p0;
          if (v1) { ((unsigned*)WL)[o1] = p1; WLT[(size_t)((it1 & 1) * 64 + lane) * MROWS + (it1 >> 1)] = p1; } }
    }
}

template <bool DRY = false>
__device__ __forceinline__ void phase_vacc32(unsigned char* ws, int layer, int G) {
    int tid = threadIdx.x; asm volatile("" : "+v"(tid)); const int lane = tid & 63, wid = __builtin_amdgcn_readfirstlane(tid >> 6);
    const int x = blockIdx.x & 7, g = (blockIdx.x >> 3) * NWAVES + wid, NG = (G >> 3) * NWAVES, r8 = lane >> 3, c8 = lane & 7, r84 = r8 * 4;
    const int* EIDL = (const int*)(ws + WS_EIDL); const float* WL = (const float*)(ws + WS_WL); float* H = (float*)(ws + (DRY ? WS_WAG : WS_H));
    const unsigned char* tbl = ws + WS_PV + (size_t)layer * NEXP * D + 16 * c8;
    const int h5 = lane >> 5, h4 = (lane >> 4) & 1, h3 = (lane >> 3) & 1, xaddr = (lane ^ 8) << 2;
    {
        constexpr int NIT = (NS32 / 8) * MROWS;
        int ea = 0, eb = 0; float wa = 0.f, wb = 0.f;
        if (g < NIT) { ea = EIDL[(size_t)g * 128 + lane]; eb = EIDL[(size_t)g * 128 + 64 + lane]; wa = WL[(size_t)g * 128 + lane]; wb = WL[(size_t)g * 128 + 64 + lane]; }
#pragma unroll 1
        for (int item = g; item < NIT; item += NG) {
            const int sp = item / MROWS, tok = item - sp * MROWS, slice = x + 8 * sp;
            const unsigned char* vbase = tbl + 128 * slice;
            u32x4 rb[16]; float wv_[16];
            unsigned eo[16];
#pragma unroll
            for (int i = 0; i < 16; ++i) eo[i] = (unsigned)lane_get(ea, eb, i, r84);
            __builtin_amdgcn_sched_barrier(0);
#pragma unroll
            for (int i = 0; i < 16; ++i) rb[i] = *(const u32x4*)(vbase + eo[i]);
            __builtin_amdgcn_sched_barrier(0);
#pragma unroll
            for (int i = 0; i < 16; ++i) wv_[i] = __int_as_float(lane_get(__float_as_int(wa), __float_as_int(wb), i, r84));
            const int ni = item + NG;
            if (ni < NIT) { const int nt = ni - (ni / MROWS) * MROWS; ea = EIDL[(size_t)nt * 128 + lane]; eb = EIDL[(size_t)nt * 128 + 64 + lane]; wa = WL[(size_t)nt * 128 + lane]; wb = WL[(size_t)nt * 128 + 64 + lane]; }
            __builtin_amdgcn_sched_barrier(0);
            float acc[16];
#pragma unroll
            for (int j = 0; j < 16; ++j) acc[j] = 0.f;
#pragma unroll
            for (int i = 0; i < 16; ++i) { const float w = wv_[i]; const unsigned wv[4] = {rb[i].x, rb[i].y, rb[i].z, rb[i].w};
#pragma unroll
                for (int q = 0; q < 4; ++q) { const f32x2 lo = __builtin_amdgcn_cvt_pk_f32_fp8((int)wv[q], false), hi = __builtin_amdgcn_cvt_pk_f32_fp8((int)wv[q], true);
                    acc[4 * q + 0] = fmaf(w, lo.x, acc[4 * q + 0]); acc[4 * q + 1] = fmaf(w, lo.y, acc[4 * q + 1]); acc[4 * q + 2] = fmaf(w, hi.x, acc[4 * q + 2]); acc[4 * q + 3] = fmaf(w, hi.y, acc[4 * q + 3]); } }
            float o8[8], o4[4], o2[2];
#pragma unroll
            for (int j = 0; j < 8; ++j) { const auto sw = __builtin_amdgcn_permlane32_swap(__float_as_uint(acc[j]), __float_as_uint(acc[8 + j]), false, false); const unsigned s0 = sw[0], s1 = sw[1]; o8[j] = __uint_as_float(s0) + __uint_as_float(s1); }
#pragma unroll
            for (int j = 0; j < 4; ++j) { const auto sw = __builtin_amdgcn_permlane16_swap(__float_as_uint(o8[j]), __float_as_uint(o8[4 + j]), false, false); const unsigned s0 = sw[0], s1 = sw[1]; o4[j] = __uint_as_float(s0) + __uint_as_float(s1); }
#pragma unroll
            for (int j = 0; j < 2; ++j) { const float keep = h3 ? o4[2 + j] : o4[j], give = h3 ? o4[j] : o4[2 + j]; o2[j] = keep + __int_as_float(__builtin_amdgcn_ds_bpermute(xaddr, __float_as_int(give))); }
            f32x2* hp = (f32x2*)(H + (size_t)tok * D + 128 * slice + 16 * c8 + 2 * r8);
            f32x2 hv = *hp; hv[0] += o2[0]; hv[1] += o2[1]; *hp = hv;
        }
    }
    (void)h5; (void)h4;
}

typedef _Float16 h16x2 __attribute__((ext_vector_type(2)));
template <bool DRY = false>
__device__ __forceinline__ void phase_vacc32d(unsigned char* ws, int layer, int G) {
    int tid = threadIdx.x; asm volatile("" : "+v"(tid)); const int lane = tid & 63, wid = __builtin_amdgcn_readfirstlane(tid >> 6);
    const int x = blockIdx.x & 7, g = (blockIdx.x >> 3) * NWAVES + wid, NG = (G >> 3) * NWAVES, r8 = lane >> 3, c8 = lane & 7, r84 = r8 * 4;
    const unsigned* WLP = (const unsigned*)(ws + WS_WL);
    float* H = (float*)(ws + (DRY ? WS_WAG : WS_H));
    const unsigned char* tbl = ws + WS_PV + (size_t)layer * NEXP * D + 16 * c8;
    const int h3 = (lane >> 3) & 1, xaddr = (lane ^ 8) << 2;
    constexpr int NIT = (NS32 / 8) * MROWS;
#define VD_IDS(pw, IT) do { const int t_ = (IT) - ((IT) / MROWS) * MROWS; const unsigned* wp_ = WLP + (size_t)t_ * 128 + r8 * 16 + (lane & 3); \
        pw[0] = wp_[0]; pw[1] = wp_[4]; pw[2] = wp_[8]; pw[3] = wp_[12]; } while (0)
#define VD_ISSUE(rb, pk, hv, hp, pw, IT) do { const int sp_ = (IT) / MROWS, t_ = (IT) - sp_ * MROWS, sl_ = x + 8 * sp_; const unsigned char* vb_ = tbl + 128 * sl_; \
        _Pragma("unroll") for (int k = 0; k < 4; ++k) { pk[4 * k + 0] = dppu<0x00>(pw[k]); pk[4 * k + 1] = dppu<0x55>(pw[k]); pk[4 * k + 2] = dppu<0xAA>(pw[k]); pk[4 * k + 3] = dppu<0xFF>(pw[k]); }     \
        _Pragma("unroll") for (int i = 0; i < 16; ++i) rb[i] = *(const u32x4*)(vb_ + ((pk[i] >> 16) << 12)); \
        hp = (f32x2*)(H + (size_t)t_ * D + 128 * sl_ + 16 * c8 + 2 * r8); hv = *hp; } while (0)
#define VD_COMP(rb, wv, hv, hp, VALID) do { h16x2 ah[8]; \
        _Pragma("unroll") for (int j = 0; j < 8; ++j) ah[j] = (h16x2){(_Float16)0.f, (_Float16)0.f}; \
        _Pragma("unroll") for (int i = 0; i < 16; ++i) { const h16x2 w2 = __builtin_bit_cast(h16x2, __builtin_amdgcn_perm(wv[i], wv[i], 0x01000100u)); const unsigned q_[4] = {rb[i].x, rb[i].y, rb[i].z, rb[i].w}; \
            _Pragma("unroll") for (int q = 0; q < 4; ++q) { const h16x2 lo = __builtin_bit_cast(h16x2, __builtin_amdgcn_perm(0u, q_[q], 0x010c000cu)), hi = __builtin_bit_cast(h16x2, __builtin_amdgcn_perm(0u, q_[q], 0x030c020cu)); \
                ah[2 * q + 0] = w2 * lo + ah[2 * q + 0]; ah[2 * q + 1] = w2 * hi + ah[2 * q + 1]; } } \
        float acc[16]; \
        _Pragma("unroll") for (int j = 0; j < 8; ++j) { const h16x2 t_ = ah[j]; const _Float16 t0 = t_[0], t1 = t_[1]; acc[2 * j] = (float)t0; acc[2 * j + 1] = (float)t1; } \
        float o8[8], o4[4], o2[2]; \
        _Pragma("unroll") for (int j = 0; j < 8; ++j) { const auto sw = __builtin_amdgcn_permlane32_swap(__float_as_uint(acc[j]), __float_as_uint(acc[8 + j]), false, false); const unsigned s0 = sw[0], s1 = sw[1]; o8[j] = __uint_as_float(s0) + __uint_as_float(s1); } \
        _Pragma("unroll") for (int j = 0; j < 4; ++j) { const auto sw = __builtin_amdgcn_permlane16_swap(__float_as_uint(o8[j]), __float_as_uint(o8[4 + j]), false, false); const unsigned s0 = sw[0], s1 = sw[1]; o4[j] = __uint_as_float(s0) + __uint_as_float(s1); } \
        _Pragma("unroll") for (int j = 0; j < 2; ++j) { const float keep = h3 ? o4[2 + j] : o4[j], give = h3 ? o4[j] : o4[2 + j]; o2[j] = keep + __int_as_float(__builtin_amdgcn_ds_bpermute(xaddr, __float_as_int(give))); } \
        f32x2 hn_ = hv; hn_[0] += o2[0]; hn_[1] += o2[1]; if (VALID) *hp = hn_; } while (0)
    if (g >= NIT) return;
    u32x4 ra[16], rc[16]; unsigned pka[16], pkc[16]; f32x2 hva, hvc; f32x2* hpa; f32x2* hpc;
    unsigned pw0[4], pw1[4];
    VD_IDS(pw0, g);
    { const int i1c = g + NG < NIT ? g + NG : g; VD_IDS(pw1, i1c); }
    VD_ISSUE(ra, pka, hva, hpa, pw0, g);
#pragma unroll 1
    for (int item = g; item < NIT; item += 2 * NG) {
        const int i1 = item + NG, i2 = item + 2 * NG, i3 = item + 3 * NG;
        const bool v1 = i1 < NIT;
        const int i1c = v1 ? i1 : item, i2c = i2 < NIT ? i2 : item, i3c = i3 < NIT ? i3 : item;
        VD_IDS(pw0, i2c);
        __builtin_amdgcn_sched_barrier(0);
        VD_ISSUE(rc, pkc, hvc, hpc, pw1, i1c);
        __builtin_amdgcn_sched_barrier(0);
        VD_COMP(ra, pka, hva, hpa, true);
        __builtin_amdgcn_sched_barrier(0);
        VD_IDS(pw1, i3c);
        __builtin_amdgcn_sched_barrier(0);
        VD_ISSUE(ra, pka, hva, hpa, pw0, i2c);
        __builtin_amdgcn_sched_barrier(0);
        VD_COMP(rc, pkc, hvc, hpc, v1);
        __builtin_amdgcn_sched_barrier(0);
    }
#undef VD_IDS
#undef VD_ISSUE
#undef VD_COMP
}

template <bool DRY = false>
__device__ __forceinline__ void phase_vaccL(unsigned char* ws, LAS unsigned char* lds, int layer, int G) {
    int tid = threadIdx.x; asm volatile("" : "+v"(tid)); const int lane = tid & 63, wid = __builtin_amdgcn_readfirstlane(tid >> 6);
    const unsigned* WLT = (const unsigned*)(ws + WS_WL); float* H = (float*)(ws + (DRY ? WS_WAG : WS_H));
    const unsigned char* pvt = ws + WS_PV + (size_t)layer * NEXP * D;
    constexpr int NTB = (MROWS + 63) / 64;
#define VL_LOAD(wr, C) do { _Pragma("unroll") for (int i = 0; i < 16; ++i) wr[i] = wp[(size_t)((C) * 16 + i) * MROWS]; } while (0)
#define VL_CHUNK(wr) do { u32x2 v_[16]; \
        _Pragma("unroll") for (int i = 0; i < 16; ++i) v_[i] = *(const LAS u32x2*)(lds + ((wr[i] >> 16) << 3)); \
        h16x2 a0 = {(_Float16)0.f, (_Float16)0.f}, a1 = a0, a2 = a0, a3 = a0; \
        _Pragma("unroll") for (int i = 0; i < 16; ++i) { const h16x2 w2 = __builtin_bit_cast(h16x2, __builtin_amdgcn_perm(wr[i], wr[i], 0x01000100u)); \
            a0 = w2 * __builtin_bit_cast(h16x2, __builtin_amdgcn_perm(0u, v_[i].x, 0x010c000cu)) + a0; a1 = w2 * __builtin_bit_cast(h16x2, __builtin_amdgcn_perm(0u, v_[i].x, 0x030c020cu)) + a1; \
            a2 = w2 * __builtin_bit_cast(h16x2, __builtin_amdgcn_perm(0u, v_[i].y, 0x010c000cu)) + a2; a3 = w2 * __builtin_bit_cast(h16x2, __builtin_amdgcn_perm(0u, v_[i].y, 0x030c020cu)) + a3; } \
        { const _Float16 t0 = a0[0], t1 = a0[1], t2 = a1[0], t3 = a1[1], t4 = a2[0], t5 = a2[1], t6 = a3[0], t7 = a3[1]; \
          accf[0] += (float)t0; accf[1] += (float)t1; accf[2] += (float)t2; accf[3] += (float)t3; accf[4] += (float)t4; accf[5] += (float)t5; accf[6] += (float)t6; accf[7] += (float)t7; } } while (0)
    for (int cg = blockIdx.x; cg < D / 8; cg += G) {
        __syncthreads();
        { const u32x4* src = (const u32x4*)(pvt + (size_t)cg * (NEXP * 8)) + tid; u32x4 t_[16];
#pragma unroll
          for (int i = 0; i < 16; ++i) t_[i] = src[512 * i];
#pragma unroll
          for (int i = 0; i < 16; ++i) ((LAS u32x4*)lds)[tid + 512 * i] = t_[i]; }
        __syncthreads();
#pragma unroll 1
        for (int tb = wid; tb < NTB; tb += NWAVES) {
            const int tok = tb * 64 + lane; const bool valid = tok < MROWS; const int tokc = valid ? tok : MROWS - 1;
            const unsigned* wp = WLT + tokc;
            f32x4* hp = (f32x4*)(H + (size_t)tokc * D + cg * 8); const f32x4 h0 = hp[0], h1 = hp[1];
            float accf[8];
#pragma unroll
            for (int j = 0; j < 8; ++j) accf[j] = 0.f;
            unsigned wa[16], wb[16];
            VL_LOAD(wa, 0);
#pragma unroll 1
            for (int c = 0; c < 8; c += 2) {
                VL_LOAD(wb, c + 1);
                __builtin_amdgcn_sched_barrier(0);
                VL_CHUNK(wa);
                __builtin_amdgcn_sched_barrier(0);
                VL_LOAD(wa, (c + 2) & 7);
                __builtin_amdgcn_sched_barrier(0);
                VL_CHUNK(wb);
                __builtin_amdgcn_sched_barrier(0);
            }
            if (valid) { hp[0] = h0 + (f32x4){accf[0], accf[1], accf[2], accf[3]}; hp[1] = h1 + (f32x4){accf[4], accf[5], accf[6], accf[7]}; }
        }
    }
#undef VL_LOAD
#undef VL_CHUNK
}

template <bool RUN_L = true, bool RUN_G = true, bool DRY = false>
__device__ __forceinline__ void phase_vaccH(unsigned char* ws, LAS unsigned char* lds, int layer, int G) {
    int tid = threadIdx.x; asm volatile("" : "+v"(tid)); const int lane = tid & 63, wid = __builtin_amdgcn_readfirstlane(tid >> 6);
    float* H = (float*)(ws + (DRY ? WS_WAG : WS_H));
    const unsigned char* pvl = ws + WS_PV + (size_t)layer * NEXP * D;
    const unsigned char* pvg = pvl + (size_t)NEXP * 2048;
    constexpr int NTB = (MROWS + 63) / 64, NGRP = 2048 / 8;
    bool first = true;
    for (int cg = blockIdx.x; cg < NGRP; cg += G) {
        __syncthreads();
        { const u32x4* src = (const u32x4*)(pvl + (size_t)cg * (NEXP * 8)) + tid; u32x4 t_[16];
#pragma unroll
          for (int i = 0; i < 16; ++i) t_[i] = src[512 * i];
#pragma unroll
          for (int i = 0; i < 16; ++i) ((LAS u32x4*)lds)[tid + 512 * i] = t_[i]; }
        __syncthreads();
        if (wid < 4) { if (RUN_L) {
            const unsigned* WLT = (const unsigned*)(ws + WS_HB8);
#define VL_LOAD(wr, C) do { _Pragma("unroll") for (int i = 0; i < 16; ++i) wr[i] = wp[(size_t)((C) * 16 + i) * MROWS]; } while (0)
#define VL_CHUNK(wr) do { u32x2 v_[16]; \
        _Pragma("unroll") for (int i = 0; i < 16; ++i) v_[i] = *(const LAS u32x2*)(lds + ((wr[i] >> 16) << 3)); \
        h16x2 a0 = {(_Float16)0.f, (_Float16)0.f}, a1 = a0, a2 = a0, a3 = a0; \
        _Pragma("unroll") for (int i = 0; i < 16; ++i) { const h16x2 w2 = __builtin_bit_cast(h16x2, __builtin_amdgcn_perm(wr[i], wr[i], 0x01000100u)); \
            a0 = w2 * __builtin_bit_cast(h16x2, __builtin_amdgcn_perm(0u, v_[i].x, 0x010c000cu)) + a0; a1 = w2 * __builtin_bit_cast(h16x2, __builtin_amdgcn_perm(0u, v_[i].x, 0x030c020cu)) + a1; \
            a2 = w2 * __builtin_bit_cast(h16x2, __builtin_amdgcn_perm(0u, v_[i].y, 0x010c000cu)) + a2; a3 = w2 * __builtin_bit_cast(h16x2, __builtin_amdgcn_perm(0u, v_[i].y, 0x030c020cu)) + a3; } \
        { const _Float16 t0 = a0[0], t1 = a0[1], t2 = a1[0], t3 = a1[1], t4 = a2[0], t5 = a2[1], t6 = a3[0], t7 = a3[1]; \
          accf[0] += (float)t0; accf[1] += (float)t1; accf[2] += (float)t2; accf[3] += (float)t3; accf[4] += (float)t4; accf[5] += (float)t5; accf[6] += (float)t6; accf[7] += (float)t7; } } while (0)
#pragma unroll 1
            for (int tb = wid; tb < NTB; tb += 4) {
                const int tok = tb * 64 + lane; const bool valid = tok < MROWS; const int tokc = valid ? tok : MROWS - 1;
                const unsigned* wp = WLT + tokc;
                f32x4* hp = (f32x4*)(H + (size_t)tokc * D + cg * 8); const f32x4 h0 = hp[0], h1 = hp[1];
                float accf[8];
#pragma unroll
                for (int j = 0; j < 8; ++j) accf[j] = 0.f;
                unsigned wa[16], wb[16];
                VL_LOAD(wa, 0);
#pragma unroll 1
                for (int c = 0; c < 8; c += 2) {
                    VL_LOAD(wb, c + 1);
                    __builtin_amdgcn_sched_barrier(0);
                    VL_CHUNK(wa);
                    __builtin_amdgcn_sched_barrier(0);
                    VL_LOAD(wa, (c + 2) & 7);
                    __builtin_amdgcn_sched_barrier(0);
                    VL_CHUNK(wb);
                    __builtin_amdgcn_sched_barrier(0);
                }
                if (valid) { hp[0] = h0 + (f32x4){accf[0], accf[1], accf[2], accf[3]}; hp[1] = h1 + (f32x4){accf[4], accf[5], accf[6], accf[7]}; }
            }
#undef VL_LOAD
#undef VL_CHUNK
        } } else if (first && RUN_G) {
            const int x = blockIdx.x & 7, g = (blockIdx.x >> 3) * 4 + (wid - 4), NG = (G >> 3) * 4, r8 = lane >> 3, c8 = lane & 7;
            const unsigned* WLP = (const unsigned*)(ws + WS_WL);
            const unsigned char* tbl = pvg + 16 * c8;
            const int h3 = (lane >> 3) & 1, xaddr = (lane ^ 8) << 2;
            constexpr int NIT = 2 * MROWS;
#define VD_IDS(pw, IT) do { const int t_ = (IT) - ((IT) / MROWS) * MROWS; const unsigned* wp_ = WLP + (size_t)t_ * 128 + r8 * 16 + (lane & 3); \
        pw[0] = wp_[0]; pw[1] = wp_[4]; pw[2] = wp_[8]; pw[3] = wp_[12]; } while (0)
#define VD_ISSUE(rb, pk, hv, hp, pw, IT) do { const int sp_ = (IT) / MROWS, t_ = (IT) - sp_ * MROWS, sl_ = x + 8 * sp_; const unsigned char* vb_ = tbl + 128 * sl_; \
        _Pragma("unroll") for (int k = 0; k < 4; ++k) { pk[4 * k + 0] = dppu<0x00>(pw[k]); pk[4 * k + 1] = dppu<0x55>(pw[k]); pk[4 * k + 2] = dppu<0xAA>(pw[k]); pk[4 * k + 3] = dppu<0xFF>(pw[k]); } \
        _Pragma("unroll") for (int i = 0; i < 16; ++i) rb[i] = *(const u32x4*)(vb_ + ((pk[i] >> 16) << 11)); \
        hp = (f32x2*)(H + (size_t)t_ * D + 2048 + 128 * sl_ + 16 * c8 + 2 * r8); hv = *hp; } while (0)
#define VD_COMP(rb, wv, hv, hp, VALID) do { h16x2 ah[8]; \
        _Pragma("unroll") for (int j = 0; j < 8; ++j) ah[j] = (h16x2){(_Float16)0.f, (_Float16)0.f}; \
        _Pragma("unroll") for (int i = 0; i < 16; ++i) { const h16x2 w2 = __builtin_bit_cast(h16x2, __builtin_amdgcn_perm(wv[i], wv[i], 0x01000100u)); const unsigned q_[4] = {rb[i].x, rb[i].y, rb[i].z, rb[i].w}; \
            _Pragma("unroll") for (int q = 0; q < 4; ++q) { const h16x2 lo = __builtin_bit_cast(h16x2, __builtin_amdgcn_perm(0u, q_[q], 0x010c000cu)), hi = __builtin_bit_cast(h16x2, __builtin_amdgcn_perm(0u, q_[q], 0x030c020cu)); \
                ah[2 * q + 0] = w2 * lo + ah[2 * q + 0]; ah[2 * q + 1] = w2 * hi + ah[2 * q + 1]; } } \
        float acc[16]; \
        _Pragma("unroll") for (int j = 0; j < 8; ++j) { const h16x2 t_ = ah[j]; const _Float16 t0 = t_[0], t1 = t_[1]; acc[2 * j] = (float)t0; acc[2 * j + 1] = (float)t1; } \
        float o8[8], o4[4], o2[2]; \
        _Pragma("unroll") for (int j = 0; j < 8; ++j) { const auto sw = __builtin_amdgcn_permlane32_swap(__float_as_uint(acc[j]), __float_as_uint(acc[8 + j]), false, false); const unsigned s0 = sw[0], s1 = sw[1]; o8[j] = __uint_as_float(s0) + __uint_as_float(s1); } \
        _Pragma("unroll") for (int j = 0; j < 4; ++j) { const auto sw = __builtin_amdgcn_permlane16_swap(__float_as_uint(o8[j]), __float_as_uint(o8[4 + j]), false, false); const unsigned s0 = sw[0], s1 = sw[1]; o4[j] = __uint_as_float(s0) + __uint_as_float(s1); } \
        _Pragma("unroll") for (int j = 0; j < 2; ++j) { const float keep = h3 ? o4[2 + j] : o4[j], give = h3 ? o4[j] : o4[2 + j]; o2[j] = keep + __int_as_float(__builtin_amdgcn_ds_bpermute(xaddr, __float_as_int(give))); } \
        f32x2 hn_ = hv; hn_[0] += o2[0]; hn_[1] += o2[1]; if (VALID) *hp = hn_; } while (0)
            if (g < NIT) {
                u32x4 ra[16], rc[16]; unsigned pka[16], pkc[16]; f32x2 hva, hvc; f32x2* hpa; f32x2* hpc;
                unsigned pw0[4], pw1[4];
                VD_IDS(pw0, g);
                { const int i1c = g + NG < NIT ? g + NG : g; VD_IDS(pw1, i1c); }
                VD_ISSUE(ra, pka, hva, hpa, pw0, g);
#pragma unroll 1
                for (int item = g; item < NIT; item += 2 * NG) {
                    const int i1 = item + NG, i2 = item + 2 * NG, i3 = item + 3 * NG;
                    const bool v1 = i1 < NIT;
                    const int i1c = v1 ? i1 : item, i2c = i2 < NIT ? i2 : item, i3c = i3 < NIT ? i3 : item;
                    VD_IDS(pw0, i2c);
                    __builtin_amdgcn_sched_barrier(0);
                    VD_ISSUE(rc, pkc, hvc, hpc, pw1, i1c);
                    __builtin_amdgcn_sched_barrier(0);
                    VD_COMP(ra, pka, hva, hpa, true);
                    __builtin_amdgcn_sched_barrier(0);
                    VD_IDS(pw1, i3c);
                    __builtin_amdgcn_sched_barrier(0);
                    VD_ISSUE(ra, pka, hva, hpa, pw0, i2c);
                    __builtin_amdgcn_sched_barrier(0);
                    VD_COMP(rc, pkc, hvc, hpc, v1);
                    __builtin_amdgcn_sched_barrier(0);
                }
            }
#undef VD_IDS
#undef VD_ISSUE
#undef VD_COMP
        }
        first = false;
    }
}

__device__ __forceinline__ void phase_udot32m(unsigned char* ws, int layer, int G) {
    int tid = threadIdx.x; asm volatile("" : "+v"(tid)); const int lane = tid & 63, wid = __builtin_amdgcn_readfirstlane(tid >> 6);
    const int x = blockIdx.x & 7, g = (blockIdx.x >> 3) * NWAVES + wid, NG = (G >> 3) * NWAVES, fr = lane & 15, fq = lane >> 4;
    const int* EIDL = (const int*)(ws + WS_EIDL); float* DOTP = (float*)(ws + WS_DOTP);
    const unsigned char* tbl = ws + WS_PU + (size_t)layer * NEXP * D + 16 * fq;
    const unsigned char* hb8 = ws + WS_HB8 + 16 * fq;
    typedef long i64x2 __attribute__((ext_vector_type(2)));
#pragma unroll 1
    for (int sp = 0; sp < NS32 / 8; ++sp) {
        const int slice = x + 8 * sp;
        const unsigned char* ubase = tbl + 128 * slice;
        int eo[8]; i64x2 hb0 = {0, 0}, hb1 = {0, 0};
#pragma unroll
        for (int b = 0; b < 8; ++b) eo[b] = 0;
        if (g < MROWS) {
#pragma unroll
            for (int b = 0; b < 8; ++b) eo[b] = EIDL[(size_t)g * 128 + 16 * b + fr];
            hb0 = *(const i64x2*)(hb8 + (size_t)g * D + 128 * slice); hb1 = *(const i64x2*)(hb8 + (size_t)g * D + 128 * slice + 64); }
#pragma unroll 1
        for (int tok = g; tok < MROWS; tok += NG) {
            i64x2 r0[8], r1[8];
#pragma unroll
            for (int b = 0; b < 8; ++b) { const unsigned char* rp = ubase + (unsigned)eo[b]; r0[b] = *(const i64x2*)rp; r1[b] = *(const i64x2*)(rp + 64); }
            const i64x2 c0 = hb0, c1 = hb1;
            const int nt = tok + NG;
            if (nt < MROWS) {
#pragma unroll
                for (int b = 0; b < 8; ++b) eo[b] = EIDL[(size_t)nt * 128 + 16 * b + fr];
                hb0 = *(const i64x2*)(hb8 + (size_t)nt * D + 128 * slice); hb1 = *(const i64x2*)(hb8 + (size_t)nt * D + 128 * slice + 64); }
            __builtin_amdgcn_sched_barrier(0);
            float* dp = DOTP + ((size_t)tok * NS32 + slice) * 128 + 4 * fq;
#pragma unroll
            for (int b = 0; b < 8; ++b) { f32x4 acc = (f32x4){0.f, 0.f, 0.f, 0.f};
                acc = __builtin_amdgcn_mfma_f32_16x16x32_fp8_fp8(r0[b][0], c0[0], acc, 0, 0, 0); acc = __builtin_amdgcn_mfma_f32_16x16x32_fp8_fp8(r0[b][1], c0[1], acc, 0, 0, 0);
                acc = __builtin_amdgcn_mfma_f32_16x16x32_fp8_fp8(r1[b][0], c1[0], acc, 0, 0, 0); acc = __builtin_amdgcn_mfma_f32_16x16x32_fp8_fp8(r1[b][1], c1[1], acc, 0, 0, 0);
                if (fr == 0) *(f32x4*)(dp + 16 * b) = acc; }
        }
    }
}

__device__ __forceinline__ void phase_udot32p(unsigned char* ws, int layer, int G) {
    int tid = threadIdx.x; asm volatile("" : "+v"(tid)); const int lane = tid & 63, wid = __builtin_amdgcn_readfirstlane(tid >> 6);
    const int x = blockIdx.x & 7, g = (blockIdx.x >> 3) * NWAVES + wid, NG = (G >> 3) * NWAVES, r8 = lane >> 3, c8 = lane & 7, r84 = r8 * 4;
    const int* EIDL = (const int*)(ws + WS_EIDL); const bf16_t* HB = (const bf16_t*)(ws + WS_HB); float* DOTP = (float*)(ws + WS_DOTP);
    const unsigned char* tbl = ws + WS_PU + (size_t)layer * NEXP * D + 16 * c8;
    const int taddr = (8 * (lane & 7) + (lane >> 3)) * 4;
#define UP_IDS(T) do { ea = EIDL[(size_t)(T) * 128 + lane]; eb = EIDL[(size_t)(T) * 128 + 64 + lane]; const u32x4* hp8_ = (const u32x4*)(HB + (size_t)(T) * D + 128 * slice + 16 * c8); h0 = hp8_[0]; h1 = hp8_[1]; } while (0)
#define UP_ISSUE(rb, hq) do { unsigned eo_[16]; _Pragma("unroll") for (int i = 0; i < 16; ++i) eo_[i] = (unsigned)lane_get(ea, eb, i, r84); \
        hq[0] = h0.x; hq[1] = h0.y; hq[2] = h0.z; hq[3] = h0.w; hq[4] = h1.x; hq[5] = h1.y; hq[6] = h1.z; hq[7] = h1.w; \
        _Pragma("unroll") for (int i = 0; i < 16; ++i) rb[i] = *(const u32x4*)(ubase + eo_[i]); } while (0)
#define UP_COMP(rb, hq, T) do { float v0 = 0.f, v1 = 0.f; _Pragma("unroll") for (int hh = 0; hh < 2; ++hh) { \
            float d0 = dot16_fp8_bf16(rb[8 * hh + 0], hq), d1 = dot16_fp8_bf16(rb[8 * hh + 1], hq), d2 = dot16_fp8_bf16(rb[8 * hh + 2], hq), d3 = dot16_fp8_bf16(rb[8 * hh + 3], hq), \
                  d4 = dot16_fp8_bf16(rb[8 * hh + 4], hq), d5 = dot16_fp8_bf16(rb[8 * hh + 5], hq), d6 = dot16_fp8_bf16(rb[8 * hh + 6], hq), d7 = dot16_fp8_bf16(rb[8 * hh + 7], hq); \
            asm volatile("s_nop 1\n\t" PEER_DPP8("quad_perm:[1,0,3,2] row_mask:0xf bank_mask:0xf bound_ctrl:1") PEER_DPP8("quad_perm:[2,3,0,1] row_mask:0xf bank_mask:0xf bound_ctrl:1") \
                         PEER_DPP8("row_half_mirror row_mask:0xf bank_mask:0xf bound_ctrl:1") : "+v"(d0), "+v"(d1), "+v"(d2), "+v"(d3), "+v"(d4), "+v"(d5), "+v"(d6), "+v"(d7)); \
            float v = d0; v = c8 == 1 ? d1 : v; v = c8 == 2 ? d2 : v; v = c8 == 3 ? d3 : v; v = c8 == 4 ? d4 : v; v = c8 == 5 ? d5 : v; v = c8 == 6 ? d6 : v; v = c8 == 7 ? d7 : v; \
            if (hh == 0) v0 = v; else v1 = v; } \
        float* dp_ = DOTP + ((size_t)(T) * NS32 + slice) * 128; \
        dp_[lane] = __int_as_float(__builtin_amdgcn_ds_bpermute(taddr, __float_as_int(v0))); dp_[64 + lane] = __int_as_float(__builtin_amdgcn_ds_bpermute(taddr, __float_as_int(v1))); } while (0)
#pragma unroll 1
    for (int sp = 0; sp < NS32 / 8; ++sp) {
        const int slice = x + 8 * sp;
        const unsigned char* ubase = tbl + 128 * slice;
        if (g >= MROWS) continue;
        int ea, eb; u32x4 h0, h1; u32x4 ra[16], rc[16]; unsigned qa[8], qc[8];
        UP_IDS(g); UP_ISSUE(ra, qa);
        if (g + NG < MROWS) UP_IDS(g + NG);
#pragma unroll 1
        for (int tok = g; tok < MROWS; tok += 2 * NG) {
            const int t1 = tok + NG, t2 = tok + 2 * NG;
            if (t1 < MROWS) { UP_ISSUE(rc, qc); if (t2 < MROWS) UP_IDS(t2); }
            __builtin_amdgcn_sched_barrier(0);
            UP_COMP(ra, qa, tok);
            __builtin_amdgcn_sched_barrier(0);
            if (t1 < MROWS) {
                if (t2 < MROWS) { UP_ISSUE(ra, qa); if (t2 + NG < MROWS) UP_IDS(t2 + NG); }
                __builtin_amdgcn_sched_barrier(0);
                UP_COMP(rc, qc, t1);
                __builtin_amdgcn_sched_barrier(0);
            }
        }
    }
#undef UP_IDS
#undef UP_ISSUE
#undef UP_COMP
}

template <bool DRY = false>
__device__ __forceinline__ void phase_vacc32p(unsigned char* ws, int layer, int G) {
    int tid = threadIdx.x; asm volatile("" : "+v"(tid)); const int lane = tid & 63, wid = __builtin_amdgcn_readfirstlane(tid >> 6);
    const int x = blockIdx.x & 7, g = (blockIdx.x >> 3) * NWAVES + wid, NG = (G >> 3) * NWAVES, r8 = lane >> 3, c8 = lane & 7, r84 = r8 * 4;
    const int* EIDL = (const int*)(ws + WS_EIDL); const float* WL = (const float*)(ws + WS_WL); float* H = (float*)(ws + (DRY ? WS_WAG : WS_H));
    const unsigned char* tbl = ws + WS_PV + (size_t)layer * NEXP * D + 16 * c8;
    const int h3 = (lane >> 3) & 1, xaddr = (lane ^ 8) << 2;
#define VP_IDS(T) do { ea = EIDL[(size_t)(T) * 128 + lane]; eb = EIDL[(size_t)(T) * 128 + 64 + lane]; wa = WL[(size_t)(T) * 128 + lane]; wb = WL[(size_t)(T) * 128 + 64 + lane]; } while (0)
#define VP_ISSUE(rb, wv) do { unsigned eo_[16]; _Pragma("unroll") for (int i = 0; i < 16; ++i) { eo_[i] = (unsigned)lane_get(ea, eb, i, r84); wv[i] = __int_as_float(lane_get(__float_as_int(wa), __float_as_int(wb), i, r84)); } \
        _Pragma("unroll") for (int i = 0; i < 16; ++i) rb[i] = *(const u32x4*)(vbase + eo_[i]); } while (0)
#define VP_COMP(rb, wvv, T) do { float acc[16]; _Pragma("unroll") for (int j = 0; j < 16; ++j) acc[j] = 0.f; \
        _Pragma("unroll") for (int i = 0; i < 16; ++i) { const float w = wvv[i]; const unsigned wv_[4] = {rb[i].x, rb[i].y, rb[i].z, rb[i].w}; \
            _Pragma("unroll") for (int q = 0; q < 4; ++q) { const f32x2 lo = __builtin_amdgcn_cvt_pk_f32_fp8((int)wv_[q], false), hi = __builtin_amdgcn_cvt_pk_f32_fp8((int)wv_[q], true); \
                acc[4 * q + 0] = fmaf(w, lo.x, acc[4 * q + 0]); acc[4 * q + 1] = fmaf(w, lo.y, acc[4 * q + 1]); acc[4 * q + 2] = fmaf(w, hi.x, acc[4 * q + 2]); acc[4 * q + 3] = fmaf(w, hi.y, acc[4 * q + 3]); } } \
        float o8[8], o4[4], o2[2]; \
        _Pragma("unroll") for (int j = 0; j < 8; ++j) { const auto sw = __builtin_amdgcn_permlane32_swap(__float_as_uint(acc[j]), __float_as_uint(acc[8 + j]), false, false); const unsigned s0 = sw[0], s1 = sw[1]; o8[j] = __uint_as_float(s0) + __uint_as_float(s1); } \
        _Pragma("unroll") for (int j = 0; j < 4; ++j) { const auto sw = __builtin_amdgcn_permlane16_swap(__float_as_uint(o8[j]), __float_as_uint(o8[4 + j]), false, false); const unsigned s0 = sw[0], s1 = sw[1]; o4[j] = __uint_as_float(s0) + __uint_as_float(s1); } \
        _Pragma("unroll") for (int j = 0; j < 2; ++j) { const float keep = h3 ? o4[2 + j] : o4[j], give = h3 ? o4[j] : o4[2 + j]; o2[j] = keep + __int_as_float(__builtin_amdgcn_ds_bpermute(xaddr, __float_as_int(give))); } \
        f32x2* hp_ = (f32x2*)(H + (size_t)(T) * D + 128 * slice + 16 * c8 + 2 * r8); f32x2 hv = *hp_; hv[0] += o2[0]; hv[1] += o2[1]; *hp_ = hv; } while (0)
#pragma unroll 1
    for (int sp = 0; sp < NS32 / 8; ++sp) {
        const int slice = x + 8 * sp;
        const unsigned char* vbase = tbl + 128 * slice;
        if (g >= MROWS) continue;
        int ea, eb; float wa, wb; u32x4 ra[16], rc[16]; float wva[16], wvc[16];
        VP_IDS(g); VP_ISSUE(ra, wva);
        if (g + NG < MROWS) VP_IDS(g + NG);
#pragma unroll 1
        for (int tok = g; tok < MROWS; tok += 2 * NG) {
            const int t1 = tok + NG, t2 = tok + 2 * NG;
            if (t1 < MROWS) { VP_ISSUE(rc, wvc); if (t2 < MROWS) VP_IDS(t2); }
            __builtin_amdgcn_sched_barrier(0);
            VP_COMP(ra, wva, tok);
            __builtin_amdgcn_sched_barrier(0);
            if (t1 < MROWS) {
                if (t2 < MROWS) { VP_ISSUE(ra, wva); if (t2 + NG < MROWS) VP_IDS(t2 + NG); }
                __builtin_amdgcn_sched_barrier(0);
                VP_COMP(rc, wvc, t1);
                __builtin_amdgcn_sched_barrier(0);
            }
        }
    }
#undef VP_IDS
#undef VP_ISSUE
#undef VP_COMP
}
#define MK_PER_PHASE 0
#ifndef PROBE_DUP
#define PROBE_DUP 0
#endif
#ifndef MK_PER_PHASE
#define MK_PER_PHASE 0
#endif
constexpr int NPHASE = 21;
#ifndef S5_SHARE_V
#define S5_SHARE_V 30000
#endif
constexpr int S5_SHARE = S5_SHARE_V;
#ifndef P4_L1_LO_V
#define P4_L1_LO_V 32768
#endif
constexpr int P4_L1_LO = P4_L1_LO_V;
#ifndef KSPLIT_OUT_V
#define KSPLIT_OUT_V 2048
#endif
constexpr int KSPLIT_OUT = KSPLIT_OUT_V;
struct Args { const float* in[34]; float* out; unsigned char* ws; int ph_lo, ph_hi; };

__global__ void __launch_bounds__(NTHREADS, 2) fwd(Args args) {
    extern __shared__ __attribute__((aligned(16))) unsigned char lds_raw[];
    LAS unsigned char* lds = (LAS unsigned char*)lds_raw;
    const int tid = threadIdx.x, G = gridDim.x, cblk = blockIdx.x;
    unsigned char* ws = args.ws;
    volatile LAS unsigned* MISC = (volatile LAS unsigned*)(lds + MISC_OFF);
    if (tid < 64) MISC[tid] = 0u;
    __syncthreads();
    const int lo = args.ph_lo, hi = args.ph_hi;
    unsigned* barw = (unsigned*)(ws + WS_CTL) + CW_BAR;
    XcdBarrier bar; bar.bar = barw; bar.x = 0; bar.st = nullptr;
    if (hi - lo > 1) bar = xcd_barrier_post(barw, MISC + 8);
#ifndef PH_MASK
#define PH_MASK 0x1fffff
#endif
#define IN(k) (((PH_MASK >> (k)) & 1) && lo <= (k) && (k) < hi)
#define SEAM(k) do { if ((k) + 1 < hi) xcd_barrier(bar); } while (0)
    bf16_t* HB = (bf16_t*)(ws + WS_HB); float* H = (float*)(ws + WS_H);

    if (IN(0)) {
#if (PROBE_DUP & 1)
        phase_prologue<1>(args.in, ws, lds, G);
#endif
#if (PROBE_DUP & 131072)
        phase_prologue<2>(args.in, ws, lds, G);
#endif
        phase_prologue(args.in, ws, lds, G); SEAM(0); }
    if (IN(1)) { pg8::Gemm g{HB, (const bf16_t*)(ws + WS_W1T), D, D, D}; pg8::StaticOrder S; S.init(MX / 256, ZLD / 256, G, cblk);
        EpiBf16 E{(bf16_t*)(ws + WS_Z), ZLD, nullptr};
#if (PROBE_DUP & 2)
        pg8::gemm_phase<EpiBf16, pg8::StaticOrder, true>(lds, g, S, E);
#endif
        pg8::gemm_phase<EpiBf16, pg8::StaticOrder, true>(lds, g, S, E);
        pg8::gemm_tail(HB + (size_t)MX * D, g, ZLD / 256, S, E, lds);
        {
            const int nunits = (MX / 256) * (ZLD / 256), nfull = nunits - (nunits / G) * G;
            int tid2 = threadIdx.x; asm volatile("" : "+v"(tid2)); const int w2 = __builtin_amdgcn_readfirstlane(tid2 >> 6);
            if (nfull > 0 && nfull < G) { if (cblk >= nfull) { early_weights(args.in, ws, (LAS float*)(lds + w2 * 16384), (cblk - nfull) * NWAVES + w2, (G - nfull) * NWAVES, (size_t)(cblk - nfull) * NTHREADS + tid2, (size_t)(G - nfull) * NTHREADS, tid2 & 63);
                                                                late_weights<2>(args.in, ws, (LAS float*)(lds + w2 * 16384), (cblk - nfull) * NWAVES + w2, (G - nfull) * NWAVES, tid2 & 63); } }
            else { early_weights(args.in, ws, (LAS float*)(lds + w2 * 16384), cblk * NWAVES + w2, G * NWAVES, (size_t)cblk * NTHREADS + tid2, (size_t)G * NTHREADS, tid2 & 63);
                   late_weights<2>(args.in, ws, (LAS float*)(lds + w2 * 16384), cblk * NWAVES + w2, G * NWAVES, tid2 & 63); } }
        SEAM(1); }
    if (IN(2)) {
#if (PROBE_DUP & 4)
        phase_prep(args.in[8], ws, G);
#endif
        phase_prep(args.in[8], ws, G); SEAM(2);
#if (PROBE_DUP & 4096)
        for (int r = 0; r < 20; ++r) xcd_barrier(bar);
#endif
    }
    if (IN(3)) {
        { pg8::Gemm g{(const bf16_t*)(ws + WS_LA), (const bf16_t*)(ws + WS_BTL), 512, 256, 256}; pg8::StaticOrder S; S.init(MX / 256, 24, G, cblk, 16, 256);
          EpiF32 E{(float*)(ws + WS_WAG), WAGLD, 0, nullptr, nullptr};
          pg8::gemm_phase<EpiF32, pg8::StaticOrder, true>(lds, g, S, E);
          pg8::gemm_tail((const bf16_t*)(ws + WS_LA) + (size_t)MX * 512, g, 24, S, E, lds); }
        { pg8::Gemm g{(const bf16_t*)(ws + WS_PM), (const bf16_t*)(ws + WS_BTP), 2048, 512, 512}; pg8::StaticOrder S; S.init(MX / 256, 8, G, cblk, 2, 512);
          EpiBf16 E{(bf16_t*)(ws + WS_Y), D, args.in[7]};
          pg8::gemm_phase<EpiBf16, pg8::StaticOrder, true>(lds, g, S, E);
          pg8::gemm_tail((const bf16_t*)(ws + WS_PM) + (size_t)MX * 2048, g, 8, S, E, lds); }
        SEAM(3); }
    if (IN(4)) {
#if (PROBE_DUP & 16)
        phase_rwkv<2>(args.in, ws, lds, G);
#endif
#if (PROBE_DUP & 32)
        phase_rwkv<1>(args.in, ws, lds, G);
#endif
        if (G >= 256) {
            if (cblk < 128) phase_rwkv(args.in, ws, lds, G);
            else { const int G2 = G - 128, c2 = cblk - 128;
                { pg8::Gemm g{(const bf16_t*)(ws + WS_Y), (const bf16_t*)(ws + WS_WOT), D, D, KSPLIT_OUT}; pg8::StaticOrder S; S.init(MX / 256, D / 256, G2, c2);
                  EpiF32 E{H, D, 1, args.in[0], args.in[1]};
                  pg8::gemm_phase<EpiF32, pg8::StaticOrder, true>(lds, g, S, E);
                  pg8::gemm_tail((const bf16_t*)(ws + WS_Y) + (size_t)MX * D, g, D / 256, S, E, lds); }
                { int tid2 = threadIdx.x; asm volatile("" : "+v"(tid2)); const int w2 = __builtin_amdgcn_readfirstlane(tid2 >> 6);
                  peer_convert(args.in, ws, c2 * NWAVES + w2, G2 * NWAVES, tid2 & 63, 0, 0, NEXP);
                  peer_convert_v<8>(args.in, ws, lds + w2 * 16384, c2 * NWAVES + w2, G2 * NWAVES, tid2 & 63, 0);
                  peer_convert_v<8>(args.in, ws, lds + w2 * 16384, c2 * NWAVES + w2, G2 * NWAVES, tid2 & 63, 1);
#if (PROBE_DUP & 4194304)
                  peer_convert_v<8>(args.in, ws, lds + w2 * 16384, c2 * NWAVES + w2, G2 * NWAVES, tid2 & 63, 1);
#endif
                  late_weights<0>(args.in, ws, (LAS float*)(lds + w2 * 16384), c2 * NWAVES + w2, G2 * NWAVES, tid2 & 63);
#if (PROBE_DUP & 64)
                  late_weights<0>(args.in, ws, (LAS float*)(lds + w2 * 16384), c2 * NWAVES + w2, G2 * NWAVES, tid2 & 63);
                  late_weights<0>(args.in, ws, (LAS float*)(lds + w2 * 16384), c2 * NWAVES + w2, G2 * NWAVES, tid2 & 63);
#endif
                } }
        } else {
            phase_rwkv(args.in, ws, lds, G);
            { pg8::Gemm g{(const bf16_t*)(ws + WS_Y), (const bf16_t*)(ws + WS_WOT), D, D, KSPLIT_OUT}; pg8::StaticOrder S; S.init(MX / 256, D / 256, G, cblk);
              EpiF32 E{H, D, 1, args.in[0], args.in[1]};
              pg8::gemm_phase<EpiF32, pg8::StaticOrder, true>(lds, g, S, E);
              pg8::gemm_tail((const bf16_t*)(ws + WS_Y) + (size_t)MX * D, g, D / 256, S, E, lds); }
            { int tid2 = threadIdx.x; asm volatile("" : "+v"(tid2)); const int w2 = __builtin_amdgcn_readfirstlane(tid2 >> 6);
              peer_convert(args.in, ws, cblk * NWAVES + w2, G * NWAVES, tid2 & 63, 0, 0, NEXP);
              peer_convert_v<8>(args.in, ws, lds + w2 * 16384, cblk * NWAVES + w2, G * NWAVES, tid2 & 63, 0);
              peer_convert_v<8>(args.in, ws, lds + w2 * 16384, cblk * NWAVES + w2, G * NWAVES, tid2 & 63, 1);
              late_weights<0>(args.in, ws, (LAS float*)(lds + w2 * 16384), cblk * NWAVES + w2, G * NWAVES, tid2 & 63); }
        }
        SEAM(4); }
    if (IN(5)) { pg8::Gemm g{(const bf16_t*)(ws + WS_Y) + KSPLIT_OUT, (const bf16_t*)(ws + WS_WOT) + KSPLIT_OUT, D, D, D - KSPLIT_OUT}; pg8::StaticOrder S; S.init(MX / 256, D / 256, G, cblk);
        EpiF32 E{H, D, 1, nullptr, nullptr};
        pg8::gemm_phase<EpiF32, pg8::StaticOrder, true>(lds, g, S, E);
        pg8::gemm_tail((const bf16_t*)(ws + WS_Y) + (size_t)MX * D + KSPLIT_OUT, g, D / 256, S, E, lds); SEAM(5); }
    if (IN(6)) { phase_norm<false, true>(ws, lds, G, args.in[3]); SEAM(6); }
    if (IN(7)) { pg8::Gemm g{HB, (const bf16_t*)(ws + WS_WST), D, D, D}; pg8::StaticOrder S; S.init(MX / 256, 8, G, cblk);
        EpiF32 E{(float*)(ws + WS_SC), 2048, 0, nullptr, nullptr};
        pg8::gemm_phase<EpiF32, pg8::StaticOrder, true>(lds, g, S, E);
        pg8::gemm_tail(HB + (size_t)MX * D, g, 8, S, E, lds); SEAM(7); }
    if (IN(8)) {
#if (PROBE_DUP & 256)
        phase_topk(ws, G);
#endif
        phase_topk(ws, G); SEAM(8); }
    if (IN(9)) {
#if (PROBE_DUP & 512)
        phase_udot(ws, 0, G);
#endif
        phase_udot(ws, 0, G); SEAM(9); }
    if (IN(10)) { phase_pw<8>(ws, 0, G); xcd_barrier(bar);
#if (PROBE_DUP & 2048)
        phase_vaccH<true, false, true>(ws, lds, 0, G);
#endif
#if (PROBE_DUP & 1048576)
        phase_vaccH<false, true, true>(ws, lds, 0, G);
#endif
        phase_vaccH(ws, lds, 0, G); SEAM(10); }
    if (IN(11)) { phase_norm<false>(ws, lds, G); SEAM(11); }
    if (IN(12)) { pg8::Gemm g{HB, (const bf16_t*)(ws + WS_WIO), D, D, D}; pg8::StaticOrder S; S.init(MX / 256, 8, G, cblk);
        EpiBf16 E{(bf16_t*)(ws + WS_U), 2048, nullptr};
        pg8::gemm_phase<EpiBf16, pg8::StaticOrder, true>(lds, g, S, E);
        pg8::gemm_tail(HB + (size_t)MX * D, g, 8, S, E, lds); SEAM(12); }
    if (IN(13)) {
        phase_s5p(args.in, ws, lds, G);
        { int tid2 = threadIdx.x; asm volatile("" : "+v"(tid2)); const int w2 = __builtin_amdgcn_readfirstlane(tid2 >> 6);
          if (w2 >= 4) { peer_convert(args.in, ws, cblk * 4 + (w2 - 4), G * 4, tid2 & 63, 1, 0, NEXP);
                         late_weights<1>(args.in, ws, (LAS float*)(lds + 65536 + (w2 - 4) * 8704), cblk * 4 + (w2 - 4), G * 4, tid2 & 63); } }
        SEAM(13); }
    if (IN(14)) { pg8::Gemm g{(const bf16_t*)(ws + WS_YS), (const bf16_t*)(ws + WS_WGT), 2048, 2048, 2048}; pg8::StaticOrder S; S.init(MX / 256, 32, G, cblk);
        EpiGlu E{H};
        pg8::gemm_phase<EpiGlu, pg8::StaticOrder, true>(lds, g, S, E);
        pg8::gemm_tail((const bf16_t*)(ws + WS_YS) + (size_t)MX * 2048, g, 32, S, E, lds); SEAM(14); }
    if (IN(15)) { phase_norm<false, true>(ws, lds, G, args.in[3] + D); SEAM(15); }
    if (IN(16)) { pg8::Gemm g{HB, (const bf16_t*)(ws + WS_WST) + (size_t)2048 * D, D, D, D}; pg8::StaticOrder S; S.init(MX / 256, 8, G, cblk);
        EpiF32 E{(float*)(ws + WS_SC), 2048, 0, nullptr, nullptr};
        pg8::gemm_phase<EpiF32, pg8::StaticOrder, true>(lds, g, S, E);
        pg8::gemm_tail(HB + (size_t)MX * D, g, 8, S, E, lds); SEAM(16); }
    if (IN(17)) { phase_topk(ws, G); SEAM(17); }
    if (IN(18)) { phase_udot(ws, 1, G); SEAM(18); }
    if (IN(19)) { phase_pw<8>(ws, 1, G); xcd_barrier(bar); phase_vaccH(ws, lds, 1, G); SEAM(19); }
    if (IN(20)) {
#if (PROBE_DUP & 262144)
        { int t3 = threadIdx.x; asm volatile("" : "+v"(t3)); unsigned a[8];
#pragma unroll
          for (int j = 0; j < 8; ++j) a[j] = (unsigned)(t3 + j) * 0x01010101u;
#pragma unroll 2
          for (int i = 0; i < 1024; ++i) {
#pragma unroll
              for (int j = 0; j < 8; ++j) { const f32x2 r = __builtin_amdgcn_cvt_pk_f32_fp8((int)a[j], false); a[j] ^= __float_as_uint(r.x) >> 9; } }
          ((unsigned*)(ws + WS_WAG))[(size_t)cblk * NTHREADS + t3] = a[0] ^ a[1] ^ a[2] ^ a[3] ^ a[4] ^ a[5] ^ a[6] ^ a[7]; }
#endif
#if (PROBE_DUP & 524288)
        { int t3 = threadIdx.x; asm volatile("" : "+v"(t3)); float a = (float)t3;
#pragma unroll 16
          for (int i = 0; i < 8192; ++i) { const float r = fmaf(a, 1.0001f, 0.5f); a = __uint_as_float(__float_as_uint(r) ^ (__float_as_uint(a) >> 9)); }
          ((float*)(ws + WS_WAG))[(size_t)cblk * NTHREADS + t3] = a; }
#endif
        phase_final(args.in[4], args.out, ws, G); }
#undef IN
#undef SEAM
}

extern "C" void kernel_launch(void* const* d_in, const int* in_sizes, int n_in, void* d_out, int out_size, void* d_ws, size_t ws_size, hipStream_t stream) {
    static int grid = 0;
    if (grid == 0) {
        if (n_in != 34 || out_size != MX * D || ws_size < WS_END) { fprintf(stderr, "kernel_launch: unexpected shapes (n_in %d, out %d, ws %zu < %zu); nothing launched\n", n_in, out_size, ws_size, (size_t)WS_END); grid = -1; return; }
        int dev = 0, cus = 0, per_cu = 0;
        if (hipGetDevice(&dev) != hipSuccess || hipDeviceGetAttribute(&cus, hipDeviceAttributeMultiprocessorCount, dev) != hipSuccess) { grid = -1; return; }
        if (hipFuncSetAttribute((const void*)fwd, hipFuncAttributeMaxDynamicSharedMemorySize, LDS_BYTES) != hipSuccess) { fprintf(stderr, "kernel_launch: hipFuncSetAttribute failed\n"); grid = -1; return; }
        if (hipOccupancyMaxActiveBlocksPerMultiprocessor(&per_cu, (const void*)fwd, NTHREADS, LDS_BYTES) != hipSuccess || per_cu < 1) { fprintf(stderr, "kernel_launch: occupancy query reports %d workgroups per CU\n", per_cu); }
        (void)hipGetLastError();
        grid = cus;
        if (grid % 8 != 0) { fprintf(stderr, "kernel_launch: %d CUs: the PEER slicing needs a multiple of 8 workgroups\n", grid); grid = (grid / 8) * 8; if (grid < 8) { grid = -1; return; } }
    }
    if (grid < 0) return;
    (void)hipMemsetAsync((char*)d_ws + WS_CTL, 0, CTL_ZERO_BYTES, stream);
    Args a{};
    for (int i = 0; i < 34; ++i) a.in[i] = (const float*)d_in[i];
    a.out = (float*)d_out; a.ws = (unsigned char*)d_ws;
#if MK_PER_PHASE
    for (int p = 0; p < NPHASE; ++p) { a.ph_lo = p; a.ph_hi = p + 1; hipLaunchKernelGGL(fwd, dim3(grid), dim3(NTHREADS), LDS_BYTES, stream, a); }
#else
    a.ph_lo = 0; a.ph_hi = NPHASE; hipLaunchKernelGGL(fwd, dim3(grid), dim3(NTHREADS), LDS_BYTES, stream, a);
#endif
}
```
